# Optimizing an MI355X kernel written in HIP

```python
import math
import jax, jax.numpy as jnp
from jax import lax
import numpy as np

D_MODEL = 1024
BATCH = 4
SEQ = 4096
DEPTH = 1

CHUNK = 64
D_MIX = D_MODEL
RET_WIDTH = D_MIX // 2
RET_HEADS = 4
RET_HEAD_DIM = RET_WIDTH // RET_HEADS
POOL_WIDTH = D_MIX - RET_WIDTH
POOL_WINDOWS = (2, 4, 8, 16)
POOL_GROUPS = len(POOL_WINDOWS)
POOL_GROUP_WIDTH = POOL_WIDTH // POOL_GROUPS
D_IN = 4 * RET_WIDTH + POOL_WIDTH
ROPE_BASE = 10000.0
N_EXPERTS = 32
TOP_K = 4
D_FF_EXPERT = D_MODEL
SWIGLU_LIMIT = 7.0
SWIGLU_ALPHA = 1.702
MOE_BLOCK = 128
EPS = 1e-6

kernel_name = "hybrid_retention_pool_moe_block"


def rms_norm(x, w):
    x32 = x.astype(jnp.float32)
    y = x32 * lax.rsqrt(jnp.mean(x32 * x32, axis=-1, keepdims=True) + EPS)
    return (y * w.astype(jnp.float32)).astype(x.dtype)


def rope_tables(seq_len, dim):
    half = dim // 2
    inv = ROPE_BASE ** (-jnp.arange(half, dtype=jnp.float32) / half)
    ang = jnp.arange(seq_len, dtype=jnp.float32)[:, None] * inv[None, :]
    return jnp.cos(ang), jnp.sin(ang)


def apply_rope(t, cos, sin):
    half = t.shape[-1] // 2
    t1, t2 = t[..., :half], t[..., half:]
    c, s = cos.astype(t.dtype), sin.astype(t.dtype)
    return jnp.concatenate([t1 * c - t2 * s, t1 * s + t2 * c], axis=-1)


def retention(q, k, v):
    B, S, _ = q.shape
    H, d, C = RET_HEADS, RET_HEAD_DIM, CHUNK
    NC = S // C

    def heads(t):
        return t.reshape(B, S, H, d).transpose(0, 2, 1, 3)

    cos, sin = rope_tables(S, d)
    qh = apply_rope(heads(q), cos, sin)
    kh = apply_rope(heads(k), cos, sin) * (d ** -0.5)
    vh = heads(v)
    qc = qh.reshape(B, H, NC, C, d)
    kc = kh.reshape(B, H, NC, C, d)
    vc = vh.reshape(B, H, NC, C, d)

    log_g = jnp.log1p(-jnp.exp2(-5.0 - jnp.arange(H, dtype=jnp.float32)))
    pos = jnp.arange(C, dtype=jnp.float32)
    dt = q.dtype

    inner_decay = jnp.exp(log_g[:, None, None] * jnp.abs(pos[:, None] - pos[None, :])).astype(dt)
    scores = jnp.einsum('bhcnd,bhcmd->bhcnm', qc, kc) * inner_decay[None, :, None]
    inner = jnp.einsum('bhcnm,bhcmv->bhcnv', scores, vc)

    k_decay = jnp.exp(log_g[:, None] * (C - 1 - pos)[None, :]).astype(dt)
    U = jnp.einsum('bhcmd,bhcmv->cbhdv', kc * k_decay[None, :, None, :, None], vc)
    chunk_decay = jnp.exp(log_g * C).astype(U.dtype)[None, :, None, None]

    def step(R, U_c):
        return chunk_decay * R + U_c, R

    _, R_prev = lax.scan(step, jnp.zeros_like(U[0]), U)
    q_decay = jnp.exp(log_g[:, None] * (pos + 1.0)[None, :]).astype(dt)
    cross = jnp.einsum('bhcnd,cbhdv->bhcnv', qc * q_decay[None, :, None, :, None], R_prev)

    o = (inner + cross).reshape(B, H, S, d).astype(jnp.float32)
    o = o * lax.rsqrt(jnp.mean(o * o, axis=-1, keepdims=True) + EPS)
    return o.transpose(0, 2, 1, 3).reshape(B, S, H * d).astype(dt)


def pool_mixer(p, w_pool, pool_scale):
    B, S, _ = p.shape
    cs = jnp.cumsum(p.astype(jnp.float32), axis=1)
    t = jnp.arange(S, dtype=jnp.int32)
    outs = []
    for g, w in enumerate(POOL_WINDOWS):
        c = cs[..., g * POOL_GROUP_WIDTH:(g + 1) * POOL_GROUP_WIDTH]
        lagged = jnp.pad(c, ((0, 0), (w, 0), (0, 0)))[:, :S]
        count = jnp.minimum(t + 1, w).astype(jnp.float32)[None, :, None]
        outs.append((c - lagged) / count)
    pooled = jnp.stack(outs, axis=2) - p.astype(jnp.float32).reshape(B, S, POOL_GROUPS, POOL_GROUP_WIDTH)
    mixed = jnp.einsum('bsgc,gcd->bsgd', pooled.astype(p.dtype), w_pool)
    return mixed.reshape(B, S, POOL_WIDTH) * pool_scale


def moe(h, w_router, b_router, w_gu, b_gu, w_down, b_down):
    B, S, D = h.shape
    N = B * S
    A = N * TOP_K
    F = D_FF_EXPERT
    xt = h.reshape(N, D)
    logits = (xt @ w_router + b_router).astype(jnp.float32)
    top_vals, top_idx = lax.top_k(logits, TOP_K)
    gates = jax.nn.softmax(top_vals, axis=-1).astype(h.dtype)

    e_flat = top_idx.reshape(A).astype(jnp.int32)
    g_flat = gates.reshape(A)
    tok_flat = jnp.arange(A, dtype=jnp.int32) // TOP_K
    order = jnp.argsort(e_flat)
    e_sorted = e_flat[order]
    counts = jnp.zeros((N_EXPERTS,), jnp.int32).at[e_flat].add(1)
    padded = ((counts + MOE_BLOCK - 1) // MOE_BLOCK) * MOE_BLOCK
    pad_end = jnp.cumsum(padded)
    pad_start = pad_end - padded
    start = jnp.cumsum(counts) - counts
    dest = pad_start[e_sorted] + (jnp.arange(A, dtype=jnp.int32) - start[e_sorted])

    n_blocks = (A + MOE_BLOCK - 1) // MOE_BLOCK + N_EXPERTS
    P = n_blocks * MOE_BLOCK
    row_tok = jnp.full((P,), N, jnp.int32).at[dest].set(tok_flat[order])
    row_gate = jnp.zeros((P,), h.dtype).at[dest].set(g_flat[order])
    block_start = jnp.arange(n_blocks, dtype=jnp.int32) * MOE_BLOCK
    block_exp = jnp.minimum(jnp.searchsorted(pad_end, block_start, side='right'), N_EXPERTS - 1)

    x_pad = jnp.concatenate([xt, jnp.zeros((1, D), xt.dtype)], axis=0)
    xb = x_pad[row_tok].reshape(n_blocks, MOE_BLOCK, D)

    def expert_block(args):
        xblk, e = args
        gu = xblk @ w_gu[e] + b_gu[e]
        x_glu = jnp.minimum(gu[:, :F], SWIGLU_LIMIT)
        x_lin = jnp.clip(gu[:, F:], -SWIGLU_LIMIT, SWIGLU_LIMIT)
        act = x_glu * jax.nn.sigmoid(SWIGLU_ALPHA * x_glu) * (x_lin + 1.0)
        return act @ w_down[e] + b_down[e]

    yb = lax.map(expert_block, (xb, block_exp))
    y = yb.reshape(P, D) * row_gate[:, None]
    out = jax.ops.segment_sum(y, row_tok, num_segments=N + 1)[:N]
    return out.reshape(B, S, D)


def setup_inputs(seed: int = 0) -> dict:
    key = jax.random.key(seed)
    ks = jax.random.split(key, 16)
    f32 = jnp.float32
    L, E, D, F = DEPTH, N_EXPERTS, D_MODEL, D_FF_EXPERT
    return {
        "x": jax.random.normal(ks[0], (BATCH, SEQ, D), f32),
        "norm_mix_w": 1.0 + 0.02 * jax.random.normal(ks[1], (L, D), f32),
        "w_in": jax.random.normal(ks[2], (L, D, D_IN), f32) * D ** -0.5,
        "ret_norm_w": 1.0 + 0.02 * jax.random.normal(ks[3], (L, RET_WIDTH), f32),
        "w_pool": jax.random.normal(ks[4], (L, POOL_GROUPS, POOL_GROUP_WIDTH, POOL_GROUP_WIDTH), f32) * POOL_GROUP_WIDTH ** -0.5,
        "pool_scale": 1.0 + 0.02 * jax.random.normal(ks[5], (L, POOL_WIDTH), f32),
        "w_out": jax.random.normal(ks[6], (L, D_MIX, D), f32) * D_MIX ** -0.5,
        "norm_ffn_w": 1.0 + 0.02 * jax.random.normal(ks[7], (L, D), f32),
        "w_router": jax.random.normal(ks[8], (L, D, E), f32) * D ** -0.5,
        "b_router": 0.01 * jax.random.normal(ks[9], (L, E), f32),
        "w_gu": jax.random.normal(ks[10], (L, E, D, 2 * F), f32) * D ** -0.5,
        "b_gu": 0.02 * jax.random.normal(ks[11], (L, E, 2 * F), f32),
        "w_down": jax.random.normal(ks[12], (L, E, F, D), f32) * F ** -0.5,
        "b_down": 0.02 * jax.random.normal(ks[13], (L, E, D), f32),
        "norm_final_w": 1.0 + 0.02 * jax.random.normal(ks[14], (D,), f32),
    }


def reference(x, norm_mix_w, w_in, ret_norm_w, w_pool, pool_scale, w_out, norm_ffn_w,
              w_router, b_router, w_gu, b_gu, w_down, b_down, norm_final_w):
    for l in range(DEPTH):
        h = rms_norm(x, norm_mix_w[l])
        z = h @ w_in[l]
        q, k, v, g, p = jnp.split(z, [RET_WIDTH, 2 * RET_WIDTH, 3 * RET_WIDTH, 4 * RET_WIDTH], axis=-1)
        ret = retention(q, k, v) * ret_norm_w[l] * jax.nn.silu(g)
        pool = pool_mixer(p, w_pool[l], pool_scale[l])
        x = x + jnp.concatenate([ret, pool], axis=-1) @ w_out[l]
        h2 = rms_norm(x, norm_ffn_w[l])
        x = x + moe(h2, w_router[l], b_router[l], w_gu[l], b_gu[l], w_down[l], b_down[l])
    return rms_norm(x, norm_final_w)
```

```cpp
#include <hip/hip_runtime.h>
#include <cstdio>
#include <cstdint>
#include <cmath>

#ifndef DBG_ONLY9
#define DBG_ONLY9 0
#define DBG_STAGE 0
#endif
#ifndef DBG_SKIP_Y
#define DBG_SKIP_Y 0
#endif
#ifndef MK_N_LAUNCHES
#define MK_N_LAUNCHES 1
#endif
constexpr int PER_PHASE = 10;
constexpr int N_LAUNCHES = MK_N_LAUNCHES;

#define LAS __attribute__((address_space(3)))
#define GAS __attribute__((address_space(1)))
typedef unsigned short bf16_t;
typedef short bf16x8 __attribute__((ext_vector_type(8)));
typedef float f32x4 __attribute__((ext_vector_type(4)));
typedef float f32x2 __attribute__((ext_vector_type(2)));
typedef unsigned u32x4 __attribute__((ext_vector_type(4)));
typedef unsigned u32x2 __attribute__((ext_vector_type(2)));
typedef GAS unsigned gu32;

constexpr int NTOK = 16384, D = 1024, SEQ = 4096, DIN = 2560, NE = 32, FF = 1024, LISTCAP = 16384;
constexpr int NWAVES = 8;
constexpr float EPS = 1e-6f;

constexpr size_t MiB = 1u << 20;
constexpr size_t WS_CTL = 0, CTL_ZERO_BYTES = 1 * MiB;
constexpr size_t WS_LIST = 1 * MiB;
constexpr size_t WS_GATE = 3 * MiB;
constexpr size_t WS_WR = 4 * MiB;
constexpr size_t WS_WPOOL = 4 * MiB + 256 * 1024;
constexpr size_t WS_WIN = 5 * MiB;
constexpr size_t WS_WOUT = 10 * MiB;
constexpr size_t WS_XN = 12 * MiB;
constexpr size_t WS_CAT = 45 * MiB;
constexpr size_t WS_U = 77 * MiB;
constexpr size_t WS_Z = 109 * MiB;
constexpr size_t WS_Y = 45 * MiB;
constexpr size_t WS_WGU = 189 * MiB;
constexpr size_t WS_WD = 317 * MiB;
constexpr size_t WS_ACT = 381 * MiB;
constexpr size_t WS_END = 525 * MiB;
static_assert(WS_Y + (size_t)65536 * 1024 * 2 <= WS_WGU, "Y overlay");
constexpr int CW_TMO = 0, CW_CODE = 1;
constexpr int CW_CNT = 1024;
constexpr int CW_BAR = 4096;

constexpr int RING_BYTES = 131072;
constexpr int LDSCTL_OFF = RING_BYTES, MISC_OFF = LDSCTL_OFF + 320, TAB_OFF = LDSCTL_OFF + 512;
constexpr int LDS_BYTES = 147456;

#define RLX_AGENT __ATOMIC_RELAXED, __HIP_MEMORY_SCOPE_AGENT
#define LDS_WAIT() asm volatile("s_waitcnt lgkmcnt(0)" ::: "memory")
#define VM_WAIT() asm volatile("s_waitcnt vmcnt(0)" ::: "memory")
typedef __bf16 bf16x2_t __attribute__((ext_vector_type(2)));
__device__ __forceinline__ unsigned cvt_pk_bf16(float lo, float hi) { const f32x2 v = {lo, hi}; const bf16x2_t b = __builtin_convertvector(v, bf16x2_t); return __builtin_bit_cast(unsigned, b); }
__device__ __forceinline__ float bf_lo(unsigned w) { return __uint_as_float(w << 16); }
__device__ __forceinline__ float bf_hi(unsigned w) { return __uint_as_float(w & 0xffff0000u); }
__device__ __forceinline__ float wave_sum(float v) {
#pragma unroll
    for (int o = 1; o < 64; o <<= 1) v += __shfl_xor(v, o);
    return v;
}
__device__ __forceinline__ f32x4 mfma16(bf16x8 a, bf16x8 b, f32x4 c) { return __builtin_amdgcn_mfma_f32_16x16x32_bf16(a, b, c, 0, 0, 0); }

namespace pg8 {
constexpr int BM = 256, BK = 64, HALF = 128, HTB = HALF * BK * 2, STAGE_BYTES = 8 * HTB, NXCD = 8, WGM = 8, KK = 1024;
__host__ __device__ __forceinline__ int lds_byte(int r, int c) { const int st = (r >> 4) * 2 + (c >> 5), rr = r & 15, cc = c & 31, ob = rr * 64 + cc * 2; return st * 1024 + (ob ^ (((ob >> 9) & 1) << 5)); }
__host__ __device__ __forceinline__ void stage_rc(int b, int& R, int& C) { const int st = b / 1024, sb = b % 1024, swz = sb ^ (((sb >> 9) & 1) << 5); R = (st >> 1) * 16 + swz / 64; C = (st & 1) * 32 + (swz % 64) / 2; }
__host__ __device__ __forceinline__ int perm32(int rho) { const int n = rho >> 4, i = rho & 15; return 8 * (i >> 2) + 4 * n + (i & 3); }

struct Unit { int pm, pn, e, rows, arow; };

__device__ __forceinline__ int xcd_remap(int L, int nwg) { const int q = nwg / NXCD, r = nwg % NXCD, xcd = L % NXCD, off = L / NXCD; return (xcd < r ? xcd * (q + 1) : r * (q + 1) + (xcd - r) * q) + off; }

struct DenseSched {
    const bf16_t* A; const bf16_t* Bt; int nM, nN, nwg, G, c;
    __device__ __forceinline__ void init(const bf16_t* A_, const bf16_t* Bt_, int M, int N, int G_, int c_) { A = A_; Bt = Bt_; nM = M / BM; nN = N / BM; nwg = nM * nN; G = G_; c = c_; }
    __device__ __forceinline__ bool next(int i, Unit& u) const {
        const long L = (long)i * G + c; if (L >= nwg) return false;
        const int wgid = xcd_remap((int)L, nwg);
        const int nig = WGM * nN, gid = wgid / nig, fm = gid * WGM, gsz = (nM - fm) < WGM ? (nM - fm) : WGM;
        u.pm = fm + ((wgid % nig) % gsz); u.pn = (wgid % nig) / gsz; u.e = 0; u.rows = 256; u.arow = u.pm * 256; return true;
    }
    __device__ __forceinline__ const char* a_base(const Unit& u) const { return (const char*)A + (size_t)u.pm * (2 * HALF * KK * 2); }
    __device__ __forceinline__ const char* b_base(const Unit& u) const { return (const char*)Bt + (size_t)u.pn * (2 * HALF * KK * 2); }
    __device__ __forceinline__ void a_offs(const Unit&, const int (&R)[2], const int (&C)[2], unsigned (&go)[2][2]) const {
#pragma unroll
        for (int h = 0; h < 2; ++h)
#pragma unroll
            for (int i = 0; i < 2; ++i) go[h][i] = (unsigned)((h * HALF + R[i]) * KK + C[i]) * 2u;
    }
};
template <bool GU> struct MoeSched {
    const bf16_t* A; const bf16_t* Bt; const int* list; const LAS int* tab; int nN, nwg, G, c;
    __device__ __forceinline__ void init(const bf16_t* A_, const bf16_t* Bt_, const int* list_, const LAS int* tab_, int G_, int c_) { A = A_; Bt = Bt_; list = list_; tab = tab_; nN = GU ? 8 : 4; nwg = tab_[32 + 32] * nN; G = G_; c = c_; }
    __device__ __forceinline__ bool next(int i, Unit& u) const {
        const long L = (long)i * G + c; if (L >= nwg) return false;
        const int wgid = xcd_remap((int)L, nwg);
        int e = 0;
#pragma unroll 1
        for (int k = 1; k < 32; ++k) { if (tab[32 + k] * nN <= wgid) e = k; }
        const int tb0 = tab[32 + e], T = tab[32 + e + 1] - tb0, local = wgid - tb0 * nN;
        int rows = tab[e] - (local % T) * 256; if (rows > 256) rows = 256;
        u.e = __builtin_amdgcn_readfirstlane(e); u.pm = __builtin_amdgcn_readfirstlane(local % T); u.pn = __builtin_amdgcn_readfirstlane(local / T); u.rows = __builtin_amdgcn_readfirstlane(rows); u.arow = __builtin_amdgcn_readfirstlane((tb0 + local % T) * 256); return true;
    }
    __device__ __forceinline__ const char* a_base(const Unit& u) const { return GU ? (const char*)A : (const char*)A + (size_t)u.arow * (KK * 2); }
    __device__ __forceinline__ const char* b_base(const Unit& u) const { return (const char*)Bt + ((size_t)u.e * (GU ? 2048 : 1024) + (size_t)u.pn * 256) * (KK * 2); }
    __device__ __forceinline__ void a_offs(const Unit& u, const int (&R)[2], const int (&C)[2], unsigned (&go)[2][2]) const {
#pragma unroll
        for (int h = 0; h < 2; ++h)
#pragma unroll
            for (int i = 0; i < 2; ++i) {
                if (GU) { const int r = h * HALF + R[i]; int tok = NTOK; if (r < u.rows) tok = list[u.e * LISTCAP + u.pm * 256 + r] >> 2; go[h][i] = (unsigned)(tok * KK + C[i]) * 2u; }
                else go[h][i] = (unsigned)((h * HALF + R[i]) * KK + C[i]) * 2u;
            }
    }
};

struct EpiBf16 {
    static constexpr bool PERM = true;
    bf16_t* O; int ldc;
    __device__ __forceinline__ void operator()(const f32x4 (&acc)[2][2][4][2], const Unit& u, int wr, int wc, int fr, int fq) const {
        const int row0 = u.pm * BM + wr * 64 + fr, col0 = u.pn * BM + wc * 32 + 8 * fq;
#pragma unroll
        for (int ai = 0; ai < 2; ++ai)
#pragma unroll
            for (int m = 0; m < 4; ++m) { bf16_t* rowp = O + (size_t)(row0 + ai * HALF + m * 16) * ldc + col0;
#pragma unroll
                for (int bj = 0; bj < 2; ++bj) { const f32x4 v0 = acc[ai][bj][m][0], v1 = acc[ai][bj][m][1];
                    u32x4 w; w.x = cvt_pk_bf16(v0[0], v0[1]); w.y = cvt_pk_bf16(v0[2], v0[3]); w.z = cvt_pk_bf16(v1[0], v1[1]); w.w = cvt_pk_bf16(v1[2], v1[3]);
                    *(u32x4*)(rowp + bj * HALF) = w; } }
    }
};
struct EpiResF32 {
    static constexpr bool PERM = false;
    const float* base; float* C; int ldc;
    __device__ __forceinline__ void operator()(const f32x4 (&acc)[2][2][4][2], const Unit& u, int wr, int wc, int fr, int fq) const {
        const int row0 = u.pm * BM + wr * 64 + fr, col0 = u.pn * BM + wc * 32 + 4 * fq;
#pragma unroll
        for (int ai = 0; ai < 2; ++ai)
#pragma unroll
            for (int m = 0; m < 4; ++m) { const size_t off = (size_t)(row0 + ai * HALF + m * 16) * ldc + col0;
#pragma unroll
                for (int bj = 0; bj < 2; ++bj)
#pragma unroll
                    for (int n = 0; n < 2; ++n) { const f32x4 b = *(const f32x4*)(base + off + bj * HALF + n * 16); *(f32x4*)(C + off + bj * HALF + n * 16) = acc[ai][bj][m][n] + b; }
                asm volatile("" ::: "memory"); }
    }
};
__device__ __forceinline__ float swiglu(float g, float l) {
    g = fminf(g, 7.0f); l = fminf(fmaxf(l, -7.0f), 7.0f);
    const float s = __builtin_amdgcn_rcpf(1.0f + __builtin_amdgcn_exp2f(-1.702f * 1.4426950408889634f * g));
    return g * s * (l + 1.0f);
}
struct EpiGU {
    static constexpr bool PERM = true;
    bf16_t* ACT; const float* bgu;
    __device__ __forceinline__ void operator()(const f32x4 (&acc)[2][2][4][2], const Unit& u, int wr, int wc, int fr, int fq) const {
        const int row0 = u.arow + wr * 64 + fr, colg = u.pn * 128 + wc * 32 + 8 * fq;
        const float* bp = bgu + (size_t)u.e * 2048 + colg;
        const f32x4 bg0 = *(const f32x4*)(bp), bg1 = *(const f32x4*)(bp + 4), bl0 = *(const f32x4*)(bp + 1024), bl1 = *(const f32x4*)(bp + 1024 + 4);
#pragma unroll
        for (int ai = 0; ai < 2; ++ai)
#pragma unroll
            for (int m = 0; m < 4; ++m) {
                const f32x4 g0 = acc[ai][0][m][0] + bg0, g1 = acc[ai][0][m][1] + bg1, l0 = acc[ai][1][m][0] + bl0, l1 = acc[ai][1][m][1] + bl1;
                u32x4 w; w.x = cvt_pk_bf16(swiglu(g0[0], l0[0]), swiglu(g0[1], l0[1])); w.y = cvt_pk_bf16(swiglu(g0[2], l0[2]), swiglu(g0[3], l0[3]));
                w.z = cvt_pk_bf16(swiglu(g1[0], l1[0]), swiglu(g1[1], l1[1])); w.w = cvt_pk_bf16(swiglu(g1[2], l1[2]), swiglu(g1[3], l1[3]));
                *(u32x4*)(ACT + (size_t)(row0 + ai * HALF + m * 16) * FF + colg) = w; }
    }
};
struct EpiDown {
    static constexpr bool PERM = true;
    bf16_t* Y; const float* bd; const int* list; const float* gate;
    __device__ __forceinline__ void operator()(const f32x4 (&acc)[2][2][4][2], const Unit& u, int wr, int wc, int fr, int fq) const {
        const int col0 = u.pn * BM + wc * 32 + 8 * fq;
        const float* bp = bd + (size_t)u.e * 1024 + col0;
        f32x4 bv[2][2];
#pragma unroll
        for (int bj = 0; bj < 2; ++bj) { bv[bj][0] = *(const f32x4*)(bp + bj * HALF); bv[bj][1] = *(const f32x4*)(bp + bj * HALF + 4); }
#pragma unroll
        for (int ai = 0; ai < 2; ++ai)
#pragma unroll
            for (int m = 0; m < 4; ++m) { const int r = ai * HALF + wr * 64 + m * 16 + fr;
                if (r < u.rows) { const int slot = list[u.e * LISTCAP + u.pm * 256 + r]; const float gt = gate[slot]; bf16_t* rowp = Y + (size_t)slot * D + col0;
#pragma unroll
                    for (int bj = 0; bj < 2; ++bj) { const f32x4 v0 = (acc[ai][bj][m][0] + bv[bj][0]) * gt, v1 = (acc[ai][bj][m][1] + bv[bj][1]) * gt;
                        u32x4 w; w.x = cvt_pk_bf16(v0[0], v0[1]); w.y = cvt_pk_bf16(v0[2], v0[3]); w.z = cvt_pk_bf16(v1[0], v1[1]); w.w = cvt_pk_bf16(v1[2], v1[3]);
                        *(u32x4*)(rowp + bj * HALF) = w; } } }
    }
};

template <class Epi, class Sched, bool ALIGN_EPI>
__device__ __forceinline__ void gemm_phase(LAS unsigned char* lds, const Sched& S, const Epi& E) {
    const int tid = threadIdx.x, wid = __builtin_amdgcn_readfirstlane(tid >> 6), lane = tid & 63, wr = wid >> 2, wc = wid & 3, fr = lane & 15, fq = lane >> 4;
    constexpr int K = KK, nt = K / BK;
    unsigned voffB[2]; int RA[2], CA[2];
#pragma unroll
    for (int i = 0; i < 2; ++i) { int R, C; stage_rc(tid * 16 + i * 8192, R, C); const int Rb = Epi::PERM ? ((R & ~31) + perm32(R & 31)) : R;
        RA[i] = R; CA[i] = C; voffB[i] = (unsigned)(Rb * K + C) * 2u; }
    constexpr size_t kstep = (size_t)(BK * 2);
    constexpr size_t hstep = (size_t)HALF * K * 2;
    const unsigned ldsw = (unsigned)wid * 1024u;
    const int aoff = lds_byte(wr * 64 + fr, fq * 8), boff = lds_byte(wc * 32 + fr, fq * 8);
#define PG8_SA(b, h) (((b) * 2 + (h)) * HTB)
#define PG8_SB(b, h) ((4 + (b) * 2 + (h)) * HTB)
#define PG8_STAGE(bufoff, gbase, voff) do { _Pragma("unroll") for (int _i = 0; _i < 2; ++_i) \
        __builtin_amdgcn_global_load_lds((const unsigned*)((const char*)(gbase) + (voff)[_i]), (LAS unsigned*)(lds + (bufoff) + ldsw + _i * 8192), 16, 0, 0); } while (0)
#define PG8_LDA(dst, b, h) do { _Pragma("unroll") for (int m = 0; m < 4; ++m) _Pragma("unroll") for (int k = 0; k < 2; ++k) dst[m][k] = *(const LAS bf16x8*)(lds + PG8_SA(b, h) + aoff + m * 2048 + k * 1024); } while (0)
#define PG8_LDB(dst, b, h) do { _Pragma("unroll") for (int n = 0; n < 2; ++n) _Pragma("unroll") for (int k = 0; k < 2; ++k) dst[n][k] = *(const LAS bf16x8*)(lds + PG8_SB(b, h) + boff + n * 2048 + k * 1024); } while (0)
#define PG8_MMA(ai, bj, At, Bt) do { __builtin_amdgcn_s_setprio(1); _Pragma("unroll") for (int m = 0; m < 4; ++m) _Pragma("unroll") for (int n = 0; n < 2; ++n) _Pragma("unroll") for (int k = 0; k < 2; ++k) \
        acc[ai][bj][m][n] = __builtin_amdgcn_mfma_f32_16x16x32_bf16(Bt[n][k], At[m][k], acc[ai][bj][m][n], 0, 0, 0); __builtin_amdgcn_s_setprio(0); } while (0)
#define PG8_WAIT_V(n) asm volatile("s_waitcnt vmcnt(" #n ")" ::: "memory")
#define PG8_WAIT_L(n) asm volatile("s_waitcnt lgkmcnt(" #n ")" ::: "memory")
#define PG8_BAR __builtin_amdgcn_s_barrier()
#define PG8_SCHED __builtin_amdgcn_sched_barrier(0)
    Unit cur, nxt; int ui = 0;
    if (!S.next(0, cur)) return;
    f32x4 acc[2][2][4][2];
#pragma unroll
    for (int a = 0; a < 2; ++a)
#pragma unroll
        for (int b = 0; b < 2; ++b)
#pragma unroll
            for (int m = 0; m < 4; ++m)
#pragma unroll
                for (int n = 0; n < 2; ++n) acc[a][b][m][n] = (f32x4){0.f, 0.f, 0.f, 0.f};
    bf16x8 At[4][2], B0[2][2], B1[2][2];
    const char* cA = S.a_base(cur); const char* cB = S.b_base(cur);
    unsigned go[2][2];
    S.a_offs(cur, RA, CA, go);
    PG8_STAGE(PG8_SB(0, 0), cB, voffB); PG8_STAGE(PG8_SB(0, 1), cB + hstep, voffB); PG8_STAGE(PG8_SA(0, 0), cA, go[0]); PG8_STAGE(PG8_SA(0, 1), cA, go[1]);
    if (wr == 1) PG8_BAR;
    PG8_WAIT_V(2); PG8_BAR;
    PG8_STAGE(PG8_SB(1, 0), cB + kstep, voffB); PG8_STAGE(PG8_SA(1, 0), cA + kstep, go[0]); PG8_STAGE(PG8_SB(1, 1), cB + hstep + kstep, voffB);
    PG8_WAIT_V(6); PG8_BAR;
    for (;;) {
        const bool has_next = S.next(ui + 1, nxt);
        const char* nA = has_next ? S.a_base(nxt) : cA; const char* nB = has_next ? S.b_base(nxt) : cB;
        for (int t = 0; t < nt; t += 2) {
            const bool last = (t == nt - 2);
            const char* a1 = cA + (size_t)(t + 1) * kstep;
            const char* a2 = last ? nA : cA + (size_t)(t + 2) * kstep; const char* b2 = last ? nB : cB + (size_t)(t + 2) * kstep;
            const char* a3 = a2 + kstep; const char* b3 = b2 + kstep;
            PG8_LDB(B0, 0, 0); PG8_LDB(B1, 0, 1); PG8_SCHED; PG8_LDA(At, 0, 0); PG8_STAGE(PG8_SA(1, 1), a1, go[1]);
            if (last && has_next) S.a_offs(nxt, RA, CA, go);
            PG8_WAIT_V(8); PG8_WAIT_L(0); PG8_BAR; PG8_MMA(0, 0, At, B0); PG8_MMA(0, 1, At, B1); PG8_BAR; PG8_SCHED;
            PG8_LDA(At, 0, 1); PG8_STAGE(PG8_SB(0, 0), b2, voffB); PG8_STAGE(PG8_SB(0, 1), b2 + hstep, voffB); PG8_STAGE(PG8_SA(0, 0), a2, go[0]);
            PG8_WAIT_V(8); PG8_WAIT_L(0); PG8_BAR; PG8_MMA(1, 0, At, B0); PG8_MMA(1, 1, At, B1); PG8_BAR; PG8_SCHED;
            PG8_LDB(B0, 1, 0); PG8_LDB(B1, 1, 1); PG8_SCHED; PG8_LDA(At, 1, 0); PG8_STAGE(PG8_SA(0, 1), a2, go[1]);
            PG8_WAIT_V(8); PG8_WAIT_L(0); PG8_BAR; PG8_MMA(0, 0, At, B0); PG8_MMA(0, 1, At, B1); PG8_BAR; PG8_SCHED;
            PG8_LDA(At, 1, 1); PG8_STAGE(PG8_SB(1, 0), b3, voffB); PG8_STAGE(PG8_SB(1, 1), b3 + hstep, voffB); PG8_STAGE(PG8_SA(1, 0), a3, go[0]);
            PG8_WAIT_V(8); PG8_WAIT_L(0); PG8_BAR; PG8_MMA(1, 0, At, B0); PG8_MMA(1, 1, At, B1); PG8_BAR; PG8_SCHED;
        }
        if constexpr (ALIGN_EPI) { if (wr == 0) PG8_BAR; }
        E(acc, cur, wr, wc, fr, fq);
        if (!has_next) break;
#pragma unroll
        for (int a = 0; a < 2; ++a)
#pragma unroll
            for (int b = 0; b < 2; ++b)
#pragma unroll
                for (int m = 0; m < 4; ++m)
#pragma unroll
                    for (int n = 0; n < 2; ++n) acc[a][b][m][n] = (f32x4){0.f, 0.f, 0.f, 0.f};
        cur = nxt; cA = nA; cB = nB; ++ui;
        if constexpr (ALIGN_EPI) { if (wr == 1) PG8_BAR; }
    }
    PG8_WAIT_V(0);
    if constexpr (!ALIGN_EPI) { if (wr == 0) PG8_BAR; }
    PG8_BAR;
#undef PG8_SA
#undef PG8_SB
#undef PG8_STAGE
#undef PG8_LDA
#undef PG8_LDB
#undef PG8_MMA
#undef PG8_WAIT_V
#undef PG8_WAIT_L
#undef PG8_BAR
#undef PG8_SCHED
}
}

#define XB_TMO      128
#define XB_XCNT(j)  (256  + 64 * (j))
#define XB_XSUB(j)  (1280 + 64 * (j))
#define XB_XGEN(j)  (2304 + 64 * (j))
#define XB_TOP      3328
#define XB_TOPGEN   3392
#define XCD_BAR_WORDS 3456
#define XB_SPIN_CAP (1u << 18)
__device__ __forceinline__ unsigned xb_ld(unsigned* p)              { return __hip_atomic_load(p, __ATOMIC_RELAXED, __HIP_MEMORY_SCOPE_AGENT); }
__device__ __forceinline__ unsigned xb_add(unsigned* p, unsigned v) { return __hip_atomic_fetch_add(p, v, __ATOMIC_RELAXED, __HIP_MEMORY_SCOPE_AGENT); }
__device__ __forceinline__ unsigned xb_xcc_id() { return (unsigned)__builtin_amdgcn_s_getreg((3 << 11) | 20) & 0xFu; }
#define XB_SPIN(cond, bar) do { unsigned _sp = 0; while (cond) { __builtin_amdgcn_s_sleep(1); \
    if ((++_sp & 255u) == 0u) { if (xb_ld(&(bar)[XB_TMO])) break; if (_sp > XB_SPIN_CAP) { atomicAdd(&(bar)[XB_TMO], 1u); break; } } } } while (0)
struct XcdBarrier { unsigned* bar; unsigned x; volatile LAS unsigned* st; };
__device__ __forceinline__ XcdBarrier xcd_barrier_post(unsigned* bar, volatile LAS unsigned* st) {
    XcdBarrier b; b.bar = bar; b.x = xb_xcc_id(); b.st = st;
    if (threadIdx.x == 0) (void)xb_add(&bar[XB_XCNT(b.x)], 1u);
    return b;
}
__device__ __forceinline__ void xcd_barrier_complete(unsigned* bar, unsigned x, unsigned& nloc, unsigned& nx) {
    const unsigned G = gridDim.x * gridDim.y * gridDim.z;
    unsigned sum, cnt, mine, sp = 0u;
    for (;;) {
        sum = 0u; cnt = 0u; mine = 0u;
#pragma unroll
        for (unsigned j = 0; j < 16; ++j) { const unsigned c = xb_ld(&bar[XB_XCNT(j)]); sum += c; cnt += (c > 0u) ? 1u : 0u; mine = (j == x) ? c : mine; }
        if (sum == G) break;
        __builtin_amdgcn_s_sleep(1);
        if ((++sp & 255u) == 0u) { if (xb_ld(&bar[XB_TMO])) break; if (sp > XB_SPIN_CAP) { atomicAdd(&bar[XB_TMO], 1u); break; } }
    }
    nloc = mine > 0u ? mine : 1u; nx = cnt > 0u ? cnt : 1u;
}
__device__ __forceinline__ void xcd_barrier(const XcdBarrier& b) {
    asm volatile("s_waitcnt vmcnt(0)" ::: "memory");
    __syncthreads();
    if (threadIdx.x == 0) {
        unsigned* bar = b.bar;
        __builtin_amdgcn_s_waitcnt(0);
        unsigned nloc = b.st[0], nx = b.st[1];
        if (nloc == 0u) { xcd_barrier_complete(bar, b.x, nloc, nx); b.st[0] = nloc; b.st[1] = nx; }
        const unsigned old = xb_add(&bar[XB_XSUB(b.x)], 1u);
        const unsigned gen = old / nloc;
        if (old + 1u == (gen + 1u) * nloc) {
            __builtin_amdgcn_fence(__ATOMIC_RELEASE, "agent");
            asm volatile("s_waitcnt vmcnt(0)" ::: "memory");
            const unsigned og = xb_add(&bar[XB_TOP], 1u);
            const unsigned tg = og / nx;
            if (og + 1u == (tg + 1u) * nx) xb_add(&bar[XB_TOPGEN], 1u);
            else XB_SPIN(xb_ld(&bar[XB_TOPGEN]) == tg, bar);
            __builtin_amdgcn_fence(__ATOMIC_ACQUIRE, "agent");
            xb_add(&bar[XB_XGEN(b.x)], 1u);
            asm volatile("s_waitcnt vmcnt(0)" ::: "memory");
        } else {
            XB_SPIN(xb_ld(&bar[XB_XGEN(b.x)]) == gen, bar);
            __builtin_amdgcn_fence(__ATOMIC_ACQUIRE, "agent");
            asm volatile("s_waitcnt vmcnt(0)" ::: "memory");
        }
    }
    __syncthreads();
}

struct Frame {
    LAS unsigned char* lds;
    volatile LAS unsigned* MISC;
    gu32* ctl;
    int tid, lane, wave, vcu, G;
    const float *x, *norm_mix_w, *w_in, *ret_norm_w, *w_pool, *pool_scale, *w_out, *norm_ffn_w, *w_router, *b_router, *w_gu, *b_gu, *w_down, *b_down, *norm_final_w;
    float* out;
    bf16_t *Wr_hi, *Wr_lo, *Wpool_t, *Win_t, *Wout_t, *XN, *CAT, *U, *Z, *Y, *Wgu_t, *Wd_t, *ACT;
    int* list; float* gate;
    float lg2g0, lg2g1, lg2g2, lg2g3;
    __device__ __forceinline__ float lg2(int h) const { return h == 0 ? lg2g0 : (h == 1 ? lg2g1 : (h == 2 ? lg2g2 : lg2g3)); }
};

template <bool SPLIT>
__device__ __forceinline__ void p0_transpose_item(const float* W, int ldw, bf16_t* WT, bf16_t* WT2, int ldo, LAS float* scr, int k0, int n0, int orow0, int lane) {
#pragma unroll 8
    for (int i = 0; i < 32; ++i) { const int kk = 2 * i + (lane >> 5); scr[kk * 33 + (lane & 31)] = W[(size_t)(k0 + kk) * ldw + n0 + (lane & 31)]; }
    LDS_WAIT(); asm volatile("" ::: "memory");
    const int c = lane & 7;
#pragma unroll
    for (int j = 0; j < 4; ++j) { const int n = (lane >> 3) + 8 * j; const LAS float* s = scr + (8 * c) * 33 + n;
        float v[8];
#pragma unroll
        for (int q = 0; q < 8; ++q) v[q] = s[q * 33];
        u32x4 o; o.x = cvt_pk_bf16(v[0], v[1]); o.y = cvt_pk_bf16(v[2], v[3]); o.z = cvt_pk_bf16(v[4], v[5]); o.w = cvt_pk_bf16(v[6], v[7]);
        *(GAS u32x4*)(WT + (size_t)(orow0 + n) * ldo + k0 + 8 * c) = o;
        if (SPLIT) { u32x4 o2; o2.x = cvt_pk_bf16(v[0] - bf_lo(o.x), v[1] - bf_hi(o.x)); o2.y = cvt_pk_bf16(v[2] - bf_lo(o.y), v[3] - bf_hi(o.y));
            o2.z = cvt_pk_bf16(v[4] - bf_lo(o.z), v[5] - bf_hi(o.z)); o2.w = cvt_pk_bf16(v[6] - bf_lo(o.w), v[7] - bf_hi(o.w));
            *(GAS u32x4*)(WT2 + (size_t)(orow0 + n) * ldo + k0 + 8 * c) = o2; } }
    LDS_WAIT(); asm volatile("" ::: "memory");
}
__device__ __forceinline__ void rms_row_to_bf16(int lane, const float* xrow, const float* w, bf16_t* orow) {
    const GAS f32x4* xr = (const GAS f32x4*)xrow + lane; const GAS f32x4* wr = (const GAS f32x4*)w + lane;
    f32x4 v[4]; float s = 0.f;
#pragma unroll
    for (int j = 0; j < 4; ++j) { v[j] = xr[64 * j]; s += (v[j].x * v[j].x + v[j].y * v[j].y) + (v[j].z * v[j].z + v[j].w * v[j].w); }
    const float rstd = 1.f / sqrtf(wave_sum(s) * (1.f / D) + EPS);
    GAS unsigned long long* o8 = (GAS unsigned long long*)orow + lane;
#pragma unroll
    for (int j = 0; j < 4; ++j) { const f32x4 ww = wr[64 * j]; o8[64 * j] = (unsigned long long)cvt_pk_bf16(v[j].x * rstd * ww.x, v[j].y * rstd * ww.y) | ((unsigned long long)cvt_pk_bf16(v[j].z * rstd * ww.z, v[j].w * rstd * ww.w) << 32); }
}
__device__ __forceinline__ void p0_prologue(Frame& F) {
    LAS float* scr = (LAS float*)(F.lds + F.wave * 16384);
    const int gw = F.vcu * NWAVES + F.wave, NGW = F.G * NWAVES;
    constexpr int I_IN = 16 * 80, I_OUT = 16 * 32, I_POOL = 32, I_R = 16, I_GU = 32 * 16 * 64, I_D = 32 * 16 * 32;
    constexpr int NITEMS = I_IN + I_OUT + I_POOL + I_R + I_GU + I_D;
    for (int it = gw; it < NITEMS; it += NGW) {
        int r = it;
        if (r < I_GU) { const int e = r / 1024, q = r % 1024, kb = q / 64, nb = q % 64, n0 = nb * 32;
            const int orow = (n0 < 1024) ? ((n0 >> 7) * 256 + (n0 & 127)) : ((((n0 - 1024) >> 7) * 256) + 128 + ((n0 - 1024) & 127));
            p0_transpose_item<false>(F.w_gu + (size_t)e * 1024 * 2048, 2048, F.Wgu_t + (size_t)e * 2048 * 1024, nullptr, 1024, scr, kb * 64, n0, orow, F.lane); continue; } r -= I_GU;
        if (r < I_D) { const int e = r / 512, q = r % 512, kb = q / 32, nb = q % 32;
            p0_transpose_item<false>(F.w_down + (size_t)e * 1024 * 1024, 1024, F.Wd_t + (size_t)e * 1024 * 1024, nullptr, 1024, scr, kb * 64, nb * 32, nb * 32, F.lane); continue; } r -= I_D;
        if (r < I_IN) { const int kb = r / 80, nb = r % 80; p0_transpose_item<false>(F.w_in, DIN, F.Win_t, nullptr, 1024, scr, kb * 64, nb * 32, nb * 32, F.lane); continue; } r -= I_IN;
        if (r < I_OUT) { const int kb = r / 32, nb = r % 32; p0_transpose_item<false>(F.w_out, 1024, F.Wout_t, nullptr, 1024, scr, kb * 64, nb * 32, nb * 32, F.lane); continue; } r -= I_OUT;
        if (r < I_POOL) { const int g = r / 8, q = r % 8, kb = q / 4, nb = q % 4; p0_transpose_item<false>(F.w_pool + g * 16384, 128, F.Wpool_t + g * 16384, nullptr, 128, scr, kb * 64, nb * 32, nb * 32, F.lane); continue; } r -= I_POOL;
        { const int kb = r; p0_transpose_item<true>(F.w_router, 32, F.Wr_hi, F.Wr_lo, 1024, scr, kb * 64, 0, 0, F.lane); }
    }
    for (int m = gw; m < NTOK; m += NGW) rms_row_to_bf16(F.lane, F.x + (size_t)m * D, F.norm_mix_w, F.XN + (size_t)m * D);
    if (gw == 0) { GAS u32x4* z = (GAS u32x4*)(F.XN + (size_t)NTOK * D) + F.lane; z[0] = (u32x4){0u, 0u, 0u, 0u}; z[64] = (u32x4){0u, 0u, 0u, 0u}; }
}

__device__ __forceinline__ void rope_cs(int pos, int j, float& cs, float& sn) {
    const float inv = __builtin_amdgcn_exp2f((float)j * (-13.287712379549449f / 64.0f));
    const double revd = (double)pos * (double)inv * 0.15915494309189535;
    const float rev = (float)(revd - __builtin_floor(revd));
    sn = __builtin_amdgcn_sinf(rev); cs = __builtin_amdgcn_cosf(rev);
}

__device__ __forceinline__ void retA_unit(Frame& F, int unit) {
    const int c = unit & 63, bh = unit >> 6, h = bh & 3, b = bh >> 2;
    const int tok0 = b * SEQ + c * 64;
    LAS bf16_t* KT = (LAS bf16_t*)(F.lds);
    LAS bf16_t* VT = KT + 128 * 72;
    const int t = F.tid, m = t >> 3, o = t & 7;
    {
        const bf16_t* zrow = F.Z + (size_t)(tok0 + m) * DIN + h * 128 + 8 * o;
        const u32x4 klo = *(const u32x4*)(zrow + 512), khi = *(const u32x4*)(zrow + 512 + 64);
        const u32x4 vlo = *(const u32x4*)(zrow + 1024), vhi = *(const u32x4*)(zrow + 1024 + 64);
        const float ksc = __builtin_amdgcn_exp2f(F.lg2(h) * (float)(63 - m)) * 0.08838834764831845f;
        const int pos = c * 64 + m;
#pragma unroll
        for (int i = 0; i < 8; ++i) {
            const unsigned wl = klo[i >> 1], wh = khi[i >> 1];
            const float lo = (i & 1) ? bf_hi(wl) : bf_lo(wl), hi = (i & 1) ? bf_hi(wh) : bf_lo(wh);
            float cs, sn; rope_cs(pos, 8 * o + i, cs, sn);
            const unsigned pk = cvt_pk_bf16((lo * cs - hi * sn) * ksc, (lo * sn + hi * cs) * ksc);
            KT[(8 * o + i) * 72 + m] = (bf16_t)(pk & 0xffffu); KT[(64 + 8 * o + i) * 72 + m] = (bf16_t)(pk >> 16);
            const unsigned vl = vlo[i >> 1], vh = vhi[i >> 1];
            VT[(8 * o + i) * 72 + m] = (bf16_t)((i & 1) ? (vl >> 16) : (vl & 0xffffu)); VT[(64 + 8 * o + i) * 72 + m] = (bf16_t)((i & 1) ? (vh >> 16) : (vh & 0xffffu));
        }
    }
    __syncthreads();
    {
        const int w = F.wave, fr = F.lane & 15, fq = F.lane >> 4;
        bf16x8 vf[2];
#pragma unroll
        for (int ks = 0; ks < 2; ++ks) vf[ks] = *(const LAS bf16x8*)(VT + (16 * w + fr) * 72 + 32 * ks + 8 * fq);
        bf16_t* urow = F.U + ((size_t)unit * 128 + 16 * w + fr) * 128 + 4 * fq;
#pragma unroll
        for (int dt = 0; dt < 8; ++dt) {
            f32x4 acc = (f32x4){0.f, 0.f, 0.f, 0.f};
#pragma unroll
            for (int ks = 0; ks < 2; ++ks) { const bf16x8 kf = *(const LAS bf16x8*)(KT + (16 * dt + fr) * 72 + 32 * ks + 8 * fq); acc = mfma16(kf, vf[ks], acc); }
            u32x2 pk; pk.x = cvt_pk_bf16(acc[0], acc[1]); pk.y = cvt_pk_bf16(acc[2], acc[3]);
            *(u32x2*)(urow + 16 * dt) = pk;
        }
    }
    __syncthreads();
}

__device__ __forceinline__ void pool_unit(Frame& F, int unit) {
    const int g = unit & 3, tile = unit >> 2, st = (tile & 63) * 64;
    const int tok0 = tile * 64, win = 2 << g;
    LAS float* P = (LAS float*)(F.lds);
    LAS bf16_t* A = (LAS bf16_t*)(F.lds + 79 * 132 * 4);
    const int t = F.tid;
    for (int idx = t; idx < 79 * 16; idx += 512) {
        const int r = idx >> 4, ch = idx & 15, s = st - 15 + r;
        f32x4 a = (f32x4){0.f, 0.f, 0.f, 0.f}, b2 = a;
        if (s >= 0) { const u32x4 w = *(const u32x4*)(F.Z + (size_t)(tok0 - 15 + r) * DIN + 2048 + g * 128 + 8 * ch);
            a = (f32x4){bf_lo(w.x), bf_hi(w.x), bf_lo(w.y), bf_hi(w.y)}; b2 = (f32x4){bf_lo(w.z), bf_hi(w.z), bf_lo(w.w), bf_hi(w.w)}; }
        *(LAS f32x4*)(P + r * 132 + 8 * ch) = a; *(LAS f32x4*)(P + r * 132 + 8 * ch + 4) = b2;
    }
    __syncthreads();
    {
        const int n = t >> 3, c0 = (t & 7) * 16, s = st + n;
        const float rc = 1.0f / (float)((s + 1 < win) ? (s + 1) : win);
#pragma unroll
        for (int q = 0; q < 4; ++q) {
            f32x4 sum = (f32x4){0.f, 0.f, 0.f, 0.f};
            for (int j = 0; j < win; ++j) sum += *(const LAS f32x4*)(P + (15 + n - j) * 132 + c0 + 4 * q);
            const f32x4 self = *(const LAS f32x4*)(P + (15 + n) * 132 + c0 + 4 * q);
            const f32x4 pv = sum * rc - self;
            u32x2 pk; pk.x = cvt_pk_bf16(pv[0], pv[1]); pk.y = cvt_pk_bf16(pv[2], pv[3]);
            *(LAS u32x2*)(A + n * 136 + c0 + 4 * q) = pk;
        }
    }
    __syncthreads();
    {
        const int w = F.wave, rt = w & 3, chf = w >> 2, fr = F.lane & 15, fq = F.lane >> 4;
        bf16x8 af[4];
#pragma unroll
        for (int ks = 0; ks < 4; ++ks) af[ks] = *(const LAS bf16x8*)(A + (16 * rt + fr) * 136 + 32 * ks + 8 * fq);
        const bf16_t* wp = F.Wpool_t + g * 16384;
        bf16_t* orow = F.CAT + (size_t)(tok0 + 16 * rt + fr) * D + 512 + g * 128;
#pragma unroll
        for (int dd = 0; dd < 4; ++dd) { const int dt = 4 * chf + dd;
            f32x4 acc = (f32x4){0.f, 0.f, 0.f, 0.f};
#pragma unroll
            for (int ks = 0; ks < 4; ++ks) { const bf16x8 wf = *(const bf16x8*)(wp + (16 * dt + fr) * 128 + 32 * ks + 8 * fq); acc = mfma16(wf, af[ks], acc); }
            const f32x4 sc = *(const f32x4*)(F.pool_scale + g * 128 + 16 * dt + 4 * fq);
            u32x2 pk; pk.x = cvt_pk_bf16(acc[0] * sc[0], acc[1] * sc[1]); pk.y = cvt_pk_bf16(acc[2] * sc[2], acc[3] * sc[3]);
            *(u32x2*)(orow + 16 * dt + 4 * fq) = pk;
        }
    }
    __syncthreads();
}

__device__ __forceinline__ void retB_unit(Frame& F, int unit) {
    const int c = unit & 63, bh = unit >> 6, h = bh & 3, b = bh >> 2;
    const int tok0 = b * SEQ + c * 64;
    LAS bf16_t* Q = (LAS bf16_t*)(F.lds);
    LAS bf16_t* Kr = Q + 64 * 136;
    LAS bf16_t* VT = Kr + 64 * 136;
    LAS bf16_t* Sm = VT + 128 * 72;
    LAS float* red = (LAS float*)(Sm + 64 * 72);
    const int t = F.tid;
    const float lg = F.lg2(h);
    {
        const int m = t >> 3, o = t & 7;
        const bf16_t* zrow = F.Z + (size_t)(tok0 + m) * DIN + h * 128 + 8 * o;
        const u32x4 qlo = *(const u32x4*)(zrow), qhi = *(const u32x4*)(zrow + 64);
        const u32x4 klo = *(const u32x4*)(zrow + 512), khi = *(const u32x4*)(zrow + 512 + 64);
        const u32x4 vlo = *(const u32x4*)(zrow + 1024), vhi = *(const u32x4*)(zrow + 1024 + 64);
        const int pos = c * 64 + m;
        unsigned ql[4], qh[4], kl[4], kh[4];
#pragma unroll
        for (int i = 0; i < 8; i += 2) {
            float cs0, sn0, cs1, sn1; rope_cs(pos, 8 * o + i, cs0, sn0); rope_cs(pos, 8 * o + i + 1, cs1, sn1);
            { const float l0 = bf_lo(qlo[i >> 1]), l1 = bf_hi(qlo[i >> 1]), h0 = bf_lo(qhi[i >> 1]), h1 = bf_hi(qhi[i >> 1]);
              ql[i >> 1] = cvt_pk_bf16(l0 * cs0 - h0 * sn0, l1 * cs1 - h1 * sn1); qh[i >> 1] = cvt_pk_bf16(l0 * sn0 + h0 * cs0, l1 * sn1 + h1 * cs1); }
            { const float l0 = bf_lo(klo[i >> 1]), l1 = bf_hi(klo[i >> 1]), h0 = bf_lo(khi[i >> 1]), h1 = bf_hi(khi[i >> 1]); const float sc = 0.08838834764831845f;
              kl[i >> 1] = cvt_pk_bf16((l0 * cs0 - h0 * sn0) * sc, (l1 * cs1 - h1 * sn1) * sc); kh[i >> 1] = cvt_pk_bf16((l0 * sn0 + h0 * cs0) * sc, (l1 * sn1 + h1 * cs1) * sc); }
        }
        *(LAS u32x4*)(Q + m * 136 + 8 * o) = (u32x4){ql[0], ql[1], ql[2], ql[3]}; *(LAS u32x4*)(Q + m * 136 + 64 + 8 * o) = (u32x4){qh[0], qh[1], qh[2], qh[3]};
        *(LAS u32x4*)(Kr + m * 136 + 8 * o) = (u32x4){kl[0], kl[1], kl[2], kl[3]}; *(LAS u32x4*)(Kr + m * 136 + 64 + 8 * o) = (u32x4){kh[0], kh[1], kh[2], kh[3]};
#pragma unroll
        for (int i = 0; i < 8; ++i) { const unsigned vl = vlo[i >> 1], vh = vhi[i >> 1];
            VT[(8 * o + i) * 72 + m] = (bf16_t)((i & 1) ? (vl >> 16) : (vl & 0xffffu)); VT[(64 + 8 * o + i) * 72 + m] = (bf16_t)((i & 1) ? (vh >> 16) : (vh & 0xffffu)); }
    }
    __syncthreads();
    const int w = F.wave, fr = F.lane & 15, fq = F.lane >> 4;
    {
        const int ntl = w >> 1;
        bf16x8 qf[4];
#pragma unroll
        for (int ks = 0; ks < 4; ++ks) qf[ks] = *(const LAS bf16x8*)(Q + (16 * ntl + fr) * 136 + 32 * ks + 8 * fq);
#pragma unroll
        for (int mm = 0; mm < 2; ++mm) { const int mt = 2 * (w & 1) + mm;
            f32x4 acc = (f32x4){0.f, 0.f, 0.f, 0.f};
#pragma unroll
            for (int ks = 0; ks < 4; ++ks) { const bf16x8 kf = *(const LAS bf16x8*)(Kr + (16 * mt + fr) * 136 + 32 * ks + 8 * fq); acc = mfma16(kf, qf[ks], acc); }
            const int n = 16 * ntl + fr, m0 = 16 * mt + 4 * fq;
            float sv[4];
#pragma unroll
            for (int j = 0; j < 4; ++j) { const int dd = n - (m0 + j); sv[j] = acc[j] * __builtin_amdgcn_exp2f(lg * (float)(dd < 0 ? -dd : dd)); }
            u32x2 pk; pk.x = cvt_pk_bf16(sv[0], sv[1]); pk.y = cvt_pk_bf16(sv[2], sv[3]);
            *(LAS u32x2*)(Sm + n * 72 + m0) = pk;
        }
    }
    __syncthreads();
    {
        const int rt = w & 3, chf = w >> 2, n = 16 * rt + fr;
        bf16x8 sf[2], qf[4];
#pragma unroll
        for (int ks = 0; ks < 2; ++ks) sf[ks] = *(const LAS bf16x8*)(Sm + n * 72 + 32 * ks + 8 * fq);
#pragma unroll
        for (int ks = 0; ks < 4; ++ks) qf[ks] = *(const LAS bf16x8*)(Q + n * 136 + 32 * ks + 8 * fq);
        const float qd = __builtin_amdgcn_exp2f(lg * (float)(n + 1));
        f32x4 ov[4]; float ss = 0.f;
#pragma unroll
        for (int dd = 0; dd < 4; ++dd) { const int vt = 4 * chf + dd;
            f32x4 ai = (f32x4){0.f, 0.f, 0.f, 0.f}, ac = ai;
#pragma unroll
            for (int ks = 0; ks < 2; ++ks) { const bf16x8 vf = *(const LAS bf16x8*)(VT + (16 * vt + fr) * 72 + 32 * ks + 8 * fq); ai = mfma16(vf, sf[ks], ai); }
            const bf16_t* rrow = F.U + ((size_t)unit * 128 + 16 * vt + fr) * 128 + 8 * fq;
#pragma unroll
            for (int ks = 0; ks < 4; ++ks) { const bf16x8 rf = *(const bf16x8*)(rrow + 32 * ks); ac = mfma16(rf, qf[ks], ac); }
            ov[dd] = ai + ac * qd;
            ss += (ov[dd][0] * ov[dd][0] + ov[dd][1] * ov[dd][1]) + (ov[dd][2] * ov[dd][2] + ov[dd][3] * ov[dd][3]);
        }
        ss += __shfl_xor(ss, 16); ss += __shfl_xor(ss, 32);
        if (fq == 0) red[chf * 64 + n] = ss;
        __syncthreads();
        const float rstd = 1.f / sqrtf((red[n] + red[64 + n]) * (1.f / 128.f) + EPS);
        const size_t tok = (size_t)(tok0 + n);
#pragma unroll
        for (int dd = 0; dd < 4; ++dd) { const int v0 = 16 * (4 * chf + dd) + 4 * fq;
            const u32x2 gw2 = *(const u32x2*)(F.Z + tok * DIN + 1536 + h * 128 + v0);
            const f32x4 rw = *(const f32x4*)(F.ret_norm_w + h * 128 + v0);
            const float gv[4] = {bf_lo(gw2.x), bf_hi(gw2.x), bf_lo(gw2.y), bf_hi(gw2.y)};
            float r[4];
#pragma unroll
            for (int j = 0; j < 4; ++j) { const float sg = gv[j] * __builtin_amdgcn_rcpf(1.0f + __builtin_amdgcn_exp2f(-1.4426950408889634f * gv[j])); r[j] = ov[dd][j] * rstd * rw[j] * sg; }
            u32x2 pk; pk.x = cvt_pk_bf16(r[0], r[1]); pk.y = cvt_pk_bf16(r[2], r[3]);
            *(u32x2*)(F.CAT + tok * D + h * 128 + v0) = pk;
        }
    }
    __syncthreads();
}

struct Args { const float* in[15]; float* out; unsigned char* ws; float lg2g[4]; int ph_lo, ph_hi, li, pad; };

__global__ void __launch_bounds__(NWAVES * 64, 2) fwd_kernel(Args args) {
    extern __shared__ __attribute__((aligned(16))) unsigned char lds[];
    Frame F;
    F.lds = (LAS unsigned char*)lds;
    F.MISC = (volatile LAS unsigned*)(F.lds + MISC_OFF);
    F.tid = threadIdx.x; F.lane = F.tid & 63; F.wave = __builtin_amdgcn_readfirstlane(F.tid >> 6);
    F.G = gridDim.x; { const int bx = blockIdx.x; F.vcu = (F.G % 8 == 0) ? (bx % 8) * (F.G / 8) + bx / 8 : bx; }
    unsigned char* ws = args.ws;
    F.ctl = (gu32*)(ws + WS_CTL);
    F.x = args.in[0]; F.norm_mix_w = args.in[1]; F.w_in = args.in[2]; F.ret_norm_w = args.in[3]; F.w_pool = args.in[4]; F.pool_scale = args.in[5]; F.w_out = args.in[6]; F.norm_ffn_w = args.in[7];
    F.w_router = args.in[8]; F.b_router = args.in[9]; F.w_gu = args.in[10]; F.b_gu = args.in[11]; F.w_down = args.in[12]; F.b_down = args.in[13]; F.norm_final_w = args.in[14]; F.out = args.out;
    F.Wr_hi = (bf16_t*)(ws + WS_WR); F.Wr_lo = F.Wr_hi + 32 * 1024; F.Wpool_t = (bf16_t*)(ws + WS_WPOOL); F.Win_t = (bf16_t*)(ws + WS_WIN); F.Wout_t = (bf16_t*)(ws + WS_WOUT);
    F.XN = (bf16_t*)(ws + WS_XN); F.CAT = (bf16_t*)(ws + WS_CAT); F.U = (bf16_t*)(ws + WS_U); F.Z = (bf16_t*)(ws + WS_Z); F.Y = (bf16_t*)(ws + WS_Y);
    F.Wgu_t = (bf16_t*)(ws + WS_WGU); F.Wd_t = (bf16_t*)(ws + WS_WD); F.ACT = (bf16_t*)(ws + WS_ACT); F.list = (int*)(ws + WS_LIST); F.gate = (float*)(ws + WS_GATE);
    F.lg2g0 = args.lg2g[0]; F.lg2g1 = args.lg2g[1]; F.lg2g2 = args.lg2g[2]; F.lg2g3 = args.lg2g[3];
    for (int u = F.tid; u < (LDS_BYTES - LDSCTL_OFF) / 4; u += NWAVES * 64) ((LAS unsigned*)(F.lds + LDSCTL_OFF))[u] = 0u;
    __syncthreads();
    XcdBarrier bar; bar.bar = (unsigned*)(F.ctl + CW_BAR); bar.x = 0; bar.st = nullptr;
    if (N_LAUNCHES != PER_PHASE) bar = xcd_barrier_post((unsigned*)(F.ctl + CW_BAR), F.MISC + 8);
#define GRID_BAR() do { if (N_LAUNCHES != PER_PHASE) xcd_barrier(bar); } while (0)
    const int lo = DBG_ONLY9 ? (args.ph_lo < 9 ? 9 : args.ph_lo) : args.ph_lo, hi = args.ph_hi;
#define IN(k) (lo <= (k) && (k) < hi)
#define BOTH(k) (IN(k) && IN((k) + 1))
    const int gw = F.vcu * NWAVES + F.wave, NGW = F.G * NWAVES;

    if (IN(0)) { p0_prologue(F); if (BOTH(0)) GRID_BAR(); }

    if (IN(1)) {
        pg8::DenseSched S; S.init(F.XN, F.Win_t, NTOK, DIN, F.G, (int)blockIdx.x);
        pg8::EpiBf16 E{F.Z, DIN};
        pg8::gemm_phase<pg8::EpiBf16, pg8::DenseSched, true>(F.lds, S, E);
        if (BOTH(1)) GRID_BAR();
    }

    if (IN(2)) {
        for (int u = F.vcu; u < 1024; u += F.G) retA_unit(F, u);
        for (int u = F.vcu; u < 1024; u += F.G) pool_unit(F, u);
        if (BOTH(2)) GRID_BAR();
    }

    if (IN(3) && DBG_STAGE != 4) {
        const int gt = F.vcu * 512 + F.tid, NGT = F.G * 512;
        for (int p = gt; p < 16 * 8192; p += NGT) {
            const int bh = p >> 13, i = p & 8191;
            const float cd = __builtin_amdgcn_exp2f(F.lg2(bh & 3) * 64.0f);
            unsigned* up = (unsigned*)(F.U + (size_t)bh * 64 * 16384) + i;
            float s0 = 0.f, s1 = 0.f;
#pragma unroll 8
            for (int c = 0; c < 64; ++c) { const unsigned uw = up[(size_t)c * 8192]; up[(size_t)c * 8192] = cvt_pk_bf16(s0, s1); s0 = cd * s0 + bf_lo(uw); s1 = cd * s1 + bf_hi(uw); }
        }
        if (BOTH(3)) GRID_BAR();
    }

    if (IN(4) && DBG_STAGE != 4) {
        for (int u = F.vcu; u < 1024; u += F.G) retB_unit(F, u);
        if (BOTH(4)) GRID_BAR();
    }

    if (IN(5) && !DBG_STAGE) {
        pg8::DenseSched S; S.init(F.CAT, F.Wout_t, NTOK, D, F.G, (int)blockIdx.x);
        pg8::EpiResF32 E{F.x, F.out, D};
        pg8::gemm_phase<pg8::EpiResF32, pg8::DenseSched, false>(F.lds, S, E);
        if (BOTH(5)) GRID_BAR();
    }

    if (IN(6) && !DBG_SKIP_Y) {
        LAS float* lgs = (LAS float*)(F.lds + F.wave * 4096);
        const int fr = F.lane & 15, fq = F.lane >> 4;
        for (int grp = gw; grp < NTOK / 16; grp += NGW) {
            const int row = grp * 16 + fr;
            const float* xr = F.out + (size_t)row * D + 8 * fq;
            float ss = 0.f;
#pragma unroll 8
            for (int ks = 0; ks < 32; ++ks) { const f32x4 a = *(const f32x4*)(xr + 32 * ks), b2 = *(const f32x4*)(xr + 32 * ks + 4);
                ss += (a[0] * a[0] + a[1] * a[1]) + (a[2] * a[2] + a[3] * a[3]) + (b2[0] * b2[0] + b2[1] * b2[1]) + (b2[2] * b2[2] + b2[3] * b2[3]); }
            ss += __shfl_xor(ss, 16); ss += __shfl_xor(ss, 32);
            const float rstd = 1.f / sqrtf(ss * (1.f / D) + EPS);
            f32x4 acc[2] = {(f32x4){0.f, 0.f, 0.f, 0.f}, (f32x4){0.f, 0.f, 0.f, 0.f}};
            bf16_t* hrow = F.XN + (size_t)row * D + 8 * fq;
#pragma unroll 2
            for (int ks = 0; ks < 32; ++ks) {
                const f32x4 a = *(const f32x4*)(xr + 32 * ks), b2 = *(const f32x4*)(xr + 32 * ks + 4);
                const f32x4 wa = *(const f32x4*)(F.norm_ffn_w + 32 * ks + 8 * fq), wb = *(const f32x4*)(F.norm_ffn_w + 32 * ks + 8 * fq + 4);
                float hv[8];
#pragma unroll
                for (int j = 0; j < 4; ++j) { hv[j] = a[j] * rstd * wa[j]; hv[4 + j] = b2[j] * rstd * wb[j]; }
                u32x4 hh, hl;
#pragma unroll
                for (int j = 0; j < 4; ++j) { const unsigned p = cvt_pk_bf16(hv[2 * j], hv[2 * j + 1]); hh[j] = p; hl[j] = cvt_pk_bf16(hv[2 * j] - bf_lo(p), hv[2 * j + 1] - bf_hi(p)); }
                *(u32x4*)(hrow + 32 * ks) = hh;
                const bf16x8 bhh = __builtin_bit_cast(bf16x8, hh), bhl = __builtin_bit_cast(bf16x8, hl);
#pragma unroll
                for (int et = 0; et < 2; ++et) {
                    const bf16x8 wh = *(const bf16x8*)(F.Wr_hi + (16 * et + fr) * 1024 + 32 * ks + 8 * fq), wl = *(const bf16x8*)(F.Wr_lo + (16 * et + fr) * 1024 + 32 * ks + 8 * fq);
                    acc[et] = mfma16(wh, bhh, acc[et]); acc[et] = mfma16(wh, bhl, acc[et]); acc[et] = mfma16(wl, bhh, acc[et]);
                }
            }
#pragma unroll
            for (int et = 0; et < 2; ++et)
#pragma unroll
                for (int j = 0; j < 4; ++j) lgs[fr * 33 + 16 * et + 4 * fq + j] = acc[et][j];
            LDS_WAIT(); __builtin_amdgcn_wave_barrier();
            if (F.lane < 16) {
                const int r = grp * 16 + F.lane;
                float v0 = -3.0e38f, v1 = -3.0e38f, v2 = -3.0e38f, v3 = -3.0e38f; int i0 = 0, i1 = 0, i2 = 0, i3 = 0;
                for (int e = 0; e < 32; ++e) {
                    const float v = lgs[F.lane * 33 + e] + F.b_router[e];
                    if (v > v3) {
                        if (v > v0) { v3 = v2; i3 = i2; v2 = v1; i2 = i1; v1 = v0; i1 = i0; v0 = v; i0 = e; }
                        else if (v > v1) { v3 = v2; i3 = i2; v2 = v1; i2 = i1; v1 = v; i1 = e; }
                        else if (v > v2) { v3 = v2; i3 = i2; v2 = v; i2 = e; }
                        else { v3 = v; i3 = e; }
                    }
                }
                const float e1 = __expf(v1 - v0), e2 = __expf(v2 - v0), e3 = __expf(v3 - v0), inv = 1.0f / (1.0f + e1 + e2 + e3);
                const float g4[4] = {inv, e1 * inv, e2 * inv, e3 * inv}; const int i4[4] = {i0, i1, i2, i3};
#pragma unroll
                for (int k = 0; k < 4; ++k) { const int e = i4[k]; const unsigned pos = atomicAdd((unsigned*)(F.ctl + CW_CNT + 64 * e), 1u);
                    F.list[e * LISTCAP + (int)pos] = r * 4 + k; F.gate[r * 4 + k] = g4[k]; }
            }
            LDS_WAIT(); __builtin_amdgcn_wave_barrier();
        }
        if (BOTH(6)) GRID_BAR();
    }

    if ((IN(7) || IN(8)) && !DBG_SKIP_Y) {
        LAS int* tab = (LAS int*)(F.lds + TAB_OFF);
        if (F.tid < 32) tab[F.tid] = (int)__hip_atomic_load(F.ctl + CW_CNT + 64 * F.tid, RLX_AGENT);
        __syncthreads();
        if (F.tid == 0) { int s = 0; for (int e = 0; e < 32; ++e) { tab[32 + e] = s; s += (tab[e] + 255) >> 8; } tab[64] = s; }
        __syncthreads();
    }
    if (IN(7) && !DBG_SKIP_Y) {
        pg8::MoeSched<true> S; S.init(F.XN, F.Wgu_t, F.list, (const LAS int*)(F.lds + TAB_OFF), F.G, (int)blockIdx.x);
        pg8::EpiGU E{F.ACT, F.b_gu};
        pg8::gemm_phase<pg8::EpiGU, pg8::MoeSched<true>, true>(F.lds, S, E);
        if (BOTH(7)) GRID_BAR();
    }
    if (IN(8) && !DBG_SKIP_Y) {
        pg8::MoeSched<false> S; S.init(F.ACT, F.Wd_t, F.list, (const LAS int*)(F.lds + TAB_OFF), F.G, (int)blockIdx.x);
        pg8::EpiDown E{F.Y, F.b_down, F.list, F.gate};
        pg8::gemm_phase<pg8::EpiDown, pg8::MoeSched<false>, true>(F.lds, S, E);
        if (BOTH(8)) GRID_BAR();
    }
    if (IN(9) && DBG_STAGE) {
        for (int m = gw; m < NTOK; m += NGW) {
            const bf16_t* src = DBG_STAGE == 1 ? F.XN + (size_t)m * D : DBG_STAGE == 2 ? F.Z + (size_t)m * DIN + 1024 : DBG_STAGE == 3 ? F.CAT + (size_t)m * D : F.U + (size_t)m * D;
            for (int j = F.lane; j < D; j += 64) F.out[(size_t)m * D + j] = __uint_as_float(((unsigned)src[j]) << 16);
        }
    }
    if (IN(9) && !DBG_STAGE) {
        for (int m = gw; m < NTOK; m += NGW) {
            const GAS f32x4* xr = (const GAS f32x4*)((DBG_ONLY9 ? F.x : F.out) + (size_t)m * D) + F.lane; const GAS f32x4* wr = (const GAS f32x4*)F.norm_final_w + F.lane;
            f32x4 v[4]; float s = 0.f;
#pragma unroll
            for (int j = 0; j < 4; ++j) v[j] = xr[64 * j];
#pragma unroll
            for (int k = 0; k < (DBG_SKIP_Y ? 0 : 4); ++k) { const GAS u32x2* yr = (const GAS u32x2*)(F.Y + ((size_t)m * 4 + k) * D) + F.lane;
#pragma unroll
                for (int j = 0; j < 4; ++j) { const u32x2 y = yr[64 * j]; v[j] += (f32x4){bf_lo(y.x), bf_hi(y.x), bf_lo(y.y), bf_hi(y.y)}; } }
#pragma unroll
            for (int j = 0; j < 4; ++j) s += (v[j].x * v[j].x + v[j].y * v[j].y) + (v[j].z * v[j].z + v[j].w * v[j].w);
            const float rstd = 1.f / sqrtf(wave_sum(s) * (1.f / D) + EPS);
            GAS f32x4* orow = (GAS f32x4*)(F.out + (size_t)m * D) + F.lane;
#pragma unroll
            for (int j = 0; j < 4; ++j) orow[64 * j] = v[j] * rstd * wr[64 * j];
        }
    }
#undef IN
#undef BOTH
#undef GRID_BAR
}

extern "C" void kernel_launch(void* const* d_in, const int* in_sizes, int n_in, void* d_out, int out_size, void* d_ws, size_t ws_size, hipStream_t stream) {
    static int grid = 0;
    if (grid == 0) {
        if (n_in != 15 || in_sizes[0] != NTOK * D || out_size != NTOK * D || ws_size < WS_END) { fprintf(stderr, "kernel_launch: unexpected shapes / workspace (n_in %d, ws %zu); nothing launched\n", n_in, ws_size); grid = -1; return; }
        int dev = 0, cus = 0, per_cu = 0;
        if (hipGetDevice(&dev) != hipSuccess || hipDeviceGetAttribute(&cus, hipDeviceAttributeMultiprocessorCount, dev) != hipSuccess) { grid = -1; return; }
        if (hipFuncSetAttribute((const void*)fwd_kernel, hipFuncAttributeMaxDynamicSharedMemorySize, LDS_BYTES) != hipSuccess) { fprintf(stderr, "kernel_launch: hipFuncSetAttribute failed\n"); grid = -1; return; }
        if (hipOccupancyMaxActiveBlocksPerMultiprocessor(&per_cu, (const void*)fwd_kernel, NWAVES * 64, LDS_BYTES) != hipSuccess || per_cu < 1)
            fprintf(stderr, "kernel_launch: note: occupancy query reports %d workgroups per CU\n", per_cu);
        (void)hipGetLastError();
        grid = cus;
    }
    if (grid < 0) return;
    if (hipMemsetAsync((char*)d_ws + WS_CTL, 0, CTL_ZERO_BYTES, stream) != hipSuccess) { fprintf(stderr, "kernel_launch: memset failed\n"); return; }
    Args a{};
    for (int i = 0; i < 15; ++i) a.in[i] = (const float*)d_in[i];
    a.out = (float*)d_out; a.ws = (unsigned char*)d_ws;
    for (int h = 0; h < 4; ++h) a.lg2g[h] = (float)(log1p(-exp2(-5.0 - (double)h)) / log(2.0));
    for (int li = 0; li < N_LAUNCHES; ++li) {
        a.ph_lo = (N_LAUNCHES == PER_PHASE) ? li : 0; a.ph_hi = (N_LAUNCHES == PER_PHASE) ? li + 1 : PER_PHASE; a.li = li; a.pad = 0;
        hipLaunchKernelGGL(fwd_kernel, dim3(grid), dim3(NWAVES * 64), LDS_BYTES, stream, a);
        const hipError_t le = hipPeekAtLastError();
        if (le != hipSuccess) { fprintf(stderr, "kernel_launch: launch %d failed: %s\n", li, hipGetErrorName(le)); break; }
    }
}
```

```cpp
#include <hip/hip_runtime.h>
#include <cstdio>
#include <cstdint>
#include <cmath>

#ifndef DBG_ONLY9
#define DBG_ONLY9 0
#define DBG_STAGE 0
#endif
#ifndef DBG_SKIP_Y
#define DBG_SKIP_Y 0
#endif
#ifndef MK_N_LAUNCHES
#define MK_N_LAUNCHES 1
#endif
constexpr int PER_PHASE = 10;
constexpr int N_LAUNCHES = MK_N_LAUNCHES;

#define LAS __attribute__((address_space(3)))
#define GAS __attribute__((address_space(1)))
typedef unsigned short bf16_t;
typedef short bf16x8 __attribute__((ext_vector_type(8)));
typedef float f32x4 __attribute__((ext_vector_type(4)));
typedef float f32x2 __attribute__((ext_vector_type(2)));
typedef unsigned u32x4 __attribute__((ext_vector_type(4)));
typedef unsigned u32x2 __attribute__((ext_vector_type(2)));
typedef GAS unsigned gu32;

constexpr int NTOK = 16384, D = 1024, SEQ = 4096, DIN = 2560, NE = 32, FF = 1024, LISTCAP = 16384;
constexpr int NWAVES = 8;
constexpr float EPS = 1e-6f;

constexpr size_t MiB = 1u << 20;
constexpr size_t WS_CTL = 0, CTL_ZERO_BYTES = 1 * MiB;
constexpr size_t WS_LIST = 1 * MiB;
constexpr size_t WS_GATE = 3 * MiB;
constexpr size_t WS_WR = 4 * MiB;
constexpr size_t WS_WPOOL = 4 * MiB + 256 * 1024;
constexpr size_t WS_WIN = 5 * MiB;
constexpr size_t WS_WOUT = 10 * MiB;
constexpr size_t WS_XN = 12 * MiB;
constexpr size_t WS_CAT = 45 * MiB;
constexpr size_t WS_U = 77 * MiB;
constexpr size_t WS_Z = 109 * MiB;
constexpr size_t WS_Y = 45 * MiB;
constexpr size_t WS_WGU = 189 * MiB;
constexpr size_t WS_WD = 317 * MiB;
constexpr size_t WS_ACT = 381 * MiB;
constexpr size_t WS_END = 525 * MiB;
static_assert(WS_Y + (size_t)65536 * 1024 * 2 <= WS_WGU, "Y overlay");
constexpr int CW_TMO = 0, CW_CODE = 1;
constexpr int CW_CNT = 1024;
constexpr int CW_BAR = 4096;

constexpr int RING_BYTES = 131072;
constexpr int LDSCTL_OFF = RING_BYTES, MISC_OFF = LDSCTL_OFF + 320, TAB_OFF = LDSCTL_OFF + 512;
constexpr int LDS_BYTES = 147456;

#define RLX_AGENT __ATOMIC_RELAXED, __HIP_MEMORY_SCOPE_AGENT
#define LDS_WAIT() asm volatile("s_waitcnt lgkmcnt(0)" ::: "memory")
#define VM_WAIT() asm volatile("s_waitcnt vmcnt(0)" ::: "memory")
typedef __bf16 bf16x2_t __attribute__((ext_vector_type(2)));
__device__ __forceinline__ unsigned cvt_pk_bf16(float lo, float hi) { const f32x2 v = {lo, hi}; const bf16x2_t b = __builtin_convertvector(v, bf16x2_t); return __builtin_bit_cast(unsigned, b); }
__device__ __forceinline__ unsigned cvt4_fp8(float a, float b, float c, float d) { int r = __builtin_amdgcn_cvt_pk_fp8_f32(a, b, 0, false); r = __builtin_amdgcn_cvt_pk_fp8_f32(c, d, r, true); return (unsigned)r; }
typedef int i32x8 __attribute__((ext_vector_type(8)));
__device__ __forceinline__ float bf_lo(unsigned w) { return __uint_as_float(w << 16); }
__device__ __forceinline__ float bf_hi(unsigned w) { return __uint_as_float(w & 0xffff0000u); }
__device__ __forceinline__ float wave_sum(float v) {
#pragma unroll
    for (int o = 1; o < 64; o <<= 1) v += __shfl_xor(v, o);
    return v;
}
__device__ __forceinline__ f32x4 mfma16(bf16x8 a, bf16x8 b, f32x4 c) { return __builtin_amdgcn_mfma_f32_16x16x32_bf16(a, b, c, 0, 0, 0); }

namespace pg8 {
constexpr int BM = 256, BK = 64, HALF = 128, HTB = HALF * BK * 2, STAGE_BYTES = 8 * HTB, NXCD = 8, WGM = 8, KK = 1024;
__host__ __device__ __forceinline__ int lds_byte(int r, int c) { const int st = (r >> 4) * 2 + (c >> 5), rr = r & 15, cc = c & 31, ob = rr * 64 + cc * 2; return st * 1024 + (ob ^ (((ob >> 9) & 1) << 5)); }
__host__ __device__ __forceinline__ void stage_rc(int b, int& R, int& C) { const int st = b / 1024, sb = b % 1024, swz = sb ^ (((sb >> 9) & 1) << 5); R = (st >> 1) * 16 + swz / 64; C = (st & 1) * 32 + (swz % 64) / 2; }
__host__ __device__ __forceinline__ int perm32(int rho) { const int n = rho >> 4, i = rho & 15; return 8 * (i >> 2) + 4 * n + (i & 3); }

struct Unit { int pm, pn, e, rows, arow; };

__device__ __forceinline__ int xcd_remap(int L, int nwg) { const int q = nwg / NXCD, r = nwg % NXCD, xcd = L % NXCD, off = L / NXCD; return (xcd < r ? xcd * (q + 1) : r * (q + 1) + (xcd - r) * q) + off; }

struct DenseSched {
    const bf16_t* A; const bf16_t* Bt; int nM, nN, nwg, G, c;
    __device__ __forceinline__ void init(const bf16_t* A_, const bf16_t* Bt_, int M, int N, int G_, int c_) { A = A_; Bt = Bt_; nM = M / BM; nN = N / BM; nwg = nM * nN; G = G_; c = c_; }
    __device__ __forceinline__ bool next(int i, Unit& u) const {
        const long L = (long)i * G + c; if (L >= nwg) return false;
        const int wgid = xcd_remap((int)L, nwg);
        const int nig = WGM * nN, gid = wgid / nig, fm = gid * WGM, gsz = (nM - fm) < WGM ? (nM - fm) : WGM;
        u.pm = fm + ((wgid % nig) % gsz); u.pn = (wgid % nig) / gsz; u.e = 0; u.rows = 256; u.arow = u.pm * 256; return true;
    }
    __device__ __forceinline__ const char* a_base(const Unit& u) const { return (const char*)A + (size_t)u.pm * (2 * HALF * KK * 2); }
    __device__ __forceinline__ const char* b_base(const Unit& u) const { return (const char*)Bt + (size_t)u.pn * (2 * HALF * KK * 2); }
    __device__ __forceinline__ void a_offs(const Unit&, int tid, unsigned (&go)[2][2]) const {
#pragma unroll
        for (int i = 0; i < 2; ++i) { int R, C; stage_rc(tid * 16 + i * 8192, R, C);
#pragma unroll
            for (int h = 0; h < 2; ++h) go[h][i] = (unsigned)((h * HALF + R) * KK + C) * 2u; }
    }
};
constexpr int KU8 = 512;
template <bool GU> struct MoeSched {
    const bf16_t* A; const bf16_t* Bt; const int* list; const LAS int* tab; int nN, nwg, G, c;
    __device__ __forceinline__ void init(const bf16_t* A_, const bf16_t* Bt_, const int* list_, const LAS int* tab_, int G_, int c_) { A = A_; Bt = Bt_; list = list_; tab = tab_; nN = GU ? 8 : 4; nwg = __builtin_amdgcn_readfirstlane(tab_[32 + 32]) * nN; G = G_; c = c_; }
    __device__ __forceinline__ bool next(int i, Unit& u) const {
        const long L = (long)i * G + c; if (L >= nwg) return false;
        const int wgid = xcd_remap((int)L, nwg);
        int e = 0;
#pragma unroll 1
        for (int k = 1; k < 32; ++k) { if (tab[32 + k] * nN <= wgid) e = k; }
        const int tb0 = tab[32 + e], T = tab[32 + e + 1] - tb0, local = wgid - tb0 * nN;
        int rows = tab[e] - (local % T) * 256; if (rows > 256) rows = 256;
        u.e = __builtin_amdgcn_readfirstlane(e); u.pm = __builtin_amdgcn_readfirstlane(local % T); u.pn = __builtin_amdgcn_readfirstlane(local / T); u.rows = __builtin_amdgcn_readfirstlane(rows); u.arow = __builtin_amdgcn_readfirstlane((tb0 + local % T) * 256); return true;
    }
    __device__ __forceinline__ const char* a_base(const Unit& u) const { return GU ? (const char*)A : (const char*)A + (size_t)u.arow * (KU8 * 2); }
    __device__ __forceinline__ const char* b_base(const Unit& u) const { return (const char*)Bt + ((size_t)u.e * (GU ? 2048 : 1024) + (size_t)u.pn * 256) * (KU8 * 2); }
    __device__ __forceinline__ void a_offs(const Unit& u, int tid, unsigned (&go)[2][2]) const {
#pragma unroll
        for (int i = 0; i < 2; ++i) { int R, C; stage_rc(tid * 16 + i * 8192, R, C);
#pragma unroll
            for (int h = 0; h < 2; ++h) {
                if (GU) { const int r = h * HALF + R, rc = r < u.rows ? r : u.rows - 1; const int raw = list[u.e * LISTCAP + u.pm * 256 + rc]; const int tok = r < u.rows ? (raw >> 2) : NTOK; go[h][i] = (unsigned)(tok * KU8 + C) * 2u; }
                else go[h][i] = (unsigned)((h * HALF + R) * KU8 + C) * 2u;
            } }
    }
};

struct EpiBf16 {
    static constexpr bool PERM = true;
    bf16_t* O; int ldc;
    __device__ __forceinline__ void operator()(const f32x4 (&acc)[2][2][4][2], const Unit& u, int wr, int wc, int fr, int fq) const {
        const int row0 = u.pm * BM + wr * 64 + fr, col0 = u.pn * BM + wc * 32 + 8 * fq;
#pragma unroll
        for (int ai = 0; ai < 2; ++ai)
#pragma unroll
            for (int m = 0; m < 4; ++m) { bf16_t* rowp = O + (size_t)(row0 + ai * HALF + m * 16) * ldc + col0;
#pragma unroll
                for (int bj = 0; bj < 2; ++bj) { const f32x4 v0 = acc[ai][bj][m][0], v1 = acc[ai][bj][m][1];
                    u32x4 w; w.x = cvt_pk_bf16(v0[0], v0[1]); w.y = cvt_pk_bf16(v0[2], v0[3]); w.z = cvt_pk_bf16(v1[0], v1[1]); w.w = cvt_pk_bf16(v1[2], v1[3]);
                    *(u32x4*)(rowp + bj * HALF) = w; } }
    }
};
struct EpiResF32 {
    static constexpr bool PERM = false;
    const float* base; float* C; int ldc;
    __device__ __forceinline__ void operator()(const f32x4 (&acc)[2][2][4][2], const Unit& u, int wr, int wc, int fr, int fq) const {
        const int row0 = u.pm * BM + wr * 64 + fr, col0 = u.pn * BM + wc * 32 + 4 * fq;
#pragma unroll
        for (int ai = 0; ai < 2; ++ai)
#pragma unroll
            for (int m = 0; m < 4; ++m) { const size_t off = (size_t)(row0 + ai * HALF + m * 16) * ldc + col0;
#pragma unroll
                for (int bj = 0; bj < 2; ++bj)
#pragma unroll
                    for (int n = 0; n < 2; ++n) { const f32x4 b = *(const f32x4*)(base + off + bj * HALF + n * 16); *(f32x4*)(C + off + bj * HALF + n * 16) = acc[ai][bj][m][n] + b; }
                asm volatile("" ::: "memory"); }
    }
};
constexpr float WSCL = 1.0f / 32.0f;
__device__ __forceinline__ float swiglu(float g, float l) {
    g = fminf(g, 7.0f); l = fminf(fmaxf(l, -7.0f), 7.0f);
    const float s = __builtin_amdgcn_rcpf(1.0f + __builtin_amdgcn_exp2f(-1.702f * 1.4426950408889634f * g));
    return g * s * (l + 1.0f);
}
struct EpiGU {
    static constexpr bool PERM = true;
    unsigned char* ACT; const float* bgu;
    __device__ __forceinline__ void operator()(const f32x4 (&acc)[2][2][4][2], const Unit& u, int wr, int wc, int fr, int fq) const {
        const int row0 = u.arow + wr * 64 + fr, colg = u.pn * 128 + wc * 32 + 8 * fq;
        const float* bp = bgu + (size_t)u.e * 2048 + colg;
        const f32x4 bg0 = *(const f32x4*)(bp), bg1 = *(const f32x4*)(bp + 4), bl0 = *(const f32x4*)(bp + 1024), bl1 = *(const f32x4*)(bp + 1024 + 4);
#pragma unroll
        for (int ai = 0; ai < 2; ++ai)
#pragma unroll
            for (int m = 0; m < 4; ++m) {
                const f32x4 g0 = acc[ai][0][m][0] * WSCL + bg0, g1 = acc[ai][0][m][1] * WSCL + bg1, l0 = acc[ai][1][m][0] * WSCL + bl0, l1 = acc[ai][1][m][1] * WSCL + bl1;
                u32x2 w; w.x = cvt4_fp8(swiglu(g0[0], l0[0]), swiglu(g0[1], l0[1]), swiglu(g0[2], l0[2]), swiglu(g0[3], l0[3]));
                w.y = cvt4_fp8(swiglu(g1[0], l1[0]), swiglu(g1[1], l1[1]), swiglu(g1[2], l1[2]), swiglu(g1[3], l1[3]));
                *(u32x2*)(ACT + (size_t)(row0 + ai * HALF + m * 16) * FF + colg) = w; }
    }
};
struct EpiDown {
    static constexpr bool PERM = true;
    bf16_t* Y; const float* bd; const int* list; const float* gate;
    __device__ __forceinline__ void operator()(const f32x4 (&acc)[2][2][4][2], const Unit& u, int wr, int wc, int fr, int fq) const {
        const int col0 = u.pn * BM + wc * 32 + 8 * fq;
        const float* bp = bd + (size_t)u.e * 1024 + col0;
        const int* lp = list + u.e * LISTCAP + u.pm * 256;
        int rb = wr * 64 + fr; asm volatile("" : "+v"(rb));
#pragma unroll
        for (int bj = 0; bj < 2; ++bj) {
            const f32x4 b0 = *(const f32x4*)(bp + bj * HALF), b1 = *(const f32x4*)(bp + bj * HALF + 4);
#pragma unroll
            for (int ai = 0; ai < 2; ++ai)
#pragma unroll
                for (int m = 0; m < 4; ++m) { const int r = ai * HALF + m * 16 + rb;
                    if (r < u.rows) { const int slot = lp[r]; const float gt = gate[slot];
                        const f32x4 v0 = (acc[ai][bj][m][0] * WSCL + b0) * gt, v1 = (acc[ai][bj][m][1] * WSCL + b1) * gt;
                        u32x4 w; w.x = cvt_pk_bf16(v0[0], v0[1]); w.y = cvt_pk_bf16(v0[2], v0[3]); w.z = cvt_pk_bf16(v1[0], v1[1]); w.w = cvt_pk_bf16(v1[2], v1[3]);
                        *(u32x4*)(Y + (size_t)slot * D + col0 + bj * HALF) = w; } }
        }
    }
};

typedef int i32x4 __attribute__((ext_vector_type(4)));
__device__ __forceinline__ bf16x8 lo8(i32x8 a) { return __builtin_bit_cast(bf16x8, __builtin_shufflevector(a, a, 0, 1, 2, 3)); }
__device__ __forceinline__ bf16x8 hi8(i32x8 a) { return __builtin_bit_cast(bf16x8, __builtin_shufflevector(a, a, 4, 5, 6, 7)); }
template <class Epi, class Sched, bool ALIGN_EPI, bool FP8 = false>
__device__ __forceinline__ void gemm_phase(LAS unsigned char* lds, const Sched& S, const Epi& E) {
    const int tid = threadIdx.x, wid = __builtin_amdgcn_readfirstlane(tid >> 6), lane = tid & 63, wr = wid >> 2, wc = wid & 3, fr = lane & 15, fq = lane >> 4;
    constexpr int K = FP8 ? 512 : KK;
    int nt = K / BK; asm volatile("" : "+s"(nt));
    unsigned voffB[2];
#pragma unroll
    for (int i = 0; i < 2; ++i) { int R, C; stage_rc(tid * 16 + i * 8192, R, C); const int Rb = Epi::PERM ? ((R & ~31) + perm32(R & 31)) : R;
        voffB[i] = (unsigned)(Rb * K + C) * 2u; }
    constexpr size_t kstep = (size_t)(BK * 2);
    constexpr size_t hstep = (size_t)HALF * K * 2;
    const unsigned ldsw = (unsigned)wid * 1024u;
    const int aoff = lds_byte(wr * 64 + fr, fq * 8), boff = lds_byte(wc * 32 + fr, fq * 8);
#define PG8_SA(b, h) (((b) * 2 + (h)) * HTB)
#define PG8_SB(b, h) ((4 + (b) * 2 + (h)) * HTB)
#define PG8_STAGE(bufoff, gbase, voff) do { _Pragma("unroll") for (int _i = 0; _i < 2; ++_i) \
        __builtin_amdgcn_global_load_lds((const unsigned*)((const char*)(gbase) + (voff)[_i]), (LAS unsigned*)(lds + (bufoff) + ldsw + _i * 8192), 16, 0, 0); } while (0)
#define PG8_LDA(dst, b, h) do { _Pragma("unroll") for (int m = 0; m < 4; ++m) { const u32x4 _x = *(const LAS u32x4*)(lds + PG8_SA(b, h) + aoff + m * 2048), _y = *(const LAS u32x4*)(lds + PG8_SA(b, h) + aoff + m * 2048 + 1024); \
        dst[m] = (i32x8){(int)_x[0], (int)_x[1], (int)_x[2], (int)_x[3], (int)_y[0], (int)_y[1], (int)_y[2], (int)_y[3]}; } } while (0)
#define PG8_LDB(dst, b, h) do { _Pragma("unroll") for (int n = 0; n < 2; ++n) { const u32x4 _x = *(const LAS u32x4*)(lds + PG8_SB(b, h) + boff + n * 2048), _y = *(const LAS u32x4*)(lds + PG8_SB(b, h) + boff + n * 2048 + 1024); \
        dst[n] = (i32x8){(int)_x[0], (int)_x[1], (int)_x[2], (int)_x[3], (int)_y[0], (int)_y[1], (int)_y[2], (int)_y[3]}; } } while (0)
#define PG8_MMA(ai, bj, At, Bt) do { __builtin_amdgcn_s_setprio(1); _Pragma("unroll") for (int m = 0; m < 4; ++m) _Pragma("unroll") for (int n = 0; n < 2; ++n) { \
        if constexpr (FP8) { acc[ai][bj][m][n] = __builtin_amdgcn_mfma_scale_f32_16x16x128_f8f6f4(Bt[n], At[m], acc[ai][bj][m][n], 0, 0, 0, 0, 0, 0); } \
        else { acc[ai][bj][m][n] = __builtin_amdgcn_mfma_f32_16x16x32_bf16(lo8(Bt[n]), lo8(At[m]), acc[ai][bj][m][n], 0, 0, 0); acc[ai][bj][m][n] = __builtin_amdgcn_mfma_f32_16x16x32_bf16(hi8(Bt[n]), hi8(At[m]), acc[ai][bj][m][n], 0, 0, 0); } } __builtin_amdgcn_s_setprio(0); } while (0)
#define PG8_WAIT_V(n) asm volatile("s_waitcnt vmcnt(" #n ")" ::: "memory")
#define PG8_WAIT_L(n) asm volatile("s_waitcnt lgkmcnt(" #n ")" ::: "memory")
#define PG8_BAR __builtin_amdgcn_s_barrier()
#define PG8_SCHED __builtin_amdgcn_sched_barrier(0)
    Unit cur, nxt; int ui = 0;
    if (!S.next(0, cur)) return;
    f32x4 acc[2][2][4][2];
#pragma unroll
    for (int a = 0; a < 2; ++a)
#pragma unroll
        for (int b = 0; b < 2; ++b)
#pragma unroll
            for (int m = 0; m < 4; ++m)
#pragma unroll
                for (int n = 0; n < 2; ++n) acc[a][b][m][n] = (f32x4){0.f, 0.f, 0.f, 0.f};
    i32x8 At[4], B0[2], B1[2];
    const char* cA = S.a_base(cur); const char* cB = S.b_base(cur);
    unsigned go[2][2];
    { int t2 = tid; asm volatile("" : "+v"(t2)); S.a_offs(cur, t2, go); }
    PG8_STAGE(PG8_SB(0, 0), cB, voffB); PG8_STAGE(PG8_SB(0, 1), cB + hstep, voffB); PG8_STAGE(PG8_SA(0, 0), cA, go[0]); PG8_STAGE(PG8_SA(0, 1), cA, go[1]);
    if (wr == 1) PG8_BAR;
    PG8_WAIT_V(2); PG8_BAR;
    PG8_STAGE(PG8_SB(1, 0), cB + kstep, voffB); PG8_STAGE(PG8_SA(1, 0), cA + kstep, go[0]); PG8_STAGE(PG8_SB(1, 1), cB + hstep + kstep, voffB);
    PG8_WAIT_V(6); PG8_BAR;
    for (;;) {
        const bool has_next = S.next(ui + 1, nxt);
        const char* nA = has_next ? S.a_base(nxt) : cA; const char* nB = has_next ? S.b_base(nxt) : cB;
#pragma clang loop unroll(disable)
        for (int t = 0; t < nt; t += 2) {
            const bool last = (t == nt - 2);
            asm volatile("" : "+v"(voffB[0]), "+v"(voffB[1]));
            const char* a1 = cA + (size_t)(t + 1) * kstep;
            const char* a2 = last ? nA : cA + (size_t)(t + 2) * kstep; const char* b2 = last ? nB : cB + (size_t)(t + 2) * kstep;
            const char* a3 = a2 + kstep; const char* b3 = b2 + kstep;
            PG8_LDB(B0, 0, 0); PG8_LDB(B1, 0, 1); PG8_SCHED; PG8_LDA(At, 0, 0); PG8_STAGE(PG8_SA(1, 1), a1, go[1]);
            if (last && has_next) { int t2 = tid; asm volatile("" : "+v"(t2)); S.a_offs(nxt, t2, go); }
            PG8_WAIT_V(8); PG8_WAIT_L(0); PG8_BAR; PG8_MMA(0, 0, At, B0); PG8_MMA(0, 1, At, B1); PG8_BAR; PG8_SCHED;
            PG8_LDA(At, 0, 1); PG8_STAGE(PG8_SB(0, 0), b2, voffB); PG8_STAGE(PG8_SB(0, 1), b2 + hstep, voffB); PG8_STAGE(PG8_SA(0, 0), a2, go[0]);
            PG8_WAIT_V(8); PG8_WAIT_L(0); PG8_BAR; PG8_MMA(1, 0, At, B0); PG8_MMA(1, 1, At, B1); PG8_BAR; PG8_SCHED;
            PG8_LDB(B0, 1, 0); PG8_LDB(B1, 1, 1); PG8_SCHED; PG8_LDA(At, 1, 0); PG8_STAGE(PG8_SA(0, 1), a2, go[1]);
            PG8_WAIT_V(8); PG8_WAIT_L(0); PG8_BAR; PG8_MMA(0, 0, At, B0); PG8_MMA(0, 1, At, B1); PG8_BAR; PG8_SCHED;
            PG8_LDA(At, 1, 1); PG8_STAGE(PG8_SB(1, 0), b3, voffB); PG8_STAGE(PG8_SB(1, 1), b3 + hstep, voffB); PG8_STAGE(PG8_SA(1, 0), a3, go[0]);
            PG8_WAIT_V(8); PG8_WAIT_L(0); PG8_BAR; PG8_MMA(1, 0, At, B0); PG8_MMA(1, 1, At, B1); PG8_BAR; PG8_SCHED;
        }
        if constexpr (ALIGN_EPI) { if (wr == 0) PG8_BAR; }
        { int t2 = tid; asm volatile("" : "+v"(t2)); const int l2 = t2 & 63; E(acc, cur, wr, wc, l2 & 15, l2 >> 4); }
        if (!has_next) break;
#pragma unroll
        for (int a = 0; a < 2; ++a)
#pragma unroll
            for (int b = 0; b < 2; ++b)
#pragma unroll
                for (int m = 0; m < 4; ++m)
#pragma unroll
                    for (int n = 0; n < 2; ++n) acc[a][b][m][n] = (f32x4){0.f, 0.f, 0.f, 0.f};
        cur = nxt; cA = nA; cB = nB; ++ui;
        if constexpr (ALIGN_EPI) { if (wr == 1) PG8_BAR; }
    }
    PG8_WAIT_V(0);
    if constexpr (!ALIGN_EPI) { if (wr == 0) PG8_BAR; }
    PG8_BAR;
#undef PG8_SA
#undef PG8_SB
#undef PG8_STAGE
#undef PG8_LDA
#undef PG8_LDB
#undef PG8_MMA
#undef PG8_WAIT_V
#undef PG8_WAIT_L
#undef PG8_BAR
#undef PG8_SCHED
}
}

#define XB_TMO      128
#define XB_XCNT(j)  (256  + 64 * (j))
#define XB_XSUB(j)  (1280 + 64 * (j))
#define XB_XGEN(j)  (2304 + 64 * (j))
#define XB_TOP      3328
#define XB_TOPGEN   3392
#define XCD_BAR_WORDS 3456
#define XB_SPIN_CAP (1u << 18)
__device__ __forceinline__ unsigned xb_ld(unsigned* p)              { return __hip_atomic_load(p, __ATOMIC_RELAXED, __HIP_MEMORY_SCOPE_AGENT); }
__device__ __forceinline__ unsigned xb_add(unsigned* p, unsigned v) { return __hip_atomic_fetch_add(p, v, __ATOMIC_RELAXED, __HIP_MEMORY_SCOPE_AGENT); }
__device__ __forceinline__ unsigned xb_xcc_id() { return (unsigned)__builtin_amdgcn_s_getreg((3 << 11) | 20) & 0xFu; }
#define XB_SPIN(cond, bar) do { unsigned _sp = 0; while (cond) { __builtin_amdgcn_s_sleep(1); \
    if ((++_sp & 255u) == 0u) { if (xb_ld(&(bar)[XB_TMO])) break; if (_sp > XB_SPIN_CAP) { atomicAdd(&(bar)[XB_TMO], 1u); break; } } } } while (0)
struct XcdBarrier { unsigned* bar; unsigned x; volatile LAS unsigned* st; };
__device__ __forceinline__ XcdBarrier xcd_barrier_post(unsigned* bar, volatile LAS unsigned* st) {
    XcdBarrier b; b.bar = bar; b.x = xb_xcc_id(); b.st = st;
    if (threadIdx.x == 0) (void)xb_add(&bar[XB_XCNT(b.x)], 1u);
    return b;
}
__device__ __forceinline__ void xcd_barrier_complete(unsigned* bar, unsigned x, unsigned& nloc, unsigned& nx) {
    const unsigned G = gridDim.x * gridDim.y * gridDim.z;
    unsigned sum, cnt, mine, sp = 0u;
    for (;;) {
        sum = 0u; cnt = 0u; mine = 0u;
#pragma unroll
        for (unsigned j = 0; j < 16; ++j) { const unsigned c = xb_ld(&bar[XB_XCNT(j)]); sum += c; cnt += (c > 0u) ? 1u : 0u; mine = (j == x) ? c : mine; }
        if (sum == G) break;
        __builtin_amdgcn_s_sleep(1);
        if ((++sp & 255u) == 0u) { if (xb_ld(&bar[XB_TMO])) break; if (sp > XB_SPIN_CAP) { atomicAdd(&bar[XB_TMO], 1u); break; } }
    }
    nloc = mine > 0u ? mine : 1u; nx = cnt > 0u ? cnt : 1u;
}
__device__ __forceinline__ void xcd_barrier(const XcdBarrier& b) {
    asm volatile("s_waitcnt vmcnt(0)" ::: "memory");
    __syncthreads();
    if (threadIdx.x == 0) {
        unsigned* bar = b.bar;
        __builtin_amdgcn_s_waitcnt(0);
        unsigned nloc = b.st[0], nx = b.st[1];
        if (nloc == 0u) { xcd_barrier_complete(bar, b.x, nloc, nx); b.st[0] = nloc; b.st[1] = nx; }
        const unsigned old = xb_add(&bar[XB_XSUB(b.x)], 1u);
        const unsigned gen = old / nloc;
        if (old + 1u == (gen + 1u) * nloc) {
            __builtin_amdgcn_fence(__ATOMIC_RELEASE, "agent");
            asm volatile("s_waitcnt vmcnt(0)" ::: "memory");
            const unsigned og = xb_add(&bar[XB_TOP], 1u);
            const unsigned tg = og / nx;
            if (og + 1u == (tg + 1u) * nx) xb_add(&bar[XB_TOPGEN], 1u);
            else XB_SPIN(xb_ld(&bar[XB_TOPGEN]) == tg, bar);
            __builtin_amdgcn_fence(__ATOMIC_ACQUIRE, "agent");
            xb_add(&bar[XB_XGEN(b.x)], 1u);
            asm volatile("s_waitcnt vmcnt(0)" ::: "memory");
        } else {
            XB_SPIN(xb_ld(&bar[XB_XGEN(b.x)]) == gen, bar);
            __builtin_amdgcn_fence(__ATOMIC_ACQUIRE, "agent");
            asm volatile("s_waitcnt vmcnt(0)" ::: "memory");
        }
    }
    __syncthreads();
}

struct Frame {
    LAS unsigned char* lds;
    volatile LAS unsigned* MISC;
    gu32* ctl;
    int tid, lane, wave, vcu, G;
    const float *x, *norm_mix_w, *w_in, *ret_norm_w, *w_pool, *pool_scale, *w_out, *norm_ffn_w, *w_router, *b_router, *w_gu, *b_gu, *w_down, *b_down, *norm_final_w;
    float* out;
    bf16_t *Wr_hi, *Wr_lo, *Wpool_t, *Win_t, *Wout_t, *XN, *CAT, *U, *Z, *Y;
    unsigned char *Wgu8, *Wd8, *ACT8, *H8;
    int* list; float* gate;
    float lg2g0, lg2g1, lg2g2, lg2g3;
    __device__ __forceinline__ float lg2(int h) const { return h == 0 ? lg2g0 : (h == 1 ? lg2g1 : (h == 2 ? lg2g2 : lg2g3)); }
};

template <bool SPLIT>
__device__ __forceinline__ void p0_transpose_item(const float* W, int ldw, bf16_t* WT, bf16_t* WT2, int ldo, LAS float* scr, int k0, int n0, int orow0, int lane) {
#pragma unroll 8
    for (int i = 0; i < 32; ++i) { const int kk = 2 * i + (lane >> 5); scr[kk * 33 + (lane & 31)] = W[(size_t)(k0 + kk) * ldw + n0 + (lane & 31)]; }
    LDS_WAIT(); asm volatile("" ::: "memory");
    const int c = lane & 7;
#pragma unroll
    for (int j = 0; j < 4; ++j) { const int n = (lane >> 3) + 8 * j; const LAS float* s = scr + (8 * c) * 33 + n;
        float v[8];
#pragma unroll
        for (int q = 0; q < 8; ++q) v[q] = s[q * 33];
        u32x4 o; o.x = cvt_pk_bf16(v[0], v[1]); o.y = cvt_pk_bf16(v[2], v[3]); o.z = cvt_pk_bf16(v[4], v[5]); o.w = cvt_pk_bf16(v[6], v[7]);
        *(GAS u32x4*)(WT + (size_t)(orow0 + n) * ldo + k0 + 8 * c) = o;
        if (SPLIT) { u32x4 o2; o2.x = cvt_pk_bf16(v[0] - bf_lo(o.x), v[1] - bf_hi(o.x)); o2.y = cvt_pk_bf16(v[2] - bf_lo(o.y), v[3] - bf_hi(o.y));
            o2.z = cvt_pk_bf16(v[4] - bf_lo(o.z), v[5] - bf_hi(o.z)); o2.w = cvt_pk_bf16(v[6] - bf_lo(o.w), v[7] - bf_hi(o.w));
            *(GAS u32x4*)(WT2 + (size_t)(orow0 + n) * ldo + k0 + 8 * c) = o2; } }
    LDS_WAIT(); asm volatile("" ::: "memory");
}
__device__ __forceinline__ void p0_transpose_item_fp8(const float* W, int ldw, unsigned char* WT, LAS float* scr, int k0, int n0, int orow0, int lane) {
#pragma unroll 8
    for (int i = 0; i < 32; ++i) { const int kk = 2 * i + (lane >> 5); scr[kk * 33 + (lane & 31)] = W[(size_t)(k0 + kk) * ldw + n0 + (lane & 31)]; }
    LDS_WAIT(); asm volatile("" ::: "memory");
    const int c = lane & 7;
#pragma unroll
    for (int j = 0; j < 4; ++j) { const int n = (lane >> 3) + 8 * j; const LAS float* s = scr + (8 * c) * 33 + n;
        float v[8];
#pragma unroll
        for (int q = 0; q < 8; ++q) v[q] = s[q * 33] * 32.0f;
        u32x2 o; o.x = cvt4_fp8(v[0], v[1], v[2], v[3]); o.y = cvt4_fp8(v[4], v[5], v[6], v[7]);
        *(GAS u32x2*)(WT + (size_t)(orow0 + n) * 1024 + k0 + 8 * c) = o; }
    LDS_WAIT(); asm volatile("" ::: "memory");
}
__device__ __forceinline__ void rms_row_to_bf16(int lane, const float* xrow, const float* w, bf16_t* orow) {
    const GAS f32x4* xr = (const GAS f32x4*)xrow + lane; const GAS f32x4* wr = (const GAS f32x4*)w + lane;
    f32x4 v[4]; float s = 0.f;
#pragma unroll
    for (int j = 0; j < 4; ++j) { v[j] = xr[64 * j]; s += (v[j].x * v[j].x + v[j].y * v[j].y) + (v[j].z * v[j].z + v[j].w * v[j].w); }
    const float rstd = 1.f / sqrtf(wave_sum(s) * (1.f / D) + EPS);
    GAS unsigned long long* o8 = (GAS unsigned long long*)orow + lane;
#pragma unroll
    for (int j = 0; j < 4; ++j) { const f32x4 ww = wr[64 * j]; o8[64 * j] = (unsigned long long)cvt_pk_bf16(v[j].x * rstd * ww.x, v[j].y * rstd * ww.y) | ((unsigned long long)cvt_pk_bf16(v[j].z * rstd * ww.z, v[j].w * rstd * ww.w) << 32); }
}
__device__ __forceinline__ void p0_prologue(Frame& F) {
    LAS float* scr = (LAS float*)(F.lds + F.wave * 16384);
    const int gw = F.vcu * NWAVES + F.wave, NGW = F.G * NWAVES;
    constexpr int I_IN = 16 * 80, I_OUT = 16 * 32, I_POOL = 32, I_R = 16, I_GU = 32 * 16 * 64, I_D = 32 * 16 * 32;
    constexpr int NITEMS = I_IN + I_OUT + I_POOL + I_R + I_GU + I_D;
    for (int it = gw; it < NITEMS; it += NGW) {
        int r = it;
        if (r < I_GU) { const int e = r / 1024, q = r % 1024, kb = q / 64, nb = q % 64, n0 = nb * 32;
            const int orow = (n0 < 1024) ? ((n0 >> 7) * 256 + (n0 & 127)) : ((((n0 - 1024) >> 7) * 256) + 128 + ((n0 - 1024) & 127));
            p0_transpose_item_fp8(F.w_gu + (size_t)e * 1024 * 2048, 2048, F.Wgu8 + (size_t)e * 2048 * 1024, scr, kb * 64, n0, orow, F.lane); continue; } r -= I_GU;
        if (r < I_D) { const int e = r / 512, q = r % 512, kb = q / 32, nb = q % 32;
            p0_transpose_item_fp8(F.w_down + (size_t)e * 1024 * 1024, 1024, F.Wd8 + (size_t)e * 1024 * 1024, scr, kb * 64, nb * 32, nb * 32, F.lane); continue; } r -= I_D;
        if (r < I_IN) { const int kb = r / 80, nb = r % 80; p0_transpose_item<false>(F.w_in, DIN, F.Win_t, nullptr, 1024, scr, kb * 64, nb * 32, nb * 32, F.lane); continue; } r -= I_IN;
        if (r < I_OUT) { const int kb = r / 32, nb = r % 32; p0_transpose_item<false>(F.w_out, 1024, F.Wout_t, nullptr, 1024, scr, kb * 64, nb * 32, nb * 32, F.lane); continue; } r -= I_OUT;
        if (r < I_POOL) { const int g = r / 8, q = r % 8, kb = q / 4, nb = q % 4; p0_transpose_item<false>(F.w_pool + g * 16384, 128, F.Wpool_t + g * 16384, nullptr, 128, scr, kb * 64, nb * 32, nb * 32, F.lane); continue; } r -= I_POOL;
        { const int kb = r; p0_transpose_item<true>(F.w_router, 32, F.Wr_hi, F.Wr_lo, 1024, scr, kb * 64, 0, 0, F.lane); }
    }
    for (int m = gw; m < NTOK; m += NGW) rms_row_to_bf16(F.lane, F.x + (size_t)m * D, F.norm_mix_w, F.XN + (size_t)m * D);
}

__device__ __forceinline__ void rope_cs(int pos, int j, float& cs, float& sn) {
    const float inv = __builtin_amdgcn_exp2f((float)j * (-13.287712379549449f / 64.0f));
    const double revd = (double)pos * (double)inv * 0.15915494309189535;
    const float rev = (float)(revd - __builtin_floor(revd));
    sn = __builtin_amdgcn_sinf(rev); cs = __builtin_amdgcn_cosf(rev);
}

__device__ __forceinline__ void retA_unit(Frame& F, int unit) {
    const int c = unit & 63, bh = unit >> 6, h = bh & 3, b = bh >> 2;
    const int tok0 = b * SEQ + c * 64;
    LAS bf16_t* KT = (LAS bf16_t*)(F.lds);
    LAS bf16_t* VT = KT + 128 * 72;
    const int t = F.tid, m = t >> 3, o = t & 7;
    {
        const bf16_t* zrow = F.Z + (size_t)(tok0 + m) * DIN + h * 128 + 8 * o;
        const u32x4 klo = *(const u32x4*)(zrow + 512), khi = *(const u32x4*)(zrow + 512 + 64);
        const u32x4 vlo = *(const u32x4*)(zrow + 1024), vhi = *(const u32x4*)(zrow + 1024 + 64);
        const float ksc = __builtin_amdgcn_exp2f(F.lg2(h) * (float)(63 - m)) * 0.08838834764831845f;
        const int pos = c * 64 + m;
#pragma unroll
        for (int i = 0; i < 8; ++i) {
            const unsigned wl = klo[i >> 1], wh = khi[i >> 1];
            const float lo = (i & 1) ? bf_hi(wl) : bf_lo(wl), hi = (i & 1) ? bf_hi(wh) : bf_lo(wh);
            float cs, sn; rope_cs(pos, 8 * o + i, cs, sn);
            const unsigned pk = cvt_pk_bf16((lo * cs - hi * sn) * ksc, (lo * sn + hi * cs) * ksc);
            KT[(8 * o + i) * 72 + m] = (bf16_t)(pk & 0xffffu); KT[(64 + 8 * o + i) * 72 + m] = (bf16_t)(pk >> 16);
            const unsigned vl = vlo[i >> 1], vh = vhi[i >> 1];
            VT[(8 * o + i) * 72 + m] = (bf16_t)((i & 1) ? (vl >> 16) : (vl & 0xffffu)); VT[(64 + 8 * o + i) * 72 + m] = (bf16_t)((i & 1) ? (vh >> 16) : (vh & 0xffffu));
        }
    }
    __syncthreads();
    {
        const int w = F.wave, fr = F.lane & 15, fq = F.lane >> 4;
        bf16x8 vf[2];
#pragma unroll
        for (int ks = 0; ks < 2; ++ks) vf[ks] = *(const LAS bf16x8*)(VT + (16 * w + fr) * 72 + 32 * ks + 8 * fq);
        bf16_t* urow = F.U + ((size_t)unit * 128 + 16 * w + fr) * 128 + 4 * fq;
#pragma unroll
        for (int dt = 0; dt < 8; ++dt) {
            f32x4 acc = (f32x4){0.f, 0.f, 0.f, 0.f};
#pragma unroll
            for (int ks = 0; ks < 2; ++ks) { const bf16x8 kf = *(const LAS bf16x8*)(KT + (16 * dt + fr) * 72 + 32 * ks + 8 * fq); acc = mfma16(kf, vf[ks], acc); }
            u32x2 pk; pk.x = cvt_pk_bf16(acc[0], acc[1]); pk.y = cvt_pk_bf16(acc[2], acc[3]);
            *(u32x2*)(urow + 16 * dt) = pk;
        }
    }
    __syncthreads();
}

__device__ __forceinline__ void pool_unit(Frame& F, int unit) {
    const int g = unit & 3, tile = unit >> 2, st = (tile & 63) * 64;
    const int tok0 = tile * 64, win = 2 << g;
    LAS float* P = (LAS float*)(F.lds);
    LAS bf16_t* A = (LAS bf16_t*)(F.lds + 79 * 132 * 4);
    const int t = F.tid;
    for (int idx = t; idx < 79 * 16; idx += 512) {
        const int r = idx >> 4, ch = idx & 15, s = st - 15 + r;
        f32x4 a = (f32x4){0.f, 0.f, 0.f, 0.f}, b2 = a;
        if (s >= 0) { const u32x4 w = *(const u32x4*)(F.Z + (size_t)(tok0 - 15 + r) * DIN + 2048 + g * 128 + 8 * ch);
            a = (f32x4){bf_lo(w.x), bf_hi(w.x), bf_lo(w.y), bf_hi(w.y)}; b2 = (f32x4){bf_lo(w.z), bf_hi(w.z), bf_lo(w.w), bf_hi(w.w)}; }
        *(LAS f32x4*)(P + r * 132 + 8 * ch) = a; *(LAS f32x4*)(P + r * 132 + 8 * ch + 4) = b2;
    }
    __syncthreads();
    {
        const int n = t >> 3, c0 = (t & 7) * 16, s = st + n;
        const float rc = 1.0f / (float)((s + 1 < win) ? (s + 1) : win);
#pragma unroll
        for (int q = 0; q < 4; ++q) {
            f32x4 sum = (f32x4){0.f, 0.f, 0.f, 0.f};
            for (int j = 0; j < win; ++j) sum += *(const LAS f32x4*)(P + (15 + n - j) * 132 + c0 + 4 * q);
            const f32x4 self = *(const LAS f32x4*)(P + (15 + n) * 132 + c0 + 4 * q);
            const f32x4 pv = sum * rc - self;
            u32x2 pk; pk.x = cvt_pk_bf16(pv[0], pv[1]); pk.y = cvt_pk_bf16(pv[2], pv[3]);
            *(LAS u32x2*)(A + n * 136 + c0 + 4 * q) = pk;
        }
    }
    __syncthreads();
    {
        const int w = F.wave, rt = w & 3, chf = w >> 2, fr = F.lane & 15, fq = F.lane >> 4;
        bf16x8 af[4];
#pragma unroll
        for (int ks = 0; ks < 4; ++ks) af[ks] = *(const LAS bf16x8*)(A + (16 * rt + fr) * 136 + 32 * ks + 8 * fq);
        const bf16_t* wp = F.Wpool_t + g * 16384;
        bf16_t* orow = F.CAT + (size_t)(tok0 + 16 * rt + fr) * D + 512 + g * 128;
#pragma unroll
        for (int dd = 0; dd < 4; ++dd) { const int dt = 4 * chf + dd;
            f32x4 acc = (f32x4){0.f, 0.f, 0.f, 0.f};
#pragma unroll
            for (int ks = 0; ks < 4; ++ks) { const bf16x8 wf = *(const bf16x8*)(wp + (16 * dt + fr) * 128 + 32 * ks + 8 * fq); acc = mfma16(wf, af[ks], acc); }
            const f32x4 sc = *(const f32x4*)(F.pool_scale + g * 128 + 16 * dt + 4 * fq);
            u32x2 pk; pk.x = cvt_pk_bf16(acc[0] * sc[0], acc[1] * sc[1]); pk.y = cvt_pk_bf16(acc[2] * sc[2], acc[3] * sc[3]);
            *(u32x2*)(orow + 16 * dt + 4 * fq) = pk;
        }
    }
    __syncthreads();
}

__device__ __forceinline__ void retB_unit(Frame& F, int unit) {
    const int c = unit & 63, bh = unit >> 6, h = bh & 3, b = bh >> 2;
    const int tok0 = b * SEQ + c * 64;
    LAS bf16_t* Q = (LAS bf16_t*)(F.lds);
    LAS bf16_t* Kr = Q + 64 * 136;
    LAS bf16_t* VT = Kr + 64 * 136;
    LAS bf16_t* Sm = VT + 128 * 72;
    LAS float* red = (LAS float*)(Sm + 64 * 72);
    const int t = F.tid;
    const float lg = F.lg2(h);
    {
        const int m = t >> 3, o = t & 7;
        const bf16_t* zrow = F.Z + (size_t)(tok0 + m) * DIN + h * 128 + 8 * o;
        const u32x4 qlo = *(const u32x4*)(zrow), qhi = *(const u32x4*)(zrow + 64);
        const u32x4 klo = *(const u32x4*)(zrow + 512), khi = *(const u32x4*)(zrow + 512 + 64);
        const u32x4 vlo = *(const u32x4*)(zrow + 1024), vhi = *(const u32x4*)(zrow + 1024 + 64);
        const int pos = c * 64 + m;
        unsigned ql[4], qh[4], kl[4], kh[4];
#pragma unroll
        for (int i = 0; i < 8; i += 2) {
            float cs0, sn0, cs1, sn1; rope_cs(pos, 8 * o + i, cs0, sn0); rope_cs(pos, 8 * o + i + 1, cs1, sn1);
            { const float l0 = bf_lo(qlo[i >> 1]), l1 = bf_hi(qlo[i >> 1]), h0 = bf_lo(qhi[i >> 1]), h1 = bf_hi(qhi[i >> 1]);
              ql[i >> 1] = cvt_pk_bf16(l0 * cs0 - h0 * sn0, l1 * cs1 - h1 * sn1); qh[i >> 1] = cvt_pk_bf16(l0 * sn0 + h0 * cs0, l1 * sn1 + h1 * cs1); }
            { const float l0 = bf_lo(klo[i >> 1]), l1 = bf_hi(klo[i >> 1]), h0 = bf_lo(khi[i >> 1]), h1 = bf_hi(khi[i >> 1]); const float sc = 0.08838834764831845f;
              kl[i >> 1] = cvt_pk_bf16((l0 * cs0 - h0 * sn0) * sc, (l1 * cs1 - h1 * sn1) * sc); kh[i >> 1] = cvt_pk_bf16((l0 * sn0 + h0 * cs0) * sc, (l1 * sn1 + h1 * cs1) * sc); }
        }
        *(LAS u32x4*)(Q + m * 136 + 8 * o) = (u32x4){ql[0], ql[1], ql[2], ql[3]}; *(LAS u32x4*)(Q + m * 136 + 64 + 8 * o) = (u32x4){qh[0], qh[1], qh[2], qh[3]};
        *(LAS u32x4*)(Kr + m * 136 + 8 * o) = (u32x4){kl[0], kl[1], kl[2], kl[3]}; *(LAS u32x4*)(Kr + m * 136 + 64 + 8 * o) = (u32x4){kh[0], kh[1], kh[2], kh[3]};
#pragma unroll
        for (int i = 0; i < 8; ++i) { const unsigned vl = vlo[i >> 1], vh = vhi[i >> 1];
            VT[(8 * o + i) * 72 + m] = (bf16_t)((i & 1) ? (vl >> 16) : (vl & 0xffffu)); VT[(64 + 8 * o + i) * 72 + m] = (bf16_t)((i & 1) ? (vh >> 16) : (vh & 0xffffu)); }
    }
    __syncthreads();
    const int w = F.wave, fr = F.lane & 15, fq = F.lane >> 4;
    {
        const int ntl = w >> 1;
        bf16x8 qf[4];
#pragma unroll
        for (int ks = 0; ks < 4; ++ks) qf[ks] = *(const LAS bf16x8*)(Q + (16 * ntl + fr) * 136 + 32 * ks + 8 * fq);
#pragma unroll
        for (int mm = 0; mm < 2; ++mm) { const int mt = 2 * (w & 1) + mm;
            f32x4 acc = (f32x4){0.f, 0.f, 0.f, 0.f};
#pragma unroll
            for (int ks = 0; ks < 4; ++ks) { const bf16x8 kf = *(const LAS bf16x8*)(Kr + (16 * mt + fr) * 136 + 32 * ks + 8 * fq); acc = mfma16(kf, qf[ks], acc); }
            const int n = 16 * ntl + fr, m0 = 16 * mt + 4 * fq;
            float sv[4];
#pragma unroll
            for (int j = 0; j < 4; ++j) { const int dd = n - (m0 + j); sv[j] = acc[j] * __builtin_amdgcn_exp2f(lg * (float)(dd < 0 ? -dd : dd)); }
            u32x2 pk; pk.x = cvt_pk_bf16(sv[0], sv[1]); pk.y = cvt_pk_bf16(sv[2], sv[3]);
            *(LAS u32x2*)(Sm + n * 72 + m0) = pk;
        }
    }
    __syncthreads();
    {
        const int rt = w & 3, chf = w >> 2, n = 16 * rt + fr;
        bf16x8 sf[2], qf[4];
#pragma unroll
        for (int ks = 0; ks < 2; ++ks) sf[ks] = *(const LAS bf16x8*)(Sm + n * 72 + 32 * ks + 8 * fq);
#pragma unroll
        for (int ks = 0; ks < 4; ++ks) qf[ks] = *(const LAS bf16x8*)(Q + n * 136 + 32 * ks + 8 * fq);
        const float qd = __builtin_amdgcn_exp2f(lg * (float)(n + 1));
        f32x4 ov[4]; float ss = 0.f;
#pragma unroll
        for (int dd = 0; dd < 4; ++dd) { const int vt = 4 * chf + dd;
            f32x4 ai = (f32x4){0.f, 0.f, 0.f, 0.f}, ac = ai;
#pragma unroll
            for (int ks = 0; ks < 2; ++ks) { const bf16x8 vf = *(const LAS bf16x8*)(VT + (16 * vt + fr) * 72 + 32 * ks + 8 * fq); ai = mfma16(vf, sf[ks], ai); }
            const bf16_t* rrow = F.U + ((size_t)unit * 128 + 16 * vt + fr) * 128 + 8 * fq;
#pragma unroll
            for (int ks = 0; ks < 4; ++ks) { const bf16x8 rf = *(const bf16x8*)(rrow + 32 * ks); ac = mfma16(rf, qf[ks], ac); }
            ov[dd] = ai + ac * qd;
            ss += (ov[dd][0] * ov[dd][0] + ov[dd][1] * ov[dd][1]) + (ov[dd][2] * ov[dd][2] + ov[dd][3] * ov[dd][3]);
        }
        ss += __shfl_xor(ss, 16); ss += __shfl_xor(ss, 32);
        if (fq == 0) red[chf * 64 + n] = ss;
        __syncthreads();
        const float rstd = 1.f / sqrtf((red[n] + red[64 + n]) * (1.f / 128.f) + EPS);
        const size_t tok = (size_t)(tok0 + n);
#pragma unroll
        for (int dd = 0; dd < 4; ++dd) { const int v0 = 16 * (4 * chf + dd) + 4 * fq;
            const u32x2 gw2 = *(const u32x2*)(F.Z + tok * DIN + 1536 + h * 128 + v0);
            const f32x4 rw = *(const f32x4*)(F.ret_norm_w + h * 128 + v0);
            const float gv[4] = {bf_lo(gw2.x), bf_hi(gw2.x), bf_lo(gw2.y), bf_hi(gw2.y)};
            float r[4];
#pragma unroll
            for (int j = 0; j < 4; ++j) { const float sg = gv[j] * __builtin_amdgcn_rcpf(1.0f + __builtin_amdgcn_exp2f(-1.4426950408889634f * gv[j])); r[j] = ov[dd][j] * rstd * rw[j] * sg; }
            u32x2 pk; pk.x = cvt_pk_bf16(r[0], r[1]); pk.y = cvt_pk_bf16(r[2], r[3]);
            *(u32x2*)(F.CAT + tok * D + h * 128 + v0) = pk;
        }
    }
    __syncthreads();
}

struct Args { const float* in[15]; float* out; unsigned char* ws; float lg2g[4]; int ph_lo, ph_hi, li, pad; };

__global__ void __launch_bounds__(NWAVES * 64, 2) fwd_kernel(Args args) {
    extern __shared__ __attribute__((aligned(16))) unsigned char lds[];
    Frame F;
    F.lds = (LAS unsigned char*)lds;
    F.MISC = (volatile LAS unsigned*)(F.lds + MISC_OFF);
    F.tid = threadIdx.x; F.lane = F.tid & 63; F.wave = __builtin_amdgcn_readfirstlane(F.tid >> 6);
    F.G = gridDim.x; { const int bx = blockIdx.x; F.vcu = (F.G % 8 == 0) ? (bx % 8) * (F.G / 8) + bx / 8 : bx; }
    unsigned char* ws = args.ws;
    F.ctl = (gu32*)(ws + WS_CTL);
    F.x = args.in[0]; F.norm_mix_w = args.in[1]; F.w_in = args.in[2]; F.ret_norm_w = args.in[3]; F.w_pool = args.in[4]; F.pool_scale = args.in[5]; F.w_out = args.in[6]; F.norm_ffn_w = args.in[7];
    F.w_router = args.in[8]; F.b_router = args.in[9]; F.w_gu = args.in[10]; F.b_gu = args.in[11]; F.w_down = args.in[12]; F.b_down = args.in[13]; F.norm_final_w = args.in[14]; F.out = args.out;
    F.Wr_hi = (bf16_t*)(ws + WS_WR); F.Wr_lo = F.Wr_hi + 32 * 1024; F.Wpool_t = (bf16_t*)(ws + WS_WPOOL); F.Win_t = (bf16_t*)(ws + WS_WIN); F.Wout_t = (bf16_t*)(ws + WS_WOUT);
    F.XN = (bf16_t*)(ws + WS_XN); F.CAT = (bf16_t*)(ws + WS_CAT); F.U = (bf16_t*)(ws + WS_U); F.Z = (bf16_t*)(ws + WS_Z); F.Y = (bf16_t*)(ws + WS_Y);
    F.Wgu8 = ws + WS_WGU; F.Wd8 = ws + WS_WD; F.ACT8 = ws + WS_ACT; F.H8 = ws + WS_XN; F.list = (int*)(ws + WS_LIST); F.gate = (float*)(ws + WS_GATE);
    F.lg2g0 = args.lg2g[0]; F.lg2g1 = args.lg2g[1]; F.lg2g2 = args.lg2g[2]; F.lg2g3 = args.lg2g[3];
    for (int u = F.tid; u < (LDS_BYTES - LDSCTL_OFF) / 4; u += NWAVES * 64) ((LAS unsigned*)(F.lds + LDSCTL_OFF))[u] = 0u;
    __syncthreads();
    XcdBarrier bar; bar.bar = (unsigned*)(F.ctl + CW_BAR); bar.x = 0; bar.st = nullptr;
    if (N_LAUNCHES != PER_PHASE) bar = xcd_barrier_post((unsigned*)(F.ctl + CW_BAR), F.MISC + 8);
#define GRID_BAR() do { if (N_LAUNCHES != PER_PHASE) xcd_barrier(bar); } while (0)
    const int lo = DBG_ONLY9 ? (args.ph_lo < 9 ? 9 : args.ph_lo) : args.ph_lo, hi = args.ph_hi;
#define IN(k) (lo <= (k) && (k) < hi)
#define BOTH(k) (IN(k) && IN((k) + 1))
    const int gw = F.vcu * NWAVES + F.wave, NGW = F.G * NWAVES;

    if (IN(0)) { p0_prologue(F); if (BOTH(0)) GRID_BAR(); }

    if (IN(1)) {
        pg8::DenseSched S; S.init(F.XN, F.Win_t, NTOK, DIN, F.G, (int)blockIdx.x);
        pg8::EpiBf16 E{F.Z, DIN};
        pg8::gemm_phase<pg8::EpiBf16, pg8::DenseSched, true>(F.lds, S, E);
        if (BOTH(1)) GRID_BAR();
    }

    if (IN(2)) {
        for (int u = F.vcu; u < 1024; u += F.G) retA_unit(F, u);
        for (int u = F.vcu; u < 1024; u += F.G) pool_unit(F, u);
        if (BOTH(2)) GRID_BAR();
    }

    if (IN(3) && DBG_STAGE != 4) {
        const int gt = F.vcu * 512 + F.tid, NGT = F.G * 512;
        for (int p = gt; p < 16 * 8192; p += NGT) {
            const int bh = p >> 13, i = p & 8191;
            const float cd = __builtin_amdgcn_exp2f(F.lg2(bh & 3) * 64.0f);
            unsigned* up = (unsigned*)(F.U + (size_t)bh * 64 * 16384) + i;
            float s0 = 0.f, s1 = 0.f;
#pragma unroll 8
            for (int c = 0; c < 64; ++c) { const unsigned uw = up[(size_t)c * 8192]; up[(size_t)c * 8192] = cvt_pk_bf16(s0, s1); s0 = cd * s0 + bf_lo(uw); s1 = cd * s1 + bf_hi(uw); }
        }
        if (BOTH(3)) GRID_BAR();
    }

    if (IN(4) && DBG_STAGE != 4) {
        for (int u = F.vcu; u < 1024; u += F.G) retB_unit(F, u);
        if (BOTH(4)) GRID_BAR();
    }

    if (IN(5) && !DBG_STAGE) {
        pg8::DenseSched S; S.init(F.CAT, F.Wout_t, NTOK, D, F.G, (int)blockIdx.x);
        pg8::EpiResF32 E{F.x, F.out, D};
        pg8::gemm_phase<pg8::EpiResF32, pg8::DenseSched, false>(F.lds, S, E);
        if (BOTH(5)) GRID_BAR();
    }

    if (IN(6) && !DBG_SKIP_Y) {
        LAS float* lgs = (LAS float*)(F.lds + F.wave * 4096);
        if (gw == 0) { GAS u32x4* z = (GAS u32x4*)(F.H8 + (size_t)NTOK * D) + F.lane; z[0] = (u32x4){0u, 0u, 0u, 0u}; }
        const int fr = F.lane & 15, fq = F.lane >> 4;
        for (int grp = gw; grp < NTOK / 16; grp += NGW) {
            const int row = grp * 16 + fr;
            const float* xr = F.out + (size_t)row * D + 8 * fq;
            float ss = 0.f;
#pragma unroll 8
            for (int ks = 0; ks < 32; ++ks) { const f32x4 a = *(const f32x4*)(xr + 32 * ks), b2 = *(const f32x4*)(xr + 32 * ks + 4);
                ss += (a[0] * a[0] + a[1] * a[1]) + (a[2] * a[2] + a[3] * a[3]) + (b2[0] * b2[0] + b2[1] * b2[1]) + (b2[2] * b2[2] + b2[3] * b2[3]); }
            ss += __shfl_xor(ss, 16); ss += __shfl_xor(ss, 32);
            const float rstd = 1.f / sqrtf(ss * (1.f / D) + EPS);
            f32x4 acc[2] = {(f32x4){0.f, 0.f, 0.f, 0.f}, (f32x4){0.f, 0.f, 0.f, 0.f}};
            unsigned char* hrow = F.H8 + (size_t)row * D + 8 * fq;
#pragma unroll 2
            for (int ks = 0; ks < 32; ++ks) {
                const f32x4 a = *(const f32x4*)(xr + 32 * ks), b2 = *(const f32x4*)(xr + 32 * ks + 4);
                const f32x4 wa = *(const f32x4*)(F.norm_ffn_w + 32 * ks + 8 * fq), wb = *(const f32x4*)(F.norm_ffn_w + 32 * ks + 8 * fq + 4);
                float hv[8];
#pragma unroll
                for (int j = 0; j < 4; ++j) { hv[j] = a[j] * rstd * wa[j]; hv[4 + j] = b2[j] * rstd * wb[j]; }
                u32x4 hh, hl;
#pragma unroll
                for (int j = 0; j < 4; ++j) { const unsigned p = cvt_pk_bf16(hv[2 * j], hv[2 * j + 1]); hh[j] = p; hl[j] = cvt_pk_bf16(hv[2 * j] - bf_lo(p), hv[2 * j + 1] - bf_hi(p)); }
                { u32x2 h8; h8.x = cvt4_fp8(hv[0], hv[1], hv[2], hv[3]); h8.y = cvt4_fp8(hv[4], hv[5], hv[6], hv[7]); *(u32x2*)(hrow + 32 * ks) = h8; }
                const bf16x8 bhh = __builtin_bit_cast(bf16x8, hh), bhl = __builtin_bit_cast(bf16x8, hl);
#pragma unroll
                for (int et = 0; et < 2; ++et) {
                    const bf16x8 wh = *(const bf16x8*)(F.Wr_hi + (16 * et + fr) * 1024 + 32 * ks + 8 * fq), wl = *(const bf16x8*)(F.Wr_lo + (16 * et + fr) * 1024 + 32 * ks + 8 * fq);
                    acc[et] = mfma16(wh, bhh, acc[et]); acc[et] = mfma16(wh, bhl, acc[et]); acc[et] = mfma16(wl, bhh, acc[et]);
                }
            }
#pragma unroll
            for (int et = 0; et < 2; ++et)
#pragma unroll
                for (int j = 0; j < 4; ++j) lgs[fr * 33 + 16 * et + 4 * fq + j] = acc[et][j];
            LDS_WAIT(); __builtin_amdgcn_wave_barrier();
            if (F.lane < 16) {
                const int r = grp * 16 + F.lane;
                float v0 = -3.0e38f, v1 = -3.0e38f, v2 = -3.0e38f, v3 = -3.0e38f; int i0 = 0, i1 = 0, i2 = 0, i3 = 0;
                for (int e = 0; e < 32; ++e) {
                    const float v = lgs[F.lane * 33 + e] + F.b_router[e];
                    if (v > v3) {
                        if (v > v0) { v3 = v2; i3 = i2; v2 = v1; i2 = i1; v1 = v0; i1 = i0; v0 = v; i0 = e; }
                        else if (v > v1) { v3 = v2; i3 = i2; v2 = v1; i2 = i1; v1 = v; i1 = e; }
                        else if (v > v2) { v3 = v2; i3 = i2; v2 = v; i2 = e; }
                        else { v3 = v; i3 = e; }
                    }
                }
                const float e1 = __expf(v1 - v0), e2 = __expf(v2 - v0), e3 = __expf(v3 - v0), inv = 1.0f / (1.0f + e1 + e2 + e3);
                const float g4[4] = {inv, e1 * inv, e2 * inv, e3 * inv}; const int i4[4] = {i0, i1, i2, i3};
#pragma unroll
                for (int k = 0; k < 4; ++k) { const int e = i4[k]; const unsigned pos = atomicAdd((unsigned*)(F.ctl + CW_CNT + 64 * e), 1u);
                    F.list[e * LISTCAP + (int)pos] = r * 4 + k; F.gate[r * 4 + k] = g4[k]; }
            }
            LDS_WAIT(); __builtin_amdgcn_wave_barrier();
        }
        if (BOTH(6)) GRID_BAR();
    }

    if ((IN(7) || IN(8)) && !DBG_SKIP_Y) {
        LAS int* tab = (LAS int*)(F.lds + TAB_OFF);
        if (F.tid < 32) tab[F.tid] = (int)__hip_atomic_load(F.ctl + CW_CNT + 64 * F.tid, RLX_AGENT);
        __syncthreads();
        if (F.tid == 0) { int s = 0; for (int e = 0; e < 32; ++e) { tab[32 + e] = s; s += (tab[e] + 255) >> 8; } tab[64] = s; }
        __syncthreads();
    }
    if (IN(7) && !DBG_SKIP_Y) {
        pg8::MoeSched<true> S; S.init((const bf16_t*)F.H8, (const bf16_t*)F.Wgu8, F.list, (const LAS int*)(F.lds + TAB_OFF), F.G, (int)blockIdx.x);
        pg8::EpiGU E{F.ACT8, F.b_gu};
        pg8::gemm_phase<pg8::EpiGU, pg8::MoeSched<true>, true, true>(F.lds, S, E);
        if (BOTH(7)) GRID_BAR();
    }
    if (IN(8) && !DBG_SKIP_Y) {
        pg8::MoeSched<false> S; S.init((const bf16_t*)F.ACT8, (const bf16_t*)F.Wd8, F.list, (const LAS int*)(F.lds + TAB_OFF), F.G, (int)blockIdx.x);
        pg8::EpiDown E{F.Y, F.b_down, F.list, F.gate};
        pg8::gemm_phase<pg8::EpiDown, pg8::MoeSched<false>, true, true>(F.lds, S, E);
        if (BOTH(8)) GRID_BAR();
    }
    if (IN(9) && DBG_STAGE) {
        for (int m = gw; m < NTOK; m += NGW) {
            const bf16_t* src = DBG_STAGE == 1 ? F.XN + (size_t)m * D : DBG_STAGE == 2 ? F.Z + (size_t)m * DIN + 1024 : DBG_STAGE == 3 ? F.CAT + (size_t)m * D : F.U + (size_t)m * D;
            for (int j = F.lane; j < D; j += 64) F.out[(size_t)m * D + j] = __uint_as_float(((unsigned)src[j]) << 16);
        }
    }
    if (IN(9) && !DBG_STAGE) {
        for (int m = gw; m < NTOK; m += NGW) {
            const GAS f32x4* xr = (const GAS f32x4*)((DBG_ONLY9 ? F.x : F.out) + (size_t)m * D) + F.lane; const GAS f32x4* wr = (const GAS f32x4*)F.norm_final_w + F.lane;
            f32x4 v[4]; float s = 0.f;
#pragma unroll
            for (int j = 0; j < 4; ++j) v[j] = xr[64 * j];
#pragma unroll
            for (int k = 0; k < (DBG_SKIP_Y ? 0 : 4); ++k) { const GAS u32x2* yr = (const GAS u32x2*)(F.Y + ((size_t)m * 4 + k) * D) + F.lane;
#pragma unroll
                for (int j = 0; j < 4; ++j) { const u32x2 y = yr[64 * j]; v[j] += (f32x4){bf_lo(y.x), bf_hi(y.x), bf_lo(y.y), bf_hi(y.y)}; } }
#pragma unroll
            for (int j = 0; j < 4; ++j) s += (v[j].x * v[j].x + v[j].y * v[j].y) + (v[j].z * v[j].z + v[j].w * v[j].w);
            const float rstd = 1.f / sqrtf(wave_sum(s) * (1.f / D) + EPS);
            GAS f32x4* orow = (GAS f32x4*)(F.out + (size_t)m * D) + F.lane;
#pragma unroll
            for (int j = 0; j < 4; ++j) orow[64 * j] = v[j] * rstd * wr[64 * j];
        }
    }
#undef IN
#undef BOTH
#undef GRID_BAR
}

extern "C" void kernel_launch(void* const* d_in, const int* in_sizes, int n_in, void* d_out, int out_size, void* d_ws, size_t ws_size, hipStream_t stream) {
    static int grid = 0;
    if (grid == 0) {
        if (n_in != 15 || in_sizes[0] != NTOK * D || out_size != NTOK * D || ws_size < WS_END) { fprintf(stderr, "kernel_launch: unexpected shapes / workspace (n_in %d, ws %zu); nothing launched\n", n_in, ws_size); grid = -1; return; }
        int dev = 0, cus = 0, per_cu = 0;
        if (hipGetDevice(&dev) != hipSuccess || hipDeviceGetAttribute(&cus, hipDeviceAttributeMultiprocessorCount, dev) != hipSuccess) { grid = -1; return; }
        if (hipFuncSetAttribute((const void*)fwd_kernel, hipFuncAttributeMaxDynamicSharedMemorySize, LDS_BYTES) != hipSuccess) { fprintf(stderr, "kernel_launch: hipFuncSetAttribute failed\n"); grid = -1; return; }
        if (hipOccupancyMaxActiveBlocksPerMultiprocessor(&per_cu, (const void*)fwd_kernel, NWAVES * 64, LDS_BYTES) != hipSuccess || per_cu < 1)
            fprintf(stderr, "kernel_launch: note: occupancy query reports %d workgroups per CU\n", per_cu);
        (void)hipGetLastError();
        grid = cus;
    }
    if (grid < 0) return;
    if (hipMemsetAsync((char*)d_ws + WS_CTL, 0, CTL_ZERO_BYTES, stream) != hipSuccess) { fprintf(stderr, "kernel_launch: memset failed\n"); return; }
    Args a{};
    for (int i = 0; i < 15; ++i) a.in[i] = (const float*)d_in[i];
    a.out = (float*)d_out; a.ws = (unsigned char*)d_ws;
    for (int h = 0; h < 4; ++h) a.lg2g[h] = (float)(log1p(-exp2(-5.0 - (double)h)) / log(2.0));
    for (int li = 0; li < N_LAUNCHES; ++li) {
        a.ph_lo = (N_LAUNCHES == PER_PHASE) ? li : 0; a.ph_hi = (N_LAUNCHES == PER_PHASE) ? li + 1 : PER_PHASE; a.li = li; a.pad = 0;
        hipLaunchKernelGGL(fwd_kernel, dim3(grid), dim3(NWAVES * 64), LDS_BYTES, stream, a);
        const hipError_t le = hipPeekAtLastError();
        if (le != hipSuccess) { fprintf(stderr, "kernel_launch: launch %d failed: %s\n", li, hipGetErrorName(le)); break; }
    }
}
```

```cpp
#include <hip/hip_runtime.h>
#include <cstdio>
#include <cstdint>
#include <cmath>

#ifndef DBG_ONLY9
#define DBG_ONLY9 0
#define DBG_STAGE 0
#endif
#ifndef DBG_SPIN_A
#define DBG_SPIN_A -1
#define DBG_SPIN_B -1
#define DBG_SPIN_W 2
#endif
#ifndef DBG_SKIP_Y
#define DBG_SKIP_Y 0
#endif
#ifndef MK_N_LAUNCHES
#define MK_N_LAUNCHES 1
#endif
constexpr int PER_PHASE = 10;
constexpr int N_LAUNCHES = MK_N_LAUNCHES;

#define LAS __attribute__((address_space(3)))
#define GAS __attribute__((address_space(1)))
typedef unsigned short bf16_t;
typedef short bf16x8 __attribute__((ext_vector_type(8)));
typedef float f32x4 __attribute__((ext_vector_type(4)));
typedef float f32x2 __attribute__((ext_vector_type(2)));
typedef unsigned u32x4 __attribute__((ext_vector_type(4)));
typedef unsigned u32x2 __attribute__((ext_vector_type(2)));
typedef GAS unsigned gu32;
typedef int i32x2 __attribute__((ext_vector_type(2)));

constexpr int NTOK = 16384, D = 1024, SEQ = 4096, DIN = 2560, NE = 32, FF = 1024, LISTCAP = 16384;
constexpr int NWAVES = 8;
constexpr float EPS = 1e-6f;

constexpr size_t MiB = 1u << 20;
constexpr size_t WS_CTL = 0, CTL_ZERO_BYTES = 1 * MiB;
constexpr size_t WS_LIST = 1 * MiB;
constexpr size_t WS_SSQ = 5 * MiB + 512 * 1024;
constexpr size_t WS_WR = 6 * MiB + 512 * 1024;
constexpr size_t WS_WPOOL = 6 * MiB + 768 * 1024;
constexpr size_t WS_WIN = 7 * MiB;
constexpr size_t WS_WOUT = 12 * MiB;
constexpr size_t WS_XN = 14 * MiB;
constexpr size_t WS_CAT = 47 * MiB;
constexpr size_t WS_U = 79 * MiB;
constexpr size_t WS_Z = 111 * MiB;
constexpr size_t WS_Y = 47 * MiB;
constexpr size_t WS_WGU = 192 * MiB;
constexpr size_t WS_WD = 256 * MiB;
constexpr size_t WS_ACT = 288 * MiB;
constexpr size_t WS_END = 360 * MiB;
static_assert(WS_Y + (size_t)65536 * 1024 * 2 <= WS_WGU && WS_Z + (size_t)16384 * 2560 * 2 <= WS_WGU, "Y overlay / Z");
constexpr int CW_TMO = 0, CW_CODE = 1;
constexpr int CW_CNT = 1024;
constexpr int CW_BAR = 4096;

constexpr int RING_BYTES = 131072;
constexpr int LDSCTL_OFF = RING_BYTES, MISC_OFF = LDSCTL_OFF + 320, TAB_OFF = LDSCTL_OFF + 512;
constexpr int LDS_BYTES = 147456;

#define RLX_AGENT __ATOMIC_RELAXED, __HIP_MEMORY_SCOPE_AGENT
#define LDS_WAIT() asm volatile("s_waitcnt lgkmcnt(0)" ::: "memory")
#define VM_WAIT() asm volatile("s_waitcnt vmcnt(0)" ::: "memory")
typedef __bf16 bf16x2_t __attribute__((ext_vector_type(2)));
__device__ __forceinline__ unsigned cvt_pk_bf16(float lo, float hi) { const f32x2 v = {lo, hi}; const bf16x2_t b = __builtin_convertvector(v, bf16x2_t); return __builtin_bit_cast(unsigned, b); }
__device__ __forceinline__ unsigned cvt4_fp8(float a, float b, float c, float d) { int r = __builtin_amdgcn_cvt_pk_fp8_f32(a, b, 0, false); r = __builtin_amdgcn_cvt_pk_fp8_f32(c, d, r, true); return (unsigned)r; }
typedef int i32x8 __attribute__((ext_vector_type(8)));
__device__ __forceinline__ float bf_lo(unsigned w) { return __uint_as_float(w << 16); }
__device__ __forceinline__ float bf_hi(unsigned w) { return __uint_as_float(w & 0xffff0000u); }
__device__ __forceinline__ float wave_sum(float v) {
#pragma unroll
    for (int o = 1; o < 64; o <<= 1) v += __shfl_xor(v, o);
    return v;
}
__device__ __forceinline__ f32x4 mfma16(bf16x8 a, bf16x8 b, f32x4 c) { return __builtin_amdgcn_mfma_f32_16x16x32_bf16(a, b, c, 0, 0, 0); }

namespace pg8 {
constexpr int BM = 256, BK = 64, HALF = 128, HTB = HALF * BK * 2, STAGE_BYTES = 8 * HTB, NXCD = 8, WGM = 8, KK = 1024;
__host__ __device__ __forceinline__ int lds_byte(int r, int c) { const int st = (r >> 4) * 2 + (c >> 5), rr = r & 15, cc = c & 31, ob = rr * 64 + cc * 2; return st * 1024 + (ob ^ (((ob >> 9) & 1) << 5)); }
__host__ __device__ __forceinline__ void stage_rc(int b, int& R, int& C) { const int st = b / 1024, sb = b % 1024, swz = sb ^ (((sb >> 9) & 1) << 5); R = (st >> 1) * 16 + swz / 64; C = (st & 1) * 32 + (swz % 64) / 2; }
__host__ __device__ __forceinline__ int perm32(int rho) { const int n = rho >> 4, i = rho & 15; return 8 * (i >> 2) + 4 * n + (i & 3); }

struct Unit { int pm, pn, e, rows, arow; };

__device__ __forceinline__ int xcd_remap(int L, int nwg) { const int q = nwg / NXCD, r = nwg % NXCD, xcd = L % NXCD, off = L / NXCD; return (xcd < r ? xcd * (q + 1) : r * (q + 1) + (xcd - r) * q) + off; }

struct DenseSched {
    const bf16_t* A; const bf16_t* Bt; int nM, nN, nwg, G, c;
    __device__ __forceinline__ void init(const bf16_t* A_, const bf16_t* Bt_, int M, int N, int G_, int c_) { A = A_; Bt = Bt_; nM = M / BM; nN = N / BM; nwg = nM * nN; G = G_; c = c_; }
    __device__ __forceinline__ bool next(int i, Unit& u) const {
        const long L = (long)i * G + c; if (L >= nwg) return false;
        const int wgid = xcd_remap((int)L, nwg);
        const int nig = WGM * nN, gid = wgid / nig, fm = gid * WGM, gsz = (nM - fm) < WGM ? (nM - fm) : WGM;
        u.pm = fm + ((wgid % nig) % gsz); u.pn = (wgid % nig) / gsz; u.e = 0; u.rows = 256; u.arow = u.pm * 256; return true;
    }
    __device__ __forceinline__ const char* a_base(const Unit& u) const { return (const char*)A + (size_t)u.pm * (2 * HALF * KK * 2); }
    __device__ __forceinline__ const char* b_base(const Unit& u) const { return (const char*)Bt + (size_t)u.pn * (2 * HALF * KK * 2); }
    __device__ __forceinline__ void a_offs(const Unit&, int tid, unsigned (&go)[2][2]) const {
#pragma unroll
        for (int i = 0; i < 2; ++i) { int R, C; stage_rc(tid * 16 + i * 8192, R, C);
#pragma unroll
            for (int h = 0; h < 2; ++h) go[h][i] = (unsigned)((h * HALF + R) * KK + C) * 2u; }
    }
};
constexpr int KU8 = 512;
template <bool GU> struct MoeSched {
    const bf16_t* A; const bf16_t* Bt; const i32x2* list; const LAS int* tab; int nN, nwg, G, c;
    __device__ __forceinline__ void init(const bf16_t* A_, const bf16_t* Bt_, const i32x2* list_, const LAS int* tab_, int G_, int c_) { A = A_; Bt = Bt_; list = list_; tab = tab_; nN = GU ? 8 : 4; nwg = __builtin_amdgcn_readfirstlane(tab_[32 + 32]) * nN; G = G_; c = c_; }
    __device__ __forceinline__ bool next(int i, Unit& u) const {
        const long L = (long)i * G + c; if (L >= nwg) return false;
        const int wgid = xcd_remap((int)L, nwg);
        int e = 0;
#pragma unroll 1
        for (int k = 1; k < 32; ++k) { if (tab[32 + k] * nN <= wgid) e = k; }
        const int tb0 = tab[32 + e], T = tab[32 + e + 1] - tb0, local = wgid - tb0 * nN;
        int rows = tab[e] - (local % T) * 256; if (rows > 256) rows = 256;
        u.e = __builtin_amdgcn_readfirstlane(e); u.pm = __builtin_amdgcn_readfirstlane(local % T); u.pn = __builtin_amdgcn_readfirstlane(local / T); u.rows = __builtin_amdgcn_readfirstlane(rows); u.arow = __builtin_amdgcn_readfirstlane((tb0 + local % T) * 256); return true;
    }
    __device__ __forceinline__ const char* a_base(const Unit& u) const { return GU ? (const char*)A : (const char*)A + (size_t)u.arow * (KU8 * 2); }
    __device__ __forceinline__ const char* b_base(const Unit& u) const { return (const char*)Bt + ((size_t)u.e * (GU ? 2048 : 1024) + (size_t)u.pn * 256) * (KU8 * 2); }
    __device__ __forceinline__ void a_offs(const Unit& u, int tid, unsigned (&go)[2][2]) const {
#pragma unroll
        for (int i = 0; i < 2; ++i) { int R, C; stage_rc(tid * 16 + i * 8192, R, C);
#pragma unroll
            for (int h = 0; h < 2; ++h) {
                if (GU) { const int r = h * HALF + R, rc = r < u.rows ? r : u.rows - 1; const int raw = list[u.e * LISTCAP + u.pm * 256 + rc].x; const int tok = r < u.rows ? (raw >> 2) : NTOK; go[h][i] = (unsigned)(tok * KU8 + C) * 2u; }
                else go[h][i] = (unsigned)((h * HALF + R) * KU8 + C) * 2u;
            } }
    }
};

struct EpiBf16 {
    static constexpr bool PERM = true;
    bf16_t* O; int ldc;
    __device__ __forceinline__ void operator()(const f32x4 (&acc)[2][2][4][2], const Unit& u, int wr, int wc, int fr, int fq) const {
        const int row0 = u.pm * BM + wr * 64 + fr, col0 = u.pn * BM + wc * 32 + 8 * fq;
#pragma unroll
        for (int ai = 0; ai < 2; ++ai)
#pragma unroll
            for (int m = 0; m < 4; ++m) { bf16_t* rowp = O + (size_t)(row0 + ai * HALF + m * 16) * ldc + col0;
#pragma unroll
                for (int bj = 0; bj < 2; ++bj) { const f32x4 v0 = acc[ai][bj][m][0], v1 = acc[ai][bj][m][1];
                    u32x4 w; w.x = cvt_pk_bf16(v0[0], v0[1]); w.y = cvt_pk_bf16(v0[2], v0[3]); w.z = cvt_pk_bf16(v1[0], v1[1]); w.w = cvt_pk_bf16(v1[2], v1[3]);
                    *(u32x4*)(rowp + bj * HALF) = w; } }
    }
};
struct EpiResF32 {
    static constexpr bool PERM = false;
    const float* base; float* C; int ldc; float* ssq;
    __device__ __forceinline__ void operator()(const f32x4 (&acc)[2][2][4][2], const Unit& u, int wr, int wc, int fr, int fq) const {
        const int row0 = u.pm * BM + wr * 64 + fr, col0 = u.pn * BM + wc * 32 + 4 * fq;
        float* sp = ssq + (size_t)(u.pn * 4 + wc) * NTOK;
#pragma unroll
        for (int ai = 0; ai < 2; ++ai)
#pragma unroll
            for (int m = 0; m < 4; ++m) { const int row = row0 + ai * HALF + m * 16; const size_t off = (size_t)row * ldc + col0; float s2 = 0.f;
#pragma unroll
                for (int bj = 0; bj < 2; ++bj)
#pragma unroll
                    for (int n = 0; n < 2; ++n) { const f32x4 b = *(const f32x4*)(base + off + bj * HALF + n * 16); const f32x4 v = acc[ai][bj][m][n] + b; *(f32x4*)(C + off + bj * HALF + n * 16) = v;
                        s2 += (v[0] * v[0] + v[1] * v[1]) + (v[2] * v[2] + v[3] * v[3]); }
                s2 += __shfl_xor(s2, 16); s2 += __shfl_xor(s2, 32);
                if (fq == 0) sp[row] = s2;
                asm volatile("" ::: "memory"); }
    }
};
constexpr float WSCL = 1.0f / 32.0f;
__device__ __forceinline__ float swiglu(float g, float l) {
    g = fminf(g, 7.0f); l = fminf(fmaxf(l, -7.0f), 7.0f);
    const float s = __builtin_amdgcn_rcpf(1.0f + __builtin_amdgcn_exp2f(-1.702f * 1.4426950408889634f * g));
    return g * s * (l + 1.0f);
}
struct EpiGU {
    static constexpr bool PERM = true;
    unsigned char* ACT; const float* bgu;
    __device__ __forceinline__ void operator()(const f32x4 (&acc)[2][2][4][2], const Unit& u, int wr, int wc, int fr, int fq) const {
        const int row0 = u.arow + wr * 64 + fr, colg = u.pn * 128 + wc * 32 + 8 * fq;
        const float* bp = bgu + (size_t)u.e * 2048 + colg;
        const f32x4 bg0 = *(const f32x4*)(bp), bg1 = *(const f32x4*)(bp + 4), bl0 = *(const f32x4*)(bp + 1024), bl1 = *(const f32x4*)(bp + 1024 + 4);
#pragma unroll
        for (int ai = 0; ai < 2; ++ai)
#pragma unroll
            for (int m = 0; m < 4; ++m) {
                const f32x4 g0 = acc[ai][0][m][0] * WSCL + bg0, g1 = acc[ai][0][m][1] * WSCL + bg1, l0 = acc[ai][1][m][0] * WSCL + bl0, l1 = acc[ai][1][m][1] * WSCL + bl1;
                u32x2 w; w.x = cvt4_fp8(swiglu(g0[0], l0[0]), swiglu(g0[1], l0[1]), swiglu(g0[2], l0[2]), swiglu(g0[3], l0[3]));
                w.y = cvt4_fp8(swiglu(g1[0], l1[0]), swiglu(g1[1], l1[1]), swiglu(g1[2], l1[2]), swiglu(g1[3], l1[3]));
                *(u32x2*)(ACT + (size_t)(row0 + ai * HALF + m * 16) * FF + colg) = w; }
    }
};
struct EpiDown {
    static constexpr bool PERM = true;
    bf16_t* Y; const float* bd; const i32x2* list;
    __device__ __forceinline__ void operator()(const f32x4 (&acc)[2][2][4][2], const Unit& u, int wr, int wc, int fr, int fq) const {
        const int col0 = u.pn * BM + wc * 32 + 8 * fq;
        const float* bp = bd + (size_t)u.e * 1024 + col0;
        const i32x2* lp = list + u.e * LISTCAP + u.pm * 256;
        int rb = wr * 64 + fr; asm volatile("" : "+v"(rb));
        i32x2 sg[2][4];
#pragma unroll
        for (int ai = 0; ai < 2; ++ai)
#pragma unroll
            for (int m = 0; m < 4; ++m) { const int r = ai * HALF + m * 16 + rb; sg[ai][m] = lp[r < u.rows ? r : u.rows - 1]; }
#pragma unroll
        for (int bj = 0; bj < 2; ++bj) {
            const f32x4 b0 = *(const f32x4*)(bp + bj * HALF), b1 = *(const f32x4*)(bp + bj * HALF + 4);
#pragma unroll
            for (int ai = 0; ai < 2; ++ai)
#pragma unroll
                for (int m = 0; m < 4; ++m) { const int r = ai * HALF + m * 16 + rb;
                    if (r < u.rows) { const int slot = sg[ai][m].x; const float gt = __int_as_float(sg[ai][m].y);
                        const f32x4 v0 = (acc[ai][bj][m][0] * WSCL + b0) * gt, v1 = (acc[ai][bj][m][1] * WSCL + b1) * gt;
                        u32x4 w; w.x = cvt_pk_bf16(v0[0], v0[1]); w.y = cvt_pk_bf16(v0[2], v0[3]); w.z = cvt_pk_bf16(v1[0], v1[1]); w.w = cvt_pk_bf16(v1[2], v1[3]);
                        *(u32x4*)(Y + (size_t)slot * D + col0 + bj * HALF) = w; } }
        }
    }
};

typedef int i32x4 __attribute__((ext_vector_type(4)));
__device__ __forceinline__ bf16x8 lo8(i32x8 a) { return __builtin_bit_cast(bf16x8, __builtin_shufflevector(a, a, 0, 1, 2, 3)); }
__device__ __forceinline__ bf16x8 hi8(i32x8 a) { return __builtin_bit_cast(bf16x8, __builtin_shufflevector(a, a, 4, 5, 6, 7)); }
template <class Epi, class Sched, bool ALIGN_EPI, bool FP8 = false>
__device__ __forceinline__ void gemm_phase(LAS unsigned char* lds, const Sched& S, const Epi& E) {
    const int tid = threadIdx.x, wid = __builtin_amdgcn_readfirstlane(tid >> 6), lane = tid & 63, wr = wid >> 2, wc = wid & 3, fr = lane & 15, fq = lane >> 4;
    constexpr int K = FP8 ? 512 : KK;
    int nt = K / BK; asm volatile("" : "+s"(nt));
    unsigned voffB[2];
#pragma unroll
    for (int i = 0; i < 2; ++i) { int R, C; stage_rc(tid * 16 + i * 8192, R, C); const int Rb = Epi::PERM ? ((R & ~31) + perm32(R & 31)) : R;
        voffB[i] = (unsigned)(Rb * K + C) * 2u; }
    constexpr size_t kstep = (size_t)(BK * 2);
    constexpr size_t hstep = (size_t)HALF * K * 2;
    const unsigned ldsw = (unsigned)wid * 1024u;
    const int aoff = lds_byte(wr * 64 + fr, fq * 8), boff = lds_byte(wc * 32 + fr, fq * 8);
#define PG8_SA(b, h) (((b) * 2 + (h)) * HTB)
#define PG8_SB(b, h) ((4 + (b) * 2 + (h)) * HTB)
#define PG8_STAGE(bufoff, gbase, voff) do { _Pragma("unroll") for (int _i = 0; _i < 2; ++_i) \
        __builtin_amdgcn_global_load_lds((const unsigned*)((const char*)(gbase) + (voff)[_i]), (LAS unsigned*)(lds + (bufoff) + ldsw + _i * 8192), 16, 0, 0); } while (0)
#define PG8_LDA(dst, b, h) do { _Pragma("unroll") for (int m = 0; m < 4; ++m) { const u32x4 _x = *(const LAS u32x4*)(lds + PG8_SA(b, h) + aoff + m * 2048), _y = *(const LAS u32x4*)(lds + PG8_SA(b, h) + aoff + m * 2048 + 1024); \
        dst[m] = (i32x8){(int)_x[0], (int)_x[1], (int)_x[2], (int)_x[3], (int)_y[0], (int)_y[1], (int)_y[2], (int)_y[3]}; } } while (0)
#define PG8_LDB(dst, b, h) do { _Pragma("unroll") for (int n = 0; n < 2; ++n) { const u32x4 _x = *(const LAS u32x4*)(lds + PG8_SB(b, h) + boff + n * 2048), _y = *(const LAS u32x4*)(lds + PG8_SB(b, h) + boff + n * 2048 + 1024); \
        dst[n] = (i32x8){(int)_x[0], (int)_x[1], (int)_x[2], (int)_x[3], (int)_y[0], (int)_y[1], (int)_y[2], (int)_y[3]}; } } while (0)
#define PG8_MMA(ai, bj, At, Bt) do { __builtin_amdgcn_s_setprio(1); _Pragma("unroll") for (int m = 0; m < 4; ++m) _Pragma("unroll") for (int n = 0; n < 2; ++n) { \
        if constexpr (FP8) { acc[ai][bj][m][n] = __builtin_amdgcn_mfma_scale_f32_16x16x128_f8f6f4(Bt[n], At[m], acc[ai][bj][m][n], 0, 0, 0, 0, 0, 0); } \
        else { acc[ai][bj][m][n] = __builtin_amdgcn_mfma_f32_16x16x32_bf16(lo8(Bt[n]), lo8(At[m]), acc[ai][bj][m][n], 0, 0, 0); acc[ai][bj][m][n] = __builtin_amdgcn_mfma_f32_16x16x32_bf16(hi8(Bt[n]), hi8(At[m]), acc[ai][bj][m][n], 0, 0, 0); } } __builtin_amdgcn_s_setprio(0); } while (0)
#define PG8_WAIT_V(n) asm volatile("s_waitcnt vmcnt(" #n ")" ::: "memory")
#define PG8_WAIT_L(n) asm volatile("s_waitcnt lgkmcnt(" #n ")" ::: "memory")
#define PG8_BAR __builtin_amdgcn_s_barrier()
#define PG8_SCHED __builtin_amdgcn_sched_barrier(0)
    Unit cur, nxt; int ui = 0;
    if (!S.next(0, cur)) return;
    f32x4 acc[2][2][4][2];
#pragma unroll
    for (int a = 0; a < 2; ++a)
#pragma unroll
        for (int b = 0; b < 2; ++b)
#pragma unroll
            for (int m = 0; m < 4; ++m)
#pragma unroll
                for (int n = 0; n < 2; ++n) acc[a][b][m][n] = (f32x4){0.f, 0.f, 0.f, 0.f};
    i32x8 At[4], B0[2], B1[2];
    const char* cA = S.a_base(cur); const char* cB = S.b_base(cur);
    unsigned go[2][2];
    { int t2 = tid; asm volatile("" : "+v"(t2)); S.a_offs(cur, t2, go); }
    PG8_STAGE(PG8_SB(0, 0), cB, voffB); PG8_STAGE(PG8_SB(0, 1), cB + hstep, voffB); PG8_STAGE(PG8_SA(0, 0), cA, go[0]); PG8_STAGE(PG8_SA(0, 1), cA, go[1]);
    if (wr == 1) PG8_BAR;
    PG8_WAIT_V(2); PG8_BAR;
    PG8_STAGE(PG8_SB(1, 0), cB + kstep, voffB); PG8_STAGE(PG8_SA(1, 0), cA + kstep, go[0]); PG8_STAGE(PG8_SB(1, 1), cB + hstep + kstep, voffB);
    PG8_WAIT_V(6); PG8_BAR;
    for (;;) {
        const bool has_next = S.next(ui + 1, nxt);
        const char* nA = has_next ? S.a_base(nxt) : cA; const char* nB = has_next ? S.b_base(nxt) : cB;
#pragma clang loop unroll(disable)
        for (int t = 0; t < nt; t += 2) {
            const bool last = (t == nt - 2);
            asm volatile("" : "+v"(voffB[0]), "+v"(voffB[1]));
            const char* a1 = cA + (size_t)(t + 1) * kstep;
            const char* a2 = last ? nA : cA + (size_t)(t + 2) * kstep; const char* b2 = last ? nB : cB + (size_t)(t + 2) * kstep;
            const char* a3 = a2 + kstep; const char* b3 = b2 + kstep;
            PG8_LDB(B0, 0, 0); PG8_LDB(B1, 0, 1); PG8_SCHED; PG8_LDA(At, 0, 0); PG8_STAGE(PG8_SA(1, 1), a1, go[1]);
            if (last && has_next) { int t2 = tid; asm volatile("" : "+v"(t2)); S.a_offs(nxt, t2, go); }
            PG8_WAIT_V(8); PG8_WAIT_L(0); PG8_BAR; PG8_MMA(0, 0, At, B0); PG8_MMA(0, 1, At, B1); PG8_BAR; PG8_SCHED;
            PG8_LDA(At, 0, 1); PG8_STAGE(PG8_SB(0, 0), b2, voffB); PG8_STAGE(PG8_SB(0, 1), b2 + hstep, voffB); PG8_STAGE(PG8_SA(0, 0), a2, go[0]);
            PG8_WAIT_V(8); PG8_WAIT_L(0); PG8_BAR; PG8_MMA(1, 0, At, B0); PG8_MMA(1, 1, At, B1); PG8_BAR; PG8_SCHED;
            PG8_LDB(B0, 1, 0); PG8_LDB(B1, 1, 1); PG8_SCHED; PG8_LDA(At, 1, 0); PG8_STAGE(PG8_SA(0, 1), a2, go[1]);
            PG8_WAIT_V(8); PG8_WAIT_L(0); PG8_BAR; PG8_MMA(0, 0, At, B0); PG8_MMA(0, 1, At, B1); PG8_BAR; PG8_SCHED;
            PG8_LDA(At, 1, 1); PG8_STAGE(PG8_SB(1, 0), b3, voffB); PG8_STAGE(PG8_SB(1, 1), b3 + hstep, voffB); PG8_STAGE(PG8_SA(1, 0), a3, go[0]);
            PG8_WAIT_V(8); PG8_WAIT_L(0); PG8_BAR; PG8_MMA(1, 0, At, B0); PG8_MMA(1, 1, At, B1); PG8_BAR; PG8_SCHED;
        }
        if constexpr (ALIGN_EPI) { if (wr == 0) PG8_BAR; }
        { int t2 = tid; asm volatile("" : "+v"(t2)); const int l2 = t2 & 63; E(acc, cur, wr, wc, l2 & 15, l2 >> 4); }
        if (!has_next) break;
#pragma unroll
        for (int a = 0; a < 2; ++a)
#pragma unroll
            for (int b = 0; b < 2; ++b)
#pragma unroll
                for (int m = 0; m < 4; ++m)
#pragma unroll
                    for (int n = 0; n < 2; ++n) acc[a][b][m][n] = (f32x4){0.f, 0.f, 0.f, 0.f};
        cur = nxt; cA = nA; cB = nB; ++ui;
        if constexpr (ALIGN_EPI) { if (wr == 1) PG8_BAR; }
    }
    PG8_WAIT_V(0);
    if constexpr (!ALIGN_EPI) { if (wr == 0) PG8_BAR; }
    PG8_BAR;
#undef PG8_SA
#undef PG8_SB
#undef PG8_STAGE
#undef PG8_LDA
#undef PG8_LDB
#undef PG8_MMA
#undef PG8_WAIT_V
#undef PG8_WAIT_L
#undef PG8_BAR
#undef PG8_SCHED
}
}

#define XB_TMO      128
#define XB_XCNT(j)  (256  + 64 * (j))
#define XB_XSUB(j)  (1280 + 64 * (j))
#define XB_XGEN(j)  (2304 + 64 * (j))
#define XB_TOP      3328
#define XB_TOPGEN   3392
#define XCD_BAR_WORDS 3456
#define XB_SPIN_CAP (1u << 18)
__device__ __forceinline__ unsigned xb_ld(unsigned* p)              { return __hip_atomic_load(p, __ATOMIC_RELAXED, __HIP_MEMORY_SCOPE_AGENT); }
__device__ __forceinline__ unsigned xb_add(unsigned* p, unsigned v) { return __hip_atomic_fetch_add(p, v, __ATOMIC_RELAXED, __HIP_MEMORY_SCOPE_AGENT); }
__device__ __forceinline__ unsigned xb_xcc_id() { return (unsigned)__builtin_amdgcn_s_getreg((3 << 11) | 20) & 0xFu; }
#define XB_SPIN(cond, bar) do { unsigned _sp = 0; while (cond) { __builtin_amdgcn_s_sleep(1); \
    if ((++_sp & 255u) == 0u) { if (xb_ld(&(bar)[XB_TMO])) break; if (_sp > XB_SPIN_CAP) { atomicAdd(&(bar)[XB_TMO], 1u); break; } } } } while (0)
struct XcdBarrier { unsigned* bar; unsigned x; volatile LAS unsigned* st; };
__device__ __forceinline__ XcdBarrier xcd_barrier_post(unsigned* bar, volatile LAS unsigned* st) {
    XcdBarrier b; b.bar = bar; b.x = xb_xcc_id(); b.st = st;
    if (threadIdx.x == 0) (void)xb_add(&bar[XB_XCNT(b.x)], 1u);
    return b;
}
__device__ __forceinline__ void xcd_barrier_complete(unsigned* bar, unsigned x, unsigned& nloc, unsigned& nx) {
    const unsigned G = gridDim.x * gridDim.y * gridDim.z;
    unsigned sum, cnt, mine, sp = 0u;
    for (;;) {
        sum = 0u; cnt = 0u; mine = 0u;
#pragma unroll
        for (unsigned j = 0; j < 16; ++j) { const unsigned c = xb_ld(&bar[XB_XCNT(j)]); sum += c; cnt += (c > 0u) ? 1u : 0u; mine = (j == x) ? c : mine; }
        if (sum == G) break;
        __builtin_amdgcn_s_sleep(1);
        if ((++sp & 255u) == 0u) { if (xb_ld(&bar[XB_TMO])) break; if (sp > XB_SPIN_CAP) { atomicAdd(&bar[XB_TMO], 1u); break; } }
    }
    nloc = mine > 0u ? mine : 1u; nx = cnt > 0u ? cnt : 1u;
}
__device__ __forceinline__ void xcd_barrier(const XcdBarrier& b) {
    asm volatile("s_waitcnt vmcnt(0)" ::: "memory");
    __syncthreads();
    if (threadIdx.x == 0) {
        unsigned* bar = b.bar;
        __builtin_amdgcn_s_waitcnt(0);
        unsigned nloc = b.st[0], nx = b.st[1];
        if (nloc == 0u) { xcd_barrier_complete(bar, b.x, nloc, nx); b.st[0] = nloc; b.st[1] = nx; }
        const unsigned old = xb_add(&bar[XB_XSUB(b.x)], 1u);
        const unsigned gen = old / nloc;
        if (old + 1u == (gen + 1u) * nloc) {
            __builtin_amdgcn_fence(__ATOMIC_RELEASE, "agent");
            asm volatile("s_waitcnt vmcnt(0)" ::: "memory");
            const unsigned og = xb_add(&bar[XB_TOP], 1u);
            const unsigned tg = og / nx;
            if (og + 1u == (tg + 1u) * nx) xb_add(&bar[XB_TOPGEN], 1u);
            else XB_SPIN(xb_ld(&bar[XB_TOPGEN]) == tg, bar);
            __builtin_amdgcn_fence(__ATOMIC_ACQUIRE, "agent");
            xb_add(&bar[XB_XGEN(b.x)], 1u);
            asm volatile("s_waitcnt vmcnt(0)" ::: "memory");
        } else {
            XB_SPIN(xb_ld(&bar[XB_XGEN(b.x)]) == gen, bar);
            __builtin_amdgcn_fence(__ATOMIC_ACQUIRE, "agent");
            asm volatile("s_waitcnt vmcnt(0)" ::: "memory");
        }
    }
    __syncthreads();
}

struct Frame {
    LAS unsigned char* lds;
    volatile LAS unsigned* MISC;
    gu32* ctl;
    int tid, lane, wave, vcu, G;
    const float *x, *norm_mix_w, *w_in, *ret_norm_w, *w_pool, *pool_scale, *w_out, *norm_ffn_w, *w_router, *b_router, *w_gu, *b_gu, *w_down, *b_down, *norm_final_w;
    float* out;
    bf16_t *Wr_hi, *Wr_lo, *Wpool_t, *Win_t, *Wout_t, *XN, *CAT, *U, *Z, *Y;
    unsigned char *Wgu8, *Wd8, *ACT8, *H8;
    i32x2* list; float* ssq;
    float lg2g0, lg2g1, lg2g2, lg2g3;
    __device__ __forceinline__ float lg2(int h) const { return h == 0 ? lg2g0 : (h == 1 ? lg2g1 : (h == 2 ? lg2g2 : lg2g3)); }
};

template <int MODE>
__device__ __forceinline__ void p0_item(const float* W, int ldw, void* WT, void* WT2, int ldo, LAS float* scr, int k0, int n0, int orow0, int lane) {
    f32x4 v[16];
    const float* src = W + (size_t)(k0 + (lane >> 3)) * ldw + n0 + 4 * (lane & 7);
#pragma unroll
    for (int i = 0; i < 16; ++i) v[i] = *(const GAS f32x4*)(src + (size_t)(8 * i) * ldw);
#pragma unroll
    for (int i = 0; i < 16; ++i) *(LAS f32x4*)(scr + (8 * i + (lane >> 3)) * 32 + 4 * ((lane & 7) ^ (i & 7))) = v[i];
    LDS_WAIT(); asm volatile("" ::: "memory");
    const int c = lane & 15, ns = lane >> 4;
#pragma unroll
    for (int J = 0; J < 8; ++J) {
        const LAS float* sp = scr + (8 * c) * 32 + 4 * (J ^ (c & 7)) + ns;
        float x[8];
#pragma unroll
        for (int q = 0; q < 8; ++q) x[q] = sp[q * 32];
        const int n = 4 * J + ns;
        if (MODE == 2) { u32x2 o; o.x = cvt4_fp8(x[0] * 32.f, x[1] * 32.f, x[2] * 32.f, x[3] * 32.f); o.y = cvt4_fp8(x[4] * 32.f, x[5] * 32.f, x[6] * 32.f, x[7] * 32.f);
            *(GAS u32x2*)((unsigned char*)WT + (size_t)(orow0 + n) * 1024 + k0 + 8 * c) = o; }
        else { u32x4 o; o.x = cvt_pk_bf16(x[0], x[1]); o.y = cvt_pk_bf16(x[2], x[3]); o.z = cvt_pk_bf16(x[4], x[5]); o.w = cvt_pk_bf16(x[6], x[7]);
            *(GAS u32x4*)((bf16_t*)WT + (size_t)(orow0 + n) * ldo + k0 + 8 * c) = o;
            if (MODE == 1) { u32x4 o2; o2.x = cvt_pk_bf16(x[0] - bf_lo(o.x), x[1] - bf_hi(o.x)); o2.y = cvt_pk_bf16(x[2] - bf_lo(o.y), x[3] - bf_hi(o.y));
                o2.z = cvt_pk_bf16(x[4] - bf_lo(o.z), x[5] - bf_hi(o.z)); o2.w = cvt_pk_bf16(x[6] - bf_lo(o.w), x[7] - bf_hi(o.w));
                *(GAS u32x4*)((bf16_t*)WT2 + (size_t)(orow0 + n) * ldo + k0 + 8 * c) = o2; } }
    }
    LDS_WAIT(); asm volatile("" ::: "memory");
}
__device__ __forceinline__ void rms_rows4_to_bf16(int lane, const float* x, const float* w, bf16_t* o, int m, int rs) {
    f32x4 v[4][4];
#pragma unroll
    for (int r = 0; r < 4; ++r) { const GAS f32x4* xr = (const GAS f32x4*)(x + (size_t)(m + r * rs) * D) + lane;
#pragma unroll
        for (int j = 0; j < 4; ++j) v[r][j] = xr[64 * j]; }
    const GAS f32x4* wr = (const GAS f32x4*)w + lane;
    f32x4 ww[4];
#pragma unroll
    for (int j = 0; j < 4; ++j) ww[j] = wr[64 * j];
#pragma unroll
    for (int r = 0; r < 4; ++r) { float s = 0.f;
#pragma unroll
        for (int j = 0; j < 4; ++j) s += (v[r][j].x * v[r][j].x + v[r][j].y * v[r][j].y) + (v[r][j].z * v[r][j].z + v[r][j].w * v[r][j].w);
        const float rstd = 1.f / sqrtf(wave_sum(s) * (1.f / D) + EPS);
        GAS u32x2* o8 = (GAS u32x2*)(o + (size_t)(m + r * rs) * D) + lane;
#pragma unroll
        for (int j = 0; j < 4; ++j) { u32x2 p; p.x = cvt_pk_bf16(v[r][j].x * rstd * ww[j].x, v[r][j].y * rstd * ww[j].y); p.y = cvt_pk_bf16(v[r][j].z * rstd * ww[j].z, v[r][j].w * rstd * ww[j].w); o8[64 * j] = p; } }
}
__device__ __forceinline__ void p0_prologue(Frame& F) {
    LAS float* scr = (LAS float*)(F.lds + F.wave * 16384);
    const int gw = F.vcu * NWAVES + F.wave, NGW = F.G * NWAVES;
    constexpr int I_GU = 32 * 8 * 64, I_D = 32 * 8 * 32, I_IN = 8 * 80, I_OUT = 8 * 32, I_POOL = 16, I_R = 8;
    constexpr int NITEMS = I_GU + I_D + I_IN + I_OUT + I_POOL + I_R;
    for (int it = gw; it < NITEMS; it += NGW) {
        int r = it;
        if (r < I_GU) { const int e = r / 512, q = r % 512, kb = q / 64, nb = q % 64, n0 = nb * 32;
            const int orow = (n0 < 1024) ? ((n0 >> 7) * 256 + (n0 & 127)) : ((((n0 - 1024) >> 7) * 256) + 128 + ((n0 - 1024) & 127));
            p0_item<2>(F.w_gu + (size_t)e * 1024 * 2048, 2048, F.Wgu8 + (size_t)e * 2048 * 1024, nullptr, 1024, scr, kb * 128, n0, orow, F.lane); continue; } r -= I_GU;
        if (r < I_D) { const int e = r / 256, q = r % 256, kb = q / 32, nb = q % 32;
            p0_item<2>(F.w_down + (size_t)e * 1024 * 1024, 1024, F.Wd8 + (size_t)e * 1024 * 1024, nullptr, 1024, scr, kb * 128, nb * 32, nb * 32, F.lane); continue; } r -= I_D;
        if (r < I_IN) { const int kb = r / 80, nb = r % 80; p0_item<0>(F.w_in, DIN, F.Win_t, nullptr, 1024, scr, kb * 128, nb * 32, nb * 32, F.lane); continue; } r -= I_IN;
        if (r < I_OUT) { const int kb = r / 32, nb = r % 32; p0_item<0>(F.w_out, 1024, F.Wout_t, nullptr, 1024, scr, kb * 128, nb * 32, nb * 32, F.lane); continue; } r -= I_OUT;
        if (r < I_POOL) { const int g = r / 4, nb = r % 4; p0_item<0>(F.w_pool + g * 16384, 128, F.Wpool_t + g * 16384, nullptr, 128, scr, 0, nb * 32, nb * 32, F.lane); continue; } r -= I_POOL;
        { const int kb = r; p0_item<1>(F.w_router, 32, F.Wr_hi, F.Wr_lo, 1024, scr, kb * 128, 0, 0, F.lane); }
    }
    for (int m = gw; m < NTOK / 4; m += NGW) rms_rows4_to_bf16(F.lane, F.x, F.norm_mix_w, F.XN, m, NTOK / 4);
}

__device__ __forceinline__ void rope_cs(int pos, int j, float& cs, float& sn) {
    const float inv = __builtin_amdgcn_exp2f((float)j * (-13.287712379549449f / 64.0f));
    const double revd = (double)pos * (double)inv * 0.15915494309189535;
    const float rev = (float)(revd - __builtin_floor(revd));
    sn = __builtin_amdgcn_sinf(rev); cs = __builtin_amdgcn_cosf(rev);
}

__device__ __forceinline__ void retA_unit(Frame& F, int unit) {
    const int c = unit & 63, bh = unit >> 6, h = bh & 3, b = bh >> 2;
    const int tok0 = b * SEQ + c * 64;
    LAS bf16_t* KT = (LAS bf16_t*)(F.lds);
    LAS bf16_t* VT = KT + 128 * 72;
    const int t = F.tid, m = t >> 3, o = t & 7;
    {
        const bf16_t* zrow = F.Z + (size_t)(tok0 + m) * DIN + h * 128 + 8 * o;
        const u32x4 klo = *(const u32x4*)(zrow + 512), khi = *(const u32x4*)(zrow + 512 + 64);
        const u32x4 vlo = *(const u32x4*)(zrow + 1024), vhi = *(const u32x4*)(zrow + 1024 + 64);
        const float ksc = __builtin_amdgcn_exp2f(F.lg2(h) * (float)(63 - m)) * 0.08838834764831845f;
        const int pos = c * 64 + m;
#pragma unroll
        for (int i = 0; i < 8; ++i) {
            const unsigned wl = klo[i >> 1], wh = khi[i >> 1];
            const float lo = (i & 1) ? bf_hi(wl) : bf_lo(wl), hi = (i & 1) ? bf_hi(wh) : bf_lo(wh);
            float cs, sn; rope_cs(pos, 8 * o + i, cs, sn);
            const unsigned pk = cvt_pk_bf16((lo * cs - hi * sn) * ksc, (lo * sn + hi * cs) * ksc);
            KT[(8 * o + i) * 72 + m] = (bf16_t)(pk & 0xffffu); KT[(64 + 8 * o + i) * 72 + m] = (bf16_t)(pk >> 16);
            const unsigned vl = vlo[i >> 1], vh = vhi[i >> 1];
            VT[(8 * o + i) * 72 + m] = (bf16_t)((i & 1) ? (vl >> 16) : (vl & 0xffffu)); VT[(64 + 8 * o + i) * 72 + m] = (bf16_t)((i & 1) ? (vh >> 16) : (vh & 0xffffu));
        }
    }
    __syncthreads();
    {
        const int w = F.wave, fr = F.lane & 15, fq = F.lane >> 4;
        bf16x8 vf[2];
#pragma unroll
        for (int ks = 0; ks < 2; ++ks) vf[ks] = *(const LAS bf16x8*)(VT + (16 * w + fr) * 72 + 32 * ks + 8 * fq);
        bf16_t* urow = F.U + ((size_t)unit * 128 + 16 * w + fr) * 128 + 4 * fq;
#pragma unroll
        for (int dt = 0; dt < 8; ++dt) {
            f32x4 acc = (f32x4){0.f, 0.f, 0.f, 0.f};
#pragma unroll
            for (int ks = 0; ks < 2; ++ks) { const bf16x8 kf = *(const LAS bf16x8*)(KT + (16 * dt + fr) * 72 + 32 * ks + 8 * fq); acc = mfma16(kf, vf[ks], acc); }
            u32x2 pk; pk.x = cvt_pk_bf16(acc[0], acc[1]); pk.y = cvt_pk_bf16(acc[2], acc[3]);
            *(u32x2*)(urow + 16 * dt) = pk;
        }
    }
    __syncthreads();
}

__device__ __forceinline__ void pool_unit(Frame& F, int unit) {
    const int g = unit & 3, tile = unit >> 2, st = (tile & 63) * 64;
    const int tok0 = tile * 64, win = 2 << g;
    LAS float* P = (LAS float*)(F.lds);
    LAS bf16_t* A = (LAS bf16_t*)(F.lds + 79 * 132 * 4);
    const int t = F.tid;
    for (int idx = t; idx < 79 * 16; idx += 512) {
        const int r = idx >> 4, ch = idx & 15, s = st - 15 + r;
        f32x4 a = (f32x4){0.f, 0.f, 0.f, 0.f}, b2 = a;
        if (s >= 0) { const u32x4 w = *(const u32x4*)(F.Z + (size_t)(tok0 - 15 + r) * DIN + 2048 + g * 128 + 8 * ch);
            a = (f32x4){bf_lo(w.x), bf_hi(w.x), bf_lo(w.y), bf_hi(w.y)}; b2 = (f32x4){bf_lo(w.z), bf_hi(w.z), bf_lo(w.w), bf_hi(w.w)}; }
        *(LAS f32x4*)(P + r * 132 + 8 * ch) = a; *(LAS f32x4*)(P + r * 132 + 8 * ch + 4) = b2;
    }
    __syncthreads();
    {
        const int n = t >> 3, c0 = (t & 7) * 16, s = st + n;
        const float rc = 1.0f / (float)((s + 1 < win) ? (s + 1) : win);
#pragma unroll
        for (int q = 0; q < 4; ++q) {
            f32x4 sum = (f32x4){0.f, 0.f, 0.f, 0.f};
            for (int j = 0; j < win; ++j) sum += *(const LAS f32x4*)(P + (15 + n - j) * 132 + c0 + 4 * q);
            const f32x4 self = *(const LAS f32x4*)(P + (15 + n) * 132 + c0 + 4 * q);
            const f32x4 pv = sum * rc - self;
            u32x2 pk; pk.x = cvt_pk_bf16(pv[0], pv[1]); pk.y = cvt_pk_bf16(pv[2], pv[3]);
            *(LAS u32x2*)(A + n * 136 + c0 + 4 * q) = pk;
        }
    }
    __syncthreads();
    {
        const int w = F.wave, rt = w & 3, chf = w >> 2, fr = F.lane & 15, fq = F.lane >> 4;
        bf16x8 af[4];
#pragma unroll
        for (int ks = 0; ks < 4; ++ks) af[ks] = *(const LAS bf16x8*)(A + (16 * rt + fr) * 136 + 32 * ks + 8 * fq);
        const bf16_t* wp = F.Wpool_t + g * 16384;
        bf16_t* orow = F.CAT + (size_t)(tok0 + 16 * rt + fr) * D + 512 + g * 128;
#pragma unroll
        for (int dd = 0; dd < 4; ++dd) { const int dt = 4 * chf + dd;
            f32x4 acc = (f32x4){0.f, 0.f, 0.f, 0.f};
#pragma unroll
            for (int ks = 0; ks < 4; ++ks) { const bf16x8 wf = *(const bf16x8*)(wp + (16 * dt + fr) * 128 + 32 * ks + 8 * fq); acc = mfma16(wf, af[ks], acc); }
            const f32x4 sc = *(const f32x4*)(F.pool_scale + g * 128 + 16 * dt + 4 * fq);
            u32x2 pk; pk.x = cvt_pk_bf16(acc[0] * sc[0], acc[1] * sc[1]); pk.y = cvt_pk_bf16(acc[2] * sc[2], acc[3] * sc[3]);
            *(u32x2*)(orow + 16 * dt + 4 * fq) = pk;
        }
    }
    __syncthreads();
}

__device__ __forceinline__ void retB_unit(Frame& F, int unit) {
    const int c = unit & 63, bh = unit >> 6, h = bh & 3, b = bh >> 2;
    const int tok0 = b * SEQ + c * 64;
    LAS bf16_t* Q = (LAS bf16_t*)(F.lds);
    LAS bf16_t* Kr = Q + 64 * 136;
    LAS bf16_t* VT = Kr + 64 * 136;
    LAS bf16_t* Sm = VT + 128 * 72;
    LAS float* red = (LAS float*)(Sm + 64 * 72);
    const int t = F.tid;
    const float lg = F.lg2(h);
    {
        const int m = t >> 3, o = t & 7;
        const bf16_t* zrow = F.Z + (size_t)(tok0 + m) * DIN + h * 128 + 8 * o;
        const u32x4 qlo = *(const u32x4*)(zrow), qhi = *(const u32x4*)(zrow + 64);
        const u32x4 klo = *(const u32x4*)(zrow + 512), khi = *(const u32x4*)(zrow + 512 + 64);
        const u32x4 vlo = *(const u32x4*)(zrow + 1024), vhi = *(const u32x4*)(zrow + 1024 + 64);
        const int pos = c * 64 + m;
        unsigned ql[4], qh[4], kl[4], kh[4];
#pragma unroll
        for (int i = 0; i < 8; i += 2) {
            float cs0, sn0, cs1, sn1; rope_cs(pos, 8 * o + i, cs0, sn0); rope_cs(pos, 8 * o + i + 1, cs1, sn1);
            { const float l0 = bf_lo(qlo[i >> 1]), l1 = bf_hi(qlo[i >> 1]), h0 = bf_lo(qhi[i >> 1]), h1 = bf_hi(qhi[i >> 1]);
              ql[i >> 1] = cvt_pk_bf16(l0 * cs0 - h0 * sn0, l1 * cs1 - h1 * sn1); qh[i >> 1] = cvt_pk_bf16(l0 * sn0 + h0 * cs0, l1 * sn1 + h1 * cs1); }
            { const float l0 = bf_lo(klo[i >> 1]), l1 = bf_hi(klo[i >> 1]), h0 = bf_lo(khi[i >> 1]), h1 = bf_hi(khi[i >> 1]); const float sc = 0.08838834764831845f;
              kl[i >> 1] = cvt_pk_bf16((l0 * cs0 - h0 * sn0) * sc, (l1 * cs1 - h1 * sn1) * sc); kh[i >> 1] = cvt_pk_bf16((l0 * sn0 + h0 * cs0) * sc, (l1 * sn1 + h1 * cs1) * sc); }
        }
        *(LAS u32x4*)(Q + m * 136 + 8 * o) = (u32x4){ql[0], ql[1], ql[2], ql[3]}; *(LAS u32x4*)(Q + m * 136 + 64 + 8 * o) = (u32x4){qh[0], qh[1], qh[2], qh[3]};
        *(LAS u32x4*)(Kr + m * 136 + 8 * o) = (u32x4){kl[0], kl[1], kl[2], kl[3]}; *(LAS u32x4*)(Kr + m * 136 + 64 + 8 * o) = (u32x4){kh[0], kh[1], kh[2], kh[3]};
#pragma unroll
        for (int i = 0; i < 8; ++i) { const unsigned vl = vlo[i >> 1], vh = vhi[i >> 1];
            VT[(8 * o + i) * 72 + m] = (bf16_t)((i & 1) ? (vl >> 16) : (vl & 0xffffu)); VT[(64 + 8 * o + i) * 72 + m] = (bf16_t)((i & 1) ? (vh >> 16) : (vh & 0xffffu)); }
    }
    __syncthreads();
    const int w = F.wave, fr = F.lane & 15, fq = F.lane >> 4;
    {
        const int ntl = w >> 1;
        bf16x8 qf[4];
#pragma unroll
        for (int ks = 0; ks < 4; ++ks) qf[ks] = *(const LAS bf16x8*)(Q + (16 * ntl + fr) * 136 + 32 * ks + 8 * fq);
#pragma unroll
        for (int mm = 0; mm < 2; ++mm) { const int mt = 2 * (w & 1) + mm;
            f32x4 acc = (f32x4){0.f, 0.f, 0.f, 0.f};
#pragma unroll
            for (int ks = 0; ks < 4; ++ks) { const bf16x8 kf = *(const LAS bf16x8*)(Kr + (16 * mt + fr) * 136 + 32 * ks + 8 * fq); acc = mfma16(kf, qf[ks], acc); }
            const int n = 16 * ntl + fr, m0 = 16 * mt + 4 * fq;
            float sv[4];
#pragma unroll
            for (int j = 0; j < 4; ++j) { const int dd = n - (m0 + j); sv[j] = acc[j] * __builtin_amdgcn_exp2f(lg * (float)(dd < 0 ? -dd : dd)); }
            u32x2 pk; pk.x = cvt_pk_bf16(sv[0], sv[1]); pk.y = cvt_pk_bf16(sv[2], sv[3]);
            *(LAS u32x2*)(Sm + n * 72 + m0) = pk;
        }
    }
    __syncthreads();
    {
        const int rt = w & 3, chf = w >> 2, n = 16 * rt + fr;
        bf16x8 sf[2], qf[4];
#pragma unroll
        for (int ks = 0; ks < 2; ++ks) sf[ks] = *(const LAS bf16x8*)(Sm + n * 72 + 32 * ks + 8 * fq);
#pragma unroll
        for (int ks = 0; ks < 4; ++ks) qf[ks] = *(const LAS bf16x8*)(Q + n * 136 + 32 * ks + 8 * fq);
        const float qd = __builtin_amdgcn_exp2f(lg * (float)(n + 1));
        f32x4 ov[4]; float ss = 0.f;
#pragma unroll
        for (int dd = 0; dd < 4; ++dd) { const int vt = 4 * chf + dd;
            f32x4 ai = (f32x4){0.f, 0.f, 0.f, 0.f}, ac = ai;
#pragma unroll
            for (int ks = 0; ks < 2; ++ks) { const bf16x8 vf = *(const LAS bf16x8*)(VT + (16 * vt + fr) * 72 + 32 * ks + 8 * fq); ai = mfma16(vf, sf[ks], ai); }
            const bf16_t* rrow = F.U + ((size_t)unit * 128 + 16 * vt + fr) * 128 + 8 * fq;
#pragma unroll
            for (int ks = 0; ks < 4; ++ks) { const bf16x8 rf = *(const bf16x8*)(rrow + 32 * ks); ac = mfma16(rf, qf[ks], ac); }
            ov[dd] = ai + ac * qd;
            ss += (ov[dd][0] * ov[dd][0] + ov[dd][1] * ov[dd][1]) + (ov[dd][2] * ov[dd][2] + ov[dd][3] * ov[dd][3]);
        }
        ss += __shfl_xor(ss, 16); ss += __shfl_xor(ss, 32);
        if (fq == 0) red[chf * 64 + n] = ss;
        __syncthreads();
        const float rstd = 1.f / sqrtf((red[n] + red[64 + n]) * (1.f / 128.f) + EPS);
        const size_t tok = (size_t)(tok0 + n);
#pragma unroll
        for (int dd = 0; dd < 4; ++dd) { const int v0 = 16 * (4 * chf + dd) + 4 * fq;
            const u32x2 gw2 = *(const u32x2*)(F.Z + tok * DIN + 1536 + h * 128 + v0);
            const f32x4 rw = *(const f32x4*)(F.ret_norm_w + h * 128 + v0);
            const float gv[4] = {bf_lo(gw2.x), bf_hi(gw2.x), bf_lo(gw2.y), bf_hi(gw2.y)};
            float r[4];
#pragma unroll
            for (int j = 0; j < 4; ++j) { const float sg = gv[j] * __builtin_amdgcn_rcpf(1.0f + __builtin_amdgcn_exp2f(-1.4426950408889634f * gv[j])); r[j] = ov[dd][j] * rstd * rw[j] * sg; }
            u32x2 pk; pk.x = cvt_pk_bf16(r[0], r[1]); pk.y = cvt_pk_bf16(r[2], r[3]);
            *(u32x2*)(F.CAT + tok * D + h * 128 + v0) = pk;
        }
    }
    __syncthreads();
}

struct Args { const float* in[15]; float* out; unsigned char* ws; float lg2g[4]; int ph_lo, ph_hi, li, pad; };

__global__ void __launch_bounds__(NWAVES * 64, 2) fwd_kernel(Args args) {
    extern __shared__ __attribute__((aligned(16))) unsigned char lds[];
    Frame F;
    F.lds = (LAS unsigned char*)lds;
    F.MISC = (volatile LAS unsigned*)(F.lds + MISC_OFF);
    F.tid = threadIdx.x; F.lane = F.tid & 63; F.wave = __builtin_amdgcn_readfirstlane(F.tid >> 6);
    F.G = gridDim.x; { const int bx = blockIdx.x; F.vcu = (F.G % 8 == 0) ? (bx % 8) * (F.G / 8) + bx / 8 : bx; }
    unsigned char* ws = args.ws;
    F.ctl = (gu32*)(ws + WS_CTL);
    F.x = args.in[0]; F.norm_mix_w = args.in[1]; F.w_in = args.in[2]; F.ret_norm_w = args.in[3]; F.w_pool = args.in[4]; F.pool_scale = args.in[5]; F.w_out = args.in[6]; F.norm_ffn_w = args.in[7];
    F.w_router = args.in[8]; F.b_router = args.in[9]; F.w_gu = args.in[10]; F.b_gu = args.in[11]; F.w_down = args.in[12]; F.b_down = args.in[13]; F.norm_final_w = args.in[14]; F.out = args.out;
    F.Wr_hi = (bf16_t*)(ws + WS_WR); F.Wr_lo = F.Wr_hi + 32 * 1024; F.Wpool_t = (bf16_t*)(ws + WS_WPOOL); F.Win_t = (bf16_t*)(ws + WS_WIN); F.Wout_t = (bf16_t*)(ws + WS_WOUT);
    F.XN = (bf16_t*)(ws + WS_XN); F.CAT = (bf16_t*)(ws + WS_CAT); F.U = (bf16_t*)(ws + WS_U); F.Z = (bf16_t*)(ws + WS_Z); F.Y = (bf16_t*)(ws + WS_Y);
    F.Wgu8 = ws + WS_WGU; F.Wd8 = ws + WS_WD; F.ACT8 = ws + WS_ACT; F.H8 = ws + WS_XN; F.list = (i32x2*)(ws + WS_LIST); F.ssq = (float*)(ws + WS_SSQ);
    F.lg2g0 = args.lg2g[0]; F.lg2g1 = args.lg2g[1]; F.lg2g2 = args.lg2g[2]; F.lg2g3 = args.lg2g[3];
    for (int u = F.tid; u < (LDS_BYTES - LDSCTL_OFF) / 4; u += NWAVES * 64) ((LAS unsigned*)(F.lds + LDSCTL_OFF))[u] = 0u;
    __syncthreads();
    XcdBarrier bar; bar.bar = (unsigned*)(F.ctl + CW_BAR); bar.x = 0; bar.st = nullptr;
    if (N_LAUNCHES != PER_PHASE) bar = xcd_barrier_post((unsigned*)(F.ctl + CW_BAR), F.MISC + 8);
    int n_stamp = 0;
#define STAMP() do { if (DBG_SPIN_A >= 0) { if (F.tid == 0) { const unsigned long long _t = __builtin_amdgcn_s_memrealtime(); F.MISC[16 + 2 * n_stamp] = (unsigned)_t; F.MISC[17 + 2 * n_stamp] = (unsigned)(_t >> 32); } ++n_stamp; } } while (0)
    STAMP();
#define GRID_BAR() do { if (N_LAUNCHES != PER_PHASE) xcd_barrier(bar); STAMP(); } while (0)
    const int lo = DBG_ONLY9 ? (args.ph_lo < 9 ? 9 : args.ph_lo) : args.ph_lo, hi = args.ph_hi;
#define IN(k) (lo <= (k) && (k) < hi)
#define BOTH(k) (IN(k) && IN((k) + 1))
    const int gw = F.vcu * NWAVES + F.wave, NGW = F.G * NWAVES;

    if (IN(0)) { p0_prologue(F); if (BOTH(0)) GRID_BAR(); }

    if (IN(1)) {
        pg8::DenseSched S; S.init(F.XN, F.Win_t, NTOK, DIN, F.G, (int)blockIdx.x);
        pg8::EpiBf16 E{F.Z, DIN};
        pg8::gemm_phase<pg8::EpiBf16, pg8::DenseSched, true>(F.lds, S, E);
        if (BOTH(1)) GRID_BAR();
    }

    if (IN(2)) {
        for (int u = F.vcu; u < 1024; u += F.G) retA_unit(F, u);
        for (int u = F.vcu; u < 1024; u += F.G) pool_unit(F, u);
        if (BOTH(2)) GRID_BAR();
    }

    if (IN(3) && DBG_STAGE != 4) {
        const int gt = F.vcu * 512 + F.tid, NGT = F.G * 512;
        for (int p = gt; p < 16 * 8192; p += NGT) {
            const int bh = p >> 13, i = p & 8191;
            const float cd = __builtin_amdgcn_exp2f(F.lg2(bh & 3) * 64.0f);
            unsigned* up = (unsigned*)(F.U + (size_t)bh * 64 * 16384) + i;
            float s0 = 0.f, s1 = 0.f;
#pragma unroll
            for (int cb = 0; cb < 64; cb += 32) {
                unsigned uw[32];
#pragma unroll
                for (int c = 0; c < 32; ++c) uw[c] = up[(size_t)(cb + c) * 8192];
#pragma unroll
                for (int c = 0; c < 32; ++c) { up[(size_t)(cb + c) * 8192] = cvt_pk_bf16(s0, s1); s0 = cd * s0 + bf_lo(uw[c]); s1 = cd * s1 + bf_hi(uw[c]); }
            }
        }
        if (BOTH(3)) GRID_BAR();
    }

    if (IN(4) && DBG_STAGE != 4) {
        for (int u = F.vcu; u < 1024; u += F.G) retB_unit(F, u);
        if (BOTH(4)) GRID_BAR();
    }

    if (IN(5) && !DBG_STAGE) {
        pg8::DenseSched S; S.init(F.CAT, F.Wout_t, NTOK, D, F.G, (int)blockIdx.x);
        pg8::EpiResF32 E{F.x, F.out, D, F.ssq};
        pg8::gemm_phase<pg8::EpiResF32, pg8::DenseSched, false>(F.lds, S, E);
        if (BOTH(5)) GRID_BAR();
    }

    if (IN(6) && !DBG_SKIP_Y) {
        LAS float* lgs = (LAS float*)(F.lds + F.wave * 4096);
        LAS f32x4* part = (LAS f32x4*)(F.lds + 32768);
        if (gw == 0) { GAS u32x4* z = (GAS u32x4*)(F.H8 + (size_t)NTOK * D) + F.lane; z[0] = (u32x4){0u, 0u, 0u, 0u}; }
        const int fr = F.lane & 15, fq = F.lane >> 4, gsel = F.wave & 3, kh = F.wave >> 2;
        for (int g0 = F.vcu * 4; g0 < NTOK / 16; g0 += F.G * 4) {
            const int grp = g0 + gsel, row = grp * 16 + fr;
            float ss = 0.f;
#pragma unroll
            for (int p = 0; p < 16; ++p) ss += F.ssq[(size_t)p * NTOK + row];
            const float rstd = 1.f / sqrtf(ss * (1.f / D) + EPS);
            const float* xr = F.out + (size_t)row * D + 512 * kh + 8 * fq;
            const float* wn = F.norm_ffn_w + 512 * kh + 8 * fq;
            unsigned char* hrow = F.H8 + (size_t)row * D + 512 * kh + 8 * fq;
            const bf16_t* wrh = F.Wr_hi + fr * 1024 + 512 * kh + 8 * fq; const bf16_t* wrl = F.Wr_lo + fr * 1024 + 512 * kh + 8 * fq;
            f32x4 acc[2] = {(f32x4){0.f, 0.f, 0.f, 0.f}, (f32x4){0.f, 0.f, 0.f, 0.f}};
#pragma unroll 4
            for (int ks = 0; ks < 16; ++ks) {
                const f32x4 a = *(const f32x4*)(xr + 32 * ks), b2 = *(const f32x4*)(xr + 32 * ks + 4);
                const f32x4 wa = *(const f32x4*)(wn + 32 * ks), wb = *(const f32x4*)(wn + 32 * ks + 4);
                float hv[8];
#pragma unroll
                for (int j = 0; j < 4; ++j) { hv[j] = a[j] * rstd * wa[j]; hv[4 + j] = b2[j] * rstd * wb[j]; }
                u32x4 hh, hl;
#pragma unroll
                for (int j = 0; j < 4; ++j) { const unsigned p = cvt_pk_bf16(hv[2 * j], hv[2 * j + 1]); hh[j] = p; hl[j] = cvt_pk_bf16(hv[2 * j] - bf_lo(p), hv[2 * j + 1] - bf_hi(p)); }
                { u32x2 h8; h8.x = cvt4_fp8(hv[0], hv[1], hv[2], hv[3]); h8.y = cvt4_fp8(hv[4], hv[5], hv[6], hv[7]); *(u32x2*)(hrow + 32 * ks) = h8; }
                const bf16x8 bhh = __builtin_bit_cast(bf16x8, hh), bhl = __builtin_bit_cast(bf16x8, hl);
#pragma unroll
                for (int et = 0; et < 2; ++et) {
                    const bf16x8 wh = *(const bf16x8*)(wrh + et * 16384 + 32 * ks), wl = *(const bf16x8*)(wrl + et * 16384 + 32 * ks);
                    acc[et] = mfma16(wh, bhh, acc[et]); acc[et] = mfma16(wh, bhl, acc[et]); acc[et] = mfma16(wl, bhh, acc[et]);
                }
            }
            if (kh == 1) { part[(gsel * 2 + 0) * 64 + F.lane] = acc[0]; part[(gsel * 2 + 1) * 64 + F.lane] = acc[1]; }
            __syncthreads();
            if (kh == 0) {
                acc[0] += part[(gsel * 2 + 0) * 64 + F.lane]; acc[1] += part[(gsel * 2 + 1) * 64 + F.lane];
#pragma unroll
                for (int et = 0; et < 2; ++et)
#pragma unroll
                    for (int j = 0; j < 4; ++j) lgs[fr * 33 + 16 * et + 4 * fq + j] = acc[et][j];
                LDS_WAIT(); __builtin_amdgcn_wave_barrier();
                if (F.lane < 16) {
                    const int r = grp * 16 + F.lane;
                    float v0 = -3.0e38f, v1 = -3.0e38f, v2 = -3.0e38f, v3 = -3.0e38f; int i0 = 0, i1 = 0, i2 = 0, i3 = 0;
                    for (int e = 0; e < 32; ++e) {
                        const float v = lgs[F.lane * 33 + e] + F.b_router[e];
                        if (v > v3) {
                            if (v > v0) { v3 = v2; i3 = i2; v2 = v1; i2 = i1; v1 = v0; i1 = i0; v0 = v; i0 = e; }
                            else if (v > v1) { v3 = v2; i3 = i2; v2 = v1; i2 = i1; v1 = v; i1 = e; }
                            else if (v > v2) { v3 = v2; i3 = i2; v2 = v; i2 = e; }
                            else { v3 = v; i3 = e; }
                        }
                    }
                    const float e1 = __expf(v1 - v0), e2 = __expf(v2 - v0), e3 = __expf(v3 - v0), inv = 1.0f / (1.0f + e1 + e2 + e3);
                    const float g4[4] = {inv, e1 * inv, e2 * inv, e3 * inv}; const int i4[4] = {i0, i1, i2, i3};
                    unsigned pos[4];
#pragma unroll
                    for (int k = 0; k < 4; ++k) pos[k] = atomicAdd((unsigned*)(F.ctl + CW_CNT + 64 * i4[k]), 1u);
#pragma unroll
                    for (int k = 0; k < 4; ++k) F.list[i4[k] * LISTCAP + (int)pos[k]] = (i32x2){r * 4 + k, __float_as_int(g4[k])};
                }
            }
            __syncthreads();
        }
        if (BOTH(6)) GRID_BAR();
    }

    if ((IN(7) || IN(8)) && !DBG_SKIP_Y) {
        LAS int* tab = (LAS int*)(F.lds + TAB_OFF);
        if (F.tid < 32) tab[F.tid] = (int)__hip_atomic_load(F.ctl + CW_CNT + 64 * F.tid, RLX_AGENT);
        __syncthreads();
        if (F.tid == 0) { int s = 0; for (int e = 0; e < 32; ++e) { tab[32 + e] = s; s += (tab[e] + 255) >> 8; } tab[64] = s; }
        __syncthreads();
    }
    if (IN(7) && !DBG_SKIP_Y) {
        pg8::MoeSched<true> S; S.init((const bf16_t*)F.H8, (const bf16_t*)F.Wgu8, F.list, (const LAS int*)(F.lds + TAB_OFF), F.G, (int)blockIdx.x);
        pg8::EpiGU E{F.ACT8, F.b_gu};
        pg8::gemm_phase<pg8::EpiGU, pg8::MoeSched<true>, true, true>(F.lds, S, E);
        if (BOTH(7)) GRID_BAR();
    }
    if (IN(8) && !DBG_SKIP_Y) {
        pg8::MoeSched<false> S; S.init((const bf16_t*)F.ACT8, (const bf16_t*)F.Wd8, F.list, (const LAS int*)(F.lds + TAB_OFF), F.G, (int)blockIdx.x);
        pg8::EpiDown E{F.Y, F.b_down, F.list};
        pg8::gemm_phase<pg8::EpiDown, pg8::MoeSched<false>, true, true>(F.lds, S, E);
        if (BOTH(8)) GRID_BAR();
    }
    if (IN(9) && DBG_STAGE) {
        for (int m = gw; m < NTOK; m += NGW) {
            const bf16_t* src = DBG_STAGE == 1 ? F.XN + (size_t)m * D : DBG_STAGE == 2 ? F.Z + (size_t)m * DIN + 1024 : DBG_STAGE == 3 ? F.CAT + (size_t)m * D : F.U + (size_t)m * D;
            for (int j = F.lane; j < D; j += 64) F.out[(size_t)m * D + j] = __uint_as_float(((unsigned)src[j]) << 16);
        }
    }
    if (IN(9) && !DBG_STAGE) {
        for (int m = gw; m < NTOK; m += NGW) {
            const GAS f32x4* xr = (const GAS f32x4*)((DBG_ONLY9 ? F.x : F.out) + (size_t)m * D) + F.lane; const GAS f32x4* wr = (const GAS f32x4*)F.norm_final_w + F.lane;
            f32x4 v[4]; float s = 0.f;
#pragma unroll
            for (int j = 0; j < 4; ++j) v[j] = xr[64 * j];
#pragma unroll
            for (int k = 0; k < (DBG_SKIP_Y ? 0 : 4); ++k) { const GAS u32x2* yr = (const GAS u32x2*)(F.Y + ((size_t)m * 4 + k) * D) + F.lane;
#pragma unroll
                for (int j = 0; j < 4; ++j) { const u32x2 y = yr[64 * j]; v[j] += (f32x4){bf_lo(y.x), bf_hi(y.x), bf_lo(y.y), bf_hi(y.y)}; } }
#pragma unroll
            for (int j = 0; j < 4; ++j) s += (v[j].x * v[j].x + v[j].y * v[j].y) + (v[j].z * v[j].z + v[j].w * v[j].w);
            const float rstd = 1.f / sqrtf(wave_sum(s) * (1.f / D) + EPS);
            GAS f32x4* orow = (GAS f32x4*)(F.out + (size_t)m * D) + F.lane;
#pragma unroll
            for (int j = 0; j < 4; ++j) orow[64 * j] = v[j] * rstd * wr[64 * j];
        }
    }
    if (DBG_SPIN_A >= 0) { STAMP();
        if (blockIdx.x == 0 && F.tid == 0) {
            const unsigned long long ta = ((unsigned long long)F.MISC[17 + 2 * DBG_SPIN_A] << 32) | F.MISC[16 + 2 * DBG_SPIN_A], tb = ((unsigned long long)F.MISC[17 + 2 * DBG_SPIN_B] << 32) | F.MISC[16 + 2 * DBG_SPIN_B];
            const unsigned long long t0 = __builtin_amdgcn_s_memrealtime(), want = (tb - ta) * DBG_SPIN_W;
            while (__builtin_amdgcn_s_memrealtime() - t0 < want) __builtin_amdgcn_s_sleep(8);
        } }
#undef IN
#undef BOTH
#undef GRID_BAR
#undef STAMP
}

extern "C" void kernel_launch(void* const* d_in, const int* in_sizes, int n_in, void* d_out, int out_size, void* d_ws, size_t ws_size, hipStream_t stream) {
    static int grid = 0;
    if (grid == 0) {
        if (n_in != 15 || in_sizes[0] != NTOK * D || out_size != NTOK * D || ws_size < WS_END) { fprintf(stderr, "kernel_launch: unexpected shapes / workspace (n_in %d, ws %zu); nothing launched\n", n_in, ws_size); grid = -1; return; }
        int dev = 0, cus = 0, per_cu = 0;
        if (hipGetDevice(&dev) != hipSuccess || hipDeviceGetAttribute(&cus, hipDeviceAttributeMultiprocessorCount, dev) != hipSuccess) { grid = -1; return; }
        if (hipFuncSetAttribute((const void*)fwd_kernel, hipFuncAttributeMaxDynamicSharedMemorySize, LDS_BYTES) != hipSuccess) { fprintf(stderr, "kernel_launch: hipFuncSetAttribute failed\n"); grid = -1; return; }
        if (hipOccupancyMaxActiveBlocksPerMultiprocessor(&per_cu, (const void*)fwd_kernel, NWAVES * 64, LDS_BYTES) != hipSuccess || per_cu < 1)
            fprintf(stderr, "kernel_launch: note: occupancy query reports %d workgroups per CU\n", per_cu);
        (void)hipGetLastError();
        grid = cus;
    }
    if (grid < 0) return;
    if (hipMemsetAsync((char*)d_ws + WS_CTL, 0, CTL_ZERO_BYTES, stream) != hipSuccess) { fprintf(stderr, "kernel_launch: memset failed\n"); return; }
    Args a{};
    for (int i = 0; i < 15; ++i) a.in[i] = (const float*)d_in[i];
    a.out = (float*)d_out; a.ws = (unsigned char*)d_ws;
    for (int h = 0; h < 4; ++h) a.lg2g[h] = (float)(log1p(-exp2(-5.0 - (double)h)) / log(2.0));
    for (int li = 0; li < N_LAUNCHES; ++li) {
        a.ph_lo = (N_LAUNCHES == PER_PHASE) ? li : 0; a.ph_hi = (N_LAUNCHES == PER_PHASE) ? li + 1 : PER_PHASE; a.li = li; a.pad = 0;
        hipLaunchKernelGGL(fwd_kernel, dim3(grid), dim3(NWAVES * 64), LDS_BYTES, stream, a);
        const hipError_t le = hipPeekAtLastError();
        if (le != hipSuccess) { fprintf(stderr, "kernel_launch: launch %d failed: %s\n", li, hipGetErrorName(le)); break; }
    }
}
```

```cpp
#include <hip/hip_runtime.h>
#include <cstdio>
#include <cstdint>
#include <cmath>

#ifndef DBG_ONLY9
#define DBG_ONLY9 0
#define DBG_STAGE 0
#endif
#ifndef DBG_SPIN_A
#define DBG_SPIN_A -1
#define DBG_SPIN_B -1
#define DBG_SPIN_W 2
#endif
#ifndef DBG_SKIP_Y
#define DBG_SKIP_Y 0
#endif
#ifndef MK_N_LAUNCHES
#define MK_N_LAUNCHES 1
#endif
constexpr int PER_PHASE = 10;
constexpr int N_LAUNCHES = MK_N_LAUNCHES;

#define LAS __attribute__((address_space(3)))
#define GAS __attribute__((address_space(1)))
typedef unsigned short bf16_t;
typedef short bf16x8 __attribute__((ext_vector_type(8)));
typedef float f32x4 __attribute__((ext_vector_type(4)));
typedef float f32x2 __attribute__((ext_vector_type(2)));
typedef unsigned u32x4 __attribute__((ext_vector_type(4)));
typedef unsigned u32x2 __attribute__((ext_vector_type(2)));
typedef GAS unsigned gu32;
typedef int i32x2 __attribute__((ext_vector_type(2)));

constexpr int NTOK = 16384, D = 1024, SEQ = 4096, DIN = 2560, NE = 32, FF = 1024, LISTCAP = 16384;
constexpr int NWAVES = 8;
constexpr float EPS = 1e-6f;

constexpr size_t MiB = 1u << 20;
constexpr size_t WS_CTL = 0, CTL_ZERO_BYTES = 1 * MiB;
constexpr size_t WS_LIST = 1 * MiB;
constexpr size_t WS_SSQ = 5 * MiB + 512 * 1024;
constexpr size_t WS_WR = 6 * MiB + 512 * 1024;
constexpr size_t WS_WPOOL = 6 * MiB + 768 * 1024;
constexpr size_t WS_WIN = 7 * MiB;
constexpr size_t WS_WOUT = 12 * MiB;
constexpr size_t WS_XN = 14 * MiB;
constexpr size_t WS_CAT = 47 * MiB;
constexpr size_t WS_U = 79 * MiB;
constexpr size_t WS_Z = 111 * MiB;
constexpr size_t WS_Y = 47 * MiB;
constexpr size_t WS_WGU = 192 * MiB;
constexpr size_t WS_WD = 256 * MiB;
constexpr size_t WS_ACT = 288 * MiB;
constexpr size_t WS_END = 360 * MiB;
static_assert(WS_Y + (size_t)65536 * 1024 * 2 <= WS_WGU && WS_Z + (size_t)16384 * 2560 * 2 <= WS_WGU, "Y overlay / Z");
constexpr int CW_TMO = 0, CW_CODE = 1;
constexpr int CW_CNT = 1024;
constexpr int CW_BAR = 4096;

constexpr int RING_BYTES = 131072;
constexpr int LDSCTL_OFF = RING_BYTES, MISC_OFF = LDSCTL_OFF + 320, TAB_OFF = LDSCTL_OFF + 512;
constexpr int MB_OFF = LDSCTL_OFF + 1024;
constexpr int LDS_BYTES = 147456;

#define RLX_AGENT __ATOMIC_RELAXED, __HIP_MEMORY_SCOPE_AGENT
#define LDS_WAIT() asm volatile("s_waitcnt lgkmcnt(0)" ::: "memory")
#define VM_WAIT() asm volatile("s_waitcnt vmcnt(0)" ::: "memory")
typedef __bf16 bf16x2_t __attribute__((ext_vector_type(2)));
__device__ __forceinline__ unsigned cvt_pk_bf16(float lo, float hi) { const f32x2 v = {lo, hi}; const bf16x2_t b = __builtin_convertvector(v, bf16x2_t); return __builtin_bit_cast(unsigned, b); }
__device__ __forceinline__ unsigned cvt4_fp8(float a, float b, float c, float d) { int r = __builtin_amdgcn_cvt_pk_fp8_f32(a, b, 0, false); r = __builtin_amdgcn_cvt_pk_fp8_f32(c, d, r, true); return (unsigned)r; }
typedef int i32x8 __attribute__((ext_vector_type(8)));
__device__ __forceinline__ float bf_lo(unsigned w) { return __uint_as_float(w << 16); }
__device__ __forceinline__ float bf_hi(unsigned w) { return __uint_as_float(w & 0xffff0000u); }
__device__ __forceinline__ float wave_sum(float v) {
#pragma unroll
    for (int o = 1; o < 64; o <<= 1) v += __shfl_xor(v, o);
    return v;
}
__device__ __forceinline__ f32x4 mfma16(bf16x8 a, bf16x8 b, f32x4 c) { return __builtin_amdgcn_mfma_f32_16x16x32_bf16(a, b, c, 0, 0, 0); }

namespace pg8 {
constexpr int BM = 256, BK = 64, HALF = 128, HTB = HALF * BK * 2, STAGE_BYTES = 8 * HTB, NXCD = 8, WGM = 8, KK = 1024;
__host__ __device__ __forceinline__ int lds_byte(int r, int c) { const int st = (r >> 4) * 2 + (c >> 5), rr = r & 15, cc = c & 31, ob = rr * 64 + cc * 2; return st * 1024 + (ob ^ (((ob >> 9) & 1) << 5)); }
__host__ __device__ __forceinline__ void stage_rc(int b, int& R, int& C) { const int st = b / 1024, sb = b % 1024, swz = sb ^ (((sb >> 9) & 1) << 5); R = (st >> 1) * 16 + swz / 64; C = (st & 1) * 32 + (swz % 64) / 2; }
__host__ __device__ __forceinline__ int perm32(int rho) { const int n = rho >> 4, i = rho & 15; return 8 * (i >> 2) + 4 * n + (i & 3); }

struct Unit { int pm, pn, e, rows, arow; };

__device__ __forceinline__ int xcd_remap(int L, int nwg) { const int q = nwg / NXCD, r = nwg % NXCD, xcd = L % NXCD, off = L / NXCD; return (xcd < r ? xcd * (q + 1) : r * (q + 1) + (xcd - r) * q) + off; }

struct DenseSched {
    const bf16_t* A; const bf16_t* Bt; int nM, nN, nwg, G, c;
    __device__ __forceinline__ void init(const bf16_t* A_, const bf16_t* Bt_, int M, int N, int G_, int c_) { A = A_; Bt = Bt_; nM = M / BM; nN = N / BM; nwg = nM * nN; G = G_; c = c_; }
    __device__ __forceinline__ bool next(int i, Unit& u) const {
        const int L = i * G + c; if (L >= nwg) return false;
        const int wgid = xcd_remap(L, nwg);
        const int nig = WGM * nN, gid = wgid / nig, fm = gid * WGM, gsz = (nM - fm) < WGM ? (nM - fm) : WGM;
        u.pm = fm + ((wgid % nig) % gsz); u.pn = (wgid % nig) / gsz; u.e = 0; u.rows = 256; u.arow = u.pm * 256; return true;
    }
    __device__ __forceinline__ const char* a_base(const Unit& u) const { return (const char*)A + (size_t)u.pm * (2 * HALF * KK * 2); }
    __device__ __forceinline__ const char* b_base(const Unit& u) const { return (const char*)Bt + (size_t)u.pn * (2 * HALF * KK * 2); }
    static constexpr bool MB = false;
    __device__ __forceinline__ void mb_issue(LAS unsigned char*, const Unit&, int, int) const {}
    __device__ __forceinline__ void a_offs(const Unit&, int tid, unsigned (&go)[2][2], const LAS i32x2*) const {
#pragma unroll
        for (int i = 0; i < 2; ++i) { int R, C; stage_rc(tid * 16 + i * 8192, R, C);
#pragma unroll
            for (int h = 0; h < 2; ++h) go[h][i] = (unsigned)((h * HALF + R) * KK + C) * 2u; }
    }
};
constexpr int KU8 = 512;
template <bool GU> struct MoeSched {
    const bf16_t* A; const bf16_t* Bt; const i32x2* list; const LAS int* tab; int nN, nwg, G, c;
    __device__ __forceinline__ void init(const bf16_t* A_, const bf16_t* Bt_, const i32x2* list_, const LAS int* tab_, int G_, int c_) { A = A_; Bt = Bt_; list = list_; tab = tab_; nN = GU ? 8 : 4; nwg = __builtin_amdgcn_readfirstlane(tab_[32 + 32]) * nN; G = G_; c = c_; }
    __device__ __forceinline__ bool next(int i, Unit& u) const {
        const int L = i * G + c; if (L >= nwg) return false;
        const int wgid = xcd_remap(L, nwg);
        int ln = (int)(threadIdx.x & 31u); asm volatile("" : "+v"(ln));
        const unsigned long long bal = __ballot(tab[32 + ln] * nN <= wgid);
        const int e = 31 - __builtin_clz((unsigned)(bal & 0xffffffffull));
        const int tb0 = tab[32 + e], T = tab[32 + e + 1] - tb0, local = wgid - tb0 * nN;
        int rows = tab[e] - (local % T) * 256; if (rows > 256) rows = 256;
        u.e = __builtin_amdgcn_readfirstlane(e); u.pm = __builtin_amdgcn_readfirstlane(local % T); u.pn = __builtin_amdgcn_readfirstlane(local / T); u.rows = __builtin_amdgcn_readfirstlane(rows); u.arow = __builtin_amdgcn_readfirstlane((tb0 + local % T) * 256); return true;
    }
    __device__ __forceinline__ const char* a_base(const Unit& u) const { return GU ? (const char*)A : (const char*)A + (size_t)u.arow * (KU8 * 2); }
    __device__ __forceinline__ const char* b_base(const Unit& u) const { return (const char*)Bt + ((size_t)u.e * (GU ? 2048 : 1024) + (size_t)u.pn * 256) * (KU8 * 2); }
    static constexpr bool MB = true;
    __device__ __forceinline__ void mb_issue(LAS unsigned char* mb, const Unit& u, int wid, int lane) const {
        asm volatile("" : "+v"(lane));
        if (wid < 2) __builtin_amdgcn_global_load_lds((const unsigned*)(list + u.e * LISTCAP + u.pm * 256 + wid * 128 + lane * 2), (LAS unsigned*)(mb + wid * 1024), 16, 0, 0);
    }
    __device__ __forceinline__ void a_offs(const Unit& u, int tid, unsigned (&go)[2][2], const LAS i32x2* mb) const {
#pragma unroll
        for (int i = 0; i < 2; ++i) { int R, C; stage_rc(tid * 16 + i * 8192, R, C);
#pragma unroll
            for (int h = 0; h < 2; ++h) {
                if (GU) { const int r = h * HALF + R; const int raw = mb[r].x; const int tok = r < u.rows ? (raw >> 2) : NTOK; go[h][i] = (unsigned)(tok * KU8 + C) * 2u; }
                else go[h][i] = (unsigned)((h * HALF + R) * KU8 + C) * 2u;
            } }
    }
};

struct EpiBf16 {
    static constexpr bool PERM = true;
    bf16_t* O; int ldc;
    __device__ __forceinline__ void operator()(const f32x4 (&acc)[2][2][4][2], const Unit& u, int wr, int wc, int fr, int fq, const LAS i32x2*) const {
        const int row0 = u.pm * BM + wr * 64 + fr, col0 = u.pn * BM + wc * 32 + 8 * fq;
#pragma unroll
        for (int ai = 0; ai < 2; ++ai)
#pragma unroll
            for (int m = 0; m < 4; ++m) { bf16_t* rowp = O + (size_t)(row0 + ai * HALF + m * 16) * ldc + col0;
#pragma unroll
                for (int bj = 0; bj < 2; ++bj) { const f32x4 v0 = acc[ai][bj][m][0], v1 = acc[ai][bj][m][1];
                    u32x4 w; w.x = cvt_pk_bf16(v0[0], v0[1]); w.y = cvt_pk_bf16(v0[2], v0[3]); w.z = cvt_pk_bf16(v1[0], v1[1]); w.w = cvt_pk_bf16(v1[2], v1[3]);
                    *(u32x4*)(rowp + bj * HALF) = w; } }
    }
};
struct EpiResF32 {
    static constexpr bool PERM = false;
    const float* base; float* C; int ldc; float* ssq;
    __device__ __forceinline__ void operator()(const f32x4 (&acc)[2][2][4][2], const Unit& u, int wr, int wc, int fr, int fq, const LAS i32x2*) const {
        const int row0 = u.pm * BM + wr * 64 + fr, col0 = u.pn * BM + wc * 32 + 4 * fq;
        float* sp = ssq + (size_t)(u.pn * 4 + wc) * NTOK;
#pragma unroll
        for (int ai = 0; ai < 2; ++ai)
#pragma unroll
            for (int m = 0; m < 4; ++m) { const int row = row0 + ai * HALF + m * 16; const size_t off = (size_t)row * ldc + col0; float s2 = 0.f;
#pragma unroll
                for (int bj = 0; bj < 2; ++bj)
#pragma unroll
                    for (int n = 0; n < 2; ++n) { const f32x4 b = *(const f32x4*)(base + off + bj * HALF + n * 16); const f32x4 v = acc[ai][bj][m][n] + b; *(f32x4*)(C + off + bj * HALF + n * 16) = v;
                        s2 += (v[0] * v[0] + v[1] * v[1]) + (v[2] * v[2] + v[3] * v[3]); }
                s2 += __shfl_xor(s2, 16); s2 += __shfl_xor(s2, 32);
                if (fq == 0) sp[row] = s2;
                asm volatile("" ::: "memory"); }
    }
};
constexpr float WSCL = 1.0f / 32.0f;
__device__ __forceinline__ float swiglu(float g, float l) {
    g = fminf(g, 7.0f); l = fminf(fmaxf(l, -7.0f), 7.0f);
    const float s = __builtin_amdgcn_rcpf(1.0f + __builtin_amdgcn_exp2f(-1.702f * 1.4426950408889634f * g));
    return g * s * (l + 1.0f);
}
struct EpiGU {
    static constexpr bool PERM = true;
    unsigned char* ACT; const float* bgu;
    __device__ __forceinline__ void operator()(const f32x4 (&acc)[2][2][4][2], const Unit& u, int wr, int wc, int fr, int fq, const LAS i32x2*) const {
        const int row0 = u.arow + wr * 64 + fr, colg = u.pn * 128 + wc * 32 + 8 * fq;
        const float* bp = bgu + (size_t)u.e * 2048 + colg;
#pragma unroll
        for (int ai = 0; ai < 2; ++ai) {
            asm volatile("" : "+v"(bp));
            const f32x4 bg0 = *(const f32x4*)(bp), bg1 = *(const f32x4*)(bp + 4), bl0 = *(const f32x4*)(bp + 1024), bl1 = *(const f32x4*)(bp + 1024 + 4);
#pragma unroll
            for (int m = 0; m < 4; ++m) {
                const f32x4 g0 = acc[ai][0][m][0] * WSCL + bg0, g1 = acc[ai][0][m][1] * WSCL + bg1, l0 = acc[ai][1][m][0] * WSCL + bl0, l1 = acc[ai][1][m][1] * WSCL + bl1;
                u32x2 w; w.x = cvt4_fp8(swiglu(g0[0], l0[0]), swiglu(g0[1], l0[1]), swiglu(g0[2], l0[2]), swiglu(g0[3], l0[3]));
                w.y = cvt4_fp8(swiglu(g1[0], l1[0]), swiglu(g1[1], l1[1]), swiglu(g1[2], l1[2]), swiglu(g1[3], l1[3]));
                *(u32x2*)(ACT + (size_t)(row0 + ai * HALF + m * 16) * FF + colg) = w; }
        }
    }
};
struct EpiDown {
    static constexpr bool PERM = true;
    bf16_t* Y; const float* bd;
    __device__ __forceinline__ void operator()(const f32x4 (&acc)[2][2][4][2], const Unit& u, int wr, int wc, int fr, int fq, const LAS i32x2* mb) const {
        const int col0 = u.pn * BM + wc * 32 + 8 * fq;
        const float* bp = bd + (size_t)u.e * 1024 + col0;
        int rb = wr * 64 + fr; asm volatile("" : "+v"(rb));
#pragma unroll
        for (int bj = 0; bj < 2; ++bj) {
            const f32x4 b0 = *(const f32x4*)(bp + bj * HALF), b1 = *(const f32x4*)(bp + bj * HALF + 4);
#pragma unroll
            for (int ai = 0; ai < 2; ++ai)
#pragma unroll
                for (int m = 0; m < 4; ++m) { const int r = ai * HALF + m * 16 + rb;
                    if (r < u.rows) { const i32x2 sg = mb[r]; const int slot = sg.x; const float gt = __int_as_float(sg.y);
                        const f32x4 v0 = (acc[ai][bj][m][0] * WSCL + b0) * gt, v1 = (acc[ai][bj][m][1] * WSCL + b1) * gt;
                        u32x4 w; w.x = cvt_pk_bf16(v0[0], v0[1]); w.y = cvt_pk_bf16(v0[2], v0[3]); w.z = cvt_pk_bf16(v1[0], v1[1]); w.w = cvt_pk_bf16(v1[2], v1[3]);
                        *(u32x4*)(Y + (size_t)slot * D + col0 + bj * HALF) = w; } }
        }
    }
};

typedef int i32x4 __attribute__((ext_vector_type(4)));
__device__ __forceinline__ bf16x8 lo8(i32x8 a) { return __builtin_bit_cast(bf16x8, __builtin_shufflevector(a, a, 0, 1, 2, 3)); }
__device__ __forceinline__ bf16x8 hi8(i32x8 a) { return __builtin_bit_cast(bf16x8, __builtin_shufflevector(a, a, 4, 5, 6, 7)); }
template <class Epi, class Sched, bool ALIGN_EPI, bool FP8 = false>
__device__ __forceinline__ void gemm_phase(LAS unsigned char* lds, const Sched& S, const Epi& E) {
    const int tid = threadIdx.x, wid = __builtin_amdgcn_readfirstlane(tid >> 6), lane = tid & 63, wr = wid >> 2, wc = wid & 3, fr = lane & 15, fq = lane >> 4;
    constexpr int K = FP8 ? 512 : KK;
    int nt = K / BK; asm volatile("" : "+s"(nt));
    unsigned voffB[2];
#pragma unroll
    for (int i = 0; i < 2; ++i) { int R, C; stage_rc(tid * 16 + i * 8192, R, C); const int Rb = Epi::PERM ? ((R & ~31) + perm32(R & 31)) : R;
        voffB[i] = (unsigned)(Rb * K + C) * 2u; }
    constexpr size_t kstep = (size_t)(BK * 2);
    constexpr size_t hstep = (size_t)HALF * K * 2;
    const unsigned ldsw = (unsigned)wid * 1024u;
    const int aoff = lds_byte(wr * 64 + fr, fq * 8), boff = lds_byte(wc * 32 + fr, fq * 8);
#define PG8_SA(b, h) (((b) * 2 + (h)) * HTB)
#define PG8_SB(b, h) ((4 + (b) * 2 + (h)) * HTB)
#define PG8_STAGE(bufoff, gbase, voff) do { _Pragma("unroll") for (int _i = 0; _i < 2; ++_i) \
        __builtin_amdgcn_global_load_lds((const unsigned*)((const char*)(gbase) + (voff)[_i]), (LAS unsigned*)(lds + (bufoff) + ldsw + _i * 8192), 16, 0, 0); } while (0)
#define PG8_LDA(dst, b, h) do { _Pragma("unroll") for (int m = 0; m < 4; ++m) { const u32x4 _x = *(const LAS u32x4*)(lds + PG8_SA(b, h) + aoff + m * 2048), _y = *(const LAS u32x4*)(lds + PG8_SA(b, h) + aoff + m * 2048 + 1024); \
        dst[m] = (i32x8){(int)_x[0], (int)_x[1], (int)_x[2], (int)_x[3], (int)_y[0], (int)_y[1], (int)_y[2], (int)_y[3]}; } } while (0)
#define PG8_LDB(dst, b, h) do { _Pragma("unroll") for (int n = 0; n < 2; ++n) { const u32x4 _x = *(const LAS u32x4*)(lds + PG8_SB(b, h) + boff + n * 2048), _y = *(const LAS u32x4*)(lds + PG8_SB(b, h) + boff + n * 2048 + 1024); \
        dst[n] = (i32x8){(int)_x[0], (int)_x[1], (int)_x[2], (int)_x[3], (int)_y[0], (int)_y[1], (int)_y[2], (int)_y[3]}; } } while (0)
#define PG8_MMA(ai, bj, At, Bt) do { __builtin_amdgcn_s_setprio(1); _Pragma("unroll") for (int m = 0; m < 4; ++m) _Pragma("unroll") for (int n = 0; n < 2; ++n) { \
        if constexpr (FP8) { acc[ai][bj][m][n] = __builtin_amdgcn_mfma_scale_f32_16x16x128_f8f6f4(Bt[n], At[m], acc[ai][bj][m][n], 0, 0, 0, 0, 0, 0); } \
        else { acc[ai][bj][m][n] = __builtin_amdgcn_mfma_f32_16x16x32_bf16(lo8(Bt[n]), lo8(At[m]), acc[ai][bj][m][n], 0, 0, 0); acc[ai][bj][m][n] = __builtin_amdgcn_mfma_f32_16x16x32_bf16(hi8(Bt[n]), hi8(At[m]), acc[ai][bj][m][n], 0, 0, 0); } } __builtin_amdgcn_s_setprio(0); } while (0)
#define PG8_WAIT_V(n) asm volatile("s_waitcnt vmcnt(" #n ")" ::: "memory")
#define PG8_WAIT_L(n) asm volatile("s_waitcnt lgkmcnt(" #n ")" ::: "memory")
#define PG8_BAR __builtin_amdgcn_s_barrier()
#define PG8_SCHED __builtin_amdgcn_sched_barrier(0)
    Unit cur, nxt; int ui = 0;
    if (!S.next(0, cur)) return;
    f32x4 acc[2][2][4][2];
#pragma unroll
    for (int a = 0; a < 2; ++a)
#pragma unroll
        for (int b = 0; b < 2; ++b)
#pragma unroll
            for (int m = 0; m < 4; ++m)
#pragma unroll
                for (int n = 0; n < 2; ++n) acc[a][b][m][n] = (f32x4){0.f, 0.f, 0.f, 0.f};
    i32x8 At[4], B0[2], B1[2];
    const char* cA = S.a_base(cur); const char* cB = S.b_base(cur);
    unsigned go[2][2];
    LAS unsigned char* const mbx = lds + (MB_OFF - 0);
    if constexpr (Sched::MB) { S.mb_issue(mbx, cur, wid, lane); asm volatile("s_waitcnt vmcnt(0)" ::: "memory"); __builtin_amdgcn_s_barrier(); asm volatile("" ::: "memory"); }
    { int t2 = tid; asm volatile("" : "+v"(t2)); S.a_offs(cur, t2, go, (const LAS i32x2*)mbx); }
    PG8_STAGE(PG8_SB(0, 0), cB, voffB); PG8_STAGE(PG8_SB(0, 1), cB + hstep, voffB); PG8_STAGE(PG8_SA(0, 0), cA, go[0]); PG8_STAGE(PG8_SA(0, 1), cA, go[1]);
    if (wr == 1) PG8_BAR;
    PG8_WAIT_V(2); PG8_BAR;
    PG8_STAGE(PG8_SB(1, 0), cB + kstep, voffB); PG8_STAGE(PG8_SA(1, 0), cA + kstep, go[0]); PG8_STAGE(PG8_SB(1, 1), cB + hstep + kstep, voffB);
    PG8_WAIT_V(6); PG8_BAR;
    asm volatile("" : "+v"(voffB[0]), "+v"(voffB[1]), "+v"(go[0][0]), "+v"(go[0][1]), "+v"(go[1][0]), "+v"(go[1][1]));
    for (;;) {
        const bool has_next = S.next(ui + 1, nxt);
        const char* nA = has_next ? S.a_base(nxt) : cA; const char* nB = has_next ? S.b_base(nxt) : cB;
#pragma clang loop unroll(disable)
        for (int t = 0; t < nt; t += 2) {
            const bool last = (t == nt - 2);
            asm volatile("" : "+v"(voffB[0]), "+v"(voffB[1]));
            const char* a1 = cA + (size_t)(t + 1) * kstep;
            const char* a2 = last ? nA : cA + (size_t)(t + 2) * kstep; const char* b2 = last ? nB : cB + (size_t)(t + 2) * kstep;
            const char* a3 = a2 + kstep; const char* b3 = b2 + kstep;
            PG8_LDB(B0, 0, 0); PG8_LDB(B1, 0, 1); PG8_SCHED; PG8_LDA(At, 0, 0); PG8_STAGE(PG8_SA(1, 1), a1, go[1]);
            if (last && has_next) { int t2 = tid; asm volatile("" : "+v"(t2)); S.a_offs(nxt, t2, go, (const LAS i32x2*)(mbx + ((ui + 1) & 1) * 2048)); }
            PG8_WAIT_V(8); PG8_WAIT_L(0); PG8_BAR; PG8_MMA(0, 0, At, B0); PG8_MMA(0, 1, At, B1); PG8_BAR; PG8_SCHED;
            if constexpr (Sched::MB) { if (t == 0 && has_next) S.mb_issue(mbx + ((ui + 1) & 1) * 2048, nxt, wid, lane); }
            PG8_LDA(At, 0, 1); PG8_STAGE(PG8_SB(0, 0), b2, voffB); PG8_STAGE(PG8_SB(0, 1), b2 + hstep, voffB); PG8_STAGE(PG8_SA(0, 0), a2, go[0]);
            PG8_WAIT_V(8); PG8_WAIT_L(0); PG8_BAR; PG8_MMA(1, 0, At, B0); PG8_MMA(1, 1, At, B1); PG8_BAR; PG8_SCHED;
            PG8_LDB(B0, 1, 0); PG8_LDB(B1, 1, 1); PG8_SCHED; PG8_LDA(At, 1, 0); PG8_STAGE(PG8_SA(0, 1), a2, go[1]);
            PG8_WAIT_V(8); PG8_WAIT_L(0); PG8_BAR; PG8_MMA(0, 0, At, B0); PG8_MMA(0, 1, At, B1); PG8_BAR; PG8_SCHED;
            PG8_LDA(At, 1, 1); PG8_STAGE(PG8_SB(1, 0), b3, voffB); PG8_STAGE(PG8_SB(1, 1), b3 + hstep, voffB); PG8_STAGE(PG8_SA(1, 0), a3, go[0]);
            PG8_WAIT_V(8); PG8_WAIT_L(0); PG8_BAR; PG8_MMA(1, 0, At, B0); PG8_MMA(1, 1, At, B1); PG8_BAR; PG8_SCHED;
        }
        if constexpr (ALIGN_EPI) { if (wr == 0) PG8_BAR; }
        { int t2 = tid; asm volatile("" : "+v"(t2)); const int l2 = t2 & 63; E(acc, cur, wr, wc, l2 & 15, l2 >> 4, (const LAS i32x2*)(mbx + (ui & 1) * 2048)); }
        if (!has_next) break;
#pragma unroll
        for (int a = 0; a < 2; ++a)
#pragma unroll
            for (int b = 0; b < 2; ++b)
#pragma unroll
                for (int m = 0; m < 4; ++m)
#pragma unroll
                    for (int n = 0; n < 2; ++n) acc[a][b][m][n] = (f32x4){0.f, 0.f, 0.f, 0.f};
        cur = nxt; cA = nA; cB = nB; ++ui;
        if constexpr (ALIGN_EPI) { if (wr == 1) PG8_BAR; }
    }
    PG8_WAIT_V(0);
    if constexpr (!ALIGN_EPI) { if (wr == 0) PG8_BAR; }
    PG8_BAR;
#undef PG8_SA
#undef PG8_SB
#undef PG8_STAGE
#undef PG8_LDA
#undef PG8_LDB
#undef PG8_MMA
#undef PG8_WAIT_V
#undef PG8_WAIT_L
#undef PG8_BAR
#undef PG8_SCHED
}
}

#define XB_TMO      128
#define XB_XCNT(j)  (256  + 64 * (j))
#define XB_XSUB(j)  (1280 + 64 * (j))
#define XB_XGEN(j)  (2304 + 64 * (j))
#define XB_TOP      3328
#define XB_TOPGEN   3392
#define XCD_BAR_WORDS 3456
#define XB_SPIN_CAP (1u << 18)
__device__ __forceinline__ unsigned xb_ld(unsigned* p)              { return __hip_atomic_load(p, __ATOMIC_RELAXED, __HIP_MEMORY_SCOPE_AGENT); }
__device__ __forceinline__ unsigned xb_add(unsigned* p, unsigned v) { return __hip_atomic_fetch_add(p, v, __ATOMIC_RELAXED, __HIP_MEMORY_SCOPE_AGENT); }
__device__ __forceinline__ unsigned xb_xcc_id() { return (unsigned)__builtin_amdgcn_s_getreg((3 << 11) | 20) & 0xFu; }
#define XB_SPIN(cond, bar) do { unsigned _sp = 0; while (cond) { __builtin_amdgcn_s_sleep(1); \
    if ((++_sp & 255u) == 0u) { if (xb_ld(&(bar)[XB_TMO])) break; if (_sp > XB_SPIN_CAP) { atomicAdd(&(bar)[XB_TMO], 1u); break; } } } } while (0)
struct XcdBarrier { unsigned* bar; unsigned x; volatile LAS unsigned* st; };
__device__ __forceinline__ XcdBarrier xcd_barrier_post(unsigned* bar, volatile LAS unsigned* st) {
    XcdBarrier b; b.bar = bar; b.x = xb_xcc_id(); b.st = st;
    if (threadIdx.x == 0) (void)xb_add(&bar[XB_XCNT(b.x)], 1u);
    return b;
}
__device__ __forceinline__ void xcd_barrier_complete(unsigned* bar, unsigned x, unsigned& nloc, unsigned& nx) {
    const unsigned G = gridDim.x * gridDim.y * gridDim.z;
    unsigned sum, cnt, mine, sp = 0u;
    for (;;) {
        sum = 0u; cnt = 0u; mine = 0u;
#pragma unroll
        for (unsigned j = 0; j < 16; ++j) { const unsigned c = xb_ld(&bar[XB_XCNT(j)]); sum += c; cnt += (c > 0u) ? 1u : 0u; mine = (j == x) ? c : mine; }
        if (sum == G) break;
        __builtin_amdgcn_s_sleep(1);
        if ((++sp & 255u) == 0u) { if (xb_ld(&bar[XB_TMO])) break; if (sp > XB_SPIN_CAP) { atomicAdd(&bar[XB_TMO], 1u); break; } }
    }
    nloc = mine > 0u ? mine : 1u; nx = cnt > 0u ? cnt : 1u;
}
__device__ __forceinline__ void xcd_barrier(const XcdBarrier& b) {
    asm volatile("s_waitcnt vmcnt(0)" ::: "memory");
    __syncthreads();
    if (threadIdx.x == 0) {
        unsigned* bar = b.bar;
        __builtin_amdgcn_s_waitcnt(0);
        unsigned nloc = b.st[0], nx = b.st[1];
        if (nloc == 0u) { xcd_barrier_complete(bar, b.x, nloc, nx); b.st[0] = nloc; b.st[1] = nx; }
        const unsigned old = xb_add(&bar[XB_XSUB(b.x)], 1u);
        const unsigned gen = old / nloc;
        if (old + 1u == (gen + 1u) * nloc) {
            __builtin_amdgcn_fence(__ATOMIC_RELEASE, "agent");
            asm volatile("s_waitcnt vmcnt(0)" ::: "memory");
            const unsigned og = xb_add(&bar[XB_TOP], 1u);
            const unsigned tg = og / nx;
            if (og + 1u == (tg + 1u) * nx) xb_add(&bar[XB_TOPGEN], 1u);
            else XB_SPIN(xb_ld(&bar[XB_TOPGEN]) == tg, bar);
            __builtin_amdgcn_fence(__ATOMIC_ACQUIRE, "agent");
            xb_add(&bar[XB_XGEN(b.x)], 1u);
            asm volatile("s_waitcnt vmcnt(0)" ::: "memory");
        } else {
            XB_SPIN(xb_ld(&bar[XB_XGEN(b.x)]) == gen, bar);
            __builtin_amdgcn_fence(__ATOMIC_ACQUIRE, "agent");
            asm volatile("s_waitcnt vmcnt(0)" ::: "memory");
        }
    }
    __syncthreads();
}

struct Frame {
    LAS unsigned char* lds;
    volatile LAS unsigned* MISC;
    gu32* ctl;
    int tid, lane, wave, vcu, G;
    const float *x, *norm_mix_w, *w_in, *ret_norm_w, *w_pool, *pool_scale, *w_out, *norm_ffn_w, *w_router, *b_router, *w_gu, *b_gu, *w_down, *b_down, *norm_final_w;
    float* out;
    bf16_t *Wr_hi, *Wr_lo, *Wpool_t, *Win_t, *Wout_t, *XN, *CAT, *U, *Z, *Y;
    unsigned char *Wgu8, *Wd8, *ACT8, *H8;
    i32x2* list; float* ssq;
    float lg2g0, lg2g1, lg2g2, lg2g3;
    __device__ __forceinline__ float lg2(int h) const { return h == 0 ? lg2g0 : (h == 1 ? lg2g1 : (h == 2 ? lg2g2 : lg2g3)); }
};

template <int MODE>
__device__ __forceinline__ void p0_item(const float* W, int ldw, void* WT, void* WT2, int ldo, LAS float* scr, int k0, int n0, int orow0, int lane) {
    f32x4 v[16];
    const float* src = W + (size_t)(k0 + (lane >> 3)) * ldw + n0 + 4 * (lane & 7);
#pragma unroll
    for (int i = 0; i < 16; ++i) v[i] = *(const GAS f32x4*)(src + (size_t)(8 * i) * ldw);
#pragma unroll
    for (int i = 0; i < 16; ++i) *(LAS f32x4*)(scr + (8 * i + (lane >> 3)) * 32 + 4 * ((lane & 7) ^ (i & 7))) = v[i];
    LDS_WAIT(); asm volatile("" ::: "memory");
    const int c = lane & 15, ns = lane >> 4;
#pragma unroll
    for (int J = 0; J < 8; ++J) {
        const LAS float* sp = scr + (8 * c) * 32 + 4 * (J ^ (c & 7)) + ns;
        float x[8];
#pragma unroll
        for (int q = 0; q < 8; ++q) x[q] = sp[q * 32];
        const int n = 4 * J + ns;
        if (MODE == 2) { u32x2 o; o.x = cvt4_fp8(x[0] * 32.f, x[1] * 32.f, x[2] * 32.f, x[3] * 32.f); o.y = cvt4_fp8(x[4] * 32.f, x[5] * 32.f, x[6] * 32.f, x[7] * 32.f);
            *(GAS u32x2*)((unsigned char*)WT + (size_t)(orow0 + n) * 1024 + k0 + 8 * c) = o; }
        else { u32x4 o; o.x = cvt_pk_bf16(x[0], x[1]); o.y = cvt_pk_bf16(x[2], x[3]); o.z = cvt_pk_bf16(x[4], x[5]); o.w = cvt_pk_bf16(x[6], x[7]);
            *(GAS u32x4*)((bf16_t*)WT + (size_t)(orow0 + n) * ldo + k0 + 8 * c) = o;
            if (MODE == 1) { u32x4 o2; o2.x = cvt_pk_bf16(x[0] - bf_lo(o.x), x[1] - bf_hi(o.x)); o2.y = cvt_pk_bf16(x[2] - bf_lo(o.y), x[3] - bf_hi(o.y));
                o2.z = cvt_pk_bf16(x[4] - bf_lo(o.z), x[5] - bf_hi(o.z)); o2.w = cvt_pk_bf16(x[6] - bf_lo(o.w), x[7] - bf_hi(o.w));
                *(GAS u32x4*)((bf16_t*)WT2 + (size_t)(orow0 + n) * ldo + k0 + 8 * c) = o2; } }
    }
    LDS_WAIT(); asm volatile("" ::: "memory");
}
__device__ __forceinline__ void rms_rows4_to_bf16(int lane, const float* x, const float* w, bf16_t* o, int m, int rs) {
    f32x4 v[4][4];
#pragma unroll
    for (int r = 0; r < 4; ++r) { const GAS f32x4* xr = (const GAS f32x4*)(x + (size_t)(m + r * rs) * D) + lane;
#pragma unroll
        for (int j = 0; j < 4; ++j) v[r][j] = __builtin_nontemporal_load(xr + 64 * j); }
    const GAS f32x4* wr = (const GAS f32x4*)w + lane;
    f32x4 ww[4];
#pragma unroll
    for (int j = 0; j < 4; ++j) ww[j] = wr[64 * j];
#pragma unroll
    for (int r = 0; r < 4; ++r) { float s = 0.f;
#pragma unroll
        for (int j = 0; j < 4; ++j) s += (v[r][j].x * v[r][j].x + v[r][j].y * v[r][j].y) + (v[r][j].z * v[r][j].z + v[r][j].w * v[r][j].w);
        const float rstd = 1.f / sqrtf(wave_sum(s) * (1.f / D) + EPS);
        GAS u32x2* o8 = (GAS u32x2*)(o + (size_t)(m + r * rs) * D) + lane;
#pragma unroll
        for (int j = 0; j < 4; ++j) { u32x2 p; p.x = cvt_pk_bf16(v[r][j].x * rstd * ww[j].x, v[r][j].y * rstd * ww[j].y); p.y = cvt_pk_bf16(v[r][j].z * rstd * ww[j].z, v[r][j].w * rstd * ww[j].w); o8[64 * j] = p; } }
}
template <int MODE, class RM>
__device__ __forceinline__ void p0_block_item(const float* W, int ldw, void* WT, int ldo, LAS float* tile, int k0, int n0, int wave, int lane, RM rowmap) {
    f32x4 v[16];
    const float* src = W + (size_t)(k0 + 16 * wave) * ldw + n0 + 4 * lane;
#pragma unroll
    for (int i = 0; i < 16; ++i) v[i] = __builtin_nontemporal_load((const GAS f32x4*)(src + (size_t)i * ldw));
#pragma unroll
    for (int i = 0; i < 16; ++i) { const int kl = 16 * wave + i; *(LAS f32x4*)(tile + kl * 256 + 4 * (lane ^ ((kl >> 3) & 7))) = v[i]; }
    __syncthreads();
    const int c = lane & 15, ns = lane >> 4;
#pragma unroll
    for (int J = 0; J < 8; ++J) {
        const LAS float* sp = tile + (8 * c) * 256 + 4 * ((8 * wave + J) ^ (c & 7)) + ns;
        float x[8];
#pragma unroll
        for (int q = 0; q < 8; ++q) x[q] = sp[q * 256];
        const int orow = rowmap(n0 + 32 * wave + 4 * J + ns);
        if (MODE == 2) { u32x2 o; o.x = cvt4_fp8(x[0] * 32.f, x[1] * 32.f, x[2] * 32.f, x[3] * 32.f); o.y = cvt4_fp8(x[4] * 32.f, x[5] * 32.f, x[6] * 32.f, x[7] * 32.f);
            __builtin_nontemporal_store(o, (GAS u32x2*)((unsigned char*)WT + (size_t)orow * 1024 + k0 + 8 * c)); }
        else { u32x4 o; o.x = cvt_pk_bf16(x[0], x[1]); o.y = cvt_pk_bf16(x[2], x[3]); o.z = cvt_pk_bf16(x[4], x[5]); o.w = cvt_pk_bf16(x[6], x[7]);
            *(GAS u32x4*)((bf16_t*)WT + (size_t)orow * ldo + k0 + 8 * c) = o; }
    }
    __syncthreads();
}
struct RowId { __device__ __forceinline__ int operator()(int n) const { return n; } };
struct RowGU { __device__ __forceinline__ int operator()(int n) const { const int m = n & 1023; return ((m >> 7) << 8) + (n >> 10) * 128 + (m & 127); } };
__device__ __forceinline__ void p0_prologue(Frame& F) {
    LAS float* tile = (LAS float*)F.lds;
    constexpr int B_GU = 32 * 8 * 8, B_D = 32 * 8 * 4, B_IN = 8 * 10, B_OUT = 8 * 4, NB = B_GU + B_D + B_IN + B_OUT;
    for (int it = F.vcu; it < NB; it += F.G) {
        int r = it;
        if (r < B_GU) { const int e = r >> 6, q = r & 63, kb = q >> 3, nb = q & 7; p0_block_item<2>(F.w_gu + (size_t)e * 1024 * 2048, 2048, F.Wgu8 + (size_t)e * 2048 * 1024, 1024, tile, kb * 128, nb * 256, F.wave, F.lane, RowGU()); continue; } r -= B_GU;
        if (r < B_D) { const int e = r >> 5, q = r & 31, kb = q >> 2, nb = q & 3; p0_block_item<2>(F.w_down + (size_t)e * 1024 * 1024, 1024, F.Wd8 + (size_t)e * 1024 * 1024, 1024, tile, kb * 128, nb * 256, F.wave, F.lane, RowId()); continue; } r -= B_D;
        if (r < B_IN) { const int kb = r / 10, nb = r % 10; p0_block_item<0>(F.w_in, DIN, F.Win_t, 1024, tile, kb * 128, nb * 256, F.wave, F.lane, RowId()); continue; } r -= B_IN;
        { const int kb = r >> 2, nb = r & 3; p0_block_item<0>(F.w_out, 1024, F.Wout_t, 1024, tile, kb * 128, nb * 256, F.wave, F.lane, RowId()); }
    }
    LAS float* scr = (LAS float*)(F.lds + F.wave * 16384);
    const int gw = F.vcu * NWAVES + F.wave, NGW = F.G * NWAVES;
    constexpr int I_POOL = 16, I_R = 8;
    for (int it = gw; it < I_POOL + I_R; it += NGW) {
        if (it < I_POOL) { const int g = it / 4, nb = it % 4; p0_item<0>(F.w_pool + g * 16384, 128, F.Wpool_t + g * 16384, nullptr, 128, scr, 0, nb * 32, nb * 32, F.lane); }
        else { const int kb = it - I_POOL; p0_item<1>(F.w_router, 32, F.Wr_hi, F.Wr_lo, 1024, scr, kb * 128, 0, 0, F.lane); }
    }
    for (int m = gw; m < NTOK / 4; m += NGW) rms_rows4_to_bf16(F.lane, F.x, F.norm_mix_w, F.XN, m, NTOK / 4);
}

__device__ __forceinline__ void rope_cs(int pos, int j, float& cs, float& sn) {
    const float inv = __builtin_amdgcn_exp2f((float)j * (-13.287712379549449f / 64.0f));
    const double revd = (double)pos * (double)inv * 0.15915494309189535;
    const float rev = (float)(revd - __builtin_floor(revd));
    sn = __builtin_amdgcn_sinf(rev); cs = __builtin_amdgcn_cosf(rev);
}

__device__ __forceinline__ void retA_unit(Frame& F, int unit) {
    const int c = unit & 63, bh = unit >> 6, h = bh & 3, b = bh >> 2;
    const int tok0 = b * SEQ + c * 64;
    LAS bf16_t* KT = (LAS bf16_t*)(F.lds);
    LAS bf16_t* VT = KT + 128 * 72;
    const int t = F.tid, m = t >> 3, o = t & 7;
    {
        const bf16_t* zrow = F.Z + (size_t)(tok0 + m) * DIN + h * 128 + 8 * o;
        const u32x4 klo = *(const u32x4*)(zrow + 512), khi = *(const u32x4*)(zrow + 512 + 64);
        const u32x4 vlo = *(const u32x4*)(zrow + 1024), vhi = *(const u32x4*)(zrow + 1024 + 64);
        const float ksc = __builtin_amdgcn_exp2f(F.lg2(h) * (float)(63 - m)) * 0.08838834764831845f;
        const int pos = c * 64 + m;
#pragma unroll
        for (int i = 0; i < 8; ++i) {
            const unsigned wl = klo[i >> 1], wh = khi[i >> 1];
            const float lo = (i & 1) ? bf_hi(wl) : bf_lo(wl), hi = (i & 1) ? bf_hi(wh) : bf_lo(wh);
            float cs, sn; rope_cs(pos, 8 * o + i, cs, sn);
            const unsigned pk = cvt_pk_bf16((lo * cs - hi * sn) * ksc, (lo * sn + hi * cs) * ksc);
            KT[(8 * o + i) * 72 + m] = (bf16_t)(pk & 0xffffu); KT[(64 + 8 * o + i) * 72 + m] = (bf16_t)(pk >> 16);
            const unsigned vl = vlo[i >> 1], vh = vhi[i >> 1];
            VT[(8 * o + i) * 72 + m] = (bf16_t)((i & 1) ? (vl >> 16) : (vl & 0xffffu)); VT[(64 + 8 * o + i) * 72 + m] = (bf16_t)((i & 1) ? (vh >> 16) : (vh & 0xffffu));
        }
    }
    __syncthreads();
    {
        const int w = F.wave, fr = F.lane & 15, fq = F.lane >> 4;
        bf16x8 vf[2];
#pragma unroll
        for (int ks = 0; ks < 2; ++ks) vf[ks] = *(const LAS bf16x8*)(VT + (16 * w + fr) * 72 + 32 * ks + 8 * fq);
        bf16_t* urow = F.U + ((size_t)unit * 128 + 16 * w + fr) * 128 + 4 * fq;
#pragma unroll
        for (int dt = 0; dt < 8; ++dt) {
            f32x4 acc = (f32x4){0.f, 0.f, 0.f, 0.f};
#pragma unroll
            for (int ks = 0; ks < 2; ++ks) { const bf16x8 kf = *(const LAS bf16x8*)(KT + (16 * dt + fr) * 72 + 32 * ks + 8 * fq); acc = mfma16(kf, vf[ks], acc); }
            u32x2 pk; pk.x = cvt_pk_bf16(acc[0], acc[1]); pk.y = cvt_pk_bf16(acc[2], acc[3]);
            *(u32x2*)(urow + 16 * dt) = pk;
        }
    }
    __syncthreads();
}

__device__ __forceinline__ void pool_unit(Frame& F, int unit) {
    const int g = unit & 3, tile = unit >> 2, st = (tile & 63) * 64;
    const int tok0 = tile * 64, win = 2 << g;
    LAS float* P = (LAS float*)(F.lds);
    LAS bf16_t* A = (LAS bf16_t*)(F.lds + 79 * 132 * 4);
    const int t = F.tid;
    for (int idx = t; idx < 79 * 16; idx += 512) {
        const int r = idx >> 4, ch = idx & 15, s = st - 15 + r;
        f32x4 a = (f32x4){0.f, 0.f, 0.f, 0.f}, b2 = a;
        if (s >= 0) { const u32x4 w = *(const u32x4*)(F.Z + (size_t)(tok0 - 15 + r) * DIN + 2048 + g * 128 + 8 * ch);
            a = (f32x4){bf_lo(w.x), bf_hi(w.x), bf_lo(w.y), bf_hi(w.y)}; b2 = (f32x4){bf_lo(w.z), bf_hi(w.z), bf_lo(w.w), bf_hi(w.w)}; }
        *(LAS f32x4*)(P + r * 132 + 8 * ch) = a; *(LAS f32x4*)(P + r * 132 + 8 * ch + 4) = b2;
    }
    __syncthreads();
    {
        const int n = t >> 3, c0 = (t & 7) * 16, s = st + n;
        const float rc = 1.0f / (float)((s + 1 < win) ? (s + 1) : win);
#pragma unroll
        for (int q = 0; q < 4; ++q) {
            f32x4 sum = (f32x4){0.f, 0.f, 0.f, 0.f};
            for (int j = 0; j < win; ++j) sum += *(const LAS f32x4*)(P + (15 + n - j) * 132 + c0 + 4 * q);
            const f32x4 self = *(const LAS f32x4*)(P + (15 + n) * 132 + c0 + 4 * q);
            const f32x4 pv = sum * rc - self;
            u32x2 pk; pk.x = cvt_pk_bf16(pv[0], pv[1]); pk.y = cvt_pk_bf16(pv[2], pv[3]);
            *(LAS u32x2*)(A + n * 136 + c0 + 4 * q) = pk;
        }
    }
    __syncthreads();
    {
        const int w = F.wave, rt = w & 3, chf = w >> 2, fr = F.lane & 15, fq = F.lane >> 4;
        bf16x8 af[4];
#pragma unroll
        for (int ks = 0; ks < 4; ++ks) af[ks] = *(const LAS bf16x8*)(A + (16 * rt + fr) * 136 + 32 * ks + 8 * fq);
        const bf16_t* wp = F.Wpool_t + g * 16384;
        bf16_t* orow = F.CAT + (size_t)(tok0 + 16 * rt + fr) * D + 512 + g * 128;
#pragma unroll
        for (int dd = 0; dd < 4; ++dd) { const int dt = 4 * chf + dd;
            f32x4 acc = (f32x4){0.f, 0.f, 0.f, 0.f};
#pragma unroll
            for (int ks = 0; ks < 4; ++ks) { const bf16x8 wf = *(const bf16x8*)(wp + (16 * dt + fr) * 128 + 32 * ks + 8 * fq); acc = mfma16(wf, af[ks], acc); }
            const f32x4 sc = *(const f32x4*)(F.pool_scale + g * 128 + 16 * dt + 4 * fq);
            u32x2 pk; pk.x = cvt_pk_bf16(acc[0] * sc[0], acc[1] * sc[1]); pk.y = cvt_pk_bf16(acc[2] * sc[2], acc[3] * sc[3]);
            *(u32x2*)(orow + 16 * dt + 4 * fq) = pk;
        }
    }
    __syncthreads();
}

__device__ __forceinline__ void retB_unit(Frame& F, int unit) {
    const int c = unit & 63, bh = unit >> 6, h = bh & 3, b = bh >> 2;
    const int tok0 = b * SEQ + c * 64;
    LAS bf16_t* Q = (LAS bf16_t*)(F.lds);
    LAS bf16_t* Kr = Q + 64 * 136;
    LAS bf16_t* VT = Kr + 64 * 136;
    LAS bf16_t* Sm = VT + 128 * 72;
    LAS float* red = (LAS float*)(Sm + 64 * 72);
    const int t = F.tid;
    const float lg = F.lg2(h);
    {
        const int m = t >> 3, o = t & 7;
        const bf16_t* zrow = F.Z + (size_t)(tok0 + m) * DIN + h * 128 + 8 * o;
        const u32x4 qlo = *(const u32x4*)(zrow), qhi = *(const u32x4*)(zrow + 64);
        const u32x4 klo = *(const u32x4*)(zrow + 512), khi = *(const u32x4*)(zrow + 512 + 64);
        const u32x4 vlo = *(const u32x4*)(zrow + 1024), vhi = *(const u32x4*)(zrow + 1024 + 64);
        const int pos = c * 64 + m;
        unsigned ql[4], qh[4], kl[4], kh[4];
#pragma unroll
        for (int i = 0; i < 8; i += 2) {
            float cs0, sn0, cs1, sn1; rope_cs(pos, 8 * o + i, cs0, sn0); rope_cs(pos, 8 * o + i + 1, cs1, sn1);
            { const float l0 = bf_lo(qlo[i >> 1]), l1 = bf_hi(qlo[i >> 1]), h0 = bf_lo(qhi[i >> 1]), h1 = bf_hi(qhi[i >> 1]);
              ql[i >> 1] = cvt_pk_bf16(l0 * cs0 - h0 * sn0, l1 * cs1 - h1 * sn1); qh[i >> 1] = cvt_pk_bf16(l0 * sn0 + h0 * cs0, l1 * sn1 + h1 * cs1); }
            { const float l0 = bf_lo(klo[i >> 1]), l1 = bf_hi(klo[i >> 1]), h0 = bf_lo(khi[i >> 1]), h1 = bf_hi(khi[i >> 1]); const float sc = 0.08838834764831845f;
              kl[i >> 1] = cvt_pk_bf16((l0 * cs0 - h0 * sn0) * sc, (l1 * cs1 - h1 * sn1) * sc); kh[i >> 1] = cvt_pk_bf16((l0 * sn0 + h0 * cs0) * sc, (l1 * sn1 + h1 * cs1) * sc); }
        }
        *(LAS u32x4*)(Q + m * 136 + 8 * o) = (u32x4){ql[0], ql[1], ql[2], ql[3]}; *(LAS u32x4*)(Q + m * 136 + 64 + 8 * o) = (u32x4){qh[0], qh[1], qh[2], qh[3]};
        *(LAS u32x4*)(Kr + m * 136 + 8 * o) = (u32x4){kl[0], kl[1], kl[2], kl[3]}; *(LAS u32x4*)(Kr + m * 136 + 64 + 8 * o) = (u32x4){kh[0], kh[1], kh[2], kh[3]};
#pragma unroll
        for (int i = 0; i < 8; ++i) { const unsigned vl = vlo[i >> 1], vh = vhi[i >> 1];
            VT[(8 * o + i) * 72 + m] = (bf16_t)((i & 1) ? (vl >> 16) : (vl & 0xffffu)); VT[(64 + 8 * o + i) * 72 + m] = (bf16_t)((i & 1) ? (vh >> 16) : (vh & 0xffffu)); }
    }
    __syncthreads();
    const int w = F.wave, fr = F.lane & 15, fq = F.lane >> 4;
    {
        const int ntl = w >> 1;
        bf16x8 qf[4];
#pragma unroll
        for (int ks = 0; ks < 4; ++ks) qf[ks] = *(const LAS bf16x8*)(Q + (16 * ntl + fr) * 136 + 32 * ks + 8 * fq);
#pragma unroll
        for (int mm = 0; mm < 2; ++mm) { const int mt = 2 * (w & 1) + mm;
            f32x4 acc = (f32x4){0.f, 0.f, 0.f, 0.f};
#pragma unroll
            for (int ks = 0; ks < 4; ++ks) { const bf16x8 kf = *(const LAS bf16x8*)(Kr + (16 * mt + fr) * 136 + 32 * ks + 8 * fq); acc = mfma16(kf, qf[ks], acc); }
            const int n = 16 * ntl + fr, m0 = 16 * mt + 4 * fq;
            float sv[4];
#pragma unroll
            for (int j = 0; j < 4; ++j) { const int dd = n - (m0 + j); sv[j] = acc[j] * __builtin_amdgcn_exp2f(lg * (float)(dd < 0 ? -dd : dd)); }
            u32x2 pk; pk.x = cvt_pk_bf16(sv[0], sv[1]); pk.y = cvt_pk_bf16(sv[2], sv[3]);
            *(LAS u32x2*)(Sm + n * 72 + m0) = pk;
        }
    }
    __syncthreads();
    {
        const int rt = w & 3, chf = w >> 2, n = 16 * rt + fr;
        bf16x8 sf[2], qf[4];
#pragma unroll
        for (int ks = 0; ks < 2; ++ks) sf[ks] = *(const LAS bf16x8*)(Sm + n * 72 + 32 * ks + 8 * fq);
#pragma unroll
        for (int ks = 0; ks < 4; ++ks) qf[ks] = *(const LAS bf16x8*)(Q + n * 136 + 32 * ks + 8 * fq);
        const float qd = __builtin_amdgcn_exp2f(lg * (float)(n + 1));
        f32x4 ov[4]; float ss = 0.f;
#pragma unroll
        for (int dd = 0; dd < 4; ++dd) { const int vt = 4 * chf + dd;
            f32x4 ai = (f32x4){0.f, 0.f, 0.f, 0.f}, ac = ai;
#pragma unroll
            for (int ks = 0; ks < 2; ++ks) { const bf16x8 vf = *(const LAS bf16x8*)(VT + (16 * vt + fr) * 72 + 32 * ks + 8 * fq); ai = mfma16(vf, sf[ks], ai); }
            const bf16_t* rrow = F.U + ((size_t)unit * 128 + 16 * vt + fr) * 128 + 8 * fq;
#pragma unroll
            for (int ks = 0; ks < 4; ++ks) { const bf16x8 rf = *(const bf16x8*)(rrow + 32 * ks); ac = mfma16(rf, qf[ks], ac); }
            ov[dd] = ai + ac * qd;
            ss += (ov[dd][0] * ov[dd][0] + ov[dd][1] * ov[dd][1]) + (ov[dd][2] * ov[dd][2] + ov[dd][3] * ov[dd][3]);
        }
        ss += __shfl_xor(ss, 16); ss += __shfl_xor(ss, 32);
        if (fq == 0) red[chf * 64 + n] = ss;
        __syncthreads();
        const float rstd = 1.f / sqrtf((red[n] + red[64 + n]) * (1.f / 128.f) + EPS);
        const size_t tok = (size_t)(tok0 + n);
#pragma unroll
        for (int dd = 0; dd < 4; ++dd) { const int v0 = 16 * (4 * chf + dd) + 4 * fq;
            const u32x2 gw2 = *(const u32x2*)(F.Z + tok * DIN + 1536 + h * 128 + v0);
            const f32x4 rw = *(const f32x4*)(F.ret_norm_w + h * 128 + v0);
            const float gv[4] = {bf_lo(gw2.x), bf_hi(gw2.x), bf_lo(gw2.y), bf_hi(gw2.y)};
            float r[4];
#pragma unroll
            for (int j = 0; j < 4; ++j) { const float sg = gv[j] * __builtin_amdgcn_rcpf(1.0f + __builtin_amdgcn_exp2f(-1.4426950408889634f * gv[j])); r[j] = ov[dd][j] * rstd * rw[j] * sg; }
            u32x2 pk; pk.x = cvt_pk_bf16(r[0], r[1]); pk.y = cvt_pk_bf16(r[2], r[3]);
            *(u32x2*)(F.CAT + tok * D + h * 128 + v0) = pk;
        }
    }
    __syncthreads();
}

struct Args { const float* in[15]; float* out; unsigned char* ws; float lg2g[4]; int ph_lo, ph_hi, li, pad; };

__global__ void __launch_bounds__(NWAVES * 64, 2) fwd_kernel(Args args) {
    extern __shared__ __attribute__((aligned(16))) unsigned char lds[];
    Frame F;
    F.lds = (LAS unsigned char*)lds;
    F.MISC = (volatile LAS unsigned*)(F.lds + MISC_OFF);
    F.tid = threadIdx.x; F.lane = F.tid & 63; F.wave = __builtin_amdgcn_readfirstlane(F.tid >> 6);
    F.G = gridDim.x; { const int bx = blockIdx.x; F.vcu = (F.G % 8 == 0) ? (bx % 8) * (F.G / 8) + bx / 8 : bx; }
#define REFRESH() do { const __attribute__((address_space(4))) Args* A_ = (const __attribute__((address_space(4))) Args*)__builtin_amdgcn_kernarg_segment_ptr(); asm volatile("" : "+s"(A_)); \
    unsigned char* ws_ = A_->ws; F.ctl = (gu32*)(ws_ + WS_CTL); \
    F.x = A_->in[0]; F.norm_mix_w = A_->in[1]; F.w_in = A_->in[2]; F.ret_norm_w = A_->in[3]; F.w_pool = A_->in[4]; F.pool_scale = A_->in[5]; F.w_out = A_->in[6]; F.norm_ffn_w = A_->in[7]; \
    F.w_router = A_->in[8]; F.b_router = A_->in[9]; F.w_gu = A_->in[10]; F.b_gu = A_->in[11]; F.w_down = A_->in[12]; F.b_down = A_->in[13]; F.norm_final_w = A_->in[14]; F.out = A_->out; \
    F.Wr_hi = (bf16_t*)(ws_ + WS_WR); F.Wr_lo = F.Wr_hi + 32 * 1024; F.Wpool_t = (bf16_t*)(ws_ + WS_WPOOL); F.Win_t = (bf16_t*)(ws_ + WS_WIN); F.Wout_t = (bf16_t*)(ws_ + WS_WOUT); \
    F.XN = (bf16_t*)(ws_ + WS_XN); F.CAT = (bf16_t*)(ws_ + WS_CAT); F.U = (bf16_t*)(ws_ + WS_U); F.Z = (bf16_t*)(ws_ + WS_Z); F.Y = (bf16_t*)(ws_ + WS_Y); \
    F.Wgu8 = ws_ + WS_WGU; F.Wd8 = ws_ + WS_WD; F.ACT8 = ws_ + WS_ACT; F.H8 = ws_ + WS_XN; F.list = (i32x2*)(ws_ + WS_LIST); F.ssq = (float*)(ws_ + WS_SSQ); \
    F.lg2g0 = A_->lg2g[0]; F.lg2g1 = A_->lg2g[1]; F.lg2g2 = A_->lg2g[2]; F.lg2g3 = A_->lg2g[3]; \
    { int t_ = threadIdx.x; asm volatile("" : "+v"(t_)); F.tid = t_; F.lane = t_ & 63; } } while (0)
    REFRESH();
    for (int u = F.tid; u < (LDS_BYTES - LDSCTL_OFF) / 4; u += NWAVES * 64) ((LAS unsigned*)(F.lds + LDSCTL_OFF))[u] = 0u;
    __syncthreads();
    XcdBarrier bar; bar.bar = (unsigned*)(F.ctl + CW_BAR); bar.x = 0; bar.st = nullptr;
    if (N_LAUNCHES != PER_PHASE) bar = xcd_barrier_post((unsigned*)(F.ctl + CW_BAR), F.MISC + 8);
    int n_stamp = 0;
#define STAMP() do { if (DBG_SPIN_A >= 0) { if (F.tid == 0) { const unsigned long long _t = __builtin_amdgcn_s_memrealtime(); F.MISC[16 + 2 * n_stamp] = (unsigned)_t; F.MISC[17 + 2 * n_stamp] = (unsigned)(_t >> 32); } ++n_stamp; } } while (0)
    STAMP();
#define GRID_BAR() do { if (N_LAUNCHES != PER_PHASE) xcd_barrier(bar); STAMP(); } while (0)
    const int lo = DBG_ONLY9 ? (args.ph_lo < 9 ? 9 : args.ph_lo) : args.ph_lo, hi = args.ph_hi;
#define IN(k) (lo <= (k) && (k) < hi)
#define BOTH(k) (IN(k) && IN((k) + 1))
    const int gw = F.vcu * NWAVES + F.wave, NGW = F.G * NWAVES;

    if (IN(0)) { REFRESH(); p0_prologue(F); if (BOTH(0)) GRID_BAR(); }

    if (IN(1)) {
        REFRESH();
        pg8::DenseSched S; S.init(F.XN, F.Win_t, NTOK, DIN, F.G, (int)blockIdx.x);
        pg8::EpiBf16 E{F.Z, DIN};
        pg8::gemm_phase<pg8::EpiBf16, pg8::DenseSched, true>(F.lds, S, E);
        if (BOTH(1)) GRID_BAR();
    }

    if (IN(2)) {
        REFRESH();
        for (int u = F.vcu; u < 1024; u += F.G) retA_unit(F, u);
        for (int u = F.vcu; u < 1024; u += F.G) pool_unit(F, u);
        if (BOTH(2)) GRID_BAR();
    }

    if (IN(3) && DBG_STAGE != 4) {
        REFRESH();
        const int gt = F.vcu * 512 + F.tid, NGT = F.G * 512;
        for (int p = gt; p < 16 * 8192; p += NGT) {
            const int bh = p >> 13, i = p & 8191;
            const float cd = __builtin_amdgcn_exp2f(F.lg2(bh & 3) * 64.0f);
            unsigned* up = (unsigned*)(F.U + (size_t)bh * 64 * 16384) + i;
            float s0 = 0.f, s1 = 0.f;
#pragma unroll
            for (int cb = 0; cb < 64; cb += 32) {
                unsigned uw[32];
#pragma unroll
                for (int c = 0; c < 32; ++c) uw[c] = up[(size_t)(cb + c) * 8192];
#pragma unroll
                for (int c = 0; c < 32; ++c) { up[(size_t)(cb + c) * 8192] = cvt_pk_bf16(s0, s1); s0 = cd * s0 + bf_lo(uw[c]); s1 = cd * s1 + bf_hi(uw[c]); }
            }
        }
        if (BOTH(3)) GRID_BAR();
    }

    if (IN(4) && DBG_STAGE != 4) {
        REFRESH();
        for (int u = F.vcu; u < 1024; u += F.G) retB_unit(F, u);
        if (BOTH(4)) GRID_BAR();
    }

    if (IN(5) && !DBG_STAGE) {
        REFRESH();
        pg8::DenseSched S; S.init(F.CAT, F.Wout_t, NTOK, D, F.G, (int)blockIdx.x);
        pg8::EpiResF32 E{F.x, F.out, D, F.ssq};
        pg8::gemm_phase<pg8::EpiResF32, pg8::DenseSched, false>(F.lds, S, E);
        if (BOTH(5)) GRID_BAR();
    }

    if (IN(6) && !DBG_SKIP_Y) {
        REFRESH();
        LAS float* lgs = (LAS float*)(F.lds + F.wave * 4096);
        LAS f32x4* part = (LAS f32x4*)(F.lds + 32768);
        if (gw == 0) { GAS u32x4* z = (GAS u32x4*)(F.H8 + (size_t)NTOK * D) + F.lane; z[0] = (u32x4){0u, 0u, 0u, 0u}; }
        const int fr = F.lane & 15, fq = F.lane >> 4, gsel = F.wave & 3, kh = F.wave >> 2;
        LAS unsigned* lcnt = (LAS unsigned*)(F.lds + 32768 + 8192);
        LAS unsigned* lbase = lcnt + 32;
        if (F.tid < 32) lcnt[F.tid] = 0u;
        __syncthreads();
        for (int g0 = F.vcu * 4; g0 < NTOK / 16; g0 += F.G * 4) {
            const int grp = g0 + gsel, row = grp * 16 + fr;
            int ei[4] = {0, 0, 0, 0}, lp[4] = {0, 0, 0, 0}, rr = 0; float gi[4] = {0.f, 0.f, 0.f, 0.f};
            float ss = 0.f;
#pragma unroll
            for (int p = 0; p < 16; ++p) ss += F.ssq[(size_t)p * NTOK + row];
            const float rstd = 1.f / sqrtf(ss * (1.f / D) + EPS);
            const float* xr = F.out + (size_t)row * D + 512 * kh + 8 * fq;
            const float* wn = F.norm_ffn_w + 512 * kh + 8 * fq;
            unsigned char* hrow = F.H8 + (size_t)row * D + 512 * kh + 8 * fq;
            const bf16_t* wrh = F.Wr_hi + fr * 1024 + 512 * kh + 8 * fq; const bf16_t* wrl = F.Wr_lo + fr * 1024 + 512 * kh + 8 * fq;
            f32x4 acc[2] = {(f32x4){0.f, 0.f, 0.f, 0.f}, (f32x4){0.f, 0.f, 0.f, 0.f}};
#pragma unroll 4
            for (int ks = 0; ks < 16; ++ks) {
                const f32x4 a = *(const f32x4*)(xr + 32 * ks), b2 = *(const f32x4*)(xr + 32 * ks + 4);
                const f32x4 wa = *(const f32x4*)(wn + 32 * ks), wb = *(const f32x4*)(wn + 32 * ks + 4);
                float hv[8];
#pragma unroll
                for (int j = 0; j < 4; ++j) { hv[j] = a[j] * rstd * wa[j]; hv[4 + j] = b2[j] * rstd * wb[j]; }
                u32x4 hh, hl;
#pragma unroll
                for (int j = 0; j < 4; ++j) { const unsigned p = cvt_pk_bf16(hv[2 * j], hv[2 * j + 1]); hh[j] = p; hl[j] = cvt_pk_bf16(hv[2 * j] - bf_lo(p), hv[2 * j + 1] - bf_hi(p)); }
                { u32x2 h8; h8.x = cvt4_fp8(hv[0], hv[1], hv[2], hv[3]); h8.y = cvt4_fp8(hv[4], hv[5], hv[6], hv[7]); *(u32x2*)(hrow + 32 * ks) = h8; }
                const bf16x8 bhh = __builtin_bit_cast(bf16x8, hh), bhl = __builtin_bit_cast(bf16x8, hl);
#pragma unroll
                for (int et = 0; et < 2; ++et) {
                    const bf16x8 wh = *(const bf16x8*)(wrh + et * 16384 + 32 * ks), wl = *(const bf16x8*)(wrl + et * 16384 + 32 * ks);
                    acc[et] = mfma16(wh, bhh, acc[et]); acc[et] = mfma16(wh, bhl, acc[et]); acc[et] = mfma16(wl, bhh, acc[et]);
                }
            }
            if (kh == 1) { part[(gsel * 2 + 0) * 64 + F.lane] = acc[0]; part[(gsel * 2 + 1) * 64 + F.lane] = acc[1]; }
            __syncthreads();
            if (kh == 0) {
                acc[0] += part[(gsel * 2 + 0) * 64 + F.lane]; acc[1] += part[(gsel * 2 + 1) * 64 + F.lane];
#pragma unroll
                for (int et = 0; et < 2; ++et)
#pragma unroll
                    for (int j = 0; j < 4; ++j) lgs[fr * 33 + 16 * et + 4 * fq + j] = acc[et][j];
                LDS_WAIT(); __builtin_amdgcn_wave_barrier();
                if (F.lane < 16) {
                    const int r = grp * 16 + F.lane;
                    float v0 = -3.0e38f, v1 = -3.0e38f, v2 = -3.0e38f, v3 = -3.0e38f; int i0 = 0, i1 = 0, i2 = 0, i3 = 0;
                    for (int e = 0; e < 32; ++e) {
                        const float v = lgs[F.lane * 33 + e] + F.b_router[e];
                        if (v > v3) {
                            if (v > v0) { v3 = v2; i3 = i2; v2 = v1; i2 = i1; v1 = v0; i1 = i0; v0 = v; i0 = e; }
                            else if (v > v1) { v3 = v2; i3 = i2; v2 = v1; i2 = i1; v1 = v; i1 = e; }
                            else if (v > v2) { v3 = v2; i3 = i2; v2 = v; i2 = e; }
                            else { v3 = v; i3 = e; }
                        }
                    }
                    const float e1 = __expf(v1 - v0), e2 = __expf(v2 - v0), e3 = __expf(v3 - v0), inv = 1.0f / (1.0f + e1 + e2 + e3);
                    const float g4[4] = {inv, e1 * inv, e2 * inv, e3 * inv}; const int i4[4] = {i0, i1, i2, i3};
#pragma unroll
                    for (int k = 0; k < 4; ++k) { ei[k] = i4[k]; gi[k] = g4[k]; lp[k] = (int)__hip_atomic_fetch_add(lcnt + i4[k], 1u, __ATOMIC_RELAXED, __HIP_MEMORY_SCOPE_WORKGROUP); }
                    rr = r;
                }
            }
            __syncthreads();
            if (F.tid < 32) { const unsigned n = lcnt[F.tid]; lbase[F.tid] = n ? atomicAdd((unsigned*)(F.ctl + CW_CNT + 64 * F.tid), n) : 0u; }
            __syncthreads();
            if (kh == 0 && F.lane < 16) {
#pragma unroll
                for (int k = 0; k < 4; ++k) F.list[ei[k] * LISTCAP + (int)lbase[ei[k]] + lp[k]] = (i32x2){rr * 4 + k, __float_as_int(gi[k])};
            }
            __syncthreads();
            if (F.tid < 32) lcnt[F.tid] = 0u;
            __syncthreads();
        }
        if (BOTH(6)) GRID_BAR();
    }

    if ((IN(7) || IN(8)) && !DBG_SKIP_Y) {
        REFRESH();
        LAS int* tab = (LAS int*)(F.lds + TAB_OFF);
        if (F.tid < 32) tab[F.tid] = (int)__hip_atomic_load(F.ctl + CW_CNT + 64 * F.tid, RLX_AGENT);
        __syncthreads();
        if (F.tid == 0) { int s = 0; for (int e = 0; e < 32; ++e) { tab[32 + e] = s; s += (tab[e] + 255) >> 8; } tab[64] = s; }
        __syncthreads();
    }
    if (IN(7) && !DBG_SKIP_Y) {
        REFRESH();
        pg8::MoeSched<true> S; S.init((const bf16_t*)F.H8, (const bf16_t*)F.Wgu8, F.list, (const LAS int*)(F.lds + TAB_OFF), F.G, (int)blockIdx.x);
        pg8::EpiGU E{F.ACT8, F.b_gu};
        pg8::gemm_phase<pg8::EpiGU, pg8::MoeSched<true>, true, true>(F.lds, S, E);
        if (BOTH(7)) GRID_BAR();
    }
    if (IN(8) && !DBG_SKIP_Y) {
        REFRESH();
        pg8::MoeSched<false> S; S.init((const bf16_t*)F.ACT8, (const bf16_t*)F.Wd8, F.list, (const LAS int*)(F.lds + TAB_OFF), F.G, (int)blockIdx.x);
        pg8::EpiDown E{F.Y, F.b_down};
        pg8::gemm_phase<pg8::EpiDown, pg8::MoeSched<false>, true, true>(F.lds, S, E);
        if (BOTH(8)) GRID_BAR();
    }
    if (IN(9) && DBG_STAGE) {
        REFRESH();
        for (int m = gw; m < NTOK; m += NGW) {
            const bf16_t* src = DBG_STAGE == 1 ? F.XN + (size_t)m * D : DBG_STAGE == 2 ? F.Z + (size_t)m * DIN + 1024 : DBG_STAGE == 3 ? F.CAT + (size_t)m * D : F.U + (size_t)m * D;
            for (int j = F.lane; j < D; j += 64) F.out[(size_t)m * D + j] = __uint_as_float(((unsigned)src[j]) << 16);
        }
    }
    if (IN(9) && !DBG_STAGE) {
        REFRESH();
        for (int m = gw; m < NTOK; m += NGW) {
            const GAS f32x4* xr = (const GAS f32x4*)((DBG_ONLY9 ? F.x : F.out) + (size_t)m * D) + F.lane; const GAS f32x4* wr = (const GAS f32x4*)F.norm_final_w + F.lane;
            f32x4 v[4]; float s = 0.f;
#pragma unroll
            for (int j = 0; j < 4; ++j) v[j] = xr[64 * j];
#pragma unroll
            for (int k = 0; k < (DBG_SKIP_Y ? 0 : 4); ++k) { const GAS u32x2* yr = (const GAS u32x2*)(F.Y + ((size_t)m * 4 + k) * D) + F.lane;
#pragma unroll
                for (int j = 0; j < 4; ++j) { const u32x2 y = __builtin_nontemporal_load(yr + 64 * j); v[j] += (f32x4){bf_lo(y.x), bf_hi(y.x), bf_lo(y.y), bf_hi(y.y)}; } }
#pragma unroll
            for (int j = 0; j < 4; ++j) s += (v[j].x * v[j].x + v[j].y * v[j].y) + (v[j].z * v[j].z + v[j].w * v[j].w);
            const float rstd = 1.f / sqrtf(wave_sum(s) * (1.f / D) + EPS);
            GAS f32x4* orow = (GAS f32x4*)(F.out + (size_t)m * D) + F.lane;
#pragma unroll
            for (int j = 0; j < 4; ++j) __builtin_nontemporal_store(v[j] * rstd * wr[64 * j], orow + 64 * j);
        }
    }
    if (DBG_SPIN_A >= 0) { STAMP();
        if (blockIdx.x == 0 && F.tid == 0) {
            const unsigned long long ta = ((unsigned long long)F.MISC[17 + 2 * DBG_SPIN_A] << 32) | F.MISC[16 + 2 * DBG_SPIN_A], tb = ((unsigned long long)F.MISC[17 + 2 * DBG_SPIN_B] << 32) | F.MISC[16 + 2 * DBG_SPIN_B];
            const unsigned long long t0 = __builtin_amdgcn_s_memrealtime(), want = (tb - ta) * DBG_SPIN_W;
            while (__builtin_amdgcn_s_memrealtime() - t0 < want) __builtin_amdgcn_s_sleep(8);
        } }
#undef IN
#undef BOTH
#undef GRID_BAR
#undef STAMP
#undef REFRESH
}

extern "C" void kernel_launch(void* const* d_in, const int* in_sizes, int n_in, void* d_out, int out_size, void* d_ws, size_t ws_size, hipStream_t stream) {
    static int grid = 0;
    if (grid == 0) {
        if (n_in != 15 || in_sizes[0] != NTOK * D || out_size != NTOK * D || ws_size < WS_END) { fprintf(stderr, "kernel_launch: unexpected shapes / workspace (n_in %d, ws %zu); nothing launched\n", n_in, ws_size); grid = -1; return; }
        int dev = 0, cus = 0, per_cu = 0;
        if (hipGetDevice(&dev) != hipSuccess || hipDeviceGetAttribute(&cus, hipDeviceAttributeMultiprocessorCount, dev) != hipSuccess) { grid = -1; return; }
        if (hipFuncSetAttribute((const void*)fwd_kernel, hipFuncAttributeMaxDynamicSharedMemorySize, LDS_BYTES) != hipSuccess) { fprintf(stderr, "kernel_launch: hipFuncSetAttribute failed\n"); grid = -1; return; }
        if (hipOccupancyMaxActiveBlocksPerMultiprocessor(&per_cu, (const void*)fwd_kernel, NWAVES * 64, LDS_BYTES) != hipSuccess || per_cu < 1)
            fprintf(stderr, "kernel_launch: note: occupancy query reports %d workgroups per CU\n", per_cu);
        (void)hipGetLastError();
        grid = cus;
    }
    if (grid < 0) return;
    if (hipMemsetAsync((char*)d_ws + WS_CTL, 0, CTL_ZERO_BYTES, stream) != hipSuccess) { fprintf(stderr, "kernel_launch: memset failed\n"); return; }
    Args a{};
    for (int i = 0; i < 15; ++i) a.in[i] = (const float*)d_in[i];
    a.out = (float*)d_out; a.ws = (unsigned char*)d_ws;
    for (int h = 0; h < 4; ++h) a.lg2g[h] = (float)(log1p(-exp2(-5.0 - (double)h)) / log(2.0));
    for (int li = 0; li < N_LAUNCHES; ++li) {
        a.ph_lo = (N_LAUNCHES == PER_PHASE) ? li : 0; a.ph_hi = (N_LAUNCHES == PER_PHASE) ? li + 1 : PER_PHASE; a.li = li; a.pad = 0;
        hipLaunchKernelGGL(fwd_kernel, dim3(grid), dim3(NWAVES * 64), LDS_BYTES, stream, a);
        const hipError_t le = hipPeekAtLastError();
        if (le != hipSuccess) { fprintf(stderr, "kernel_launch: launch %d failed: %s\n", li, hipGetErrorName(le)); break; }
    }
}
```

```cpp
#include <hip/hip_runtime.h>
#include <cstdio>
#include <cstdint>
#include <cmath>

#ifndef DBG_ONLY9
#define DBG_ONLY9 0
#define DBG_STAGE 0
#endif
#ifndef DBG_SPIN_A
#define DBG_SPIN_A -1
#define DBG_SPIN_B -1
#define DBG_SPIN_W 2
#endif
#ifndef DBG_SKIP_Y
#define DBG_SKIP_Y 0
#endif
#ifndef MK_N_LAUNCHES
#define MK_N_LAUNCHES 1
#endif
constexpr int PER_PHASE = 10;
constexpr int N_LAUNCHES = MK_N_LAUNCHES;

#define LAS __attribute__((address_space(3)))
#define GAS __attribute__((address_space(1)))
typedef unsigned short bf16_t;
typedef short bf16x8 __attribute__((ext_vector_type(8)));
typedef float f32x4 __attribute__((ext_vector_type(4)));
typedef float f32x2 __attribute__((ext_vector_type(2)));
typedef unsigned u32x4 __attribute__((ext_vector_type(4)));
typedef unsigned u32x2 __attribute__((ext_vector_type(2)));
typedef GAS unsigned gu32;
typedef int i32x2 __attribute__((ext_vector_type(2)));

constexpr int NTOK = 16384, D = 1024, SEQ = 4096, DIN = 2560, NE = 32, FF = 1024, LISTCAP = 16384;
constexpr int NWAVES = 8;
constexpr float EPS = 1e-6f;

constexpr size_t MiB = 1u << 20;
constexpr size_t WS_CTL = 0, CTL_ZERO_BYTES = 1 * MiB;
constexpr size_t WS_LIST = 1 * MiB;
constexpr size_t WS_SSQ = 5 * MiB + 512 * 1024;
constexpr size_t WS_WR = 6 * MiB + 512 * 1024;
constexpr size_t WS_WPOOL = 6 * MiB + 768 * 1024;
constexpr size_t WS_WIN = 7 * MiB;
constexpr size_t WS_WOUT = 12 * MiB;
constexpr size_t WS_XN = 14 * MiB;
constexpr size_t WS_CAT = 47 * MiB;
constexpr size_t WS_U = 79 * MiB;
constexpr size_t WS_Z = 111 * MiB;
constexpr size_t WS_Y = 47 * MiB;
constexpr size_t WS_WGU = 192 * MiB;
constexpr size_t WS_WD = 256 * MiB;
constexpr size_t WS_ACT = 288 * MiB;
constexpr size_t WS_END = 360 * MiB;
static_assert(WS_Y + (size_t)65536 * 1024 * 2 <= WS_WGU && WS_Z + (size_t)16384 * 2560 * 2 <= WS_WGU, "Y overlay / Z");
constexpr int CW_TMO = 0, CW_CODE = 1;
constexpr int CW_CNT = 1024;
constexpr int CW_BAR = 4096;

constexpr int RING_BYTES = 131072;
constexpr int LDSCTL_OFF = RING_BYTES, MISC_OFF = LDSCTL_OFF + 320, TAB_OFF = LDSCTL_OFF + 512;
constexpr int MB_OFF = LDSCTL_OFF + 1024;
constexpr int LDS_BYTES = 147456;

#define RLX_AGENT __ATOMIC_RELAXED, __HIP_MEMORY_SCOPE_AGENT
#define LDS_WAIT() asm volatile("s_waitcnt lgkmcnt(0)" ::: "memory")
#define VM_WAIT() asm volatile("s_waitcnt vmcnt(0)" ::: "memory")
typedef __bf16 bf16x2_t __attribute__((ext_vector_type(2)));
__device__ __forceinline__ unsigned cvt_pk_bf16(float lo, float hi) { const f32x2 v = {lo, hi}; const bf16x2_t b = __builtin_convertvector(v, bf16x2_t); return __builtin_bit_cast(unsigned, b); }
__device__ __forceinline__ unsigned cvt4_fp8(float a, float b, float c, float d) { int r = __builtin_amdgcn_cvt_pk_fp8_f32(a, b, 0, false); r = __builtin_amdgcn_cvt_pk_fp8_f32(c, d, r, true); return (unsigned)r; }
typedef int i32x8 __attribute__((ext_vector_type(8)));
__device__ __forceinline__ float bf_lo(unsigned w) { return __uint_as_float(w << 16); }
__device__ __forceinline__ float bf_hi(unsigned w) { return __uint_as_float(w & 0xffff0000u); }
__device__ __forceinline__ float wave_sum(float v) {
#pragma unroll
    for (int o = 1; o < 64; o <<= 1) v += __shfl_xor(v, o);
    return v;
}
__device__ __forceinline__ f32x4 mfma16(bf16x8 a, bf16x8 b, f32x4 c) { return __builtin_amdgcn_mfma_f32_16x16x32_bf16(a, b, c, 0, 0, 0); }

namespace pg8 {
constexpr int BM = 256, BK = 64, HALF = 128, HTB = HALF * BK * 2, STAGE_BYTES = 8 * HTB, NXCD = 8, WGM = 8, KK = 1024;
__host__ __device__ __forceinline__ int lds_byte(int r, int c) { const int st = (r >> 4) * 2 + (c >> 5), rr = r & 15, cc = c & 31, ob = rr * 64 + cc * 2; return st * 1024 + (ob ^ (((ob >> 9) & 1) << 5)); }
__host__ __device__ __forceinline__ void stage_rc(int b, int& R, int& C) { const int st = b / 1024, sb = b % 1024, swz = sb ^ (((sb >> 9) & 1) << 5); R = (st >> 1) * 16 + swz / 64; C = (st & 1) * 32 + (swz % 64) / 2; }
__host__ __device__ __forceinline__ int perm32(int rho) { const int n = rho >> 4, i = rho & 15; return 8 * (i >> 2) + 4 * n + (i & 3); }

struct Unit { int pm, pn, e, rows, arow; };

__device__ __forceinline__ int xcd_remap(int L, int nwg) { const int q = nwg / NXCD, r = nwg % NXCD, xcd = L % NXCD, off = L / NXCD; return (xcd < r ? xcd * (q + 1) : r * (q + 1) + (xcd - r) * q) + off; }

struct DenseSched {
    const bf16_t* A; const bf16_t* Bt; int nM, nN, nwg, G, c;
    __device__ __forceinline__ void init(const bf16_t* A_, const bf16_t* Bt_, int M, int N, int G_, int c_) { A = A_; Bt = Bt_; nM = M / BM; nN = N / BM; nwg = nM * nN; G = G_; c = c_; }
    __device__ __forceinline__ bool next(int i, Unit& u) const {
        const int L = i * G + c; if (L >= nwg) return false;
        const int wgid = xcd_remap(L, nwg);
        const int nig = WGM * nN, gid = wgid / nig, fm = gid * WGM, gsz = (nM - fm) < WGM ? (nM - fm) : WGM;
        u.pm = fm + ((wgid % nig) % gsz); u.pn = (wgid % nig) / gsz; u.e = 0; u.rows = 256; u.arow = u.pm * 256; return true;
    }
    __device__ __forceinline__ const char* a_base(const Unit& u) const { return (const char*)A + (size_t)u.pm * (2 * HALF * KK * 2); }
    __device__ __forceinline__ const char* b_base(const Unit& u) const { return (const char*)Bt + (size_t)u.pn * (2 * HALF * KK * 2); }
    static constexpr bool MB = false;
    __device__ __forceinline__ void mb_issue(LAS unsigned char*, const Unit&, int, int) const {}
    __device__ __forceinline__ void a_offs(const Unit&, int tid, unsigned (&go)[2][2], const LAS i32x2*) const {
#pragma unroll
        for (int i = 0; i < 2; ++i) { int R, C; stage_rc(tid * 16 + i * 8192, R, C);
#pragma unroll
            for (int h = 0; h < 2; ++h) go[h][i] = (unsigned)((h * HALF + R) * KK + C) * 2u; }
    }
};
constexpr int KU8 = 512;
template <bool GU> struct MoeSched {
    const bf16_t* A; const bf16_t* Bt; const i32x2* list; const float* bias; const LAS int* tab; int nN, nwg, G, c;
    __device__ __forceinline__ void init(const bf16_t* A_, const bf16_t* Bt_, const i32x2* list_, const float* bias_, const LAS int* tab_, int G_, int c_) { A = A_; Bt = Bt_; list = list_; bias = bias_; tab = tab_; nN = GU ? 8 : 4; nwg = __builtin_amdgcn_readfirstlane(tab_[32 + 32]) * nN; G = G_; c = c_; }
    __device__ __forceinline__ bool next(int i, Unit& u) const {
        const int L = i * G + c; if (L >= nwg) return false;
        const int wgid = xcd_remap(L, nwg);
        int ln = (int)(threadIdx.x & 31u); asm volatile("" : "+v"(ln));
        const unsigned long long bal = __ballot(tab[32 + ln] * nN <= wgid);
        const int e = 31 - __builtin_clz((unsigned)(bal & 0xffffffffull));
        const int tb0 = tab[32 + e], T = tab[32 + e + 1] - tb0, local = wgid - tb0 * nN;
        int rows = tab[e] - (local % T) * 256; if (rows > 256) rows = 256;
        u.e = __builtin_amdgcn_readfirstlane(e); u.pm = __builtin_amdgcn_readfirstlane(local % T); u.pn = __builtin_amdgcn_readfirstlane(local / T); u.rows = __builtin_amdgcn_readfirstlane(rows); u.arow = __builtin_amdgcn_readfirstlane((tb0 + local % T) * 256); return true;
    }
    __device__ __forceinline__ const char* a_base(const Unit& u) const { return GU ? (const char*)A : (const char*)A + (size_t)u.arow * (KU8 * 2); }
    __device__ __forceinline__ const char* b_base(const Unit& u) const { return (const char*)Bt + ((size_t)u.e * (GU ? 2048 : 1024) + (size_t)u.pn * 256) * (KU8 * 2); }
    static constexpr bool MB = true;
    __device__ __forceinline__ void mb_issue(LAS unsigned char* mb, const Unit& u, int wid, int lane) const {
        asm volatile("" : "+v"(lane));
        if (wid < 2) __builtin_amdgcn_global_load_lds((const unsigned*)(list + u.e * LISTCAP + u.pm * 256 + wid * 128 + lane * 2), (LAS unsigned*)(mb + wid * 1024), 16, 0, 0);
        else if (wid == 2) {
            const float* bp = GU ? bias + (size_t)u.e * 2048 + u.pn * 128 + (lane >> 5) * 1024 + (lane & 31) * 4 : bias + (size_t)u.e * 1024 + u.pn * 256 + lane * 4;
            __builtin_amdgcn_global_load_lds((const unsigned*)bp, (LAS unsigned*)(mb + 2048), 16, 0, 0); }
    }
    __device__ __forceinline__ void a_offs(const Unit& u, int tid, unsigned (&go)[2][2], const LAS i32x2* mb) const {
#pragma unroll
        for (int i = 0; i < 2; ++i) { int R, C; stage_rc(tid * 16 + i * 8192, R, C);
#pragma unroll
            for (int h = 0; h < 2; ++h) {
                if (GU) { const int r = h * HALF + R; const int raw = mb[r].x; const int tok = r < u.rows ? (raw >> 2) : NTOK; go[h][i] = (unsigned)(tok * KU8 + C) * 2u; }
                else go[h][i] = (unsigned)((h * HALF + R) * KU8 + C) * 2u;
            } }
    }
};

struct EpiBf16 {
    static constexpr bool PERM = true;
    bf16_t* O; int ldc;
    __device__ __forceinline__ void operator()(const f32x4 (&acc)[2][2][4][2], const Unit& u, int wr, int wc, int fr, int fq, const LAS i32x2*) const {
        const int row0 = u.pm * BM + wr * 64 + fr, col0 = u.pn * BM + wc * 32 + 8 * fq;
#pragma unroll
        for (int ai = 0; ai < 2; ++ai)
#pragma unroll
            for (int m = 0; m < 4; ++m) { bf16_t* rowp = O + (size_t)(row0 + ai * HALF + m * 16) * ldc + col0;
#pragma unroll
                for (int bj = 0; bj < 2; ++bj) { const f32x4 v0 = acc[ai][bj][m][0], v1 = acc[ai][bj][m][1];
                    u32x4 w; w.x = cvt_pk_bf16(v0[0], v0[1]); w.y = cvt_pk_bf16(v0[2], v0[3]); w.z = cvt_pk_bf16(v1[0], v1[1]); w.w = cvt_pk_bf16(v1[2], v1[3]);
                    *(u32x4*)(rowp + bj * HALF) = w; } }
    }
};
struct EpiResF32 {
    static constexpr bool PERM = false;
    const float* base; float* C; int ldc; float* ssq;
    __device__ __forceinline__ void operator()(const f32x4 (&acc)[2][2][4][2], const Unit& u, int wr, int wc, int fr, int fq, const LAS i32x2*) const {
        const int row0 = u.pm * BM + wr * 64 + fr, col0 = u.pn * BM + wc * 32 + 4 * fq;
        float* sp = ssq + (size_t)(u.pn * 4 + wc) * NTOK;
#pragma unroll
        for (int ai = 0; ai < 2; ++ai)
#pragma unroll
            for (int m = 0; m < 4; ++m) { const int row = row0 + ai * HALF + m * 16; const size_t off = (size_t)row * ldc + col0; float s2 = 0.f;
#pragma unroll
                for (int bj = 0; bj < 2; ++bj)
#pragma unroll
                    for (int n = 0; n < 2; ++n) { const f32x4 b = *(const f32x4*)(base + off + bj * HALF + n * 16); const f32x4 v = acc[ai][bj][m][n] + b; *(f32x4*)(C + off + bj * HALF + n * 16) = v;
                        s2 += (v[0] * v[0] + v[1] * v[1]) + (v[2] * v[2] + v[3] * v[3]); }
                s2 += __shfl_xor(s2, 16); s2 += __shfl_xor(s2, 32);
                if (fq == 0) sp[row] = s2;
                asm volatile("" ::: "memory"); }
    }
};
constexpr float WSCL = 1.0f / 32.0f;
__device__ __forceinline__ float swiglu(float g, float l) {
    g = fminf(g, 7.0f); l = fminf(fmaxf(l, -7.0f), 7.0f);
    const float s = __builtin_amdgcn_rcpf(1.0f + __builtin_amdgcn_exp2f(-1.702f * 1.4426950408889634f * g));
    return g * s * (l + 1.0f);
}
struct EpiGU {
    static constexpr bool PERM = true;
    unsigned char* ACT;
    __device__ __forceinline__ void operator()(const f32x4 (&acc)[2][2][4][2], const Unit& u, int wr, int wc, int fr, int fq, const LAS i32x2* mb) const {
        const int row0 = u.arow + wr * 64 + fr, cl = wc * 32 + 8 * fq, colg = u.pn * 128 + cl;
        const LAS float* bl = (const LAS float*)mb + 512 + cl;
        const f32x4 bg0 = *(const LAS f32x4*)(bl), bg1 = *(const LAS f32x4*)(bl + 4), bl0 = *(const LAS f32x4*)(bl + 128), bl1 = *(const LAS f32x4*)(bl + 128 + 4);
#pragma unroll
        for (int ai = 0; ai < 2; ++ai)
#pragma unroll
            for (int m = 0; m < 4; ++m) {
                const f32x4 g0 = acc[ai][0][m][0] * WSCL + bg0, g1 = acc[ai][0][m][1] * WSCL + bg1, l0 = acc[ai][1][m][0] * WSCL + bl0, l1 = acc[ai][1][m][1] * WSCL + bl1;
                u32x2 w; w.x = cvt4_fp8(swiglu(g0[0], l0[0]), swiglu(g0[1], l0[1]), swiglu(g0[2], l0[2]), swiglu(g0[3], l0[3]));
                w.y = cvt4_fp8(swiglu(g1[0], l1[0]), swiglu(g1[1], l1[1]), swiglu(g1[2], l1[2]), swiglu(g1[3], l1[3]));
                *(u32x2*)(ACT + (size_t)(row0 + ai * HALF + m * 16) * FF + colg) = w; }
    }
};
struct EpiDown {
    static constexpr bool PERM = true;
    bf16_t* Y;
    __device__ __forceinline__ void operator()(const f32x4 (&acc)[2][2][4][2], const Unit& u, int wr, int wc, int fr, int fq, const LAS i32x2* mb) const {
        const int cl = wc * 32 + 8 * fq, col0 = u.pn * BM + cl;
        const LAS float* bl = (const LAS float*)mb + 512 + cl;
        int rb = wr * 64 + fr; asm volatile("" : "+v"(rb));
#pragma unroll
        for (int bj = 0; bj < 2; ++bj) {
            const f32x4 b0 = *(const LAS f32x4*)(bl + bj * HALF), b1 = *(const LAS f32x4*)(bl + bj * HALF + 4);
#pragma unroll
            for (int ai = 0; ai < 2; ++ai)
#pragma unroll
                for (int m = 0; m < 4; ++m) { const int r = ai * HALF + m * 16 + rb;
                    if (r < u.rows) { const i32x2 sg = mb[r]; const int slot = sg.x; const float gt = __int_as_float(sg.y);
                        const f32x4 v0 = (acc[ai][bj][m][0] * WSCL + b0) * gt, v1 = (acc[ai][bj][m][1] * WSCL + b1) * gt;
                        u32x4 w; w.x = cvt_pk_bf16(v0[0], v0[1]); w.y = cvt_pk_bf16(v0[2], v0[3]); w.z = cvt_pk_bf16(v1[0], v1[1]); w.w = cvt_pk_bf16(v1[2], v1[3]);
                        *(u32x4*)(Y + (size_t)slot * D + col0 + bj * HALF) = w; } }
        }
    }
};

typedef int i32x4 __attribute__((ext_vector_type(4)));
__device__ __forceinline__ bf16x8 lo8(i32x8 a) { return __builtin_bit_cast(bf16x8, __builtin_shufflevector(a, a, 0, 1, 2, 3)); }
__device__ __forceinline__ bf16x8 hi8(i32x8 a) { return __builtin_bit_cast(bf16x8, __builtin_shufflevector(a, a, 4, 5, 6, 7)); }
__device__ __forceinline__ void glds_s(unsigned voff, const char* sbase, unsigned lds_dst) { unsigned keep;
    asm volatile("s_mov_b32 %0, m0\n\ts_mov_b32 m0, %2\n\ts_nop 0\n\tglobal_load_lds_dwordx4 %1, %3\n\ts_mov_b32 m0, %0" : "=&s"(keep) : "v"(voff), "s"(lds_dst), "s"(sbase) : "memory"); }
template <class Epi, class Sched, bool ALIGN_EPI, bool FP8 = false>
__device__ __forceinline__ void gemm_phase(LAS unsigned char* lds, const Sched& S, const Epi& E) {
    const int tid = threadIdx.x, wid = __builtin_amdgcn_readfirstlane(tid >> 6), lane = tid & 63, wr = wid >> 2, wc = wid & 3, fr = lane & 15, fq = lane >> 4;
    constexpr int K = FP8 ? 512 : KK;
    int nt = K / BK; asm volatile("" : "+s"(nt));
    unsigned voffB[2];
#pragma unroll
    for (int i = 0; i < 2; ++i) { int R, C; stage_rc(tid * 16 + i * 8192, R, C); const int Rb = Epi::PERM ? ((R & ~31) + perm32(R & 31)) : R;
        voffB[i] = (unsigned)(Rb * K + C) * 2u; }
    constexpr size_t kstep = (size_t)(BK * 2);
    constexpr size_t hstep = (size_t)HALF * K * 2;
    const unsigned ldsw = (unsigned)wid * 1024u;
    const unsigned ldsb = (unsigned)__builtin_amdgcn_readfirstlane((int)((unsigned)(size_t)lds + ldsw));
    const int aoff = lds_byte(wr * 64 + fr, fq * 8), boff = lds_byte(wc * 32 + fr, fq * 8);
#define PG8_SA(b, h) (((b) * 2 + (h)) * HTB)
#define PG8_SB(b, h) ((4 + (b) * 2 + (h)) * HTB)
#define PG8_STAGE(bufoff, gbase, voff) do { _Pragma("unroll") for (int _i = 0; _i < 2; ++_i) glds_s((voff)[_i], (const char*)(gbase), ldsb + (unsigned)((bufoff) + _i * 8192)); } while (0)
#define PG8_LDA(dst, b, h) do { _Pragma("unroll") for (int m = 0; m < 4; ++m) { const u32x4 _x = *(const LAS u32x4*)(lds + PG8_SA(b, h) + aoff + m * 2048), _y = *(const LAS u32x4*)(lds + PG8_SA(b, h) + aoff + m * 2048 + 1024); \
        dst[m] = (i32x8){(int)_x[0], (int)_x[1], (int)_x[2], (int)_x[3], (int)_y[0], (int)_y[1], (int)_y[2], (int)_y[3]}; } } while (0)
#define PG8_LDB(dst, b, h) do { _Pragma("unroll") for (int n = 0; n < 2; ++n) { const u32x4 _x = *(const LAS u32x4*)(lds + PG8_SB(b, h) + boff + n * 2048), _y = *(const LAS u32x4*)(lds + PG8_SB(b, h) + boff + n * 2048 + 1024); \
        dst[n] = (i32x8){(int)_x[0], (int)_x[1], (int)_x[2], (int)_x[3], (int)_y[0], (int)_y[1], (int)_y[2], (int)_y[3]}; } } while (0)
#define PG8_MMA(ai, bj, At, Bt) do { __builtin_amdgcn_s_setprio(1); _Pragma("unroll") for (int m = 0; m < 4; ++m) _Pragma("unroll") for (int n = 0; n < 2; ++n) { \
        if constexpr (FP8) { acc[ai][bj][m][n] = __builtin_amdgcn_mfma_scale_f32_16x16x128_f8f6f4(Bt[n], At[m], acc[ai][bj][m][n], 0, 0, 0, 0, 0, 0); } \
        else { acc[ai][bj][m][n] = __builtin_amdgcn_mfma_f32_16x16x32_bf16(lo8(Bt[n]), lo8(At[m]), acc[ai][bj][m][n], 0, 0, 0); acc[ai][bj][m][n] = __builtin_amdgcn_mfma_f32_16x16x32_bf16(hi8(Bt[n]), hi8(At[m]), acc[ai][bj][m][n], 0, 0, 0); } } __builtin_amdgcn_s_setprio(0); } while (0)
#define PG8_WAIT_V(n) asm volatile("s_waitcnt vmcnt(" #n ")" ::: "memory")
#define PG8_WAIT_L(n) asm volatile("s_waitcnt lgkmcnt(" #n ")" ::: "memory")
#define PG8_BAR __builtin_amdgcn_s_barrier()
#define PG8_SCHED __builtin_amdgcn_sched_barrier(0)
    Unit cur, nxt; int ui = 0;
    if (!S.next(0, cur)) return;
    f32x4 acc[2][2][4][2];
#pragma unroll
    for (int a = 0; a < 2; ++a)
#pragma unroll
        for (int b = 0; b < 2; ++b)
#pragma unroll
            for (int m = 0; m < 4; ++m)
#pragma unroll
                for (int n = 0; n < 2; ++n) acc[a][b][m][n] = (f32x4){0.f, 0.f, 0.f, 0.f};
    i32x8 At[4], B0[2], B1[2];
    const char* cA = S.a_base(cur); const char* cB = S.b_base(cur);
    unsigned go[2][2];
    LAS unsigned char* const mbx = lds + (MB_OFF - 0);
    if constexpr (Sched::MB) { S.mb_issue(mbx, cur, wid, lane); asm volatile("s_waitcnt vmcnt(0)" ::: "memory"); __builtin_amdgcn_s_barrier(); asm volatile("" ::: "memory"); }
    { int t2 = tid; asm volatile("" : "+v"(t2)); S.a_offs(cur, t2, go, (const LAS i32x2*)mbx); }
    PG8_STAGE(PG8_SB(0, 0), cB, voffB); PG8_STAGE(PG8_SB(0, 1), cB + hstep, voffB); PG8_STAGE(PG8_SA(0, 0), cA, go[0]); PG8_STAGE(PG8_SA(0, 1), cA, go[1]);
    if (wr == 1) PG8_BAR;
    PG8_WAIT_V(2); PG8_BAR;
    PG8_STAGE(PG8_SB(1, 0), cB + kstep, voffB); PG8_STAGE(PG8_SA(1, 0), cA + kstep, go[0]); PG8_STAGE(PG8_SB(1, 1), cB + hstep + kstep, voffB);
    PG8_WAIT_V(6); PG8_BAR;
    asm volatile("" : "+v"(voffB[0]), "+v"(voffB[1]), "+v"(go[0][0]), "+v"(go[0][1]), "+v"(go[1][0]), "+v"(go[1][1]));
    for (;;) {
        const bool has_next = S.next(ui + 1, nxt);
        const char* nA = has_next ? S.a_base(nxt) : cA; const char* nB = has_next ? S.b_base(nxt) : cB;
#pragma clang loop unroll(disable)
        for (int t = 0; t < nt; t += 2) {
            const bool last = (t == nt - 2);
            asm volatile("" : "+v"(voffB[0]), "+v"(voffB[1]));
            const char* a1 = cA + (size_t)(t + 1) * kstep;
            const char* a2 = last ? nA : cA + (size_t)(t + 2) * kstep; const char* b2 = last ? nB : cB + (size_t)(t + 2) * kstep;
            const char* a3 = a2 + kstep; const char* b3 = b2 + kstep;
            PG8_LDB(B0, 0, 0); PG8_LDB(B1, 0, 1); PG8_SCHED; PG8_LDA(At, 0, 0); PG8_STAGE(PG8_SA(1, 1), a1, go[1]);
            if (last && has_next) { int t2 = tid; asm volatile("" : "+v"(t2)); S.a_offs(nxt, t2, go, (const LAS i32x2*)(mbx + ((ui + 1) & 1) * 3072)); }
            PG8_WAIT_V(8); PG8_WAIT_L(0); PG8_BAR; PG8_MMA(0, 0, At, B0); PG8_MMA(0, 1, At, B1); PG8_BAR; PG8_SCHED;
            if constexpr (Sched::MB) { if (t == 0 && has_next) S.mb_issue(mbx + ((ui + 1) & 1) * 3072, nxt, wid, lane); }
            PG8_LDA(At, 0, 1); PG8_STAGE(PG8_SB(0, 0), b2, voffB); PG8_STAGE(PG8_SB(0, 1), b2 + hstep, voffB); PG8_STAGE(PG8_SA(0, 0), a2, go[0]);
            PG8_WAIT_V(8); PG8_WAIT_L(0); PG8_BAR; PG8_MMA(1, 0, At, B0); PG8_MMA(1, 1, At, B1); PG8_BAR; PG8_SCHED;
            PG8_LDB(B0, 1, 0); PG8_LDB(B1, 1, 1); PG8_SCHED; PG8_LDA(At, 1, 0); PG8_STAGE(PG8_SA(0, 1), a2, go[1]);
            PG8_WAIT_V(8); PG8_WAIT_L(0); PG8_BAR; PG8_MMA(0, 0, At, B0); PG8_MMA(0, 1, At, B1); PG8_BAR; PG8_SCHED;
            PG8_LDA(At, 1, 1); PG8_STAGE(PG8_SB(1, 0), b3, voffB); PG8_STAGE(PG8_SB(1, 1), b3 + hstep, voffB); PG8_STAGE(PG8_SA(1, 0), a3, go[0]);
            PG8_WAIT_V(8); PG8_WAIT_L(0); PG8_BAR; PG8_MMA(1, 0, At, B0); PG8_MMA(1, 1, At, B1); PG8_BAR; PG8_SCHED;
        }
        if constexpr (ALIGN_EPI) { if (wr == 0) PG8_BAR; }
        { int t2 = tid; asm volatile("" : "+v"(t2)); const int l2 = t2 & 63; E(acc, cur, wr, wc, l2 & 15, l2 >> 4, (const LAS i32x2*)(mbx + (ui & 1) * 3072)); }
        if (!has_next) break;
#pragma unroll
        for (int a = 0; a < 2; ++a)
#pragma unroll
            for (int b = 0; b < 2; ++b)
#pragma unroll
                for (int m = 0; m < 4; ++m)
#pragma unroll
                    for (int n = 0; n < 2; ++n) acc[a][b][m][n] = (f32x4){0.f, 0.f, 0.f, 0.f};
        cur = nxt; cA = nA; cB = nB; ++ui;
        if constexpr (ALIGN_EPI) { if (wr == 1) PG8_BAR; }
    }
    PG8_WAIT_V(0);
    if constexpr (!ALIGN_EPI) { if (wr == 0) PG8_BAR; }
    PG8_BAR;
#undef PG8_SA
#undef PG8_SB
#undef PG8_STAGE
#undef PG8_LDA
#undef PG8_LDB
#undef PG8_MMA
#undef PG8_WAIT_V
#undef PG8_WAIT_L
#undef PG8_BAR
#undef PG8_SCHED
}
}

#define XB_TMO      128
#define XB_XCNT(j)  (256  + 64 * (j))
#define XB_XSUB(j)  (1280 + 64 * (j))
#define XB_XGEN(j)  (2304 + 64 * (j))
#define XB_TOP      3328
#define XB_TOPGEN   3392
#define XCD_BAR_WORDS 3456
#define XB_SPIN_CAP (1u << 18)
__device__ __forceinline__ unsigned xb_ld(unsigned* p)              { return __hip_atomic_load(p, __ATOMIC_RELAXED, __HIP_MEMORY_SCOPE_AGENT); }
__device__ __forceinline__ unsigned xb_add(unsigned* p, unsigned v) { return __hip_atomic_fetch_add(p, v, __ATOMIC_RELAXED, __HIP_MEMORY_SCOPE_AGENT); }
__device__ __forceinline__ unsigned xb_xcc_id() { return (unsigned)__builtin_amdgcn_s_getreg((3 << 11) | 20) & 0xFu; }
#define XB_SPIN(cond, bar) do { unsigned _sp = 0; while (cond) { __builtin_amdgcn_s_sleep(1); \
    if ((++_sp & 255u) == 0u) { if (xb_ld(&(bar)[XB_TMO])) break; if (_sp > XB_SPIN_CAP) { atomicAdd(&(bar)[XB_TMO], 1u); break; } } } } while (0)
struct XcdBarrier { unsigned* bar; unsigned x; volatile LAS unsigned* st; };
__device__ __forceinline__ XcdBarrier xcd_barrier_post(unsigned* bar, volatile LAS unsigned* st) {
    XcdBarrier b; b.bar = bar; b.x = xb_xcc_id(); b.st = st;
    if (threadIdx.x == 0) (void)xb_add(&bar[XB_XCNT(b.x)], 1u);
    return b;
}
__device__ __forceinline__ void xcd_barrier_complete(unsigned* bar, unsigned x, unsigned& nloc, unsigned& nx) {
    const unsigned G = gridDim.x * gridDim.y * gridDim.z;
    unsigned sum, cnt, mine, sp = 0u;
    for (;;) {
        sum = 0u; cnt = 0u; mine = 0u;
#pragma unroll
        for (unsigned j = 0; j < 16; ++j) { const unsigned c = xb_ld(&bar[XB_XCNT(j)]); sum += c; cnt += (c > 0u) ? 1u : 0u; mine = (j == x) ? c : mine; }
        if (sum == G) break;
        __builtin_amdgcn_s_sleep(1);
        if ((++sp & 255u) == 0u) { if (xb_ld(&bar[XB_TMO])) break; if (sp > XB_SPIN_CAP) { atomicAdd(&bar[XB_TMO], 1u); break; } }
    }
    nloc = mine > 0u ? mine : 1u; nx = cnt > 0u ? cnt : 1u;
}
__device__ __forceinline__ void xcd_barrier(const XcdBarrier& b) {
    asm volatile("s_waitcnt vmcnt(0)" ::: "memory");
    __syncthreads();
    if (threadIdx.x == 0) {
        unsigned* bar = b.bar;
        __builtin_amdgcn_s_waitcnt(0);
        unsigned nloc = b.st[0], nx = b.st[1];
        if (nloc == 0u) { xcd_barrier_complete(bar, b.x, nloc, nx); b.st[0] = nloc; b.st[1] = nx; }
        const unsigned old = xb_add(&bar[XB_XSUB(b.x)], 1u);
        const unsigned gen = old / nloc;
        if (old + 1u == (gen + 1u) * nloc) {
            __builtin_amdgcn_fence(__ATOMIC_RELEASE, "agent");
            asm volatile("s_waitcnt vmcnt(0)" ::: "memory");
            const unsigned og = xb_add(&bar[XB_TOP], 1u);
            const unsigned tg = og / nx;
            if (og + 1u == (tg + 1u) * nx) xb_add(&bar[XB_TOPGEN], 1u);
            else XB_SPIN(xb_ld(&bar[XB_TOPGEN]) == tg, bar);
            __builtin_amdgcn_fence(__ATOMIC_ACQUIRE, "agent");
            xb_add(&bar[XB_XGEN(b.x)], 1u);
            asm volatile("s_waitcnt vmcnt(0)" ::: "memory");
        } else {
            XB_SPIN(xb_ld(&bar[XB_XGEN(b.x)]) == gen, bar);
            __builtin_amdgcn_fence(__ATOMIC_ACQUIRE, "agent");
            asm volatile("s_waitcnt vmcnt(0)" ::: "memory");
        }
    }
    __syncthreads();
}

struct Frame {
    LAS unsigned char* lds;
    volatile LAS unsigned* MISC;
    gu32* ctl;
    int tid, lane, wave, vcu, G;
    const float *x, *norm_mix_w, *w_in, *ret_norm_w, *w_pool, *pool_scale, *w_out, *norm_ffn_w, *w_router, *b_router, *w_gu, *b_gu, *w_down, *b_down, *norm_final_w;
    float* out;
    bf16_t *Wr_hi, *Wr_lo, *Wpool_t, *Win_t, *Wout_t, *XN, *CAT, *U, *Z, *Y;
    unsigned char *Wgu8, *Wd8, *ACT8, *H8;
    i32x2* list; float* ssq;
    float lg2g0, lg2g1, lg2g2, lg2g3;
    __device__ __forceinline__ float lg2(int h) const { return h == 0 ? lg2g0 : (h == 1 ? lg2g1 : (h == 2 ? lg2g2 : lg2g3)); }
};

template <int MODE>
__device__ __forceinline__ void p0_item(const float* W, int ldw, void* WT, void* WT2, int ldo, LAS float* scr, int k0, int n0, int orow0, int lane) {
    f32x4 v[16];
    const float* src = W + (size_t)(k0 + (lane >> 3)) * ldw + n0 + 4 * (lane & 7);
#pragma unroll
    for (int i = 0; i < 16; ++i) v[i] = *(const GAS f32x4*)(src + (size_t)(8 * i) * ldw);
#pragma unroll
    for (int i = 0; i < 16; ++i) *(LAS f32x4*)(scr + (8 * i + (lane >> 3)) * 32 + 4 * ((lane & 7) ^ (i & 7))) = v[i];
    LDS_WAIT(); asm volatile("" ::: "memory");
    const int c = lane & 15, ns = lane >> 4;
#pragma unroll
    for (int J = 0; J < 8; ++J) {
        const LAS float* sp = scr + (8 * c) * 32 + 4 * (J ^ (c & 7)) + ns;
        float x[8];
#pragma unroll
        for (int q = 0; q < 8; ++q) x[q] = sp[q * 32];
        const int n = 4 * J + ns;
        if (MODE == 2) { u32x2 o; o.x = cvt4_fp8(x[0] * 32.f, x[1] * 32.f, x[2] * 32.f, x[3] * 32.f); o.y = cvt4_fp8(x[4] * 32.f, x[5] * 32.f, x[6] * 32.f, x[7] * 32.f);
            *(GAS u32x2*)((unsigned char*)WT + (size_t)(orow0 + n) * 1024 + k0 + 8 * c) = o; }
        else { u32x4 o; o.x = cvt_pk_bf16(x[0], x[1]); o.y = cvt_pk_bf16(x[2], x[3]); o.z = cvt_pk_bf16(x[4], x[5]); o.w = cvt_pk_bf16(x[6], x[7]);
            *(GAS u32x4*)((bf16_t*)WT + (size_t)(orow0 + n) * ldo + k0 + 8 * c) = o;
            if (MODE == 1) { u32x4 o2; o2.x = cvt_pk_bf16(x[0] - bf_lo(o.x), x[1] - bf_hi(o.x)); o2.y = cvt_pk_bf16(x[2] - bf_lo(o.y), x[3] - bf_hi(o.y));
                o2.z = cvt_pk_bf16(x[4] - bf_lo(o.z), x[5] - bf_hi(o.z)); o2.w = cvt_pk_bf16(x[6] - bf_lo(o.w), x[7] - bf_hi(o.w));
                *(GAS u32x4*)((bf16_t*)WT2 + (size_t)(orow0 + n) * ldo + k0 + 8 * c) = o2; } }
    }
    LDS_WAIT(); asm volatile("" ::: "memory");
}
__device__ __forceinline__ void rms_rows4_to_bf16(int lane, const float* x, const float* w, bf16_t* o, int m, int rs) {
    f32x4 v[4][4];
#pragma unroll
    for (int r = 0; r < 4; ++r) { const GAS f32x4* xr = (const GAS f32x4*)(x + (size_t)(m + r * rs) * D) + lane;
#pragma unroll
        for (int j = 0; j < 4; ++j) v[r][j] = __builtin_nontemporal_load(xr + 64 * j); }
    const GAS f32x4* wr = (const GAS f32x4*)w + lane;
    f32x4 ww[4];
#pragma unroll
    for (int j = 0; j < 4; ++j) ww[j] = wr[64 * j];
#pragma unroll
    for (int r = 0; r < 4; ++r) { float s = 0.f;
#pragma unroll
        for (int j = 0; j < 4; ++j) s += (v[r][j].x * v[r][j].x + v[r][j].y * v[r][j].y) + (v[r][j].z * v[r][j].z + v[r][j].w * v[r][j].w);
        const float rstd = 1.f / sqrtf(wave_sum(s) * (1.f / D) + EPS);
        GAS u32x2* o8 = (GAS u32x2*)(o + (size_t)(m + r * rs) * D) + lane;
#pragma unroll
        for (int j = 0; j < 4; ++j) { u32x2 p; p.x = cvt_pk_bf16(v[r][j].x * rstd * ww[j].x, v[r][j].y * rstd * ww[j].y); p.y = cvt_pk_bf16(v[r][j].z * rstd * ww[j].z, v[r][j].w * rstd * ww[j].w); o8[64 * j] = p; } }
}
template <int MODE, class RM>
__device__ __forceinline__ void p0_block_item(const float* W, int ldw, void* WT, int ldo, LAS float* tile, int k0, int n0, int wave, int lane, RM rowmap) {
    f32x4 v[16];
    const float* src = W + (size_t)(k0 + 16 * wave) * ldw + n0 + 4 * lane;
#pragma unroll
    for (int i = 0; i < 16; ++i) v[i] = __builtin_nontemporal_load((const GAS f32x4*)(src + (size_t)i * ldw));
#pragma unroll
    for (int i = 0; i < 16; ++i) { const int kl = 16 * wave + i; *(LAS f32x4*)(tile + kl * 256 + 4 * (lane ^ ((kl >> 3) & 7))) = v[i]; }
    __syncthreads();
    const int c = lane & 15, ns = lane >> 4;
#pragma unroll
    for (int J = 0; J < 8; ++J) {
        const LAS float* sp = tile + (8 * c) * 256 + 4 * ((8 * wave + J) ^ (c & 7)) + ns;
        float x[8];
#pragma unroll
        for (int q = 0; q < 8; ++q) x[q] = sp[q * 256];
        const int orow = rowmap(n0 + 32 * wave + 4 * J + ns);
        if (MODE == 2) { u32x2 o; o.x = cvt4_fp8(x[0] * 32.f, x[1] * 32.f, x[2] * 32.f, x[3] * 32.f); o.y = cvt4_fp8(x[4] * 32.f, x[5] * 32.f, x[6] * 32.f, x[7] * 32.f);
            __builtin_nontemporal_store(o, (GAS u32x2*)((unsigned char*)WT + (size_t)orow * 1024 + k0 + 8 * c)); }
        else { u32x4 o; o.x = cvt_pk_bf16(x[0], x[1]); o.y = cvt_pk_bf16(x[2], x[3]); o.z = cvt_pk_bf16(x[4], x[5]); o.w = cvt_pk_bf16(x[6], x[7]);
            *(GAS u32x4*)((bf16_t*)WT + (size_t)orow * ldo + k0 + 8 * c) = o; }
    }
    __syncthreads();
}
struct RowId { __device__ __forceinline__ int operator()(int n) const { return n; } };
struct RowGU { __device__ __forceinline__ int operator()(int n) const { const int m = n & 1023; return ((m >> 7) << 8) + (n >> 10) * 128 + (m & 127); } };
__device__ __forceinline__ void p0_prologue(Frame& F) {
    LAS float* tile = (LAS float*)F.lds;
    constexpr int B_GU = 32 * 8 * 8, B_D = 32 * 8 * 4, B_IN = 8 * 10, B_OUT = 8 * 4, NB = B_GU + B_D + B_IN + B_OUT;
    for (int it = F.vcu; it < NB; it += F.G) {
        int r = it;
        if (r < B_GU) { const int e = r >> 6, q = r & 63, kb = q >> 3, nb = q & 7; p0_block_item<2>(F.w_gu + (size_t)e * 1024 * 2048, 2048, F.Wgu8 + (size_t)e * 2048 * 1024, 1024, tile, kb * 128, nb * 256, F.wave, F.lane, RowGU()); continue; } r -= B_GU;
        if (r < B_D) { const int e = r >> 5, q = r & 31, kb = q >> 2, nb = q & 3; p0_block_item<2>(F.w_down + (size_t)e * 1024 * 1024, 1024, F.Wd8 + (size_t)e * 1024 * 1024, 1024, tile, kb * 128, nb * 256, F.wave, F.lane, RowId()); continue; } r -= B_D;
        if (r < B_IN) { const int kb = r / 10, nb = r % 10; p0_block_item<0>(F.w_in, DIN, F.Win_t, 1024, tile, kb * 128, nb * 256, F.wave, F.lane, RowId()); continue; } r -= B_IN;
        { const int kb = r >> 2, nb = r & 3; p0_block_item<0>(F.w_out, 1024, F.Wout_t, 1024, tile, kb * 128, nb * 256, F.wave, F.lane, RowId()); }
    }
    LAS float* scr = (LAS float*)(F.lds + F.wave * 16384);
    const int gw = F.vcu * NWAVES + F.wave, NGW = F.G * NWAVES;
    constexpr int I_POOL = 16, I_R = 8;
    for (int it = gw; it < I_POOL + I_R; it += NGW) {
        if (it < I_POOL) { const int g = it / 4, nb = it % 4; p0_item<0>(F.w_pool + g * 16384, 128, F.Wpool_t + g * 16384, nullptr, 128, scr, 0, nb * 32, nb * 32, F.lane); }
        else { const int kb = it - I_POOL; p0_item<1>(F.w_router, 32, F.Wr_hi, F.Wr_lo, 1024, scr, kb * 128, 0, 0, F.lane); }
    }
    for (int m = gw; m < NTOK / 4; m += NGW) rms_rows4_to_bf16(F.lane, F.x, F.norm_mix_w, F.XN, m, NTOK / 4);
}

__device__ __forceinline__ void rope_cs(int pos, int j, float& cs, float& sn) {
    const float inv = __builtin_amdgcn_exp2f((float)j * (-13.287712379549449f / 64.0f));
    const double revd = (double)pos * (double)inv * 0.15915494309189535;
    const float rev = (float)(revd - __builtin_floor(revd));
    sn = __builtin_amdgcn_sinf(rev); cs = __builtin_amdgcn_cosf(rev);
}

__device__ __forceinline__ int tr_idx(int d, int m) { return d * 72 + 8 * ((m >> 3) ^ ((d >> 3) & 7)) + (m & 7); }
__device__ __forceinline__ int tr_frag(int r, int chunk) { return r * 72 + 8 * (chunk ^ ((r >> 3) & 7)); }

struct RawKV { u32x4 klo, khi, vlo, vhi; };
__device__ __forceinline__ void retA_load(const Frame& F, int unit, RawKV& r) {
    const int c = unit & 63, bh = unit >> 6, h = bh & 3, b = bh >> 2, m = F.tid >> 3, o = F.tid & 7;
    const bf16_t* zrow = F.Z + (size_t)(b * SEQ + c * 64 + m) * DIN + h * 128 + 8 * o;
    r.klo = *(const u32x4*)(zrow + 512); r.khi = *(const u32x4*)(zrow + 512 + 64); r.vlo = *(const u32x4*)(zrow + 1024); r.vhi = *(const u32x4*)(zrow + 1024 + 64);
}
__device__ __forceinline__ void retA_stage(const Frame& F, int unit, const RawKV& r) {
    const int c = unit & 63, h = (unit >> 6) & 3, m = F.tid >> 3, o = F.tid & 7;
    LAS bf16_t* KT = (LAS bf16_t*)(F.lds);
    LAS bf16_t* VT = KT + 128 * 72;
    const float ksc = __builtin_amdgcn_exp2f(F.lg2(h) * (float)(63 - m)) * 0.08838834764831845f;
    const int pos = c * 64 + m;
#pragma unroll
    for (int i = 0; i < 8; ++i) {
        const unsigned wl = r.klo[i >> 1], wh = r.khi[i >> 1];
        const float lo = (i & 1) ? bf_hi(wl) : bf_lo(wl), hi = (i & 1) ? bf_hi(wh) : bf_lo(wh);
        float cs, sn; rope_cs(pos, 8 * o + i, cs, sn);
        const unsigned pk = cvt_pk_bf16((lo * cs - hi * sn) * ksc, (lo * sn + hi * cs) * ksc);
        KT[tr_idx(8 * o + i, m)] = (bf16_t)(pk & 0xffffu); KT[tr_idx(64 + 8 * o + i, m)] = (bf16_t)(pk >> 16);
        const unsigned vl = r.vlo[i >> 1], vh = r.vhi[i >> 1];
        VT[tr_idx(8 * o + i, m)] = (bf16_t)((i & 1) ? (vl >> 16) : (vl & 0xffffu)); VT[tr_idx(64 + 8 * o + i, m)] = (bf16_t)((i & 1) ? (vh >> 16) : (vh & 0xffffu));
    }
}
__device__ __forceinline__ void retA_compute(const Frame& F, int unit) {
    LAS bf16_t* KT = (LAS bf16_t*)(F.lds); LAS bf16_t* VT = KT + 128 * 72;
    const int w = F.wave, fr = F.lane & 15, fq = F.lane >> 4;
    bf16x8 vf[2];
#pragma unroll
    for (int ks = 0; ks < 2; ++ks) vf[ks] = *(const LAS bf16x8*)(VT + tr_frag(16 * w + fr, 4 * ks + fq));
    bf16_t* urow = F.U + ((size_t)unit * 128 + 16 * w + fr) * 128 + 4 * fq;
#pragma unroll
    for (int dt = 0; dt < 8; ++dt) {
        f32x4 acc = (f32x4){0.f, 0.f, 0.f, 0.f};
#pragma unroll
        for (int ks = 0; ks < 2; ++ks) { const bf16x8 kf = *(const LAS bf16x8*)(KT + tr_frag(16 * dt + fr, 4 * ks + fq)); acc = mfma16(kf, vf[ks], acc); }
        u32x2 pk; pk.x = cvt_pk_bf16(acc[0], acc[1]); pk.y = cvt_pk_bf16(acc[2], acc[3]);
        *(u32x2*)(urow + 16 * dt) = pk;
    }
}
__device__ __forceinline__ void retA_phase(Frame& F) {
    int u = F.vcu; if (u >= 1024) return;
    RawKV raw; retA_load(F, u, raw);
    for (; u < 1024; u += F.G) {
        retA_stage(F, u, raw);
        if (u + F.G < 1024) retA_load(F, u + F.G, raw);
        __syncthreads();
        retA_compute(F, u);
        __syncthreads();
    }
}

__device__ __forceinline__ void pool_load(const Frame& F, int unit, u32x4 (&raw)[3]) {
    const int g = unit & 3, tile = unit >> 2, st = (tile & 63) * 64, tok0 = tile * 64;
#pragma unroll
    for (int j = 0; j < 3; ++j) { const int idx = F.tid + 512 * j, r = idx >> 4, ch = idx & 15, s = st - 15 + r;
        raw[j] = (u32x4){0u, 0u, 0u, 0u};
        if (idx < 79 * 16 && s >= 0) raw[j] = *(const u32x4*)(F.Z + (size_t)(tok0 - 15 + r) * DIN + 2048 + g * 128 + 8 * ch); }
}
__device__ __forceinline__ void pool_phase(Frame& F) {
    int u = F.vcu; if (u >= 1024) return;
    LAS float* P = (LAS float*)(F.lds);
    LAS bf16_t* A = (LAS bf16_t*)(F.lds + 79 * 132 * 4);
    const int t = F.tid, w = F.wave, rt = w & 3, chf = w >> 2, fr = F.lane & 15, fq = F.lane >> 4;
    const bool fixed_g = (F.G & 3) == 0;
    bf16x8 wf[4][4]; f32x4 sc[4];
    { const int g = u & 3; const bf16_t* wp = F.Wpool_t + g * 16384;
#pragma unroll
      for (int dd = 0; dd < 4; ++dd) { const int dt = 4 * chf + dd; sc[dd] = *(const f32x4*)(F.pool_scale + g * 128 + 16 * dt + 4 * fq);
#pragma unroll
          for (int ks = 0; ks < 4; ++ks) wf[dd][ks] = *(const bf16x8*)(wp + (16 * dt + fr) * 128 + 32 * ks + 8 * fq); } }
    u32x4 raw[3]; pool_load(F, u, raw);
    for (; u < 1024; u += F.G) {
        const int g = u & 3, tile = u >> 2, st = (tile & 63) * 64, tok0 = tile * 64, win = 2 << g;
        if (!fixed_g) { const bf16_t* wp = F.Wpool_t + g * 16384;
#pragma unroll
            for (int dd = 0; dd < 4; ++dd) { const int dt = 4 * chf + dd; sc[dd] = *(const f32x4*)(F.pool_scale + g * 128 + 16 * dt + 4 * fq);
#pragma unroll
                for (int ks = 0; ks < 4; ++ks) wf[dd][ks] = *(const bf16x8*)(wp + (16 * dt + fr) * 128 + 32 * ks + 8 * fq); } }
#pragma unroll
        for (int j = 0; j < 3; ++j) { const int idx = t + 512 * j, r = idx >> 4, ch = idx & 15;
            if (idx < 79 * 16) { const u32x4 x = raw[j];
                *(LAS f32x4*)(P + r * 132 + 8 * ch) = (f32x4){bf_lo(x.x), bf_hi(x.x), bf_lo(x.y), bf_hi(x.y)}; *(LAS f32x4*)(P + r * 132 + 8 * ch + 4) = (f32x4){bf_lo(x.z), bf_hi(x.z), bf_lo(x.w), bf_hi(x.w)}; } }
        if (u + F.G < 1024) pool_load(F, u + F.G, raw);
        __syncthreads();
        {
            const int n = t >> 3, c0 = (t & 7) * 16, s = st + n;
            const float rc = 1.0f / (float)((s + 1 < win) ? (s + 1) : win);
#pragma unroll
            for (int q = 0; q < 4; ++q) {
                f32x4 sum = (f32x4){0.f, 0.f, 0.f, 0.f};
                for (int j = 0; j < win; ++j) sum += *(const LAS f32x4*)(P + (15 + n - j) * 132 + c0 + 4 * q);
                const f32x4 self = *(const LAS f32x4*)(P + (15 + n) * 132 + c0 + 4 * q);
                const f32x4 pv = sum * rc - self;
                u32x2 pk; pk.x = cvt_pk_bf16(pv[0], pv[1]); pk.y = cvt_pk_bf16(pv[2], pv[3]);
                *(LAS u32x2*)(A + n * 136 + c0 + 4 * q) = pk;
            }
        }
        __syncthreads();
        {
            bf16x8 af[4];
#pragma unroll
            for (int ks = 0; ks < 4; ++ks) af[ks] = *(const LAS bf16x8*)(A + (16 * rt + fr) * 136 + 32 * ks + 8 * fq);
            bf16_t* orow = F.CAT + (size_t)(tok0 + 16 * rt + fr) * D + 512 + g * 128;
#pragma unroll
            for (int dd = 0; dd < 4; ++dd) { const int dt = 4 * chf + dd;
                f32x4 acc = (f32x4){0.f, 0.f, 0.f, 0.f};
#pragma unroll
                for (int ks = 0; ks < 4; ++ks) acc = mfma16(wf[dd][ks], af[ks], acc);
                u32x2 pk; pk.x = cvt_pk_bf16(acc[0] * sc[dd][0], acc[1] * sc[dd][1]); pk.y = cvt_pk_bf16(acc[2] * sc[dd][2], acc[3] * sc[dd][3]);
                *(u32x2*)(orow + 16 * dt + 4 * fq) = pk;
            }
        }
        __syncthreads();
    }
}

struct RawQKV { u32x4 qlo, qhi, klo, khi, vlo, vhi; };
__device__ __forceinline__ void retB_load(const Frame& F, int unit, RawQKV& r) {
    const int c = unit & 63, bh = unit >> 6, h = bh & 3, b = bh >> 2, m = F.tid >> 3, o = F.tid & 7;
    const bf16_t* zrow = F.Z + (size_t)(b * SEQ + c * 64 + m) * DIN + h * 128 + 8 * o;
    r.qlo = *(const u32x4*)(zrow); r.qhi = *(const u32x4*)(zrow + 64); r.klo = *(const u32x4*)(zrow + 512); r.khi = *(const u32x4*)(zrow + 512 + 64); r.vlo = *(const u32x4*)(zrow + 1024); r.vhi = *(const u32x4*)(zrow + 1024 + 64);
}
__device__ __forceinline__ void retB_phase(Frame& F) {
    int unit = F.vcu; if (unit >= 1024) return;
    LAS bf16_t* Q = (LAS bf16_t*)(F.lds);
    LAS bf16_t* Kr = Q + 64 * 136;
    LAS bf16_t* VT = Kr + 64 * 136;
    LAS bf16_t* Sm = VT + 128 * 72;
    LAS float* red = (LAS float*)(Sm + 64 * 72);
    const int t = F.tid, w = F.wave, fr = F.lane & 15, fq = F.lane >> 4;
    RawQKV raw; retB_load(F, unit, raw);
    for (; unit < 1024; unit += F.G) {
        const int c = unit & 63, bh = unit >> 6, h = bh & 3, b = bh >> 2, tok0 = b * SEQ + c * 64;
        const float lg = F.lg2(h);
        const int rt = w & 3, chf = w >> 2, n = 16 * rt + fr;
        bf16x8 rf[4][4]; u32x2 gw2[4];
#pragma unroll
        for (int dd = 0; dd < 4; ++dd) { const bf16_t* rrow = F.U + ((size_t)unit * 128 + 16 * (4 * chf + dd) + fr) * 128 + 8 * fq;
#pragma unroll
            for (int ks = 0; ks < 4; ++ks) rf[dd][ks] = *(const bf16x8*)(rrow + 32 * ks);
            gw2[dd] = *(const u32x2*)(F.Z + (size_t)(tok0 + n) * DIN + 1536 + h * 128 + 16 * (4 * chf + dd) + 4 * fq); }
        {
            const int m = t >> 3, o = t & 7, pos = c * 64 + m;
            unsigned ql[4], qh[4], kl[4], kh[4];
#pragma unroll
            for (int i = 0; i < 8; i += 2) {
                float cs0, sn0, cs1, sn1; rope_cs(pos, 8 * o + i, cs0, sn0); rope_cs(pos, 8 * o + i + 1, cs1, sn1);
                { const float l0 = bf_lo(raw.qlo[i >> 1]), l1 = bf_hi(raw.qlo[i >> 1]), h0 = bf_lo(raw.qhi[i >> 1]), h1 = bf_hi(raw.qhi[i >> 1]);
                  ql[i >> 1] = cvt_pk_bf16(l0 * cs0 - h0 * sn0, l1 * cs1 - h1 * sn1); qh[i >> 1] = cvt_pk_bf16(l0 * sn0 + h0 * cs0, l1 * sn1 + h1 * cs1); }
                { const float l0 = bf_lo(raw.klo[i >> 1]), l1 = bf_hi(raw.klo[i >> 1]), h0 = bf_lo(raw.khi[i >> 1]), h1 = bf_hi(raw.khi[i >> 1]); const float sc = 0.08838834764831845f;
                  kl[i >> 1] = cvt_pk_bf16((l0 * cs0 - h0 * sn0) * sc, (l1 * cs1 - h1 * sn1) * sc); kh[i >> 1] = cvt_pk_bf16((l0 * sn0 + h0 * cs0) * sc, (l1 * sn1 + h1 * cs1) * sc); }
            }
            *(LAS u32x4*)(Q + m * 136 + 8 * o) = (u32x4){ql[0], ql[1], ql[2], ql[3]}; *(LAS u32x4*)(Q + m * 136 + 64 + 8 * o) = (u32x4){qh[0], qh[1], qh[2], qh[3]};
            *(LAS u32x4*)(Kr + m * 136 + 8 * o) = (u32x4){kl[0], kl[1], kl[2], kl[3]}; *(LAS u32x4*)(Kr + m * 136 + 64 + 8 * o) = (u32x4){kh[0], kh[1], kh[2], kh[3]};
#pragma unroll
            for (int i = 0; i < 8; ++i) { const unsigned vl = raw.vlo[i >> 1], vh = raw.vhi[i >> 1];
                VT[tr_idx(8 * o + i, m)] = (bf16_t)((i & 1) ? (vl >> 16) : (vl & 0xffffu)); VT[tr_idx(64 + 8 * o + i, m)] = (bf16_t)((i & 1) ? (vh >> 16) : (vh & 0xffffu)); }
        }
        if (unit + F.G < 1024) retB_load(F, unit + F.G, raw);
        __syncthreads();
        {
            const int ntl = w >> 1;
            bf16x8 qf[4];
#pragma unroll
            for (int ks = 0; ks < 4; ++ks) qf[ks] = *(const LAS bf16x8*)(Q + (16 * ntl + fr) * 136 + 32 * ks + 8 * fq);
#pragma unroll
            for (int mm = 0; mm < 2; ++mm) { const int mt = 2 * (w & 1) + mm;
                f32x4 acc = (f32x4){0.f, 0.f, 0.f, 0.f};
#pragma unroll
                for (int ks = 0; ks < 4; ++ks) { const bf16x8 kf = *(const LAS bf16x8*)(Kr + (16 * mt + fr) * 136 + 32 * ks + 8 * fq); acc = mfma16(kf, qf[ks], acc); }
                const int nn = 16 * ntl + fr, m0 = 16 * mt + 4 * fq;
                float sv[4];
#pragma unroll
                for (int j = 0; j < 4; ++j) { const int dd = nn - (m0 + j); sv[j] = acc[j] * __builtin_amdgcn_exp2f(lg * (float)(dd < 0 ? -dd : dd)); }
                u32x2 pk; pk.x = cvt_pk_bf16(sv[0], sv[1]); pk.y = cvt_pk_bf16(sv[2], sv[3]);
                *(LAS u32x2*)(Sm + nn * 72 + m0) = pk;
            }
        }
        __syncthreads();
        {
            bf16x8 sf[2], qf[4];
#pragma unroll
            for (int ks = 0; ks < 2; ++ks) sf[ks] = *(const LAS bf16x8*)(Sm + n * 72 + 32 * ks + 8 * fq);
#pragma unroll
            for (int ks = 0; ks < 4; ++ks) qf[ks] = *(const LAS bf16x8*)(Q + n * 136 + 32 * ks + 8 * fq);
            const float qd = __builtin_amdgcn_exp2f(lg * (float)(n + 1));
            f32x4 ov[4]; float ss = 0.f;
#pragma unroll
            for (int dd = 0; dd < 4; ++dd) { const int vt = 4 * chf + dd;
                f32x4 ai = (f32x4){0.f, 0.f, 0.f, 0.f}, ac = ai;
#pragma unroll
                for (int ks = 0; ks < 2; ++ks) { const bf16x8 vf = *(const LAS bf16x8*)(VT + tr_frag(16 * vt + fr, 4 * ks + fq)); ai = mfma16(vf, sf[ks], ai); }
#pragma unroll
                for (int ks = 0; ks < 4; ++ks) ac = mfma16(rf[dd][ks], qf[ks], ac);
                ov[dd] = ai + ac * qd;
                ss += (ov[dd][0] * ov[dd][0] + ov[dd][1] * ov[dd][1]) + (ov[dd][2] * ov[dd][2] + ov[dd][3] * ov[dd][3]);
            }
            ss += __shfl_xor(ss, 16); ss += __shfl_xor(ss, 32);
            if (fq == 0) red[chf * 64 + n] = ss;
            __syncthreads();
            const float rstd = 1.f / sqrtf((red[n] + red[64 + n]) * (1.f / 128.f) + EPS);
            const size_t tok = (size_t)(tok0 + n);
#pragma unroll
            for (int dd = 0; dd < 4; ++dd) { const int v0 = 16 * (4 * chf + dd) + 4 * fq;
                const f32x4 rw = *(const f32x4*)(F.ret_norm_w + h * 128 + v0);
                const float gv[4] = {bf_lo(gw2[dd].x), bf_hi(gw2[dd].x), bf_lo(gw2[dd].y), bf_hi(gw2[dd].y)};
                float r[4];
#pragma unroll
                for (int j = 0; j < 4; ++j) { const float sg = gv[j] * __builtin_amdgcn_rcpf(1.0f + __builtin_amdgcn_exp2f(-1.4426950408889634f * gv[j])); r[j] = ov[dd][j] * rstd * rw[j] * sg; }
                u32x2 pk; pk.x = cvt_pk_bf16(r[0], r[1]); pk.y = cvt_pk_bf16(r[2], r[3]);
                *(u32x2*)(F.CAT + tok * D + h * 128 + v0) = pk;
            }
        }
        __syncthreads();
    }
}

struct Args { const float* in[15]; float* out; unsigned char* ws; float lg2g[4]; int ph_lo, ph_hi, li, pad; };

__global__ void __launch_bounds__(NWAVES * 64, 2) fwd_kernel(Args args) {
    extern __shared__ __attribute__((aligned(16))) unsigned char lds[];
    Frame F;
    F.lds = (LAS unsigned char*)lds;
    F.MISC = (volatile LAS unsigned*)(F.lds + MISC_OFF);
    F.tid = threadIdx.x; F.lane = F.tid & 63; F.wave = __builtin_amdgcn_readfirstlane(F.tid >> 6);
    F.G = gridDim.x; { const int bx = blockIdx.x; F.vcu = (F.G % 8 == 0) ? (bx % 8) * (F.G / 8) + bx / 8 : bx; }
#define REFRESH() do { const __attribute__((address_space(4))) Args* A_ = (const __attribute__((address_space(4))) Args*)__builtin_amdgcn_kernarg_segment_ptr(); asm volatile("" : "+s"(A_)); \
    unsigned char* ws_ = A_->ws; F.ctl = (gu32*)(ws_ + WS_CTL); \
    F.x = A_->in[0]; F.norm_mix_w = A_->in[1]; F.w_in = A_->in[2]; F.ret_norm_w = A_->in[3]; F.w_pool = A_->in[4]; F.pool_scale = A_->in[5]; F.w_out = A_->in[6]; F.norm_ffn_w = A_->in[7]; \
    F.w_router = A_->in[8]; F.b_router = A_->in[9]; F.w_gu = A_->in[10]; F.b_gu = A_->in[11]; F.w_down = A_->in[12]; F.b_down = A_->in[13]; F.norm_final_w = A_->in[14]; F.out = A_->out; \
    F.Wr_hi = (bf16_t*)(ws_ + WS_WR); F.Wr_lo = F.Wr_hi + 32 * 1024; F.Wpool_t = (bf16_t*)(ws_ + WS_WPOOL); F.Win_t = (bf16_t*)(ws_ + WS_WIN); F.Wout_t = (bf16_t*)(ws_ + WS_WOUT); \
    F.XN = (bf16_t*)(ws_ + WS_XN); F.CAT = (bf16_t*)(ws_ + WS_CAT); F.U = (bf16_t*)(ws_ + WS_U); F.Z = (bf16_t*)(ws_ + WS_Z); F.Y = (bf16_t*)(ws_ + WS_Y); \
    F.Wgu8 = ws_ + WS_WGU; F.Wd8 = ws_ + WS_WD; F.ACT8 = ws_ + WS_ACT; F.H8 = ws_ + WS_XN; F.list = (i32x2*)(ws_ + WS_LIST); F.ssq = (float*)(ws_ + WS_SSQ); \
    F.lg2g0 = A_->lg2g[0]; F.lg2g1 = A_->lg2g[1]; F.lg2g2 = A_->lg2g[2]; F.lg2g3 = A_->lg2g[3]; \
    { int t_ = threadIdx.x; asm volatile("" : "+v"(t_)); F.tid = t_; F.lane = t_ & 63; } } while (0)
    REFRESH();
    for (int u = F.tid; u < (LDS_BYTES - LDSCTL_OFF) / 4; u += NWAVES * 64) ((LAS unsigned*)(F.lds + LDSCTL_OFF))[u] = 0u;
    __syncthreads();
    XcdBarrier bar; bar.bar = (unsigned*)(F.ctl + CW_BAR); bar.x = 0; bar.st = nullptr;
    if (N_LAUNCHES != PER_PHASE) bar = xcd_barrier_post((unsigned*)(F.ctl + CW_BAR), F.MISC + 8);
    int n_stamp = 0;
#define STAMP() do { if (DBG_SPIN_A >= 0) { if (F.tid == 0) { const unsigned long long _t = __builtin_amdgcn_s_memrealtime(); F.MISC[16 + 2 * n_stamp] = (unsigned)_t; F.MISC[17 + 2 * n_stamp] = (unsigned)(_t >> 32); } ++n_stamp; } } while (0)
    STAMP();
#define GRID_BAR() do { if (N_LAUNCHES != PER_PHASE) xcd_barrier(bar); STAMP(); } while (0)
    const int lo = DBG_ONLY9 ? (args.ph_lo < 9 ? 9 : args.ph_lo) : args.ph_lo, hi = args.ph_hi;
#define IN(k) (lo <= (k) && (k) < hi)
#define BOTH(k) (IN(k) && IN((k) + 1))
    const int gw = F.vcu * NWAVES + F.wave, NGW = F.G * NWAVES;

    if (IN(0)) { REFRESH(); p0_prologue(F); if (BOTH(0)) GRID_BAR(); }

    if (IN(1)) {
        REFRESH();
        pg8::DenseSched S; S.init(F.XN, F.Win_t, NTOK, DIN, F.G, (int)blockIdx.x);
        pg8::EpiBf16 E{F.Z, DIN};
        pg8::gemm_phase<pg8::EpiBf16, pg8::DenseSched, true>(F.lds, S, E);
        if (BOTH(1)) GRID_BAR();
    }

    if (IN(2)) {
        REFRESH();
        retA_phase(F);
        pool_phase(F);
        if (BOTH(2)) GRID_BAR();
    }

    if (IN(3) && DBG_STAGE != 4) {
        REFRESH();
        const int gt = F.vcu * 512 + F.tid, NGT = F.G * 512;
        for (int p = gt; p < 16 * 8192; p += NGT) {
            const int bh = p >> 13, i = p & 8191;
            const float cd = __builtin_amdgcn_exp2f(F.lg2(bh & 3) * 64.0f);
            unsigned* up = (unsigned*)(F.U + (size_t)bh * 64 * 16384) + i;
            float s0 = 0.f, s1 = 0.f;
#pragma unroll
            for (int cb = 0; cb < 64; cb += 32) {
                unsigned uw[32];
#pragma unroll
                for (int c = 0; c < 32; ++c) uw[c] = up[(size_t)(cb + c) * 8192];
#pragma unroll
                for (int c = 0; c < 32; ++c) { up[(size_t)(cb + c) * 8192] = cvt_pk_bf16(s0, s1); s0 = cd * s0 + bf_lo(uw[c]); s1 = cd * s1 + bf_hi(uw[c]); }
            }
        }
        if (BOTH(3)) GRID_BAR();
    }

    if (IN(4) && DBG_STAGE != 4) {
        REFRESH();
        retB_phase(F);
        if (BOTH(4)) GRID_BAR();
    }

    if (IN(5) && !DBG_STAGE) {
        REFRESH();
        pg8::DenseSched S; S.init(F.CAT, F.Wout_t, NTOK, D, F.G, (int)blockIdx.x);
        pg8::EpiResF32 E{F.x, F.out, D, F.ssq};
        pg8::gemm_phase<pg8::EpiResF32, pg8::DenseSched, false>(F.lds, S, E);
        if (BOTH(5)) GRID_BAR();
    }

    if (IN(6) && !DBG_SKIP_Y) {
        REFRESH();
        LAS float* lgs = (LAS float*)(F.lds + F.wave * 4096);
        LAS f32x4* part = (LAS f32x4*)(F.lds + 32768);
        if (gw == 0) { GAS u32x4* z = (GAS u32x4*)(F.H8 + (size_t)NTOK * D) + F.lane; z[0] = (u32x4){0u, 0u, 0u, 0u}; }
        const int fr = F.lane & 15, fq = F.lane >> 4, gsel = F.wave & 3, kh = F.wave >> 2;
        LAS unsigned* lcnt = (LAS unsigned*)(F.lds + 32768 + 8192);
        LAS unsigned* lbase = lcnt + 32;
        if (F.tid < 32) lcnt[F.tid] = 0u;
        __syncthreads();
        for (int g0 = F.vcu * 4; g0 < NTOK / 16; g0 += F.G * 4) {
            const int grp = g0 + gsel, row = grp * 16 + fr;
            int ei[4] = {0, 0, 0, 0}, lp[4] = {0, 0, 0, 0}, rr = 0; float gi[4] = {0.f, 0.f, 0.f, 0.f};
            float ss = 0.f;
#pragma unroll
            for (int p = 0; p < 16; ++p) ss += F.ssq[(size_t)p * NTOK + row];
            const float rstd = 1.f / sqrtf(ss * (1.f / D) + EPS);
            const float* xr = F.out + (size_t)row * D + 512 * kh + 8 * fq;
            const float* wn = F.norm_ffn_w + 512 * kh + 8 * fq;
            unsigned char* hrow = F.H8 + (size_t)row * D + 512 * kh + 8 * fq;
            const bf16_t* wrh = F.Wr_hi + fr * 1024 + 512 * kh + 8 * fq; const bf16_t* wrl = F.Wr_lo + fr * 1024 + 512 * kh + 8 * fq;
            f32x4 acc[2] = {(f32x4){0.f, 0.f, 0.f, 0.f}, (f32x4){0.f, 0.f, 0.f, 0.f}};
#pragma unroll 4
            for (int ks = 0; ks < 16; ++ks) {
                const f32x4 a = *(const f32x4*)(xr + 32 * ks), b2 = *(const f32x4*)(xr + 32 * ks + 4);
                const f32x4 wa = *(const f32x4*)(wn + 32 * ks), wb = *(const f32x4*)(wn + 32 * ks + 4);
                float hv[8];
#pragma unroll
                for (int j = 0; j < 4; ++j) { hv[j] = a[j] * rstd * wa[j]; hv[4 + j] = b2[j] * rstd * wb[j]; }
                u32x4 hh, hl;
#pragma unroll
                for (int j = 0; j < 4; ++j) { const unsigned p = cvt_pk_bf16(hv[2 * j], hv[2 * j + 1]); hh[j] = p; hl[j] = cvt_pk_bf16(hv[2 * j] - bf_lo(p), hv[2 * j + 1] - bf_hi(p)); }
                { u32x2 h8; h8.x = cvt4_fp8(hv[0], hv[1], hv[2], hv[3]); h8.y = cvt4_fp8(hv[4], hv[5], hv[6], hv[7]); *(u32x2*)(hrow + 32 * ks) = h8; }
                const bf16x8 bhh = __builtin_bit_cast(bf16x8, hh), bhl = __builtin_bit_cast(bf16x8, hl);
#pragma unroll
                for (int et = 0; et < 2; ++et) {
                    const bf16x8 wh = *(const bf16x8*)(wrh + et * 16384 + 32 * ks), wl = *(const bf16x8*)(wrl + et * 16384 + 32 * ks);
                    acc[et] = mfma16(wh, bhh, acc[et]); acc[et] = mfma16(wh, bhl, acc[et]); acc[et] = mfma16(wl, bhh, acc[et]);
                }
            }
            if (kh == 1) { part[(gsel * 2 + 0) * 64 + F.lane] = acc[0]; part[(gsel * 2 + 1) * 64 + F.lane] = acc[1]; }
            __syncthreads();
            if (kh == 0) {
                acc[0] += part[(gsel * 2 + 0) * 64 + F.lane]; acc[1] += part[(gsel * 2 + 1) * 64 + F.lane];
#pragma unroll
                for (int et = 0; et < 2; ++et)
#pragma unroll
                    for (int j = 0; j < 4; ++j) lgs[fr * 33 + 16 * et + 4 * fq + j] = acc[et][j];
                LDS_WAIT(); __builtin_amdgcn_wave_barrier();
                if (F.lane < 16) {
                    const int r = grp * 16 + F.lane;
                    float v0 = -3.0e38f, v1 = -3.0e38f, v2 = -3.0e38f, v3 = -3.0e38f; int i0 = 0, i1 = 0, i2 = 0, i3 = 0;
                    for (int e = 0; e < 32; ++e) {
                        const float v = lgs[F.lane * 33 + e] + F.b_router[e];
                        if (v > v3) {
                            if (v > v0) { v3 = v2; i3 = i2; v2 = v1; i2 = i1; v1 = v0; i1 = i0; v0 = v; i0 = e; }
                            else if (v > v1) { v3 = v2; i3 = i2; v2 = v1; i2 = i1; v1 = v; i1 = e; }
                            else if (v > v2) { v3 = v2; i3 = i2; v2 = v; i2 = e; }
                            else { v3 = v; i3 = e; }
                        }
                    }
                    const float e1 = __expf(v1 - v0), e2 = __expf(v2 - v0), e3 = __expf(v3 - v0), inv = 1.0f / (1.0f + e1 + e2 + e3);
                    const float g4[4] = {inv, e1 * inv, e2 * inv, e3 * inv}; const int i4[4] = {i0, i1, i2, i3};
#pragma unroll
                    for (int k = 0; k < 4; ++k) { ei[k] = i4[k]; gi[k] = g4[k]; lp[k] = (int)__hip_atomic_fetch_add(lcnt + i4[k], 1u, __ATOMIC_RELAXED, __HIP_MEMORY_SCOPE_WORKGROUP); }
                    rr = r;
                }
            }
            __syncthreads();
            if (F.tid < 32) { const unsigned n = lcnt[F.tid]; lbase[F.tid] = n ? atomicAdd((unsigned*)(F.ctl + CW_CNT + 64 * F.tid), n) : 0u; }
            __syncthreads();
            if (kh == 0 && F.lane < 16) {
#pragma unroll
                for (int k = 0; k < 4; ++k) F.list[ei[k] * LISTCAP + (int)lbase[ei[k]] + lp[k]] = (i32x2){rr * 4 + k, __float_as_int(gi[k])};
            }
            __syncthreads();
            if (F.tid < 32) lcnt[F.tid] = 0u;
            __syncthreads();
        }
        if (BOTH(6)) GRID_BAR();
    }

    if ((IN(7) || IN(8)) && !DBG_SKIP_Y) {
        REFRESH();
        LAS int* tab = (LAS int*)(F.lds + TAB_OFF);
        if (F.tid < 32) tab[F.tid] = (int)__hip_atomic_load(F.ctl + CW_CNT + 64 * F.tid, RLX_AGENT);
        __syncthreads();
        if (F.tid == 0) { int s = 0; for (int e = 0; e < 32; ++e) { tab[32 + e] = s; s += (tab[e] + 255) >> 8; } tab[64] = s; }
        __syncthreads();
    }
    if (IN(7) && !DBG_SKIP_Y) {
        REFRESH();
        pg8::MoeSched<true> S; S.init((const bf16_t*)F.H8, (const bf16_t*)F.Wgu8, F.list, F.b_gu, (const LAS int*)(F.lds + TAB_OFF), F.G, (int)blockIdx.x);
        pg8::EpiGU E{F.ACT8};
        pg8::gemm_phase<pg8::EpiGU, pg8::MoeSched<true>, true, true>(F.lds, S, E);
        if (BOTH(7)) GRID_BAR();
    }
    if (IN(8) && !DBG_SKIP_Y) {
        REFRESH();
        pg8::MoeSched<false> S; S.init((const bf16_t*)F.ACT8, (const bf16_t*)F.Wd8, F.list, F.b_down, (const LAS int*)(F.lds + TAB_OFF), F.G, (int)blockIdx.x);
        pg8::EpiDown E{F.Y};
        pg8::gemm_phase<pg8::EpiDown, pg8::MoeSched<false>, true, true>(F.lds, S, E);
        if (BOTH(8)) GRID_BAR();
    }
    if (IN(9) && DBG_STAGE) {
        REFRESH();
        for (int m = gw; m < NTOK; m += NGW) {
            const bf16_t* src = DBG_STAGE == 1 ? F.XN + (size_t)m * D : DBG_STAGE == 2 ? F.Z + (size_t)m * DIN + 1024 : DBG_STAGE == 3 ? F.CAT + (size_t)m * D : F.U + (size_t)m * D;
            for (int j = F.lane; j < D; j += 64) F.out[(size_t)m * D + j] = __uint_as_float(((unsigned)src[j]) << 16);
        }
    }
    if (IN(9) && !DBG_STAGE) {
        REFRESH();
        for (int m = gw; m < NTOK; m += NGW) {
            const GAS f32x4* xr = (const GAS f32x4*)((DBG_ONLY9 ? F.x : F.out) + (size_t)m * D) + F.lane; const GAS f32x4* wr = (const GAS f32x4*)F.norm_final_w + F.lane;
            f32x4 v[4]; float s = 0.f;
#pragma unroll
            for (int j = 0; j < 4; ++j) v[j] = xr[64 * j];
#pragma unroll
            for (int k = 0; k < (DBG_SKIP_Y ? 0 : 4); ++k) { const GAS u32x2* yr = (const GAS u32x2*)(F.Y + ((size_t)m * 4 + k) * D) + F.lane;
#pragma unroll
                for (int j = 0; j < 4; ++j) { const u32x2 y = __builtin_nontemporal_load(yr + 64 * j); v[j] += (f32x4){bf_lo(y.x), bf_hi(y.x), bf_lo(y.y), bf_hi(y.y)}; } }
#pragma unroll
            for (int j = 0; j < 4; ++j) s += (v[j].x * v[j].x + v[j].y * v[j].y) + (v[j].z * v[j].z + v[j].w * v[j].w);
            const float rstd = 1.f / sqrtf(wave_sum(s) * (1.f / D) + EPS);
            GAS f32x4* orow = (GAS f32x4*)(F.out + (size_t)m * D) + F.lane;
#pragma unroll
            for (int j = 0; j < 4; ++j) __builtin_nontemporal_store(v[j] * rstd * wr[64 * j], orow + 64 * j);
        }
    }
    if (DBG_SPIN_A >= 0) { STAMP();
        if (blockIdx.x == 0 && F.tid == 0) {
            const unsigned long long ta = ((unsigned long long)F.MISC[17 + 2 * DBG_SPIN_A] << 32) | F.MISC[16 + 2 * DBG_SPIN_A], tb = ((unsigned long long)F.MISC[17 + 2 * DBG_SPIN_B] << 32) | F.MISC[16 + 2 * DBG_SPIN_B];
            const unsigned long long t0 = __builtin_amdgcn_s_memrealtime(), want = (tb - ta) * DBG_SPIN_W;
            while (__builtin_amdgcn_s_memrealtime() - t0 < want) __builtin_amdgcn_s_sleep(8);
        } }
#undef IN
#undef BOTH
#undef GRID_BAR
#undef STAMP
#undef REFRESH
}

extern "C" void kernel_launch(void* const* d_in, const int* in_sizes, int n_in, void* d_out, int out_size, void* d_ws, size_t ws_size, hipStream_t stream) {
    static int grid = 0;
    if (grid == 0) {
        if (n_in != 15 || in_sizes[0] != NTOK * D || out_size != NTOK * D || ws_size < WS_END) { fprintf(stderr, "kernel_launch: unexpected shapes / workspace (n_in %d, ws %zu); nothing launched\n", n_in, ws_size); grid = -1; return; }
        int dev = 0, cus = 0, per_cu = 0;
        if (hipGetDevice(&dev) != hipSuccess || hipDeviceGetAttribute(&cus, hipDeviceAttributeMultiprocessorCount, dev) != hipSuccess) { grid = -1; return; }
        if (hipFuncSetAttribute((const void*)fwd_kernel, hipFuncAttributeMaxDynamicSharedMemorySize, LDS_BYTES) != hipSuccess) { fprintf(stderr, "kernel_launch: hipFuncSetAttribute failed\n"); grid = -1; return; }
        if (hipOccupancyMaxActiveBlocksPerMultiprocessor(&per_cu, (const void*)fwd_kernel, NWAVES * 64, LDS_BYTES) != hipSuccess || per_cu < 1)
            fprintf(stderr, "kernel_launch: note: occupancy query reports %d workgroups per CU\n", per_cu);
        (void)hipGetLastError();
        grid = cus;
    }
    if (grid < 0) return;
    if (hipMemsetAsync((char*)d_ws + WS_CTL, 0, CTL_ZERO_BYTES, stream) != hipSuccess) { fprintf(stderr, "kernel_launch: memset failed\n"); return; }
    Args a{};
    for (int i = 0; i < 15; ++i) a.in[i] = (const float*)d_in[i];
    a.out = (float*)d_out; a.ws = (unsigned char*)d_ws;
    for (int h = 0; h < 4; ++h) a.lg2g[h] = (float)(log1p(-exp2(-5.0 - (double)h)) / log(2.0));
    for (int li = 0; li < N_LAUNCHES; ++li) {
        a.ph_lo = (N_LAUNCHES == PER_PHASE) ? li : 0; a.ph_hi = (N_LAUNCHES == PER_PHASE) ? li + 1 : PER_PHASE; a.li = li; a.pad = 0;
        hipLaunchKernelGGL(fwd_kernel, dim3(grid), dim3(NWAVES * 64), LDS_BYTES, stream, a);
        const hipError_t le = hipPeekAtLastError();
        if (le != hipSuccess) { fprintf(stderr, "kernel_launch: launch %d failed: %s\n", li, hipGetErrorName(le)); break; }
    }
}
```

```cpp
#include <hip/hip_runtime.h>
#include <cstdio>
#include <cstdint>
#include <cmath>

#ifndef DBG_ONLY9
#define DBG_ONLY9 0
#define DBG_STAGE 0
#endif
#ifndef DBG_SPIN_A
#define DBG_SPIN_A -1
#define DBG_SPIN_B -1
#define DBG_SPIN_W 2
#endif
#ifndef DBG_SKIP_Y
#define DBG_SKIP_Y 0
#endif
#ifndef MK_N_LAUNCHES
#define MK_N_LAUNCHES 1
#endif
constexpr int PER_PHASE = 10;
constexpr int N_LAUNCHES = MK_N_LAUNCHES;

#define LAS __attribute__((address_space(3)))
#define GAS __attribute__((address_space(1)))
typedef unsigned short bf16_t;
typedef short bf16x8 __attribute__((ext_vector_type(8)));
typedef float f32x4 __attribute__((ext_vector_type(4)));
typedef float f32x2 __attribute__((ext_vector_type(2)));
typedef unsigned u32x4 __attribute__((ext_vector_type(4)));
typedef unsigned u32x2 __attribute__((ext_vector_type(2)));
typedef GAS unsigned gu32;
typedef int i32x2 __attribute__((ext_vector_type(2)));
typedef int le_t __attribute__((ext_vector_type(4)));

constexpr int NTOK = 16384, D = 1024, SEQ = 4096, DIN = 2560, NE = 32, FF = 1024, LISTCAP = 16384;
constexpr int NWAVES = 8;
constexpr float EPS = 1e-6f;

constexpr size_t MiB = 1u << 20;
constexpr size_t WS_CTL = 0, CTL_ZERO_BYTES = 32 * 1024;
constexpr size_t WS_LIST = 360 * MiB;
constexpr size_t WS_PL = 368 * MiB;
constexpr size_t WS_SSQ = 5 * MiB + 512 * 1024;
constexpr size_t WS_WR = 6 * MiB + 512 * 1024;
constexpr size_t WS_WPOOL = 6 * MiB + 768 * 1024;
constexpr size_t WS_WIN = 7 * MiB;
constexpr size_t WS_WOUT = 12 * MiB;
constexpr size_t WS_XN = 14 * MiB;
constexpr size_t WS_CAT = 47 * MiB;
constexpr size_t WS_U = 79 * MiB;
constexpr size_t WS_Z = 111 * MiB;
constexpr size_t WS_Y = 47 * MiB;
constexpr size_t WS_WGU = 192 * MiB;
constexpr size_t WS_WD = 256 * MiB;
constexpr size_t WS_ACT = 288 * MiB;
constexpr size_t WS_END = 400 * MiB;
static_assert(WS_Y + (size_t)65536 * 1024 * 2 <= WS_WGU && WS_Z + (size_t)16384 * 2560 * 2 <= WS_WGU, "Y overlay / Z");
constexpr int CW_TMO = 0, CW_CODE = 1;
constexpr int CW_Q = 512;
constexpr int CW_CNT = 1024;
constexpr int CW_BAR = 4096;
static_assert((CW_BAR + 3456) * 4 <= (int)CTL_ZERO_BYTES, "control words inside the memset");

constexpr int RING_BYTES = 131072;
constexpr int LDSCTL_OFF = RING_BYTES, MISC_OFF = LDSCTL_OFF + 320, TAB_OFF = LDSCTL_OFF + 512;
constexpr int MB_OFF = LDSCTL_OFF + 1024;
constexpr int LDS_BYTES = 147456;

#define RLX_AGENT __ATOMIC_RELAXED, __HIP_MEMORY_SCOPE_AGENT
#define LDS_WAIT() asm volatile("s_waitcnt lgkmcnt(0)" ::: "memory")
#define VM_WAIT() asm volatile("s_waitcnt vmcnt(0)" ::: "memory")
typedef __bf16 bf16x2_t __attribute__((ext_vector_type(2)));
__device__ __forceinline__ unsigned cvt_pk_bf16(float lo, float hi) { const f32x2 v = {lo, hi}; const bf16x2_t b = __builtin_convertvector(v, bf16x2_t); return __builtin_bit_cast(unsigned, b); }
__device__ __forceinline__ unsigned cvt4_fp8(float a, float b, float c, float d) { int r = __builtin_amdgcn_cvt_pk_fp8_f32(a, b, 0, false); r = __builtin_amdgcn_cvt_pk_fp8_f32(c, d, r, true); return (unsigned)r; }
typedef int i32x8 __attribute__((ext_vector_type(8)));
__device__ __forceinline__ float bf_lo(unsigned w) { return __uint_as_float(w << 16); }
__device__ __forceinline__ float bf_hi(unsigned w) { return __uint_as_float(w & 0xffff0000u); }
__device__ __forceinline__ float wave_sum(float v) {
#pragma unroll
    for (int o = 1; o < 64; o <<= 1) v += __shfl_xor(v, o);
    return v;
}
__device__ __forceinline__ f32x4 mfma16(bf16x8 a, bf16x8 b, f32x4 c) { return __builtin_amdgcn_mfma_f32_16x16x32_bf16(a, b, c, 0, 0, 0); }

namespace pg8 {
constexpr int BM = 256, BK = 64, HALF = 128, HTB = HALF * BK * 2, STAGE_BYTES = 8 * HTB, NXCD = 8, WGM = 8, KK = 1024;
__host__ __device__ __forceinline__ int lds_byte(int r, int c) { const int st = (r >> 4) * 2 + (c >> 5), rr = r & 15, cc = c & 31, ob = rr * 64 + cc * 2; return st * 1024 + (ob ^ (((ob >> 9) & 1) << 5)); }
__host__ __device__ __forceinline__ void stage_rc(int b, int& R, int& C) { const int st = b / 1024, sb = b % 1024, swz = sb ^ (((sb >> 9) & 1) << 5); R = (st >> 1) * 16 + swz / 64; C = (st & 1) * 32 + (swz % 64) / 2; }
__host__ __device__ __forceinline__ int perm32(int rho) { const int n = rho >> 4, i = rho & 15; return 8 * (i >> 2) + 4 * n + (i & 3); }

struct Unit { int pm, pn, e, rows, arow; };

__device__ __forceinline__ int xcd_remap(int L, int nwg) { const int q = nwg / NXCD, r = nwg % NXCD, xcd = L % NXCD, off = L / NXCD; return (xcd < r ? xcd * (q + 1) : r * (q + 1) + (xcd - r) * q) + off; }

struct DenseSched {
    const bf16_t* A; const bf16_t* Bt; int nM, nN, nwg, G, c;
    __device__ __forceinline__ void init(const bf16_t* A_, const bf16_t* Bt_, int M, int N, int G_, int c_) { A = A_; Bt = Bt_; nM = M / BM; nN = N / BM; nwg = nM * nN; G = G_; c = c_; }
    __device__ __forceinline__ bool next(int i, Unit& u) const {
        const int L = i * G + c; if (L >= nwg) return false;
        const int wgid = xcd_remap(L, nwg);
        const int nig = WGM * nN, gid = wgid / nig, fm = gid * WGM, gsz = (nM - fm) < WGM ? (nM - fm) : WGM;
        u.pm = fm + ((wgid % nig) % gsz); u.pn = (wgid % nig) / gsz; u.e = 0; u.rows = 256; u.arow = u.pm * 256; return true;
    }
    __device__ __forceinline__ const char* a_base(const Unit& u) const { return (const char*)A + (size_t)u.pm * (2 * HALF * KK * 2); }
    __device__ __forceinline__ const char* b_base(const Unit& u) const { return (const char*)Bt + (size_t)u.pn * (2 * HALF * KK * 2); }
    static constexpr bool MB = false;
    __device__ __forceinline__ void mb_issue(LAS unsigned char*, const Unit&, int, int) const {}
    __device__ __forceinline__ void a_offs(const Unit&, int tid, unsigned (&go)[2][2], const LAS le_t*) const {
#pragma unroll
        for (int i = 0; i < 2; ++i) { int R, C; stage_rc(tid * 16 + i * 8192, R, C);
#pragma unroll
            for (int h = 0; h < 2; ++h) go[h][i] = (unsigned)((h * HALF + R) * KK + C) * 2u; }
    }
};
constexpr int KU8 = 512;
template <bool GU> struct MoeSched {
    const bf16_t* A; const bf16_t* Bt; const le_t* list; const float* bias; const LAS int* tab; int nN, nwg, G, c;
    __device__ __forceinline__ void init(const bf16_t* A_, const bf16_t* Bt_, const le_t* list_, const float* bias_, const LAS int* tab_, int G_, int c_) { A = A_; Bt = Bt_; list = list_; bias = bias_; tab = tab_; nN = GU ? 8 : 4; nwg = __builtin_amdgcn_readfirstlane(tab_[32 + 32]) * nN; G = G_; c = c_; }
    __device__ __forceinline__ bool next(int i, Unit& u) const {
        const int L = i * G + c; if (L >= nwg) return false;
        const int wgid = xcd_remap(L, nwg);
        int ln = (int)(threadIdx.x & 31u); asm volatile("" : "+v"(ln));
        const unsigned long long bal = __ballot(tab[32 + ln] * nN <= wgid);
        const int e = 31 - __builtin_clz((unsigned)(bal & 0xffffffffull));
        const int tb0 = tab[32 + e], T = tab[32 + e + 1] - tb0, local = wgid - tb0 * nN;
        int rows = tab[e] - (local % T) * 256; if (rows > 256) rows = 256;
        u.e = __builtin_amdgcn_readfirstlane(e); u.pm = __builtin_amdgcn_readfirstlane(local % T); u.pn = __builtin_amdgcn_readfirstlane(local / T); u.rows = __builtin_amdgcn_readfirstlane(rows); u.arow = __builtin_amdgcn_readfirstlane((tb0 + local % T) * 256); return true;
    }
    __device__ __forceinline__ const char* a_base(const Unit& u) const { return GU ? (const char*)A : (const char*)A + (size_t)u.arow * (KU8 * 2); }
    __device__ __forceinline__ const char* b_base(const Unit& u) const { return (const char*)Bt + ((size_t)u.e * (GU ? 2048 : 1024) + (size_t)u.pn * 256) * (KU8 * 2); }
    static constexpr bool MB = true;
    __device__ __forceinline__ void mb_issue(LAS unsigned char* mb, const Unit& u, int wid, int lane) const {
        asm volatile("" : "+v"(lane));
        if (wid < 4) __builtin_amdgcn_global_load_lds((const unsigned*)(list + u.e * LISTCAP + u.pm * 256 + wid * 64 + lane), (LAS unsigned*)(mb + wid * 1024), 16, 0, 0);
        else if (wid == 4) {
            const float* bp = GU ? bias + (size_t)u.e * 2048 + u.pn * 128 + (lane >> 5) * 1024 + (lane & 31) * 4 : bias + (size_t)u.e * 1024 + u.pn * 256 + lane * 4;
            __builtin_amdgcn_global_load_lds((const unsigned*)bp, (LAS unsigned*)(mb + 4096), 16, 0, 0); }
    }
    __device__ __forceinline__ void a_offs(const Unit& u, int tid, unsigned (&go)[2][2], const LAS le_t* mb) const {
#pragma unroll
        for (int i = 0; i < 2; ++i) { int R, C; stage_rc(tid * 16 + i * 8192, R, C);
#pragma unroll
            for (int h = 0; h < 2; ++h) {
                if (GU) { const int r = h * HALF + R; const int raw = mb[r].x; const int tok = r < u.rows ? (raw >> 2) : NTOK; go[h][i] = (unsigned)(tok * KU8 + C) * 2u; }
                else go[h][i] = (unsigned)((h * HALF + R) * KU8 + C) * 2u;
            } }
    }
};

struct EpiBf16 {
    static constexpr bool PERM = true, HAS_INIT = false, AFTER_DRAIN = false;
    bf16_t* O; int ldc;
    __device__ __forceinline__ void operator()(const f32x4 (&acc)[2][2][4][2], const Unit& u, int wr, int wc, int fr, int fq, const LAS le_t*) const {
        const int row0 = u.pm * BM + wr * 64 + fr, col0 = u.pn * BM + wc * 32 + 8 * fq;
#pragma unroll
        for (int ai = 0; ai < 2; ++ai)
#pragma unroll
            for (int m = 0; m < 4; ++m) { bf16_t* rowp = O + (size_t)(row0 + ai * HALF + m * 16) * ldc + col0;
#pragma unroll
                for (int bj = 0; bj < 2; ++bj) { const f32x4 v0 = acc[ai][bj][m][0], v1 = acc[ai][bj][m][1];
                    u32x4 w; w.x = cvt_pk_bf16(v0[0], v0[1]); w.y = cvt_pk_bf16(v0[2], v0[3]); w.z = cvt_pk_bf16(v1[0], v1[1]); w.w = cvt_pk_bf16(v1[2], v1[3]);
                    *(u32x4*)(rowp + bj * HALF) = w; } }
    }
};
struct EpiX1 {
    static constexpr bool PERM = true, HAS_INIT = true, AFTER_DRAIN = true;
    const float* base; float* C; float* ssq; float* PL; unsigned char* H8; const float* nw; const bf16_t* wrh; const bf16_t* wrl;
    bool one;
    __device__ __forceinline__ void init_acc(f32x4 (&acc)[2][2][4][2], const Unit& u, int wr, int wc, int fr, int fq) const {
        const int row0 = u.pm * BM + wr * 64 + fr, col0 = u.pn * BM + wc * 32 + 8 * fq;
#pragma unroll
        for (int ai = 0; ai < 2; ++ai)
#pragma unroll
            for (int m = 0; m < 4; ++m) { const size_t off = (size_t)(row0 + ai * HALF + m * 16) * D + col0;
#pragma unroll
                for (int bj = 0; bj < 2; ++bj)
#pragma unroll
                    for (int n = 0; n < 2; ++n) acc[ai][bj][m][n] = *(const f32x4*)(base + off + bj * HALF + n * 4); }
    }
    __device__ __forceinline__ void operator()(const f32x4 (&acc)[2][2][4][2], const Unit& u, int wr, int wc, int fr, int fq, const LAS le_t*) const {
        const int row0 = u.pm * BM + wr * 64 + fr, col0 = u.pn * BM + wc * 32 + 8 * fq, p = u.pn * 4 + wc;
        f32x4 wv[2][2]; bf16x8 fh[2][2], fl[2][2];
#pragma unroll
        for (int bj = 0; bj < 2; ++bj) { wv[bj][0] = *(const f32x4*)(nw + col0 + bj * HALF); wv[bj][1] = *(const f32x4*)(nw + col0 + bj * HALF + 4);
#pragma unroll
            for (int et = 0; et < 2; ++et) { fh[bj][et] = *(const bf16x8*)(wrh + (16 * et + fr) * 1024 + col0 + bj * HALF); fl[bj][et] = *(const bf16x8*)(wrl + (16 * et + fr) * 1024 + col0 + bj * HALF); } }
        float* sp = ssq + (size_t)p * NTOK; float* plp = PL + (size_t)p * NTOK * 32 + 4 * fq;
#pragma unroll
        for (int ai = 0; ai < 2; ++ai)
#pragma unroll
            for (int m = 0; m < 4; ++m) { const int row = row0 + ai * HALF + m * 16; const size_t off = (size_t)row * D + col0; float s2 = 0.f;
                f32x4 pl0 = (f32x4){0.f, 0.f, 0.f, 0.f}, pl1 = pl0;
#pragma unroll
                for (int bj = 0; bj < 2; ++bj) { const f32x4 v0 = acc[ai][bj][m][0], v1 = acc[ai][bj][m][1];
                    { u32x4 xb; xb.x = cvt_pk_bf16(v0[0], v0[1]); xb.y = cvt_pk_bf16(v0[2], v0[3]); xb.z = cvt_pk_bf16(v1[0], v1[1]); xb.w = cvt_pk_bf16(v1[2], v1[3]);
                      *(u32x4*)((bf16_t*)(C + (size_t)row * D) + col0 + bj * HALF) = xb; }
                    s2 += (v0[0] * v0[0] + v0[1] * v0[1]) + (v0[2] * v0[2] + v0[3] * v0[3]) + (v1[0] * v1[0] + v1[1] * v1[1]) + (v1[2] * v1[2] + v1[3] * v1[3]);
                    const f32x4 h0 = v0 * wv[bj][0], h1 = v1 * wv[bj][1];
                    u32x4 hh, hl;
                    hh.x = cvt_pk_bf16(h0[0], h0[1]); hh.y = cvt_pk_bf16(h0[2], h0[3]); hh.z = cvt_pk_bf16(h1[0], h1[1]); hh.w = cvt_pk_bf16(h1[2], h1[3]);
                    hl.x = cvt_pk_bf16(h0[0] - bf_lo(hh.x), h0[1] - bf_hi(hh.x)); hl.y = cvt_pk_bf16(h0[2] - bf_lo(hh.y), h0[3] - bf_hi(hh.y));
                    hl.z = cvt_pk_bf16(h1[0] - bf_lo(hh.z), h1[1] - bf_hi(hh.z)); hl.w = cvt_pk_bf16(h1[2] - bf_lo(hh.w), h1[3] - bf_hi(hh.w));
                    u32x2 h8; h8.x = cvt4_fp8(h0[0], h0[1], h0[2], h0[3]); h8.y = cvt4_fp8(h1[0], h1[1], h1[2], h1[3]);
                    *(u32x2*)(H8 + off + bj * HALF) = h8;
                    const bf16x8 bhh = __builtin_bit_cast(bf16x8, hh), bhl = __builtin_bit_cast(bf16x8, hl);
                    pl0 = mfma16(fh[bj][0], bhh, pl0); pl0 = mfma16(fh[bj][0], bhl, pl0); pl0 = mfma16(fl[bj][0], bhh, pl0);
                    pl1 = mfma16(fh[bj][1], bhh, pl1); pl1 = mfma16(fh[bj][1], bhl, pl1); pl1 = mfma16(fl[bj][1], bhh, pl1); }
                s2 += __shfl_xor(s2, 16); s2 += __shfl_xor(s2, 32);
                if (fq == 0) sp[row] = s2;
                *(f32x4*)(plp + (size_t)row * 32) = pl0; *(f32x4*)(plp + (size_t)row * 32 + 16) = pl1; }
    }
    __device__ __forceinline__ void fused(const f32x4 (&acc)[2][2][4][2], const Unit& u, int wr, int wc, int fr, int fq, LAS unsigned char* lds, int tid) const {
        const int row0 = u.pm * BM + wr * 64 + fr, col0 = u.pn * BM + wc * 32 + 8 * fq;
        f32x4 wv[2][2]; bf16x8 fh[2][2], fl[2][2];
#pragma unroll
        for (int bj = 0; bj < 2; ++bj) { wv[bj][0] = *(const f32x4*)(nw + col0 + bj * HALF); wv[bj][1] = *(const f32x4*)(nw + col0 + bj * HALF + 4);
#pragma unroll
            for (int et = 0; et < 2; ++et) { fh[bj][et] = *(const bf16x8*)(wrh + (16 * et + fr) * 1024 + col0 + bj * HALF); fl[bj][et] = *(const bf16x8*)(wrl + (16 * et + fr) * 1024 + col0 + bj * HALF); } }
        LAS float* PLs = (LAS float*)lds + wc * (256 * 32); LAS float* SSs = (LAS float*)(lds + MB_OFF) + wc * 256;
#pragma unroll
        for (int ai = 0; ai < 2; ++ai)
#pragma unroll
            for (int m = 0; m < 4; ++m) { const int rl = ai * HALF + wr * 64 + m * 16 + fr, row = u.pm * BM + rl; const size_t off = (size_t)row * D + col0; float s2 = 0.f;
                f32x4 pl0 = (f32x4){0.f, 0.f, 0.f, 0.f}, pl1 = pl0;
#pragma unroll
                for (int bj = 0; bj < 2; ++bj) { const f32x4 v0 = acc[ai][bj][m][0], v1 = acc[ai][bj][m][1];
                    { u32x4 xb; xb.x = cvt_pk_bf16(v0[0], v0[1]); xb.y = cvt_pk_bf16(v0[2], v0[3]); xb.z = cvt_pk_bf16(v1[0], v1[1]); xb.w = cvt_pk_bf16(v1[2], v1[3]);
                      *(u32x4*)((bf16_t*)(C + (size_t)row * D) + col0 + bj * HALF) = xb; }
                    s2 += (v0[0] * v0[0] + v0[1] * v0[1]) + (v0[2] * v0[2] + v0[3] * v0[3]) + (v1[0] * v1[0] + v1[1] * v1[1]) + (v1[2] * v1[2] + v1[3] * v1[3]);
                    const f32x4 h0 = v0 * wv[bj][0], h1 = v1 * wv[bj][1];
                    u32x4 hh, hl;
                    hh.x = cvt_pk_bf16(h0[0], h0[1]); hh.y = cvt_pk_bf16(h0[2], h0[3]); hh.z = cvt_pk_bf16(h1[0], h1[1]); hh.w = cvt_pk_bf16(h1[2], h1[3]);
                    hl.x = cvt_pk_bf16(h0[0] - bf_lo(hh.x), h0[1] - bf_hi(hh.x)); hl.y = cvt_pk_bf16(h0[2] - bf_lo(hh.y), h0[3] - bf_hi(hh.y));
                    hl.z = cvt_pk_bf16(h1[0] - bf_lo(hh.z), h1[1] - bf_hi(hh.z)); hl.w = cvt_pk_bf16(h1[2] - bf_lo(hh.w), h1[3] - bf_hi(hh.w));
                    u32x2 h8; h8.x = cvt4_fp8(h0[0], h0[1], h0[2], h0[3]); h8.y = cvt4_fp8(h1[0], h1[1], h1[2], h1[3]);
                    *(u32x2*)(H8 + off + bj * HALF) = h8;
                    const bf16x8 bhh = __builtin_bit_cast(bf16x8, hh), bhl = __builtin_bit_cast(bf16x8, hl);
                    pl0 = mfma16(fh[bj][0], bhh, pl0); pl0 = mfma16(fh[bj][0], bhl, pl0); pl0 = mfma16(fl[bj][0], bhh, pl0);
                    pl1 = mfma16(fh[bj][1], bhh, pl1); pl1 = mfma16(fh[bj][1], bhl, pl1); pl1 = mfma16(fl[bj][1], bhh, pl1); }
                s2 += __shfl_xor(s2, 16); s2 += __shfl_xor(s2, 32);
                if (fq == 0) SSs[rl] = s2;
                *(LAS f32x4*)(PLs + rl * 32 + 4 * (fq ^ (rl & 7))) = pl0; *(LAS f32x4*)(PLs + rl * 32 + 4 * ((4 + fq) ^ (rl & 7))) = pl1; }
        asm volatile("s_waitcnt lgkmcnt(0)" ::: "memory"); __builtin_amdgcn_s_barrier(); asm volatile("" ::: "memory");
        {
            const int rl = tid >> 1, hf = tid & 1, row = u.pm * BM + rl;
            f32x4 sum[4];
#pragma unroll
            for (int q = 0; q < 4; ++q) { sum[q] = (f32x4){0.f, 0.f, 0.f, 0.f};
#pragma unroll
                for (int c4 = 0; c4 < 4; ++c4) sum[q] += *(const LAS f32x4*)((const LAS float*)lds + c4 * (256 * 32) + rl * 32 + 4 * ((4 * hf + q) ^ (rl & 7))); }
            float* dst = PL + ((size_t)u.pn * NTOK + row) * 32 + 16 * hf;
#pragma unroll
            for (int q = 0; q < 4; ++q) *(f32x4*)(dst + 4 * q) = sum[q];
            if (hf == 0) { const LAS float* S0 = (const LAS float*)(lds + MB_OFF); ssq[(size_t)u.pn * NTOK + row] = ((S0[rl] + S0[256 + rl]) + S0[512 + rl]) + S0[768 + rl]; }
        }
    }
};
constexpr float WSCL = 1.0f / 32.0f;
__device__ __forceinline__ float swiglu(float g, float l) {
    g = fminf(g, 7.0f); l = fminf(fmaxf(l, -7.0f), 7.0f);
    const float s = __builtin_amdgcn_rcpf(1.0f + __builtin_amdgcn_exp2f(-1.702f * 1.4426950408889634f * g));
    return g * s * (l + 1.0f);
}
struct EpiGU {
    static constexpr bool PERM = true, HAS_INIT = false, AFTER_DRAIN = false;
    unsigned char* ACT;
    __device__ __forceinline__ void operator()(const f32x4 (&acc)[2][2][4][2], const Unit& u, int wr, int wc, int fr, int fq, const LAS le_t* mb) const {
        const int row0 = u.arow + wr * 64 + fr, cl = wc * 32 + 8 * fq, colg = u.pn * 128 + cl;
        const LAS float* bl = (const LAS float*)mb + 1024 + cl;
        const f32x4 bg0 = *(const LAS f32x4*)(bl), bg1 = *(const LAS f32x4*)(bl + 4), bl0 = *(const LAS f32x4*)(bl + 128), bl1 = *(const LAS f32x4*)(bl + 128 + 4);
        int rb = wr * 64 + fr; asm volatile("" : "+v"(rb));
#pragma unroll
        for (int ai = 0; ai < 2; ++ai)
#pragma unroll
            for (int m = 0; m < 4; ++m) {
                const float rs = __int_as_float(mb[ai * HALF + m * 16 + rb].z) * WSCL;
                const f32x4 g0 = acc[ai][0][m][0] * rs + bg0, g1 = acc[ai][0][m][1] * rs + bg1, l0 = acc[ai][1][m][0] * rs + bl0, l1 = acc[ai][1][m][1] * rs + bl1;
                u32x2 w; w.x = cvt4_fp8(swiglu(g0[0], l0[0]), swiglu(g0[1], l0[1]), swiglu(g0[2], l0[2]), swiglu(g0[3], l0[3]));
                w.y = cvt4_fp8(swiglu(g1[0], l1[0]), swiglu(g1[1], l1[1]), swiglu(g1[2], l1[2]), swiglu(g1[3], l1[3]));
                *(u32x2*)(ACT + (size_t)(row0 + ai * HALF + m * 16) * FF + colg) = w; }
    }
};
struct EpiDown {
    static constexpr bool PERM = true, HAS_INIT = false, AFTER_DRAIN = false;
    unsigned char* Y;
    __device__ __forceinline__ void operator()(const f32x4 (&acc)[2][2][4][2], const Unit& u, int wr, int wc, int fr, int fq, const LAS le_t* mb) const {
        const int cl = wc * 32 + 8 * fq, col0 = u.pn * BM + cl;
        const LAS float* bl = (const LAS float*)mb + 1024 + cl;
        int rb = wr * 64 + fr; asm volatile("" : "+v"(rb));
#pragma unroll
        for (int bj = 0; bj < 2; ++bj) {
            const f32x4 b0 = *(const LAS f32x4*)(bl + bj * HALF), b1 = *(const LAS f32x4*)(bl + bj * HALF + 4);
#pragma unroll
            for (int ai = 0; ai < 2; ++ai)
#pragma unroll
                for (int m = 0; m < 4; ++m) { const int r = ai * HALF + m * 16 + rb;
                    if (r < u.rows) { const le_t sg = mb[r]; const int slot = sg.x; const float gt = __int_as_float(sg.y) * 16.0f;
                        const f32x4 v0 = (acc[ai][bj][m][0] * WSCL + b0) * gt, v1 = (acc[ai][bj][m][1] * WSCL + b1) * gt;
                        u32x2 w; w.x = cvt4_fp8(v0[0], v0[1], v0[2], v0[3]); w.y = cvt4_fp8(v1[0], v1[1], v1[2], v1[3]);
                        *(u32x2*)(Y + (size_t)slot * D + col0 + bj * HALF) = w; } }
        }
    }
};

typedef int i32x4 __attribute__((ext_vector_type(4)));
__device__ __forceinline__ bf16x8 lo8(i32x8 a) { return __builtin_bit_cast(bf16x8, __builtin_shufflevector(a, a, 0, 1, 2, 3)); }
__device__ __forceinline__ bf16x8 hi8(i32x8 a) { return __builtin_bit_cast(bf16x8, __builtin_shufflevector(a, a, 4, 5, 6, 7)); }
__device__ __forceinline__ void glds_s(unsigned voff, const char* sbase, unsigned lds_dst) { unsigned keep;
    asm volatile("s_mov_b32 %0, m0\n\ts_mov_b32 m0, %2\n\ts_nop 0\n\tglobal_load_lds_dwordx4 %1, %3\n\ts_mov_b32 m0, %0" : "=&s"(keep) : "v"(voff), "s"(lds_dst), "s"(sbase) : "memory"); }
template <class Epi, class Sched, bool ALIGN_EPI, bool FP8 = false>
__device__ __forceinline__ void gemm_phase(LAS unsigned char* lds, const Sched& S, const Epi& E) {
    const int tid = threadIdx.x, wid = __builtin_amdgcn_readfirstlane(tid >> 6), lane = tid & 63, wr = wid >> 2, wc = wid & 3, fr = lane & 15, fq = lane >> 4;
    constexpr int K = FP8 ? 512 : KK;
    int nt = K / BK; asm volatile("" : "+s"(nt));
    unsigned voffB[2];
#pragma unroll
    for (int i = 0; i < 2; ++i) { int R, C; stage_rc(tid * 16 + i * 8192, R, C); const int Rb = Epi::PERM ? ((R & ~31) + perm32(R & 31)) : R;
        voffB[i] = (unsigned)(Rb * K + C) * 2u; }
    constexpr size_t kstep = (size_t)(BK * 2);
    constexpr size_t hstep = (size_t)HALF * K * 2;
    const unsigned ldsw = (unsigned)wid * 1024u;
    const unsigned ldsb = (unsigned)__builtin_amdgcn_readfirstlane((int)((unsigned)(size_t)lds + ldsw));
    const int aoff = lds_byte(wr * 64 + fr, fq * 8), boff = lds_byte(wc * 32 + fr, fq * 8);
#define PG8_SA(b, h) (((b) * 2 + (h)) * HTB)
#define PG8_SB(b, h) ((4 + (b) * 2 + (h)) * HTB)
#define PG8_STAGE(bufoff, gbase, voff) do { _Pragma("unroll") for (int _i = 0; _i < 2; ++_i) glds_s((voff)[_i], (const char*)(gbase), ldsb + (unsigned)((bufoff) + _i * 8192)); } while (0)
#define PG8_LDA(dst, b, h) do { _Pragma("unroll") for (int m = 0; m < 4; ++m) { const u32x4 _x = *(const LAS u32x4*)(lds + PG8_SA(b, h) + aoff + m * 2048), _y = *(const LAS u32x4*)(lds + PG8_SA(b, h) + aoff + m * 2048 + 1024); \
        dst[m] = (i32x8){(int)_x[0], (int)_x[1], (int)_x[2], (int)_x[3], (int)_y[0], (int)_y[1], (int)_y[2], (int)_y[3]}; } } while (0)
#define PG8_LDB(dst, b, h) do { _Pragma("unroll") for (int n = 0; n < 2; ++n) { const u32x4 _x = *(const LAS u32x4*)(lds + PG8_SB(b, h) + boff + n * 2048), _y = *(const LAS u32x4*)(lds + PG8_SB(b, h) + boff + n * 2048 + 1024); \
        dst[n] = (i32x8){(int)_x[0], (int)_x[1], (int)_x[2], (int)_x[3], (int)_y[0], (int)_y[1], (int)_y[2], (int)_y[3]}; } } while (0)
#define PG8_MMA(ai, bj, At, Bt) do { __builtin_amdgcn_s_setprio(1); _Pragma("unroll") for (int m = 0; m < 4; ++m) _Pragma("unroll") for (int n = 0; n < 2; ++n) { \
        if constexpr (FP8) { acc[ai][bj][m][n] = __builtin_amdgcn_mfma_scale_f32_16x16x128_f8f6f4(Bt[n], At[m], acc[ai][bj][m][n], 0, 0, 0, 0, 0, 0); } \
        else { acc[ai][bj][m][n] = __builtin_amdgcn_mfma_f32_16x16x32_bf16(lo8(Bt[n]), lo8(At[m]), acc[ai][bj][m][n], 0, 0, 0); acc[ai][bj][m][n] = __builtin_amdgcn_mfma_f32_16x16x32_bf16(hi8(Bt[n]), hi8(At[m]), acc[ai][bj][m][n], 0, 0, 0); } } __builtin_amdgcn_s_setprio(0); } while (0)
#define PG8_WAIT_V(n) asm volatile("s_waitcnt vmcnt(" #n ")" ::: "memory")
#define PG8_WAIT_L(n) asm volatile("s_waitcnt lgkmcnt(" #n ")" ::: "memory")
#define PG8_BAR __builtin_amdgcn_s_barrier()
#define PG8_SCHED __builtin_amdgcn_sched_barrier(0)
    Unit cur, nxt; int ui = 0;
    if (!S.next(0, cur)) return;
    f32x4 acc[2][2][4][2];
    if constexpr (Epi::HAS_INIT) E.init_acc(acc, cur, wr, wc, fr, fq);
    else {
#pragma unroll
    for (int a = 0; a < 2; ++a)
#pragma unroll
        for (int b = 0; b < 2; ++b)
#pragma unroll
            for (int m = 0; m < 4; ++m)
#pragma unroll
                for (int n = 0; n < 2; ++n) acc[a][b][m][n] = (f32x4){0.f, 0.f, 0.f, 0.f};
    }
    i32x8 At[4], B0[2], B1[2];
    const char* cA = S.a_base(cur); const char* cB = S.b_base(cur);
    unsigned go[2][2];
    LAS unsigned char* const mbx = lds + (MB_OFF - 0);
    if constexpr (Sched::MB) { S.mb_issue(mbx, cur, wid, lane); asm volatile("s_waitcnt vmcnt(0)" ::: "memory"); __builtin_amdgcn_s_barrier(); asm volatile("" ::: "memory"); }
    { int t2 = tid; asm volatile("" : "+v"(t2)); S.a_offs(cur, t2, go, (const LAS le_t*)mbx); }
    PG8_STAGE(PG8_SB(0, 0), cB, voffB); PG8_STAGE(PG8_SB(0, 1), cB + hstep, voffB); PG8_STAGE(PG8_SA(0, 0), cA, go[0]); PG8_STAGE(PG8_SA(0, 1), cA, go[1]);
    if (wr == 1) PG8_BAR;
    PG8_WAIT_V(2); PG8_BAR;
    PG8_STAGE(PG8_SB(1, 0), cB + kstep, voffB); PG8_STAGE(PG8_SA(1, 0), cA + kstep, go[0]); PG8_STAGE(PG8_SB(1, 1), cB + hstep + kstep, voffB);
    PG8_WAIT_V(6); PG8_BAR;
    asm volatile("" : "+v"(voffB[0]), "+v"(voffB[1]), "+v"(go[0][0]), "+v"(go[0][1]), "+v"(go[1][0]), "+v"(go[1][1]));
    for (;;) {
        const bool has_next = S.next(ui + 1, nxt);
        const char* nA = has_next ? S.a_base(nxt) : cA; const char* nB = has_next ? S.b_base(nxt) : cB;
#pragma clang loop unroll(disable)
        for (int t = 0; t < nt; t += 2) {
            const bool last = (t == nt - 2);
            asm volatile("" : "+v"(voffB[0]), "+v"(voffB[1]));
            const char* a1 = cA + (size_t)(t + 1) * kstep;
            const char* a2 = last ? nA : cA + (size_t)(t + 2) * kstep; const char* b2 = last ? nB : cB + (size_t)(t + 2) * kstep;
            const char* a3 = a2 + kstep; const char* b3 = b2 + kstep;
            PG8_LDB(B0, 0, 0); PG8_LDB(B1, 0, 1); PG8_SCHED; PG8_LDA(At, 0, 0); PG8_STAGE(PG8_SA(1, 1), a1, go[1]);
            if (last && has_next) { int t2 = tid; asm volatile("" : "+v"(t2)); S.a_offs(nxt, t2, go, (const LAS le_t*)(mbx + ((ui + 1) & 1) * 5120)); }
            PG8_WAIT_V(8); PG8_WAIT_L(0); PG8_BAR; PG8_MMA(0, 0, At, B0); PG8_MMA(0, 1, At, B1); PG8_BAR; PG8_SCHED;
            if constexpr (Sched::MB) { if (t == 0 && has_next) S.mb_issue(mbx + ((ui + 1) & 1) * 5120, nxt, wid, lane); }
            PG8_LDA(At, 0, 1); PG8_STAGE(PG8_SB(0, 0), b2, voffB); PG8_STAGE(PG8_SB(0, 1), b2 + hstep, voffB); PG8_STAGE(PG8_SA(0, 0), a2, go[0]);
            PG8_WAIT_V(8); PG8_WAIT_L(0); PG8_BAR; PG8_MMA(1, 0, At, B0); PG8_MMA(1, 1, At, B1); PG8_BAR; PG8_SCHED;
            PG8_LDB(B0, 1, 0); PG8_LDB(B1, 1, 1); PG8_SCHED; PG8_LDA(At, 1, 0); PG8_STAGE(PG8_SA(0, 1), a2, go[1]);
            PG8_WAIT_V(8); PG8_WAIT_L(0); PG8_BAR; PG8_MMA(0, 0, At, B0); PG8_MMA(0, 1, At, B1); PG8_BAR; PG8_SCHED;
            PG8_LDA(At, 1, 1); PG8_STAGE(PG8_SB(1, 0), b3, voffB); PG8_STAGE(PG8_SB(1, 1), b3 + hstep, voffB); PG8_STAGE(PG8_SA(1, 0), a3, go[0]);
            PG8_WAIT_V(8); PG8_WAIT_L(0); PG8_BAR; PG8_MMA(1, 0, At, B0); PG8_MMA(1, 1, At, B1); PG8_BAR; PG8_SCHED;
        }
        if constexpr (ALIGN_EPI) { if (wr == 0) PG8_BAR; }
        bool epi_now = true; if constexpr (Epi::AFTER_DRAIN) epi_now = !E.one;
        if (epi_now) { int t2 = tid; asm volatile("" : "+v"(t2)); const int l2 = t2 & 63; E(acc, cur, wr, wc, l2 & 15, l2 >> 4, (const LAS le_t*)(mbx + (ui & 1) * 5120)); }
        if (!has_next) break;
        if constexpr (Epi::HAS_INIT) { int t2 = tid; asm volatile("" : "+v"(t2)); const int l2 = t2 & 63; E.init_acc(acc, nxt, wr, wc, l2 & 15, l2 >> 4); }
        else {
#pragma unroll
        for (int a = 0; a < 2; ++a)
#pragma unroll
            for (int b = 0; b < 2; ++b)
#pragma unroll
                for (int m = 0; m < 4; ++m)
#pragma unroll
                    for (int n = 0; n < 2; ++n) acc[a][b][m][n] = (f32x4){0.f, 0.f, 0.f, 0.f};
        }
        cur = nxt; cA = nA; cB = nB; ++ui;
        if constexpr (ALIGN_EPI) { if (wr == 1) PG8_BAR; }
    }
    PG8_WAIT_V(0);
    if constexpr (!ALIGN_EPI) { if (wr == 0) PG8_BAR; }
    PG8_BAR;
    if constexpr (Epi::AFTER_DRAIN) { if (E.one) { int t2 = tid; asm volatile("" : "+v"(t2)); const int l2 = t2 & 63; E.fused(acc, cur, wr, wc, l2 & 15, l2 >> 4, lds, t2); } }
#undef PG8_SA
#undef PG8_SB
#undef PG8_STAGE
#undef PG8_LDA
#undef PG8_LDB
#undef PG8_MMA
#undef PG8_WAIT_V
#undef PG8_WAIT_L
#undef PG8_BAR
#undef PG8_SCHED
}
}

#define XB_TMO      128
#define XB_XCNT(j)  (256  + 64 * (j))
#define XB_XSUB(j)  (1280 + 64 * (j))
#define XB_XGEN(j)  (2304 + 64 * (j))
#define XB_TOP      3328
#define XB_TOPGEN   3392
#define XCD_BAR_WORDS 3456
#define XB_SPIN_CAP (1u << 18)
__device__ __forceinline__ unsigned xb_ld(unsigned* p)              { return __hip_atomic_load(p, __ATOMIC_RELAXED, __HIP_MEMORY_SCOPE_AGENT); }
__device__ __forceinline__ unsigned xb_add(unsigned* p, unsigned v) { return __hip_atomic_fetch_add(p, v, __ATOMIC_RELAXED, __HIP_MEMORY_SCOPE_AGENT); }
__device__ __forceinline__ unsigned xb_xcc_id() { return (unsigned)__builtin_amdgcn_s_getreg((3 << 11) | 20) & 0xFu; }
#define XB_SPIN(cond, bar) do { unsigned _sp = 0; while (cond) { __builtin_amdgcn_s_sleep(1); \
    if ((++_sp & 255u) == 0u) { if (xb_ld(&(bar)[XB_TMO])) break; if (_sp > XB_SPIN_CAP) { atomicAdd(&(bar)[XB_TMO], 1u); break; } } } } while (0)
struct XcdBarrier { unsigned* bar; unsigned x; volatile LAS unsigned* st; };
__device__ __forceinline__ XcdBarrier xcd_barrier_post(unsigned* bar, volatile LAS unsigned* st) {
    XcdBarrier b; b.bar = bar; b.x = xb_xcc_id(); b.st = st;
    if (threadIdx.x == 0) (void)xb_add(&bar[XB_XCNT(b.x)], 1u);
    return b;
}
__device__ __forceinline__ void xcd_barrier_complete(unsigned* bar, unsigned x, unsigned& nloc, unsigned& nx) {
    const unsigned G = gridDim.x * gridDim.y * gridDim.z;
    unsigned sum, cnt, mine, sp = 0u;
    for (;;) {
        sum = 0u; cnt = 0u; mine = 0u;
#pragma unroll
        for (unsigned j = 0; j < 16; ++j) { const unsigned c = xb_ld(&bar[XB_XCNT(j)]); sum += c; cnt += (c > 0u) ? 1u : 0u; mine = (j == x) ? c : mine; }
        if (sum == G) break;
        __builtin_amdgcn_s_sleep(1);
        if ((++sp & 255u) == 0u) { if (xb_ld(&bar[XB_TMO])) break; if (sp > XB_SPIN_CAP) { atomicAdd(&bar[XB_TMO], 1u); break; } }
    }
    nloc = mine > 0u ? mine : 1u; nx = cnt > 0u ? cnt : 1u;
}
__device__ __forceinline__ void xcd_barrier(const XcdBarrier& b) {
    asm volatile("s_waitcnt vmcnt(0)" ::: "memory");
    __syncthreads();
    if (threadIdx.x == 0) {
        unsigned* bar = b.bar;
        __builtin_amdgcn_s_waitcnt(0);
        unsigned nloc = b.st[0], nx = b.st[1];
        if (nloc == 0u) { xcd_barrier_complete(bar, b.x, nloc, nx); b.st[0] = nloc; b.st[1] = nx; }
        const unsigned old = xb_add(&bar[XB_XSUB(b.x)], 1u);
        const unsigned gen = old / nloc;
        if (old + 1u == (gen + 1u) * nloc) {
            __builtin_amdgcn_fence(__ATOMIC_RELEASE, "agent");
            asm volatile("s_waitcnt vmcnt(0)" ::: "memory");
            const unsigned og = xb_add(&bar[XB_TOP], 1u);
            const unsigned tg = og / nx;
            if (og + 1u == (tg + 1u) * nx) xb_add(&bar[XB_TOPGEN], 1u);
            else XB_SPIN(xb_ld(&bar[XB_TOPGEN]) == tg, bar);
            __builtin_amdgcn_fence(__ATOMIC_ACQUIRE, "agent");
            xb_add(&bar[XB_XGEN(b.x)], 1u);
            asm volatile("s_waitcnt vmcnt(0)" ::: "memory");
        } else {
            XB_SPIN(xb_ld(&bar[XB_XGEN(b.x)]) == gen, bar);
            __builtin_amdgcn_fence(__ATOMIC_ACQUIRE, "agent");
            asm volatile("s_waitcnt vmcnt(0)" ::: "memory");
        }
    }
    __syncthreads();
}

struct Frame {
    LAS unsigned char* lds;
    volatile LAS unsigned* MISC;
    gu32* ctl;
    int tid, lane, wave, vcu, G;
    const float *x, *norm_mix_w, *w_in, *ret_norm_w, *w_pool, *pool_scale, *w_out, *norm_ffn_w, *w_router, *b_router, *w_gu, *b_gu, *w_down, *b_down, *norm_final_w;
    float* out;
    bf16_t *Wr_hi, *Wr_lo, *Wpool_t, *Win_t, *Wout_t, *XN, *CAT, *U, *Z, *Y;
    unsigned char *Wgu8, *Wd8, *ACT8, *H8;
    le_t* list; float* ssq; float* PL;
    float lg2g0, lg2g1, lg2g2, lg2g3;
    __device__ __forceinline__ float lg2(int h) const { return h == 0 ? lg2g0 : (h == 1 ? lg2g1 : (h == 2 ? lg2g2 : lg2g3)); }
};

template <int MODE>
__device__ __forceinline__ void p0_item(const float* W, int ldw, void* WT, void* WT2, int ldo, LAS float* scr, int k0, int n0, int orow0, int lane) {
    f32x4 v[16];
    const float* src = W + (size_t)(k0 + (lane >> 3)) * ldw + n0 + 4 * (lane & 7);
#pragma unroll
    for (int i = 0; i < 16; ++i) v[i] = *(const GAS f32x4*)(src + (size_t)(8 * i) * ldw);
#pragma unroll
    for (int i = 0; i < 16; ++i) *(LAS f32x4*)(scr + (8 * i + (lane >> 3)) * 32 + 4 * ((lane & 7) ^ (i & 7))) = v[i];
    LDS_WAIT(); asm volatile("" ::: "memory");
    const int c = lane & 15, ns = lane >> 4;
#pragma unroll
    for (int J = 0; J < 8; ++J) {
        const LAS float* sp = scr + (8 * c) * 32 + 4 * (J ^ (c & 7)) + ns;
        float x[8];
#pragma unroll
        for (int q = 0; q < 8; ++q) x[q] = sp[q * 32];
        const int n = 4 * J + ns;
        if (MODE == 2) { u32x2 o; o.x = cvt4_fp8(x[0] * 32.f, x[1] * 32.f, x[2] * 32.f, x[3] * 32.f); o.y = cvt4_fp8(x[4] * 32.f, x[5] * 32.f, x[6] * 32.f, x[7] * 32.f);
            *(GAS u32x2*)((unsigned char*)WT + (size_t)(orow0 + n) * 1024 + k0 + 8 * c) = o; }
        else { u32x4 o; o.x = cvt_pk_bf16(x[0], x[1]); o.y = cvt_pk_bf16(x[2], x[3]); o.z = cvt_pk_bf16(x[4], x[5]); o.w = cvt_pk_bf16(x[6], x[7]);
            *(GAS u32x4*)((bf16_t*)WT + (size_t)(orow0 + n) * ldo + k0 + 8 * c) = o;
            if (MODE == 1) { u32x4 o2; o2.x = cvt_pk_bf16(x[0] - bf_lo(o.x), x[1] - bf_hi(o.x)); o2.y = cvt_pk_bf16(x[2] - bf_lo(o.y), x[3] - bf_hi(o.y));
                o2.z = cvt_pk_bf16(x[4] - bf_lo(o.z), x[5] - bf_hi(o.z)); o2.w = cvt_pk_bf16(x[6] - bf_lo(o.w), x[7] - bf_hi(o.w));
                *(GAS u32x4*)((bf16_t*)WT2 + (size_t)(orow0 + n) * ldo + k0 + 8 * c) = o2; } }
    }
    LDS_WAIT(); asm volatile("" ::: "memory");
}
__device__ __forceinline__ void rms_rows4_to_bf16(int lane, const float* x, const float* w, bf16_t* o, int m, int rs) {
    f32x4 v[4][4];
#pragma unroll
    for (int r = 0; r < 4; ++r) { const GAS f32x4* xr = (const GAS f32x4*)(x + (size_t)(m + r * rs) * D) + lane;
#pragma unroll
        for (int j = 0; j < 4; ++j) v[r][j] = __builtin_nontemporal_load(xr + 64 * j); }
    const GAS f32x4* wr = (const GAS f32x4*)w + lane;
    f32x4 ww[4];
#pragma unroll
    for (int j = 0; j < 4; ++j) ww[j] = wr[64 * j];
#pragma unroll
    for (int r = 0; r < 4; ++r) { float s = 0.f;
#pragma unroll
        for (int j = 0; j < 4; ++j) s += (v[r][j].x * v[r][j].x + v[r][j].y * v[r][j].y) + (v[r][j].z * v[r][j].z + v[r][j].w * v[r][j].w);
        const float rstd = 1.f / sqrtf(wave_sum(s) * (1.f / D) + EPS);
        GAS u32x2* o8 = (GAS u32x2*)(o + (size_t)(m + r * rs) * D) + lane;
#pragma unroll
        for (int j = 0; j < 4; ++j) { u32x2 p; p.x = cvt_pk_bf16(v[r][j].x * rstd * ww[j].x, v[r][j].y * rstd * ww[j].y); p.y = cvt_pk_bf16(v[r][j].z * rstd * ww[j].z, v[r][j].w * rstd * ww[j].w); o8[64 * j] = p; } }
}
template <int MODE, class RM>
__device__ __forceinline__ void p0_block_item(const float* W, int ldw, void* WT, int ldo, LAS float* tile, int k0, int n0, int wave, int lane, RM rowmap) {
    f32x4 v[16];
    const float* src = W + (size_t)(k0 + 16 * wave) * ldw + n0 + 4 * lane;
#pragma unroll
    for (int i = 0; i < 16; ++i) v[i] = __builtin_nontemporal_load((const GAS f32x4*)(src + (size_t)i * ldw));
#pragma unroll
    for (int i = 0; i < 16; ++i) { const int kl = 16 * wave + i; *(LAS f32x4*)(tile + kl * 256 + 4 * (lane ^ ((kl >> 3) & 7))) = v[i]; }
    __syncthreads();
    const int c = lane & 15, ns = lane >> 4;
#pragma unroll
    for (int J = 0; J < 8; ++J) {
        const LAS float* sp = tile + (8 * c) * 256 + 4 * ((8 * wave + J) ^ (c & 7)) + ns;
        float x[8];
#pragma unroll
        for (int q = 0; q < 8; ++q) x[q] = sp[q * 256];
        const int orow = rowmap(n0 + 32 * wave + 4 * J + ns);
        if (MODE == 2) { u32x2 o; o.x = cvt4_fp8(x[0] * 32.f, x[1] * 32.f, x[2] * 32.f, x[3] * 32.f); o.y = cvt4_fp8(x[4] * 32.f, x[5] * 32.f, x[6] * 32.f, x[7] * 32.f);
            __builtin_nontemporal_store(o, (GAS u32x2*)((unsigned char*)WT + (size_t)orow * 1024 + k0 + 8 * c)); }
        else { u32x4 o; o.x = cvt_pk_bf16(x[0], x[1]); o.y = cvt_pk_bf16(x[2], x[3]); o.z = cvt_pk_bf16(x[4], x[5]); o.w = cvt_pk_bf16(x[6], x[7]);
            *(GAS u32x4*)((bf16_t*)WT + (size_t)orow * ldo + k0 + 8 * c) = o; }
    }
    __syncthreads();
}
struct RowId { __device__ __forceinline__ int operator()(int n) const { return n; } };
struct RowGU { __device__ __forceinline__ int operator()(int n) const { const int m = n & 1023; return ((m >> 7) << 8) + (n >> 10) * 128 + (m & 127); } };
__device__ __forceinline__ void p0_prologue(Frame& F) {
    LAS float* tile = (LAS float*)F.lds;
    constexpr int B_GU = 32 * 8 * 8, B_IN = 8 * 10, B_OUT = 8 * 4, NB = B_GU + B_IN + B_OUT;
    for (int it = F.vcu; it < NB; it += F.G) {
        int r = it;
        if (r < B_GU) { const int e = r >> 6, q = r & 63, kb = q >> 3, nb = q & 7; p0_block_item<2>(F.w_gu + (size_t)e * 1024 * 2048, 2048, F.Wgu8 + (size_t)e * 2048 * 1024, 1024, tile, kb * 128, nb * 256, F.wave, F.lane, RowGU()); continue; } r -= B_GU;
        if (r < B_IN) { const int kb = r / 10, nb = r % 10; p0_block_item<0>(F.w_in, DIN, F.Win_t, 1024, tile, kb * 128, nb * 256, F.wave, F.lane, RowId()); continue; } r -= B_IN;
        { const int kb = r >> 2, nb = r & 3; p0_block_item<0>(F.w_out, 1024, F.Wout_t, 1024, tile, kb * 128, nb * 256, F.wave, F.lane, RowId()); }
    }
    LAS float* scr = (LAS float*)(F.lds + F.wave * 16384);
    const int gw = F.vcu * NWAVES + F.wave, NGW = F.G * NWAVES;
    constexpr int I_POOL = 16, I_R = 8;
    for (int it = gw; it < I_POOL + I_R; it += NGW) {
        if (it < I_POOL) { const int g = it / 4, nb = it % 4; p0_item<0>(F.w_pool + g * 16384, 128, F.Wpool_t + g * 16384, nullptr, 128, scr, 0, nb * 32, nb * 32, F.lane); }
        else { const int kb = it - I_POOL; p0_item<1>(F.w_router, 32, F.Wr_hi, F.Wr_lo, 1024, scr, kb * 128, 0, 0, F.lane); }
    }
    for (int m = gw; m < NTOK / 4; m += NGW) rms_rows4_to_bf16(F.lane, F.x, F.norm_mix_w, F.XN, m, NTOK / 4);
}

constexpr int CONV_ITEMS = 32 * 8 * 4;
__device__ __forceinline__ void conv_pull(Frame& F, int budget) {
    LAS float* tile = (LAS float*)F.lds;
    for (int n = 0; n < budget; ++n) {
        if (F.tid == 0) F.MISC[44 + (n & 1)] = atomicAdd((unsigned*)(F.ctl + CW_Q), 1u);
        __syncthreads();
        const int it = (int)F.MISC[44 + (n & 1)];
        if (it >= CONV_ITEMS) break;
        const int e = it >> 5, q = it & 31, kb = q >> 2, nb = q & 3;
        p0_block_item<2>(F.w_down + (size_t)e * 1024 * 1024, 1024, F.Wd8 + (size_t)e * 1024 * 1024, 1024, tile, kb * 128, nb * 256, F.wave, F.lane, RowId());
    }
}

__device__ __forceinline__ void rope_cs(int pos, int j, float& cs, float& sn) {
    const float inv = __builtin_amdgcn_exp2f((float)j * (-13.287712379549449f / 64.0f));
    const double revd = (double)pos * (double)inv * 0.15915494309189535;
    const float rev = (float)(revd - __builtin_floor(revd));
    sn = __builtin_amdgcn_sinf(rev); cs = __builtin_amdgcn_cosf(rev);
}

__device__ __forceinline__ int tr_idx(int d, int m) { return d * 72 + 8 * ((m >> 3) ^ ((d >> 3) & 7)) + (m & 7); }
__device__ __forceinline__ int tr_frag(int r, int chunk) { return r * 72 + 8 * (chunk ^ ((r >> 3) & 7)); }

struct RawKV { u32x4 klo, khi, vlo, vhi; };
__device__ __forceinline__ void retA_load(const Frame& F, int unit, RawKV& r) {
    const int c = unit & 63, bh = unit >> 6, h = bh & 3, b = bh >> 2, m = F.tid >> 3, o = F.tid & 7;
    const bf16_t* zrow = F.Z + (size_t)(b * SEQ + c * 64 + m) * DIN + h * 128 + 8 * o;
    r.klo = *(const u32x4*)(zrow + 512); r.khi = *(const u32x4*)(zrow + 512 + 64); r.vlo = *(const u32x4*)(zrow + 1024); r.vhi = *(const u32x4*)(zrow + 1024 + 64);
}
__device__ __forceinline__ void retA_stage(const Frame& F, int unit, const RawKV& r) {
    const int c = unit & 63, h = (unit >> 6) & 3, m = F.tid >> 3, o = F.tid & 7;
    LAS bf16_t* KT = (LAS bf16_t*)(F.lds);
    LAS bf16_t* VT = KT + 128 * 72;
    const float ksc = __builtin_amdgcn_exp2f(F.lg2(h) * (float)(63 - m)) * 0.08838834764831845f;
    const int pos = c * 64 + m;
#pragma unroll
    for (int i = 0; i < 8; ++i) {
        const unsigned wl = r.klo[i >> 1], wh = r.khi[i >> 1];
        const float lo = (i & 1) ? bf_hi(wl) : bf_lo(wl), hi = (i & 1) ? bf_hi(wh) : bf_lo(wh);
        float cs, sn; rope_cs(pos, 8 * o + i, cs, sn);
        const unsigned pk = cvt_pk_bf16((lo * cs - hi * sn) * ksc, (lo * sn + hi * cs) * ksc);
        KT[tr_idx(8 * o + i, m)] = (bf16_t)(pk & 0xffffu); KT[tr_idx(64 + 8 * o + i, m)] = (bf16_t)(pk >> 16);
        const unsigned vl = r.vlo[i >> 1], vh = r.vhi[i >> 1];
        VT[tr_idx(8 * o + i, m)] = (bf16_t)((i & 1) ? (vl >> 16) : (vl & 0xffffu)); VT[tr_idx(64 + 8 * o + i, m)] = (bf16_t)((i & 1) ? (vh >> 16) : (vh & 0xffffu));
    }
}
__device__ __forceinline__ void retA_compute(const Frame& F, int unit) {
    LAS bf16_t* KT = (LAS bf16_t*)(F.lds); LAS bf16_t* VT = KT + 128 * 72;
    const int w = F.wave, fr = F.lane & 15, fq = F.lane >> 4;
    bf16x8 vf[2];
#pragma unroll
    for (int ks = 0; ks < 2; ++ks) vf[ks] = *(const LAS bf16x8*)(VT + tr_frag(16 * w + fr, 4 * ks + fq));
    bf16_t* urow = F.U + ((size_t)unit * 128 + 16 * w + fr) * 128 + 4 * fq;
#pragma unroll
    for (int dt = 0; dt < 8; ++dt) {
        f32x4 acc = (f32x4){0.f, 0.f, 0.f, 0.f};
#pragma unroll
        for (int ks = 0; ks < 2; ++ks) { const bf16x8 kf = *(const LAS bf16x8*)(KT + tr_frag(16 * dt + fr, 4 * ks + fq)); acc = mfma16(kf, vf[ks], acc); }
        u32x2 pk; pk.x = cvt_pk_bf16(acc[0], acc[1]); pk.y = cvt_pk_bf16(acc[2], acc[3]);
        *(u32x2*)(urow + 16 * dt) = pk;
    }
}
__device__ __forceinline__ void retA_phase(Frame& F) {
    int u = F.vcu; if (u >= 1024) return;
    RawKV raw; retA_load(F, u, raw);
    for (; u < 1024; u += F.G) {
        retA_stage(F, u, raw);
        if (u + F.G < 1024) retA_load(F, u + F.G, raw);
        __syncthreads();
        retA_compute(F, u);
        __syncthreads();
    }
}

__device__ __forceinline__ void pool_load(const Frame& F, int unit, u32x4 (&raw)[3]) {
    const int g = unit & 3, tile = unit >> 2, st = (tile & 63) * 64, tok0 = tile * 64;
#pragma unroll
    for (int j = 0; j < 3; ++j) { const int idx = F.tid + 512 * j, r = idx >> 4, ch = idx & 15, s = st - 15 + r;
        raw[j] = (u32x4){0u, 0u, 0u, 0u};
        if (idx < 79 * 16 && s >= 0) raw[j] = *(const u32x4*)(F.Z + (size_t)(tok0 - 15 + r) * DIN + 2048 + g * 128 + 8 * ch); }
}
__device__ __forceinline__ void pool_phase(Frame& F) {
    int u = F.vcu; if (u >= 1024) return;
    LAS float* P = (LAS float*)(F.lds);
    LAS bf16_t* A = (LAS bf16_t*)(F.lds + 79 * 132 * 4);
    const int t = F.tid, w = F.wave, rt = w & 3, chf = w >> 2, fr = F.lane & 15, fq = F.lane >> 4;
    const bool fixed_g = (F.G & 3) == 0;
    bf16x8 wf[4][4]; f32x4 sc[4];
    { const int g = u & 3; const bf16_t* wp = F.Wpool_t + g * 16384;
#pragma unroll
      for (int dd = 0; dd < 4; ++dd) { const int dt = 4 * chf + dd; sc[dd] = *(const f32x4*)(F.pool_scale + g * 128 + 16 * dt + 4 * fq);
#pragma unroll
          for (int ks = 0; ks < 4; ++ks) wf[dd][ks] = *(const bf16x8*)(wp + (16 * dt + fr) * 128 + 32 * ks + 8 * fq); } }
    u32x4 raw[3]; pool_load(F, u, raw);
    for (; u < 1024; u += F.G) {
        const int g = u & 3, tile = u >> 2, st = (tile & 63) * 64, tok0 = tile * 64, win = 2 << g;
        if (!fixed_g) { const bf16_t* wp = F.Wpool_t + g * 16384;
#pragma unroll
            for (int dd = 0; dd < 4; ++dd) { const int dt = 4 * chf + dd; sc[dd] = *(const f32x4*)(F.pool_scale + g * 128 + 16 * dt + 4 * fq);
#pragma unroll
                for (int ks = 0; ks < 4; ++ks) wf[dd][ks] = *(const bf16x8*)(wp + (16 * dt + fr) * 128 + 32 * ks + 8 * fq); } }
#pragma unroll
        for (int j = 0; j < 3; ++j) { const int idx = t + 512 * j, r = idx >> 4, ch = idx & 15;
            if (idx < 79 * 16) { const u32x4 x = raw[j];
                *(LAS f32x4*)(P + r * 132 + 8 * ch) = (f32x4){bf_lo(x.x), bf_hi(x.x), bf_lo(x.y), bf_hi(x.y)}; *(LAS f32x4*)(P + r * 132 + 8 * ch + 4) = (f32x4){bf_lo(x.z), bf_hi(x.z), bf_lo(x.w), bf_hi(x.w)}; } }
        if (u + F.G < 1024) pool_load(F, u + F.G, raw);
        __syncthreads();
        {
            const int n = t >> 3, c0 = (t & 7) * 16, s = st + n;
            const float rc = 1.0f / (float)((s + 1 < win) ? (s + 1) : win);
#pragma unroll
            for (int q = 0; q < 4; ++q) {
                f32x4 sum = (f32x4){0.f, 0.f, 0.f, 0.f};
                for (int j = 0; j < win; ++j) sum += *(const LAS f32x4*)(P + (15 + n - j) * 132 + c0 + 4 * q);
                const f32x4 self = *(const LAS f32x4*)(P + (15 + n) * 132 + c0 + 4 * q);
                const f32x4 pv = sum * rc - self;
                u32x2 pk; pk.x = cvt_pk_bf16(pv[0], pv[1]); pk.y = cvt_pk_bf16(pv[2], pv[3]);
                *(LAS u32x2*)(A + n * 136 + c0 + 4 * q) = pk;
            }
        }
        __syncthreads();
        {
            bf16x8 af[4];
#pragma unroll
            for (int ks = 0; ks < 4; ++ks) af[ks] = *(const LAS bf16x8*)(A + (16 * rt + fr) * 136 + 32 * ks + 8 * fq);
            bf16_t* orow = F.CAT + (size_t)(tok0 + 16 * rt + fr) * D + 512 + g * 128;
#pragma unroll
            for (int dd = 0; dd < 4; ++dd) { const int dt = 4 * chf + dd;
                f32x4 acc = (f32x4){0.f, 0.f, 0.f, 0.f};
#pragma unroll
                for (int ks = 0; ks < 4; ++ks) acc = mfma16(wf[dd][ks], af[ks], acc);
                u32x2 pk; pk.x = cvt_pk_bf16(acc[0] * sc[dd][0], acc[1] * sc[dd][1]); pk.y = cvt_pk_bf16(acc[2] * sc[dd][2], acc[3] * sc[dd][3]);
                *(u32x2*)(orow + 16 * dt + 4 * fq) = pk;
            }
        }
        __syncthreads();
    }
}

struct RawQKV { u32x4 qlo, qhi, klo, khi, vlo, vhi; };
__device__ __forceinline__ void retB_load(const Frame& F, int unit, RawQKV& r) {
    const int c = unit & 63, bh = unit >> 6, h = bh & 3, b = bh >> 2, m = F.tid >> 3, o = F.tid & 7;
    const bf16_t* zrow = F.Z + (size_t)(b * SEQ + c * 64 + m) * DIN + h * 128 + 8 * o;
    r.qlo = *(const u32x4*)(zrow); r.qhi = *(const u32x4*)(zrow + 64); r.klo = *(const u32x4*)(zrow + 512); r.khi = *(const u32x4*)(zrow + 512 + 64); r.vlo = *(const u32x4*)(zrow + 1024); r.vhi = *(const u32x4*)(zrow + 1024 + 64);
}
__device__ __forceinline__ void retB_phase(Frame& F) {
    int unit = F.vcu; if (unit >= 1024) return;
    LAS bf16_t* Q = (LAS bf16_t*)(F.lds);
    LAS bf16_t* Kr = Q + 64 * 136;
    LAS bf16_t* VT = Kr + 64 * 136;
    LAS bf16_t* Sm = VT + 128 * 72;
    LAS float* red = (LAS float*)(Sm + 64 * 72);
    const int t = F.tid, w = F.wave, fr = F.lane & 15, fq = F.lane >> 4;
    RawQKV raw; retB_load(F, unit, raw);
    for (; unit < 1024; unit += F.G) {
        const int c = unit & 63, bh = unit >> 6, h = bh & 3, b = bh >> 2, tok0 = b * SEQ + c * 64;
        const float lg = F.lg2(h);
        const int rt = w & 3, chf = w >> 2, n = 16 * rt + fr;
        bf16x8 rf[4][4]; u32x2 gw2[4];
#pragma unroll
        for (int dd = 0; dd < 4; ++dd) { const bf16_t* rrow = F.U + ((size_t)unit * 128 + 16 * (4 * chf + dd) + fr) * 128 + 8 * fq;
#pragma unroll
            for (int ks = 0; ks < 4; ++ks) rf[dd][ks] = *(const bf16x8*)(rrow + 32 * ks);
            gw2[dd] = *(const u32x2*)(F.Z + (size_t)(tok0 + n) * DIN + 1536 + h * 128 + 16 * (4 * chf + dd) + 4 * fq); }
        {
            const int m = t >> 3, o = t & 7, pos = c * 64 + m;
            unsigned ql[4], qh[4], kl[4], kh[4];
#pragma unroll
            for (int i = 0; i < 8; i += 2) {
                float cs0, sn0, cs1, sn1; rope_cs(pos, 8 * o + i, cs0, sn0); rope_cs(pos, 8 * o + i + 1, cs1, sn1);
                { const float l0 = bf_lo(raw.qlo[i >> 1]), l1 = bf_hi(raw.qlo[i >> 1]), h0 = bf_lo(raw.qhi[i >> 1]), h1 = bf_hi(raw.qhi[i >> 1]);
                  ql[i >> 1] = cvt_pk_bf16(l0 * cs0 - h0 * sn0, l1 * cs1 - h1 * sn1); qh[i >> 1] = cvt_pk_bf16(l0 * sn0 + h0 * cs0, l1 * sn1 + h1 * cs1); }
                { const float l0 = bf_lo(raw.klo[i >> 1]), l1 = bf_hi(raw.klo[i >> 1]), h0 = bf_lo(raw.khi[i >> 1]), h1 = bf_hi(raw.khi[i >> 1]); const float sc = 0.08838834764831845f;
                  kl[i >> 1] = cvt_pk_bf16((l0 * cs0 - h0 * sn0) * sc, (l1 * cs1 - h1 * sn1) * sc); kh[i >> 1] = cvt_pk_bf16((l0 * sn0 + h0 * cs0) * sc, (l1 * sn1 + h1 * cs1) * sc); }
            }
            *(LAS u32x4*)(Q + m * 136 + 8 * o) = (u32x4){ql[0], ql[1], ql[2], ql[3]}; *(LAS u32x4*)(Q + m * 136 + 64 + 8 * o) = (u32x4){qh[0], qh[1], qh[2], qh[3]};
            *(LAS u32x4*)(Kr + m * 136 + 8 * o) = (u32x4){kl[0], kl[1], kl[2], kl[3]}; *(LAS u32x4*)(Kr + m * 136 + 64 + 8 * o) = (u32x4){kh[0], kh[1], kh[2], kh[3]};
#pragma unroll
            for (int i = 0; i < 8; ++i) { const unsigned vl = raw.vlo[i >> 1], vh = raw.vhi[i >> 1];
                VT[tr_idx(8 * o + i, m)] = (bf16_t)((i & 1) ? (vl >> 16) : (vl & 0xffffu)); VT[tr_idx(64 + 8 * o + i, m)] = (bf16_t)((i & 1) ? (vh >> 16) : (vh & 0xffffu)); }
        }
        if (unit + F.G < 1024) retB_load(F, unit + F.G, raw);
        __syncthreads();
        {
            const int ntl = w >> 1;
            bf16x8 qf[4];
#pragma unroll
            for (int ks = 0; ks < 4; ++ks) qf[ks] = *(const LAS bf16x8*)(Q + (16 * ntl + fr) * 136 + 32 * ks + 8 * fq);
#pragma unroll
            for (int mm = 0; mm < 2; ++mm) { const int mt = 2 * (w & 1) + mm;
                f32x4 acc = (f32x4){0.f, 0.f, 0.f, 0.f};
#pragma unroll
                for (int ks = 0; ks < 4; ++ks) { const bf16x8 kf = *(const LAS bf16x8*)(Kr + (16 * mt + fr) * 136 + 32 * ks + 8 * fq); acc = mfma16(kf, qf[ks], acc); }
                const int nn = 16 * ntl + fr, m0 = 16 * mt + 4 * fq;
                float sv[4];
#pragma unroll
                for (int j = 0; j < 4; ++j) { const int dd = nn - (m0 + j); sv[j] = acc[j] * __builtin_amdgcn_exp2f(lg * (float)(dd < 0 ? -dd : dd)); }
                u32x2 pk; pk.x = cvt_pk_bf16(sv[0], sv[1]); pk.y = cvt_pk_bf16(sv[2], sv[3]);
                *(LAS u32x2*)(Sm + nn * 72 + m0) = pk;
            }
        }
        __syncthreads();
        {
            bf16x8 sf[2], qf[4];
#pragma unroll
            for (int ks = 0; ks < 2; ++ks) sf[ks] = *(const LAS bf16x8*)(Sm + n * 72 + 32 * ks + 8 * fq);
#pragma unroll
            for (int ks = 0; ks < 4; ++ks) qf[ks] = *(const LAS bf16x8*)(Q + n * 136 + 32 * ks + 8 * fq);
            const float qd = __builtin_amdgcn_exp2f(lg * (float)(n + 1));
            f32x4 ov[4]; float ss = 0.f;
#pragma unroll
            for (int dd = 0; dd < 4; ++dd) { const int vt = 4 * chf + dd;
                f32x4 ai = (f32x4){0.f, 0.f, 0.f, 0.f}, ac = ai;
#pragma unroll
                for (int ks = 0; ks < 2; ++ks) { const bf16x8 vf = *(const LAS bf16x8*)(VT + tr_frag(16 * vt + fr, 4 * ks + fq)); ai = mfma16(vf, sf[ks], ai); }
#pragma unroll
                for (int ks = 0; ks < 4; ++ks) ac = mfma16(rf[dd][ks], qf[ks], ac);
                ov[dd] = ai + ac * qd;
                ss += (ov[dd][0] * ov[dd][0] + ov[dd][1] * ov[dd][1]) + (ov[dd][2] * ov[dd][2] + ov[dd][3] * ov[dd][3]);
            }
            ss += __shfl_xor(ss, 16); ss += __shfl_xor(ss, 32);
            if (fq == 0) red[chf * 64 + n] = ss;
            __syncthreads();
            const float rstd = 1.f / sqrtf((red[n] + red[64 + n]) * (1.f / 128.f) + EPS);
            const size_t tok = (size_t)(tok0 + n);
#pragma unroll
            for (int dd = 0; dd < 4; ++dd) { const int v0 = 16 * (4 * chf + dd) + 4 * fq;
                const f32x4 rw = *(const f32x4*)(F.ret_norm_w + h * 128 + v0);
                const float gv[4] = {bf_lo(gw2[dd].x), bf_hi(gw2[dd].x), bf_lo(gw2[dd].y), bf_hi(gw2[dd].y)};
                float r[4];
#pragma unroll
                for (int j = 0; j < 4; ++j) { const float sg = gv[j] * __builtin_amdgcn_rcpf(1.0f + __builtin_amdgcn_exp2f(-1.4426950408889634f * gv[j])); r[j] = ov[dd][j] * rstd * rw[j] * sg; }
                u32x2 pk; pk.x = cvt_pk_bf16(r[0], r[1]); pk.y = cvt_pk_bf16(r[2], r[3]);
                *(u32x2*)(F.CAT + tok * D + h * 128 + v0) = pk;
            }
        }
        __syncthreads();
    }
}

struct Args { const float* in[15]; float* out; unsigned char* ws; float lg2g[4]; int ph_lo, ph_hi, li, pad; };

__global__ void __launch_bounds__(NWAVES * 64, 2) fwd_kernel(Args args) {
    extern __shared__ __attribute__((aligned(16))) unsigned char lds[];
    Frame F;
    F.lds = (LAS unsigned char*)lds;
    F.MISC = (volatile LAS unsigned*)(F.lds + MISC_OFF);
    F.tid = threadIdx.x; F.lane = F.tid & 63; F.wave = __builtin_amdgcn_readfirstlane(F.tid >> 6);
    F.G = gridDim.x; { const int bx = blockIdx.x; F.vcu = (F.G % 8 == 0) ? (bx % 8) * (F.G / 8) + bx / 8 : bx; }
#define REFRESH() do { const __attribute__((address_space(4))) Args* A_ = (const __attribute__((address_space(4))) Args*)__builtin_amdgcn_kernarg_segment_ptr(); asm volatile("" : "+s"(A_)); \
    unsigned char* ws_ = A_->ws; F.ctl = (gu32*)(ws_ + WS_CTL); \
    F.x = A_->in[0]; F.norm_mix_w = A_->in[1]; F.w_in = A_->in[2]; F.ret_norm_w = A_->in[3]; F.w_pool = A_->in[4]; F.pool_scale = A_->in[5]; F.w_out = A_->in[6]; F.norm_ffn_w = A_->in[7]; \
    F.w_router = A_->in[8]; F.b_router = A_->in[9]; F.w_gu = A_->in[10]; F.b_gu = A_->in[11]; F.w_down = A_->in[12]; F.b_down = A_->in[13]; F.norm_final_w = A_->in[14]; F.out = A_->out; \
    F.Wr_hi = (bf16_t*)(ws_ + WS_WR); F.Wr_lo = F.Wr_hi + 32 * 1024; F.Wpool_t = (bf16_t*)(ws_ + WS_WPOOL); F.Win_t = (bf16_t*)(ws_ + WS_WIN); F.Wout_t = (bf16_t*)(ws_ + WS_WOUT); \
    F.XN = (bf16_t*)(ws_ + WS_XN); F.CAT = (bf16_t*)(ws_ + WS_CAT); F.U = (bf16_t*)(ws_ + WS_U); F.Z = (bf16_t*)(ws_ + WS_Z); F.Y = (bf16_t*)(ws_ + WS_Y); \
    F.Wgu8 = ws_ + WS_WGU; F.Wd8 = ws_ + WS_WD; F.ACT8 = ws_ + WS_ACT; F.H8 = ws_ + WS_XN; F.list = (le_t*)(ws_ + WS_LIST); F.ssq = (float*)(ws_ + WS_SSQ); F.PL = (float*)(ws_ + WS_PL); \
    F.lg2g0 = A_->lg2g[0]; F.lg2g1 = A_->lg2g[1]; F.lg2g2 = A_->lg2g[2]; F.lg2g3 = A_->lg2g[3]; \
    { int t_ = threadIdx.x; asm volatile("" : "+v"(t_)); F.tid = t_; F.lane = t_ & 63; } } while (0)
    REFRESH();
    for (int u = F.tid; u < (LDS_BYTES - LDSCTL_OFF) / 4; u += NWAVES * 64) ((LAS unsigned*)(F.lds + LDSCTL_OFF))[u] = 0u;
    __syncthreads();
    XcdBarrier bar; bar.bar = (unsigned*)(F.ctl + CW_BAR); bar.x = 0; bar.st = nullptr;
    if (N_LAUNCHES != PER_PHASE) bar = xcd_barrier_post((unsigned*)(F.ctl + CW_BAR), F.MISC + 8);
    int n_stamp = 0;
#define STAMP() do { if (DBG_SPIN_A >= 0) { if (F.tid == 0) { const unsigned long long _t = __builtin_amdgcn_s_memrealtime(); F.MISC[16 + 2 * n_stamp] = (unsigned)_t; F.MISC[17 + 2 * n_stamp] = (unsigned)(_t >> 32); } ++n_stamp; } } while (0)
    STAMP();
#define GRID_BAR() do { if (N_LAUNCHES != PER_PHASE) xcd_barrier(bar); STAMP(); } while (0)
    const int lo = DBG_ONLY9 ? (args.ph_lo < 9 ? 9 : args.ph_lo) : args.ph_lo, hi = args.ph_hi;
#define IN(k) (lo <= (k) && (k) < hi)
#define BOTH(k) (IN(k) && IN((k) + 1))
    const int gw = F.vcu * NWAVES + F.wave, NGW = F.G * NWAVES;

    if (IN(0)) { REFRESH(); p0_prologue(F); if (BOTH(0)) GRID_BAR(); }

    if (IN(1)) {
        REFRESH();
        pg8::DenseSched S; S.init(F.XN, F.Win_t, NTOK, DIN, F.G, (int)blockIdx.x);
        pg8::EpiBf16 E{F.Z, DIN};
        pg8::gemm_phase<pg8::EpiBf16, pg8::DenseSched, true>(F.lds, S, E);
        { const int mine = (S.nwg - (int)blockIdx.x + F.G - 1) / F.G, most = (S.nwg + F.G - 1) / F.G; if (mine < most) conv_pull(F, 5 * (most - mine)); }
        if (BOTH(1)) GRID_BAR();
    }

    if (IN(2)) {
        REFRESH();
        retA_phase(F);
        pool_phase(F);
        if (BOTH(2)) GRID_BAR();
    }

    if (IN(3) && DBG_STAGE != 4) {
        REFRESH();
        const int gt = F.vcu * 512 + F.tid, NGT = F.G * 512;
        for (int p = gt; p < 16 * 8192; p += NGT) {
            const int bh = p >> 13, i = p & 8191;
            const float cd = __builtin_amdgcn_exp2f(F.lg2(bh & 3) * 64.0f);
            unsigned* up = (unsigned*)(F.U + (size_t)bh * 64 * 16384) + i;
            float s0 = 0.f, s1 = 0.f;
#pragma unroll
            for (int cb = 0; cb < 64; cb += 32) {
                unsigned uw[32];
#pragma unroll
                for (int c = 0; c < 32; ++c) uw[c] = up[(size_t)(cb + c) * 8192];
#pragma unroll
                for (int c = 0; c < 32; ++c) { up[(size_t)(cb + c) * 8192] = cvt_pk_bf16(s0, s1); s0 = cd * s0 + bf_lo(uw[c]); s1 = cd * s1 + bf_hi(uw[c]); }
            }
        }
        if (BOTH(3)) GRID_BAR();
    }

    if (IN(4) && DBG_STAGE != 4) {
        REFRESH();
        retB_phase(F);
        if (BOTH(4)) GRID_BAR();
    }

    if (IN(5) && !DBG_STAGE) {
        REFRESH();
        pg8::DenseSched S; S.init(F.CAT, F.Wout_t, NTOK, D, F.G, (int)blockIdx.x);
        pg8::EpiX1 E{F.x, F.out, F.ssq, F.PL, F.H8, F.norm_ffn_w, F.Wr_hi, F.Wr_lo, S.nwg == F.G};
        pg8::gemm_phase<pg8::EpiX1, pg8::DenseSched, false>(F.lds, S, E);
        if (BOTH(5)) GRID_BAR();
    }

    if (IN(6) && !DBG_SKIP_Y) {
        REFRESH();
        if (gw == 0) { GAS u32x4* z = (GAS u32x4*)(F.H8 + (size_t)NTOK * D) + F.lane; z[0] = (u32x4){0u, 0u, 0u, 0u}; }
        LAS unsigned* lcnt = (LAS unsigned*)(F.lds);
        LAS unsigned* lbase = lcnt + 32;
        if (F.tid < 32) lcnt[F.tid] = 0u;
        __syncthreads();
        const int half = F.lane >> 5, e = F.lane & 31;
        const float be = F.b_router[e];
        constexpr int MAXJ = 4;
        const int nsl = ((NTOK / 256) * (D / 256) == F.G) ? 4 : 16;
        for (int base = 0; base < NTOK / 2; base += NGW * MAXJ) {
            int srank[MAXJ], slp[MAXJ], srow[MAXJ]; float sgate[MAXJ], srstd[MAXJ];
#pragma unroll
            for (int j = 0; j < MAXJ; ++j) {
                const int rp = base + gw + NGW * j; srank[j] = -1; slp[j] = 0; srow[j] = 0; sgate[j] = 0.f; srstd[j] = 0.f;
                if (rp < NTOK / 2) {
                    const int row = 2 * rp + half;
                    float lg = 0.f, ss = 0.f;
                    if (nsl == 4) {
#pragma unroll
                        for (int p = 0; p < 4; ++p) lg += F.PL[((size_t)p * NTOK + row) * 32 + e];
                        if ((F.lane & 15) < 4) ss = F.ssq[(size_t)(F.lane & 15) * NTOK + row];
                    } else {
#pragma unroll
                        for (int p = 0; p < 16; ++p) lg += F.PL[((size_t)p * NTOK + row) * 32 + e];
                        ss = F.ssq[(size_t)(F.lane & 15) * NTOK + row];
                    }
                    ss += __shfl_xor(ss, 1); ss += __shfl_xor(ss, 2); ss += __shfl_xor(ss, 4); ss += __shfl_xor(ss, 8);
                    const float rstd = 1.f / sqrtf(ss * (1.f / D) + EPS);
                    float cur = lg * rstd + be;
                    float tv[4]; int ti[4]; int myrank = -1;
#pragma unroll
                    for (int k = 0; k < 4; ++k) {
                        float bv = cur; int bi = e;
#pragma unroll
                        for (int off = 16; off >= 1; off >>= 1) { const float ov = __shfl_xor(bv, off); const int oi = __shfl_xor(bi, off); if (ov > bv || (ov == bv && oi < bi)) { bv = ov; bi = oi; } }
                        tv[k] = bv; ti[k] = bi;
                        if (e == bi) { cur = -3.0e38f; myrank = k; }
                    }
                    (void)ti;
                    const float e1 = __expf(tv[1] - tv[0]), e2 = __expf(tv[2] - tv[0]), e3 = __expf(tv[3] - tv[0]), inv = 1.0f / (1.0f + e1 + e2 + e3);
                    if (myrank >= 0) {
                        srank[j] = myrank; srow[j] = row; srstd[j] = rstd;
                        sgate[j] = (myrank == 0 ? 1.0f : myrank == 1 ? e1 : myrank == 2 ? e2 : e3) * inv;
                        slp[j] = (int)__hip_atomic_fetch_add(lcnt + e, 1u, __ATOMIC_RELAXED, __HIP_MEMORY_SCOPE_WORKGROUP);
                    }
                }
            }
            __syncthreads();
            if (F.tid < 32) { const unsigned n = lcnt[F.tid]; lbase[F.tid] = n ? atomicAdd((unsigned*)(F.ctl + CW_CNT + 64 * F.tid), n) : 0u; }
            __syncthreads();
#pragma unroll
            for (int j = 0; j < MAXJ; ++j)
                if (srank[j] >= 0) F.list[e * LISTCAP + (int)lbase[e] + slp[j]] = (le_t){srow[j] * 4 + srank[j], __float_as_int(sgate[j]), __float_as_int(srstd[j]), 0};
            __syncthreads();
            if (F.tid < 32) lcnt[F.tid] = 0u;
            __syncthreads();
        }
        if (BOTH(6)) GRID_BAR();
    }

    if ((IN(7) || IN(8)) && !DBG_SKIP_Y) {
        REFRESH();
        LAS int* tab = (LAS int*)(F.lds + TAB_OFF);
        if (F.tid < 32) tab[F.tid] = (int)__hip_atomic_load(F.ctl + CW_CNT + 64 * F.tid, RLX_AGENT);
        __syncthreads();
        if (F.tid == 0) { int s = 0; for (int e = 0; e < 32; ++e) { tab[32 + e] = s; s += (tab[e] + 255) >> 8; } tab[64] = s; }
        __syncthreads();
    }
    if (IN(7) && !DBG_SKIP_Y) {
        REFRESH();
        pg8::MoeSched<true> S; S.init((const bf16_t*)F.H8, (const bf16_t*)F.Wgu8, F.list, F.b_gu, (const LAS int*)(F.lds + TAB_OFF), F.G, (int)blockIdx.x);
        pg8::EpiGU E{F.ACT8};
        pg8::gemm_phase<pg8::EpiGU, pg8::MoeSched<true>, true, true>(F.lds, S, E);
        { const int mine = (S.nwg - (int)blockIdx.x + F.G - 1) / F.G, most = (S.nwg + F.G - 1) / F.G; if (mine < most) conv_pull(F, 3 * (most - mine)); }
        conv_pull(F, CONV_ITEMS);
        if (BOTH(7)) GRID_BAR();
    }
    if (IN(8) && !DBG_SKIP_Y) {
        REFRESH();
        pg8::MoeSched<false> S; S.init((const bf16_t*)F.ACT8, (const bf16_t*)F.Wd8, F.list, F.b_down, (const LAS int*)(F.lds + TAB_OFF), F.G, (int)blockIdx.x);
        pg8::EpiDown E{(unsigned char*)F.Y};
        pg8::gemm_phase<pg8::EpiDown, pg8::MoeSched<false>, true, true>(F.lds, S, E);
        if (BOTH(8)) GRID_BAR();
    }
    if (IN(9) && DBG_STAGE) {
        REFRESH();
        for (int m = gw; m < NTOK; m += NGW) {
            const bf16_t* src = DBG_STAGE == 1 ? F.XN + (size_t)m * D : DBG_STAGE == 2 ? F.Z + (size_t)m * DIN + 1024 : DBG_STAGE == 3 ? F.CAT + (size_t)m * D : F.U + (size_t)m * D;
            for (int j = F.lane; j < D; j += 64) F.out[(size_t)m * D + j] = __uint_as_float(((unsigned)src[j]) << 16);
        }
    }
    if (IN(9) && !DBG_STAGE) {
        REFRESH();
        for (int m = gw; m < NTOK; m += NGW) {
            const GAS f32x4* xr = (const GAS f32x4*)((DBG_ONLY9 ? F.x : F.out) + (size_t)m * D) + F.lane; const GAS f32x4* wr = (const GAS f32x4*)F.norm_final_w + F.lane;
            f32x4 v[4]; float s = 0.f;
            if (DBG_ONLY9) {
#pragma unroll
            for (int j = 0; j < 4; ++j) v[j] = xr[64 * j];
            } else { const GAS u32x2* xb = (const GAS u32x2*)(F.out + (size_t)m * D) + F.lane;
#pragma unroll
            for (int j = 0; j < 4; ++j) { const u32x2 x = xb[64 * j]; v[j] = (f32x4){bf_lo(x.x), bf_hi(x.x), bf_lo(x.y), bf_hi(x.y)}; } }
#pragma unroll
            for (int k = 0; k < (DBG_SKIP_Y ? 0 : 4); ++k) { const GAS unsigned* yr = (const GAS unsigned*)((const unsigned char*)F.Y + ((size_t)m * 4 + k) * D) + F.lane;
#pragma unroll
                for (int j = 0; j < 4; ++j) { const unsigned y = __builtin_nontemporal_load(yr + 64 * j);
                    const f32x2 lo = __builtin_amdgcn_cvt_pk_f32_fp8((int)y, false), hi = __builtin_amdgcn_cvt_pk_f32_fp8((int)y, true); v[j] += (f32x4){lo[0], lo[1], hi[0], hi[1]} * 0.0625f; } }
#pragma unroll
            for (int j = 0; j < 4; ++j) s += (v[j].x * v[j].x + v[j].y * v[j].y) + (v[j].z * v[j].z + v[j].w * v[j].w);
            const float rstd = 1.f / sqrtf(wave_sum(s) * (1.f / D) + EPS);
            GAS f32x4* orow = (GAS f32x4*)(F.out + (size_t)m * D) + F.lane;
#pragma unroll
            for (int j = 0; j < 4; ++j) __builtin_nontemporal_store(v[j] * rstd * wr[64 * j], orow + 64 * j);
        }
    }
    if (DBG_SPIN_A >= 0) { STAMP();
        if (blockIdx.x == 0 && F.tid == 0) {
            const unsigned long long ta = ((unsigned long long)F.MISC[17 + 2 * DBG_SPIN_A] << 32) | F.MISC[16 + 2 * DBG_SPIN_A], tb = ((unsigned long long)F.MISC[17 + 2 * DBG_SPIN_B] << 32) | F.MISC[16 + 2 * DBG_SPIN_B];
            const unsigned long long t0 = __builtin_amdgcn_s_memrealtime(), want = (tb - ta) * DBG_SPIN_W;
            while (__builtin_amdgcn_s_memrealtime() - t0 < want) __builtin_amdgcn_s_sleep(8);
        } }
#undef IN
#undef BOTH
#undef GRID_BAR
#undef STAMP
#undef REFRESH
}

extern "C" void kernel_launch(void* const* d_in, const int* in_sizes, int n_in, void* d_out, int out_size, void* d_ws, size_t ws_size, hipStream_t stream) {
    static int grid = 0;
    if (grid == 0) {
        if (n_in != 15 || in_sizes[0] != NTOK * D || out_size != NTOK * D || ws_size < WS_END) { fprintf(stderr, "kernel_launch: unexpected shapes / workspace (n_in %d, ws %zu); nothing launched\n", n_in, ws_size); grid = -1; return; }
        int dev = 0, cus = 0, per_cu = 0;
        if (hipGetDevice(&dev) != hipSuccess || hipDeviceGetAttribute(&cus, hipDeviceAttributeMultiprocessorCount, dev) != hipSuccess) { grid = -1; return; }
        if (hipFuncSetAttribute((const void*)fwd_kernel, hipFuncAttributeMaxDynamicSharedMemorySize, LDS_BYTES) != hipSuccess) { fprintf(stderr, "kernel_launch: hipFuncSetAttribute failed\n"); grid = -1; return; }
        if (hipOccupancyMaxActiveBlocksPerMultiprocessor(&per_cu, (const void*)fwd_kernel, NWAVES * 64, LDS_BYTES) != hipSuccess || per_cu < 1)
            fprintf(stderr, "kernel_launch: note: occupancy query reports %d workgroups per CU\n", per_cu);
        (void)hipGetLastError();
        grid = cus;
    }
    if (grid < 0) return;
    if (hipMemsetAsync((char*)d_ws + WS_CTL, 0, CTL_ZERO_BYTES, stream) != hipSuccess) { fprintf(stderr, "kernel_launch: memset failed\n"); return; }
    Args a{};
    for (int i = 0; i < 15; ++i) a.in[i] = (const float*)d_in[i];
    a.out = (float*)d_out; a.ws = (unsigned char*)d_ws;
    for (int h = 0; h < 4; ++h) a.lg2g[h] = (float)(log1p(-exp2(-5.0 - (double)h)) / log(2.0));
    for (int li = 0; li < N_LAUNCHES; ++li) {
        a.ph_lo = (N_LAUNCHES == PER_PHASE) ? li : 0; a.ph_hi = (N_LAUNCHES == PER_PHASE) ? li + 1 : PER_PHASE; a.li = li; a.pad = 0;
        hipLaunchKernelGGL(fwd_kernel, dim3(grid), dim3(NWAVES * 64), LDS_BYTES, stream, a);
        const hipError_t le = hipPeekAtLastError();
        if (le != hipSuccess) { fprintf(stderr, "kernel_launch: launch %d failed: %s\n", li, hipGetErrorName(le)); break; }
    }
}
```

```cpp
#include <hip/hip_runtime.h>
#include <cstdio>
#include <cstdint>
#include <cmath>

#ifndef DBG_ONLY9
#define DBG_ONLY9 0
#define DBG_STAGE 0
#endif
#ifndef DBG_SPIN_A
#define DBG_SPIN_A -1
#define DBG_SPIN_B -1
#define DBG_SPIN_W 2
#endif
#ifndef DBG_SKIP_Y
#define DBG_SKIP_Y 0
#endif
#ifndef MK_N_LAUNCHES
#define MK_N_LAUNCHES 1
#endif
constexpr int PER_PHASE = 10;
constexpr int N_LAUNCHES = MK_N_LAUNCHES;

#define LAS __attribute__((address_space(3)))
#define GAS __attribute__((address_space(1)))
typedef unsigned short bf16_t;
typedef short bf16x8 __attribute__((ext_vector_type(8)));
typedef float f32x4 __attribute__((ext_vector_type(4)));
typedef float f32x2 __attribute__((ext_vector_type(2)));
typedef unsigned u32x4 __attribute__((ext_vector_type(4)));
typedef unsigned u32x2 __attribute__((ext_vector_type(2)));
typedef GAS unsigned gu32;
typedef int i32x2 __attribute__((ext_vector_type(2)));
typedef int le_t __attribute__((ext_vector_type(4)));

constexpr int NTOK = 16384, D = 1024, SEQ = 4096, DIN = 2560, NE = 32, FF = 1024, LISTCAP = 16384;
constexpr int NWAVES = 8;
constexpr float EPS = 1e-6f;

constexpr size_t MiB = 1u << 20;
constexpr size_t WS_CTL = 0, CTL_ZERO_BYTES = 32 * 1024;
constexpr size_t WS_LIST = 360 * MiB;
constexpr size_t WS_PL = 368 * MiB;
constexpr size_t WS_SSQ = 5 * MiB + 512 * 1024;
constexpr size_t WS_WR = 6 * MiB + 512 * 1024;
constexpr size_t WS_WPOOL = 6 * MiB + 768 * 1024;
constexpr size_t WS_WIN = 7 * MiB;
constexpr size_t WS_WOUT = 12 * MiB;
constexpr size_t WS_XN = 14 * MiB;
constexpr size_t WS_CAT = 47 * MiB;
constexpr size_t WS_U = 79 * MiB;
constexpr size_t WS_Z = 111 * MiB;
constexpr size_t WS_Y = 47 * MiB;
constexpr size_t WS_WGU = 192 * MiB;
constexpr size_t WS_WD = 256 * MiB;
constexpr size_t WS_ACT = 288 * MiB;
constexpr size_t WS_END = 400 * MiB;
static_assert(WS_Y + (size_t)65536 * 1024 * 2 <= WS_WGU && WS_Z + (size_t)16384 * 2560 * 2 <= WS_WGU, "Y overlay / Z");
constexpr int CW_TMO = 0, CW_CODE = 1;
constexpr int CW_Q = 512;
constexpr int CW_CNT = 1024;
constexpr int CW_BAR = 4096;
static_assert((CW_BAR + 3456) * 4 <= (int)CTL_ZERO_BYTES, "control words inside the memset");

constexpr int RING_BYTES = 131072;
constexpr int LDSCTL_OFF = RING_BYTES, MISC_OFF = LDSCTL_OFF + 320, TAB_OFF = LDSCTL_OFF + 512;
constexpr int MB_OFF = LDSCTL_OFF + 1024;
constexpr int LDS_BYTES = 147456;

#define RLX_AGENT __ATOMIC_RELAXED, __HIP_MEMORY_SCOPE_AGENT
#define LDS_WAIT() asm volatile("s_waitcnt lgkmcnt(0)" ::: "memory")
#define VM_WAIT() asm volatile("s_waitcnt vmcnt(0)" ::: "memory")
typedef __bf16 bf16x2_t __attribute__((ext_vector_type(2)));
__device__ __forceinline__ unsigned cvt_pk_bf16(float lo, float hi) { const f32x2 v = {lo, hi}; const bf16x2_t b = __builtin_convertvector(v, bf16x2_t); return __builtin_bit_cast(unsigned, b); }
__device__ __forceinline__ unsigned cvt4_fp8(float a, float b, float c, float d) { int r = __builtin_amdgcn_cvt_pk_fp8_f32(a, b, 0, false); r = __builtin_amdgcn_cvt_pk_fp8_f32(c, d, r, true); return (unsigned)r; }
typedef int i32x8 __attribute__((ext_vector_type(8)));
__device__ __forceinline__ float bf_lo(unsigned w) { return __uint_as_float(w << 16); }
__device__ __forceinline__ float bf_hi(unsigned w) { return __uint_as_float(w & 0xffff0000u); }
__device__ __forceinline__ float wave_sum(float v) {
#pragma unroll
    for (int o = 1; o < 64; o <<= 1) v += __shfl_xor(v, o);
    return v;
}
__device__ __forceinline__ f32x4 mfma16(bf16x8 a, bf16x8 b, f32x4 c) { return __builtin_amdgcn_mfma_f32_16x16x32_bf16(a, b, c, 0, 0, 0); }

namespace pg8 {
constexpr int BM = 256, BK = 64, HALF = 128, HTB = HALF * BK * 2, STAGE_BYTES = 8 * HTB, NXCD = 8, WGM = 8, KK = 1024;
__host__ __device__ __forceinline__ int lds_byte(int r, int c) { const int st = (r >> 4) * 2 + (c >> 5), rr = r & 15, cc = c & 31, ob = rr * 64 + cc * 2; return st * 1024 + (ob ^ (((ob >> 9) & 1) << 5)); }
__host__ __device__ __forceinline__ void stage_rc(int b, int& R, int& C) { const int st = b / 1024, sb = b % 1024, swz = sb ^ (((sb >> 9) & 1) << 5); R = (st >> 1) * 16 + swz / 64; C = (st & 1) * 32 + (swz % 64) / 2; }
__host__ __device__ __forceinline__ int perm32(int rho) { const int n = rho >> 4, i = rho & 15; return 8 * (i >> 2) + 4 * n + (i & 3); }

struct Unit { int pm, pn, e, rows, arow; };

__device__ __forceinline__ int xcd_remap(int L, int nwg) { const int q = nwg / NXCD, r = nwg % NXCD, xcd = L % NXCD, off = L / NXCD; return (xcd < r ? xcd * (q + 1) : r * (q + 1) + (xcd - r) * q) + off; }

struct DenseSched {
    const bf16_t* A; const bf16_t* Bt; int nM, nN, nwg, G, c;
    __device__ __forceinline__ void init(const bf16_t* A_, const bf16_t* Bt_, int M, int N, int G_, int c_) { A = A_; Bt = Bt_; nM = M / BM; nN = N / BM; nwg = nM * nN; G = G_; c = c_; }
    __device__ __forceinline__ bool next(int i, Unit& u) const {
        const int L = i * G + c; if (L >= nwg) return false;
        const int wgid = xcd_remap(L, nwg);
        const int nig = WGM * nN, gid = wgid / nig, fm = gid * WGM, gsz = (nM - fm) < WGM ? (nM - fm) : WGM;
        u.pm = fm + ((wgid % nig) % gsz); u.pn = (wgid % nig) / gsz; u.e = 0; u.rows = 256; u.arow = u.pm * 256; return true;
    }
    __device__ __forceinline__ const char* a_base(const Unit& u) const { return (const char*)A + (size_t)u.pm * (2 * HALF * KK * 2); }
    __device__ __forceinline__ const char* b_base(const Unit& u) const { return (const char*)Bt + (size_t)u.pn * (2 * HALF * KK * 2); }
    static constexpr bool MB = false;
    __device__ __forceinline__ void mb_issue(LAS unsigned char*, const Unit&, int, int) const {}
    __device__ __forceinline__ void a_offs(const Unit&, int tid, unsigned (&go)[2][2], const LAS le_t*) const {
#pragma unroll
        for (int i = 0; i < 2; ++i) { int R, C; stage_rc(tid * 16 + i * 8192, R, C);
#pragma unroll
            for (int h = 0; h < 2; ++h) go[h][i] = (unsigned)((h * HALF + R) * KK + C) * 2u; }
    }
};
constexpr int KU8 = 512;
template <bool GU> struct MoeSched {
    const bf16_t* A; const bf16_t* Bt; const le_t* list; const float* bias; const LAS int* tab; int nN, nwg, G, c;
    __device__ __forceinline__ void init(const bf16_t* A_, const bf16_t* Bt_, const le_t* list_, const float* bias_, const LAS int* tab_, int G_, int c_) { A = A_; Bt = Bt_; list = list_; bias = bias_; tab = tab_; nN = GU ? 8 : 4; nwg = __builtin_amdgcn_readfirstlane(tab_[32 + 32]) * nN; G = G_; c = c_; }
    __device__ __forceinline__ bool next(int i, Unit& u) const {
        const int L = i * G + c; if (L >= nwg) return false;
        const int wgid = xcd_remap(L, nwg);
        int ln = (int)(threadIdx.x & 31u); asm volatile("" : "+v"(ln));
        const unsigned long long bal = __ballot(tab[32 + ln] * nN <= wgid);
        const int e = 31 - __builtin_clz((unsigned)(bal & 0xffffffffull));
        const int tb0 = tab[32 + e], T = tab[32 + e + 1] - tb0, local = wgid - tb0 * nN;
        int rows = tab[e] - (local % T) * 256; if (rows > 256) rows = 256;
        u.e = __builtin_amdgcn_readfirstlane(e); u.pm = __builtin_amdgcn_readfirstlane(local % T); u.pn = __builtin_amdgcn_readfirstlane(local / T); u.rows = __builtin_amdgcn_readfirstlane(rows); u.arow = __builtin_amdgcn_readfirstlane((tb0 + local % T) * 256); return true;
    }
    __device__ __forceinline__ const char* a_base(const Unit& u) const { return GU ? (const char*)A : (const char*)A + (size_t)u.arow * (KU8 * 2); }
    __device__ __forceinline__ const char* b_base(const Unit& u) const { return (const char*)Bt + ((size_t)u.e * (GU ? 2048 : 1024) + (size_t)u.pn * 256) * (KU8 * 2); }
    static constexpr bool MB = true;
    __device__ __forceinline__ void mb_issue(LAS unsigned char* mb, const Unit& u, int wid, int lane) const {
        asm volatile("" : "+v"(lane));
        if (wid < 4) __builtin_amdgcn_global_load_lds((const unsigned*)(list + u.e * LISTCAP + u.pm * 256 + wid * 64 + lane), (LAS unsigned*)(mb + wid * 1024), 16, 0, 0);
        else if (wid == 4) {
            const float* bp = GU ? bias + (size_t)u.e * 2048 + u.pn * 128 + (lane >> 5) * 1024 + (lane & 31) * 4 : bias + (size_t)u.e * 1024 + u.pn * 256 + lane * 4;
            __builtin_amdgcn_global_load_lds((const unsigned*)bp, (LAS unsigned*)(mb + 4096), 16, 0, 0); }
    }
    __device__ __forceinline__ void a_offs(const Unit& u, int tid, unsigned (&go)[2][2], const LAS le_t* mb) const {
#pragma unroll
        for (int i = 0; i < 2; ++i) { int R, C; stage_rc(tid * 16 + i * 8192, R, C);
#pragma unroll
            for (int h = 0; h < 2; ++h) {
                if (GU) { const int r = h * HALF + R; const int raw = mb[r].x; const int tok = r < u.rows ? (raw >> 2) : NTOK; go[h][i] = (unsigned)(tok * KU8 + C) * 2u; }
                else go[h][i] = (unsigned)((h * HALF + R) * KU8 + C) * 2u;
            } }
    }
};

struct EpiBf16 {
    static constexpr bool PERM = true, HAS_INIT = false, AFTER_DRAIN = false;
    bf16_t* O; int ldc;
    __device__ __forceinline__ void operator()(const f32x4 (&acc)[2][2][4][2], const Unit& u, int wr, int wc, int fr, int fq, const LAS le_t*) const {
        const int row0 = u.pm * BM + wr * 64 + fr, col0 = u.pn * BM + wc * 32 + 8 * fq;
#pragma unroll
        for (int ai = 0; ai < 2; ++ai)
#pragma unroll
            for (int m = 0; m < 4; ++m) { bf16_t* rowp = O + (size_t)(row0 + ai * HALF + m * 16) * ldc + col0;
#pragma unroll
                for (int bj = 0; bj < 2; ++bj) { const f32x4 v0 = acc[ai][bj][m][0], v1 = acc[ai][bj][m][1];
                    u32x4 w; w.x = cvt_pk_bf16(v0[0], v0[1]); w.y = cvt_pk_bf16(v0[2], v0[3]); w.z = cvt_pk_bf16(v1[0], v1[1]); w.w = cvt_pk_bf16(v1[2], v1[3]);
                    *(u32x4*)(rowp + bj * HALF) = w; } }
    }
};
struct EpiX1 {
    static constexpr bool PERM = true, HAS_INIT = true, AFTER_DRAIN = true;
    const float* base; float* C; float* ssq; float* PL; unsigned char* H8; const float* nw; const bf16_t* wrh; const bf16_t* wrl;
    bool one;
    __device__ __forceinline__ void init_acc(f32x4 (&acc)[2][2][4][2], const Unit& u, int wr, int wc, int fr, int fq) const {
        const int row0 = u.pm * BM + wr * 64 + fr, col0 = u.pn * BM + wc * 32 + 8 * fq;
#pragma unroll
        for (int ai = 0; ai < 2; ++ai)
#pragma unroll
            for (int m = 0; m < 4; ++m) { const size_t off = (size_t)(row0 + ai * HALF + m * 16) * D + col0;
#pragma unroll
                for (int bj = 0; bj < 2; ++bj)
#pragma unroll
                    for (int n = 0; n < 2; ++n) acc[ai][bj][m][n] = *(const f32x4*)(base + off + bj * HALF + n * 4); }
    }
    __device__ __forceinline__ void operator()(const f32x4 (&acc)[2][2][4][2], const Unit& u, int wr, int wc, int fr, int fq, const LAS le_t*) const {
        const int row0 = u.pm * BM + wr * 64 + fr, col0 = u.pn * BM + wc * 32 + 8 * fq, p = u.pn * 4 + wc;
        f32x4 wv[2][2]; bf16x8 fh[2][2], fl[2][2];
#pragma unroll
        for (int bj = 0; bj < 2; ++bj) { wv[bj][0] = *(const f32x4*)(nw + col0 + bj * HALF); wv[bj][1] = *(const f32x4*)(nw + col0 + bj * HALF + 4);
#pragma unroll
            for (int et = 0; et < 2; ++et) { fh[bj][et] = *(const bf16x8*)(wrh + (16 * et + fr) * 1024 + col0 + bj * HALF); fl[bj][et] = *(const bf16x8*)(wrl + (16 * et + fr) * 1024 + col0 + bj * HALF); } }
        float* sp = ssq + (size_t)p * NTOK; float* plp = PL + (size_t)p * NTOK * 32 + 4 * fq;
#pragma unroll
        for (int ai = 0; ai < 2; ++ai)
#pragma unroll
            for (int m = 0; m < 4; ++m) { const int row = row0 + ai * HALF + m * 16; const size_t off = (size_t)row * D + col0; float s2 = 0.f;
                f32x4 pl0 = (f32x4){0.f, 0.f, 0.f, 0.f}, pl1 = pl0;
#pragma unroll
                for (int bj = 0; bj < 2; ++bj) { const f32x4 v0 = acc[ai][bj][m][0], v1 = acc[ai][bj][m][1];
                    { u32x4 xb; xb.x = cvt_pk_bf16(v0[0], v0[1]); xb.y = cvt_pk_bf16(v0[2], v0[3]); xb.z = cvt_pk_bf16(v1[0], v1[1]); xb.w = cvt_pk_bf16(v1[2], v1[3]);
                      *(u32x4*)((bf16_t*)(C + (size_t)row * D) + col0 + bj * HALF) = xb; }
                    s2 += (v0[0] * v0[0] + v0[1] * v0[1]) + (v0[2] * v0[2] + v0[3] * v0[3]) + (v1[0] * v1[0] + v1[1] * v1[1]) + (v1[2] * v1[2] + v1[3] * v1[3]);
                    const f32x4 h0 = v0 * wv[bj][0], h1 = v1 * wv[bj][1];
                    u32x4 hh, hl;
                    hh.x = cvt_pk_bf16(h0[0], h0[1]); hh.y = cvt_pk_bf16(h0[2], h0[3]); hh.z = cvt_pk_bf16(h1[0], h1[1]); hh.w = cvt_pk_bf16(h1[2], h1[3]);
                    hl.x = cvt_pk_bf16(h0[0] - bf_lo(hh.x), h0[1] - bf_hi(hh.x)); hl.y = cvt_pk_bf16(h0[2] - bf_lo(hh.y), h0[3] - bf_hi(hh.y));
                    hl.z = cvt_pk_bf16(h1[0] - bf_lo(hh.z), h1[1] - bf_hi(hh.z)); hl.w = cvt_pk_bf16(h1[2] - bf_lo(hh.w), h1[3] - bf_hi(hh.w));
                    u32x2 h8; h8.x = cvt4_fp8(h0[0], h0[1], h0[2], h0[3]); h8.y = cvt4_fp8(h1[0], h1[1], h1[2], h1[3]);
                    *(u32x2*)(H8 + off + bj * HALF) = h8;
                    const bf16x8 bhh = __builtin_bit_cast(bf16x8, hh), bhl = __builtin_bit_cast(bf16x8, hl);
                    pl0 = mfma16(fh[bj][0], bhh, pl0); pl0 = mfma16(fh[bj][0], bhl, pl0); pl0 = mfma16(fl[bj][0], bhh, pl0);
                    pl1 = mfma16(fh[bj][1], bhh, pl1); pl1 = mfma16(fh[bj][1], bhl, pl1); pl1 = mfma16(fl[bj][1], bhh, pl1); }
                s2 += __shfl_xor(s2, 16); s2 += __shfl_xor(s2, 32);
                if (fq == 0) sp[row] = s2;
                *(f32x4*)(plp + (size_t)row * 32) = pl0; *(f32x4*)(plp + (size_t)row * 32 + 16) = pl1; }
    }
    __device__ __forceinline__ void fused(const f32x4 (&acc)[2][2][4][2], const Unit& u, int wr, int wc, int fr, int fq, LAS unsigned char* lds, int tid) const {
        const int row0 = u.pm * BM + wr * 64 + fr, col0 = u.pn * BM + wc * 32 + 8 * fq;
        f32x4 wv[2][2]; bf16x8 fh[2][2], fl[2][2];
#pragma unroll
        for (int bj = 0; bj < 2; ++bj) { wv[bj][0] = *(const f32x4*)(nw + col0 + bj * HALF); wv[bj][1] = *(const f32x4*)(nw + col0 + bj * HALF + 4);
#pragma unroll
            for (int et = 0; et < 2; ++et) { fh[bj][et] = *(const bf16x8*)(wrh + (16 * et + fr) * 1024 + col0 + bj * HALF); fl[bj][et] = *(const bf16x8*)(wrl + (16 * et + fr) * 1024 + col0 + bj * HALF); } }
        LAS float* PLs = (LAS float*)lds + wc * (256 * 32); LAS float* SSs = (LAS float*)(lds + MB_OFF) + wc * 256;
#pragma unroll
        for (int ai = 0; ai < 2; ++ai)
#pragma unroll
            for (int m = 0; m < 4; ++m) { const int rl = ai * HALF + wr * 64 + m * 16 + fr, row = u.pm * BM + rl; const size_t off = (size_t)row * D + col0; float s2 = 0.f;
                f32x4 pl0 = (f32x4){0.f, 0.f, 0.f, 0.f}, pl1 = pl0;
#pragma unroll
                for (int bj = 0; bj < 2; ++bj) { const f32x4 v0 = acc[ai][bj][m][0], v1 = acc[ai][bj][m][1];
                    { u32x4 xb; xb.x = cvt_pk_bf16(v0[0], v0[1]); xb.y = cvt_pk_bf16(v0[2], v0[3]); xb.z = cvt_pk_bf16(v1[0], v1[1]); xb.w = cvt_pk_bf16(v1[2], v1[3]);
                      *(u32x4*)((bf16_t*)(C + (size_t)row * D) + col0 + bj * HALF) = xb; }
                    s2 += (v0[0] * v0[0] + v0[1] * v0[1]) + (v0[2] * v0[2] + v0[3] * v0[3]) + (v1[0] * v1[0] + v1[1] * v1[1]) + (v1[2] * v1[2] + v1[3] * v1[3]);
                    const f32x4 h0 = v0 * wv[bj][0], h1 = v1 * wv[bj][1];
                    u32x4 hh, hl;
                    hh.x = cvt_pk_bf16(h0[0], h0[1]); hh.y = cvt_pk_bf16(h0[2], h0[3]); hh.z = cvt_pk_bf16(h1[0], h1[1]); hh.w = cvt_pk_bf16(h1[2], h1[3]);
                    hl.x = cvt_pk_bf16(h0[0] - bf_lo(hh.x), h0[1] - bf_hi(hh.x)); hl.y = cvt_pk_bf16(h0[2] - bf_lo(hh.y), h0[3] - bf_hi(hh.y));
                    hl.z = cvt_pk_bf16(h1[0] - bf_lo(hh.z), h1[1] - bf_hi(hh.z)); hl.w = cvt_pk_bf16(h1[2] - bf_lo(hh.w), h1[3] - bf_hi(hh.w));
                    u32x2 h8; h8.x = cvt4_fp8(h0[0], h0[1], h0[2], h0[3]); h8.y = cvt4_fp8(h1[0], h1[1], h1[2], h1[3]);
                    *(u32x2*)(H8 + off + bj * HALF) = h8;
                    const bf16x8 bhh = __builtin_bit_cast(bf16x8, hh), bhl = __builtin_bit_cast(bf16x8, hl);
                    pl0 = mfma16(fh[bj][0], bhh, pl0); pl0 = mfma16(fh[bj][0], bhl, pl0); pl0 = mfma16(fl[bj][0], bhh, pl0);
                    pl1 = mfma16(fh[bj][1], bhh, pl1); pl1 = mfma16(fh[bj][1], bhl, pl1); pl1 = mfma16(fl[bj][1], bhh, pl1); }
                s2 += __shfl_xor(s2, 16); s2 += __shfl_xor(s2, 32);
                if (fq == 0) SSs[rl] = s2;
                *(LAS f32x4*)(PLs + rl * 32 + 4 * (fq ^ (rl & 7))) = pl0; *(LAS f32x4*)(PLs + rl * 32 + 4 * ((4 + fq) ^ (rl & 7))) = pl1; }
        asm volatile("s_waitcnt lgkmcnt(0)" ::: "memory"); __builtin_amdgcn_s_barrier(); asm volatile("" ::: "memory");
        {
            const int rl = tid >> 1, hf = tid & 1, row = u.pm * BM + rl;
            f32x4 sum[4];
#pragma unroll
            for (int q = 0; q < 4; ++q) { sum[q] = (f32x4){0.f, 0.f, 0.f, 0.f};
#pragma unroll
                for (int c4 = 0; c4 < 4; ++c4) sum[q] += *(const LAS f32x4*)((const LAS float*)lds + c4 * (256 * 32) + rl * 32 + 4 * ((4 * hf + q) ^ (rl & 7))); }
            float* dst = PL + ((size_t)u.pn * NTOK + row) * 32 + 16 * hf;
#pragma unroll
            for (int q = 0; q < 4; ++q) *(f32x4*)(dst + 4 * q) = sum[q];
            if (hf == 0) { const LAS float* S0 = (const LAS float*)(lds + MB_OFF); ssq[(size_t)u.pn * NTOK + row] = ((S0[rl] + S0[256 + rl]) + S0[512 + rl]) + S0[768 + rl]; }
        }
    }
};
constexpr float WSCL = 1.0f / 32.0f;
__device__ __forceinline__ float swiglu(float g, float l) {
    g = fminf(g, 7.0f); l = fminf(fmaxf(l, -7.0f), 7.0f);
    const float s = __builtin_amdgcn_rcpf(1.0f + __builtin_amdgcn_exp2f(-1.702f * 1.4426950408889634f * g));
    return g * s * (l + 1.0f);
}
struct EpiGU {
    static constexpr bool PERM = true, HAS_INIT = false, AFTER_DRAIN = false;
    unsigned char* ACT;
    __device__ __forceinline__ void operator()(const f32x4 (&acc)[2][2][4][2], const Unit& u, int wr, int wc, int fr, int fq, const LAS le_t* mb) const {
        const int row0 = u.arow + wr * 64 + fr, cl = wc * 32 + 8 * fq, colg = u.pn * 128 + cl;
        const LAS float* bl = (const LAS float*)mb + 1024 + cl;
        const f32x4 bg0 = *(const LAS f32x4*)(bl), bg1 = *(const LAS f32x4*)(bl + 4), bl0 = *(const LAS f32x4*)(bl + 128), bl1 = *(const LAS f32x4*)(bl + 128 + 4);
        int rb = wr * 64 + fr; asm volatile("" : "+v"(rb));
#pragma unroll
        for (int ai = 0; ai < 2; ++ai)
#pragma unroll
            for (int m = 0; m < 4; ++m) {
                const float rs = __int_as_float(mb[ai * HALF + m * 16 + rb].z) * WSCL;
                const f32x4 g0 = acc[ai][0][m][0] * rs + bg0, g1 = acc[ai][0][m][1] * rs + bg1, l0 = acc[ai][1][m][0] * rs + bl0, l1 = acc[ai][1][m][1] * rs + bl1;
                u32x2 w; w.x = cvt4_fp8(swiglu(g0[0], l0[0]), swiglu(g0[1], l0[1]), swiglu(g0[2], l0[2]), swiglu(g0[3], l0[3]));
                w.y = cvt4_fp8(swiglu(g1[0], l1[0]), swiglu(g1[1], l1[1]), swiglu(g1[2], l1[2]), swiglu(g1[3], l1[3]));
                *(u32x2*)(ACT + (size_t)(row0 + ai * HALF + m * 16) * FF + colg) = w; }
    }
};
struct EpiDown {
    static constexpr bool PERM = true, HAS_INIT = false, AFTER_DRAIN = false;
    unsigned char* Y;
    __device__ __forceinline__ void operator()(const f32x4 (&acc)[2][2][4][2], const Unit& u, int wr, int wc, int fr, int fq, const LAS le_t* mb) const {
        const int cl = wc * 32 + 8 * fq, col0 = u.pn * BM + cl;
        const LAS float* bl = (const LAS float*)mb + 1024 + cl;
        int rb = wr * 64 + fr; asm volatile("" : "+v"(rb));
#pragma unroll
        for (int bj = 0; bj < 2; ++bj) {
            const f32x4 b0 = *(const LAS f32x4*)(bl + bj * HALF), b1 = *(const LAS f32x4*)(bl + bj * HALF + 4);
#pragma unroll
            for (int ai = 0; ai < 2; ++ai)
#pragma unroll
                for (int m = 0; m < 4; ++m) { const int r = ai * HALF + m * 16 + rb;
                    if (r < u.rows) { const le_t sg = mb[r]; const int slot = sg.x; const float gt = __int_as_float(sg.y) * 16.0f;
                        const f32x4 v0 = (acc[ai][bj][m][0] * WSCL + b0) * gt, v1 = (acc[ai][bj][m][1] * WSCL + b1) * gt;
                        u32x2 w; w.x = cvt4_fp8(v0[0], v0[1], v0[2], v0[3]); w.y = cvt4_fp8(v1[0], v1[1], v1[2], v1[3]);
                        *(u32x2*)(Y + (size_t)slot * D + col0 + bj * HALF) = w; } }
        }
    }
};

typedef int i32x4 __attribute__((ext_vector_type(4)));
__device__ __forceinline__ bf16x8 lo8(i32x8 a) { return __builtin_bit_cast(bf16x8, __builtin_shufflevector(a, a, 0, 1, 2, 3)); }
__device__ __forceinline__ bf16x8 hi8(i32x8 a) { return __builtin_bit_cast(bf16x8, __builtin_shufflevector(a, a, 4, 5, 6, 7)); }
__device__ __forceinline__ void glds_s(unsigned voff, const char* sbase, unsigned lds_dst) { unsigned keep;
    asm volatile("s_mov_b32 %0, m0\n\ts_mov_b32 m0, %2\n\ts_nop 0\n\tglobal_load_lds_dwordx4 %1, %3\n\ts_mov_b32 m0, %0" : "=&s"(keep) : "v"(voff), "s"(lds_dst), "s"(sbase) : "memory"); }
template <class Epi, class Sched, bool ALIGN_EPI, bool FP8 = false>
__device__ __forceinline__ void gemm_phase(LAS unsigned char* lds, const Sched& S, const Epi& E) {
    const int tid = threadIdx.x, wid = __builtin_amdgcn_readfirstlane(tid >> 6), lane = tid & 63, wr = wid >> 2, wc = wid & 3, fr = lane & 15, fq = lane >> 4;
    constexpr int K = FP8 ? 512 : KK;
    int nt = K / BK; asm volatile("" : "+s"(nt));
    unsigned voffB[2];
#pragma unroll
    for (int i = 0; i < 2; ++i) { int R, C; stage_rc(tid * 16 + i * 8192, R, C); const int Rb = Epi::PERM ? ((R & ~31) + perm32(R & 31)) : R;
        voffB[i] = (unsigned)(Rb * K + C) * 2u; }
    constexpr size_t kstep = (size_t)(BK * 2);
    constexpr size_t hstep = (size_t)HALF * K * 2;
    const unsigned ldsw = (unsigned)wid * 1024u;
    const unsigned ldsb = (unsigned)__builtin_amdgcn_readfirstlane((int)((unsigned)(size_t)lds + ldsw));
    const int aoff = lds_byte(wr * 64 + fr, fq * 8), boff = lds_byte(wc * 32 + fr, fq * 8);
#define PG8_SA(b, h) (((b) * 2 + (h)) * HTB)
#define PG8_SB(b, h) ((4 + (b) * 2 + (h)) * HTB)
#define PG8_STAGE(bufoff, gbase, voff) do { _Pragma("unroll") for (int _i = 0; _i < 2; ++_i) glds_s((voff)[_i], (const char*)(gbase), ldsb + (unsigned)((bufoff) + _i * 8192)); } while (0)
#define PG8_LDA(dst, b, h) do { _Pragma("unroll") for (int m = 0; m < 4; ++m) { const u32x4 _x = *(const LAS u32x4*)(lds + PG8_SA(b, h) + aoff + m * 2048), _y = *(const LAS u32x4*)(lds + PG8_SA(b, h) + aoff + m * 2048 + 1024); \
        dst[m] = (i32x8){(int)_x[0], (int)_x[1], (int)_x[2], (int)_x[3], (int)_y[0], (int)_y[1], (int)_y[2], (int)_y[3]}; } } while (0)
#define PG8_LDB(dst, b, h) do { _Pragma("unroll") for (int n = 0; n < 2; ++n) { const u32x4 _x = *(const LAS u32x4*)(lds + PG8_SB(b, h) + boff + n * 2048), _y = *(const LAS u32x4*)(lds + PG8_SB(b, h) + boff + n * 2048 + 1024); \
        dst[n] = (i32x8){(int)_x[0], (int)_x[1], (int)_x[2], (int)_x[3], (int)_y[0], (int)_y[1], (int)_y[2], (int)_y[3]}; } } while (0)
#define PG8_MMA(ai, bj, At, Bt) do { __builtin_amdgcn_s_setprio(1); _Pragma("unroll") for (int m = 0; m < 4; ++m) _Pragma("unroll") for (int n = 0; n < 2; ++n) { \
        if constexpr (FP8) { acc[ai][bj][m][n] = __builtin_amdgcn_mfma_scale_f32_16x16x128_f8f6f4(Bt[n], At[m], acc[ai][bj][m][n], 0, 0, 0, 0, 0, 0); } \
        else { acc[ai][bj][m][n] = __builtin_amdgcn_mfma_f32_16x16x32_bf16(lo8(Bt[n]), lo8(At[m]), acc[ai][bj][m][n], 0, 0, 0); acc[ai][bj][m][n] = __builtin_amdgcn_mfma_f32_16x16x32_bf16(hi8(Bt[n]), hi8(At[m]), acc[ai][bj][m][n], 0, 0, 0); } } __builtin_amdgcn_s_setprio(0); } while (0)
#define PG8_WAIT_V(n) asm volatile("s_waitcnt vmcnt(" #n ")" ::: "memory")
#define PG8_WAIT_L(n) asm volatile("s_waitcnt lgkmcnt(" #n ")" ::: "memory")
#define PG8_BAR __builtin_amdgcn_s_barrier()
#define PG8_SCHED __builtin_amdgcn_sched_barrier(0)
    Unit cur, nxt; int ui = 0;
    if (!S.next(0, cur)) return;
    f32x4 acc[2][2][4][2];
    if constexpr (Epi::HAS_INIT) E.init_acc(acc, cur, wr, wc, fr, fq);
    else {
#pragma unroll
    for (int a = 0; a < 2; ++a)
#pragma unroll
        for (int b = 0; b < 2; ++b)
#pragma unroll
            for (int m = 0; m < 4; ++m)
#pragma unroll
                for (int n = 0; n < 2; ++n) acc[a][b][m][n] = (f32x4){0.f, 0.f, 0.f, 0.f};
    }
    i32x8 At[4], B0[2], B1[2];
    const char* cA = S.a_base(cur); const char* cB = S.b_base(cur);
    unsigned go[2][2];
    LAS unsigned char* const mbx = lds + (MB_OFF - 0);
    if constexpr (Sched::MB) { S.mb_issue(mbx, cur, wid, lane); asm volatile("s_waitcnt vmcnt(0)" ::: "memory"); __builtin_amdgcn_s_barrier(); asm volatile("" ::: "memory"); }
    { int t2 = tid; asm volatile("" : "+v"(t2)); S.a_offs(cur, t2, go, (const LAS le_t*)mbx); }
    PG8_STAGE(PG8_SB(0, 0), cB, voffB); PG8_STAGE(PG8_SB(0, 1), cB + hstep, voffB); PG8_STAGE(PG8_SA(0, 0), cA, go[0]); PG8_STAGE(PG8_SA(0, 1), cA, go[1]);
    if (wr == 1) PG8_BAR;
    PG8_WAIT_V(2); PG8_BAR;
    PG8_STAGE(PG8_SB(1, 0), cB + kstep, voffB); PG8_STAGE(PG8_SA(1, 0), cA + kstep, go[0]); PG8_STAGE(PG8_SB(1, 1), cB + hstep + kstep, voffB);
    PG8_WAIT_V(6); PG8_BAR;
    asm volatile("" : "+v"(voffB[0]), "+v"(voffB[1]), "+v"(go[0][0]), "+v"(go[0][1]), "+v"(go[1][0]), "+v"(go[1][1]));
    for (;;) {
        const bool has_next = S.next(ui + 1, nxt);
        const char* nA = has_next ? S.a_base(nxt) : cA; const char* nB = has_next ? S.b_base(nxt) : cB;
#pragma clang loop unroll(disable)
        for (int t = 0; t < nt; t += 2) {
            const bool last = (t == nt - 2);
            asm volatile("" : "+v"(voffB[0]), "+v"(voffB[1]));
            const char* a1 = cA + (size_t)(t + 1) * kstep;
            const char* a2 = last ? nA : cA + (size_t)(t + 2) * kstep; const char* b2 = last ? nB : cB + (size_t)(t + 2) * kstep;
            const char* a3 = a2 + kstep; const char* b3 = b2 + kstep;
            PG8_LDB(B0, 0, 0); PG8_LDB(B1, 0, 1); PG8_SCHED; PG8_LDA(At, 0, 0); PG8_STAGE(PG8_SA(1, 1), a1, go[1]);
            if (last && has_next) { int t2 = tid; asm volatile("" : "+v"(t2)); S.a_offs(nxt, t2, go, (const LAS le_t*)(mbx + ((ui + 1) & 1) * 5120)); }
            PG8_WAIT_V(8); PG8_WAIT_L(0); PG8_BAR; PG8_MMA(0, 0, At, B0); PG8_MMA(0, 1, At, B1); PG8_BAR; PG8_SCHED;
            if constexpr (Sched::MB) { if (t == 0 && has_next) S.mb_issue(mbx + ((ui + 1) & 1) * 5120, nxt, wid, lane); }
            PG8_LDA(At, 0, 1); PG8_STAGE(PG8_SB(0, 0), b2, voffB); PG8_STAGE(PG8_SB(0, 1), b2 + hstep, voffB); PG8_STAGE(PG8_SA(0, 0), a2, go[0]);
            PG8_WAIT_V(8); PG8_WAIT_L(0); PG8_BAR; PG8_MMA(1, 0, At, B0); PG8_MMA(1, 1, At, B1); PG8_BAR; PG8_SCHED;
            PG8_LDB(B0, 1, 0); PG8_LDB(B1, 1, 1); PG8_SCHED; PG8_LDA(At, 1, 0); PG8_STAGE(PG8_SA(0, 1), a2, go[1]);
            PG8_WAIT_V(8); PG8_WAIT_L(0); PG8_BAR; PG8_MMA(0, 0, At, B0); PG8_MMA(0, 1, At, B1); PG8_BAR; PG8_SCHED;
            PG8_LDA(At, 1, 1); PG8_STAGE(PG8_SB(1, 0), b3, voffB); PG8_STAGE(PG8_SB(1, 1), b3 + hstep, voffB); PG8_STAGE(PG8_SA(1, 0), a3, go[0]);
            PG8_WAIT_V(8); PG8_WAIT_L(0); PG8_BAR; PG8_MMA(1, 0, At, B0); PG8_MMA(1, 1, At, B1); PG8_BAR; PG8_SCHED;
        }
        if constexpr (ALIGN_EPI) { if (wr == 0) PG8_BAR; }
        bool epi_now = true; if constexpr (Epi::AFTER_DRAIN) epi_now = !E.one;
        if (epi_now) { int t2 = tid; asm volatile("" : "+v"(t2)); const int l2 = t2 & 63; E(acc, cur, wr, wc, l2 & 15, l2 >> 4, (const LAS le_t*)(mbx + (ui & 1) * 5120)); }
        if (!has_next) break;
        if constexpr (Epi::HAS_INIT) { int t2 = tid; asm volatile("" : "+v"(t2)); const int l2 = t2 & 63; E.init_acc(acc, nxt, wr, wc, l2 & 15, l2 >> 4); }
        else {
#pragma unroll
        for (int a = 0; a < 2; ++a)
#pragma unroll
            for (int b = 0; b < 2; ++b)
#pragma unroll
                for (int m = 0; m < 4; ++m)
#pragma unroll
                    for (int n = 0; n < 2; ++n) acc[a][b][m][n] = (f32x4){0.f, 0.f, 0.f, 0.f};
        }
        cur = nxt; cA = nA; cB = nB; ++ui;
        if constexpr (ALIGN_EPI) { if (wr == 1) PG8_BAR; }
    }
    PG8_WAIT_V(0);
    if constexpr (!ALIGN_EPI) { if (wr == 0) PG8_BAR; }
    PG8_BAR;
    if constexpr (Epi::AFTER_DRAIN) { if (E.one) { int t2 = tid; asm volatile("" : "+v"(t2)); const int l2 = t2 & 63; E.fused(acc, cur, wr, wc, l2 & 15, l2 >> 4, lds, t2); } }
#undef PG8_SA
#undef PG8_SB
#undef PG8_STAGE
#undef PG8_LDA
#undef PG8_LDB
#undef PG8_MMA
#undef PG8_WAIT_V
#undef PG8_WAIT_L
#undef PG8_BAR
#undef PG8_SCHED
}
}

#define XB_TMO      128
#define XB_XCNT(j)  (256  + 64 * (j))
#define XB_XSUB(j)  (1280 + 64 * (j))
#define XB_XGEN(j)  (2304 + 64 * (j))
#define XB_TOP      3328
#define XB_TOPGEN   3392
#define XCD_BAR_WORDS 3456
#define XB_SPIN_CAP (1u << 18)
__device__ __forceinline__ unsigned xb_ld(unsigned* p)              { return __hip_atomic_load(p, __ATOMIC_RELAXED, __HIP_MEMORY_SCOPE_AGENT); }
__device__ __forceinline__ unsigned xb_add(unsigned* p, unsigned v) { return __hip_atomic_fetch_add(p, v, __ATOMIC_RELAXED, __HIP_MEMORY_SCOPE_AGENT); }
__device__ __forceinline__ unsigned xb_xcc_id() { return (unsigned)__builtin_amdgcn_s_getreg((3 << 11) | 20) & 0xFu; }
#define XB_SPIN(cond, bar) do { unsigned _sp = 0; while (cond) { __builtin_amdgcn_s_sleep(1); \
    if ((++_sp & 255u) == 0u) { if (xb_ld(&(bar)[XB_TMO])) break; if (_sp > XB_SPIN_CAP) { atomicAdd(&(bar)[XB_TMO], 1u); break; } } } } while (0)
struct XcdBarrier { unsigned* bar; unsigned x; volatile LAS unsigned* st; };
__device__ __forceinline__ XcdBarrier xcd_barrier_post(unsigned* bar, volatile LAS unsigned* st) {
    XcdBarrier b; b.bar = bar; b.x = xb_xcc_id(); b.st = st;
    if (threadIdx.x == 0) (void)xb_add(&bar[XB_XCNT(b.x)], 1u);
    return b;
}
__device__ __forceinline__ void xcd_barrier_complete(unsigned* bar, unsigned x, unsigned& nloc, unsigned& nx) {
    const unsigned G = gridDim.x * gridDim.y * gridDim.z;
    unsigned sum, cnt, mine, sp = 0u;
    for (;;) {
        sum = 0u; cnt = 0u; mine = 0u;
#pragma unroll
        for (unsigned j = 0; j < 16; ++j) { const unsigned c = xb_ld(&bar[XB_XCNT(j)]); sum += c; cnt += (c > 0u) ? 1u : 0u; mine = (j == x) ? c : mine; }
        if (sum == G) break;
        __builtin_amdgcn_s_sleep(1);
        if ((++sp & 255u) == 0u) { if (xb_ld(&bar[XB_TMO])) break; if (sp > XB_SPIN_CAP) { atomicAdd(&bar[XB_TMO], 1u); break; } }
    }
    nloc = mine > 0u ? mine : 1u; nx = cnt > 0u ? cnt : 1u;
}
__device__ __forceinline__ void xcd_barrier(const XcdBarrier& b) {
    asm volatile("s_waitcnt vmcnt(0)" ::: "memory");
    __syncthreads();
    if (threadIdx.x == 0) {
        unsigned* bar = b.bar;
        __builtin_amdgcn_s_waitcnt(0);
        unsigned nloc = b.st[0], nx = b.st[1];
        if (nloc == 0u) { xcd_barrier_complete(bar, b.x, nloc, nx); b.st[0] = nloc; b.st[1] = nx; }
        const unsigned old = xb_add(&bar[XB_XSUB(b.x)], 1u);
        const unsigned gen = old / nloc;
        if (old + 1u == (gen + 1u) * nloc) {
            __builtin_amdgcn_fence(__ATOMIC_RELEASE, "agent");
            asm volatile("s_waitcnt vmcnt(0)" ::: "memory");
            const unsigned og = xb_add(&bar[XB_TOP], 1u);
            const unsigned tg = og / nx;
            if (og + 1u == (tg + 1u) * nx) xb_add(&bar[XB_TOPGEN], 1u);
            else XB_SPIN(xb_ld(&bar[XB_TOPGEN]) == tg, bar);
            __builtin_amdgcn_fence(__ATOMIC_ACQUIRE, "agent");
            xb_add(&bar[XB_XGEN(b.x)], 1u);
            asm volatile("s_waitcnt vmcnt(0)" ::: "memory");
        } else {
            XB_SPIN(xb_ld(&bar[XB_XGEN(b.x)]) == gen, bar);
            __builtin_amdgcn_fence(__ATOMIC_ACQUIRE, "agent");
            asm volatile("s_waitcnt vmcnt(0)" ::: "memory");
        }
    }
    __syncthreads();
}

struct Frame {
    LAS unsigned char* lds;
    volatile LAS unsigned* MISC;
    gu32* ctl;
    int tid, lane, wave, vcu, G;
    const float *x, *norm_mix_w, *w_in, *ret_norm_w, *w_pool, *pool_scale, *w_out, *norm_ffn_w, *w_router, *b_router, *w_gu, *b_gu, *w_down, *b_down, *norm_final_w;
    float* out;
    bf16_t *Wr_hi, *Wr_lo, *Wpool_t, *Win_t, *Wout_t, *XN, *CAT, *U, *Z, *Y;
    unsigned char *Wgu8, *Wd8, *ACT8, *H8;
    le_t* list; float* ssq; float* PL;
    float lg2g0, lg2g1, lg2g2, lg2g3;
    __device__ __forceinline__ float lg2(int h) const { return h == 0 ? lg2g0 : (h == 1 ? lg2g1 : (h == 2 ? lg2g2 : lg2g3)); }
};

template <int MODE>
__device__ __forceinline__ void p0_item(const float* W, int ldw, void* WT, void* WT2, int ldo, LAS float* scr, int k0, int n0, int orow0, int lane) {
    f32x4 v[16];
    const float* src = W + (size_t)(k0 + (lane >> 3)) * ldw + n0 + 4 * (lane & 7);
#pragma unroll
    for (int i = 0; i < 16; ++i) v[i] = *(const GAS f32x4*)(src + (size_t)(8 * i) * ldw);
#pragma unroll
    for (int i = 0; i < 16; ++i) *(LAS f32x4*)(scr + (8 * i + (lane >> 3)) * 32 + 4 * ((lane & 7) ^ (i & 7))) = v[i];
    LDS_WAIT(); asm volatile("" ::: "memory");
    const int c = lane & 15, ns = lane >> 4;
#pragma unroll
    for (int J = 0; J < 8; ++J) {
        const LAS float* sp = scr + (8 * c) * 32 + 4 * (J ^ (c & 7)) + ns;
        float x[8];
#pragma unroll
        for (int q = 0; q < 8; ++q) x[q] = sp[q * 32];
        const int n = 4 * J + ns;
        if (MODE == 2) { u32x2 o; o.x = cvt4_fp8(x[0] * 32.f, x[1] * 32.f, x[2] * 32.f, x[3] * 32.f); o.y = cvt4_fp8(x[4] * 32.f, x[5] * 32.f, x[6] * 32.f, x[7] * 32.f);
            *(GAS u32x2*)((unsigned char*)WT + (size_t)(orow0 + n) * 1024 + k0 + 8 * c) = o; }
        else { u32x4 o; o.x = cvt_pk_bf16(x[0], x[1]); o.y = cvt_pk_bf16(x[2], x[3]); o.z = cvt_pk_bf16(x[4], x[5]); o.w = cvt_pk_bf16(x[6], x[7]);
            *(GAS u32x4*)((bf16_t*)WT + (size_t)(orow0 + n) * ldo + k0 + 8 * c) = o;
            if (MODE == 1) { u32x4 o2; o2.x = cvt_pk_bf16(x[0] - bf_lo(o.x), x[1] - bf_hi(o.x)); o2.y = cvt_pk_bf16(x[2] - bf_lo(o.y), x[3] - bf_hi(o.y));
                o2.z = cvt_pk_bf16(x[4] - bf_lo(o.z), x[5] - bf_hi(o.z)); o2.w = cvt_pk_bf16(x[6] - bf_lo(o.w), x[7] - bf_hi(o.w));
                *(GAS u32x4*)((bf16_t*)WT2 + (size_t)(orow0 + n) * ldo + k0 + 8 * c) = o2; } }
    }
    LDS_WAIT(); asm volatile("" ::: "memory");
}
__device__ __forceinline__ void rms_rows4_to_bf16(int lane, const float* x, const float* w, bf16_t* o, int m, int rs) {
    f32x4 v[4][4];
#pragma unroll
    for (int r = 0; r < 4; ++r) { const GAS f32x4* xr = (const GAS f32x4*)(x + (size_t)(m + r * rs) * D) + lane;
#pragma unroll
        for (int j = 0; j < 4; ++j) v[r][j] = __builtin_nontemporal_load(xr + 64 * j); }
    const GAS f32x4* wr = (const GAS f32x4*)w + lane;
    f32x4 ww[4];
#pragma unroll
    for (int j = 0; j < 4; ++j) ww[j] = wr[64 * j];
#pragma unroll
    for (int r = 0; r < 4; ++r) { float s = 0.f;
#pragma unroll
        for (int j = 0; j < 4; ++j) s += (v[r][j].x * v[r][j].x + v[r][j].y * v[r][j].y) + (v[r][j].z * v[r][j].z + v[r][j].w * v[r][j].w);
        const float rstd = 1.f / sqrtf(wave_sum(s) * (1.f / D) + EPS);
        GAS u32x2* o8 = (GAS u32x2*)(o + (size_t)(m + r * rs) * D) + lane;
#pragma unroll
        for (int j = 0; j < 4; ++j) { u32x2 p; p.x = cvt_pk_bf16(v[r][j].x * rstd * ww[j].x, v[r][j].y * rstd * ww[j].y); p.y = cvt_pk_bf16(v[r][j].z * rstd * ww[j].z, v[r][j].w * rstd * ww[j].w); o8[64 * j] = p; } }
}
template <int MODE, class RM>
__device__ __forceinline__ void p0_block_item(const float* W, int ldw, void* WT, int ldo, LAS float* tile, int k0, int n0, int wave, int lane, RM rowmap) {
    f32x4 v[16];
    const float* src = W + (size_t)(k0 + 16 * wave) * ldw + n0 + 4 * lane;
#pragma unroll
    for (int i = 0; i < 16; ++i) v[i] = __builtin_nontemporal_load((const GAS f32x4*)(src + (size_t)i * ldw));
#pragma unroll
    for (int i = 0; i < 16; ++i) { const int kl = 16 * wave + i; *(LAS f32x4*)(tile + kl * 256 + 4 * (lane ^ ((kl >> 3) & 7))) = v[i]; }
    __syncthreads();
    const int c = lane & 15, ns = lane >> 4;
#pragma unroll
    for (int J = 0; J < 8; ++J) {
        const LAS float* sp = tile + (8 * c) * 256 + 4 * ((8 * wave + J) ^ (c & 7)) + ns;
        float x[8];
#pragma unroll
        for (int q = 0; q < 8; ++q) x[q] = sp[q * 256];
        const int orow = rowmap(n0 + 32 * wave + 4 * J + ns);
        if (MODE == 2) { u32x2 o; o.x = cvt4_fp8(x[0] * 32.f, x[1] * 32.f, x[2] * 32.f, x[3] * 32.f); o.y = cvt4_fp8(x[4] * 32.f, x[5] * 32.f, x[6] * 32.f, x[7] * 32.f);
            __builtin_nontemporal_store(o, (GAS u32x2*)((unsigned char*)WT + (size_t)orow * 1024 + k0 + 8 * c)); }
        else { u32x4 o; o.x = cvt_pk_bf16(x[0], x[1]); o.y = cvt_pk_bf16(x[2], x[3]); o.z = cvt_pk_bf16(x[4], x[5]); o.w = cvt_pk_bf16(x[6], x[7]);
            *(GAS u32x4*)((bf16_t*)WT + (size_t)orow * ldo + k0 + 8 * c) = o; }
    }
    __syncthreads();
}
struct RowId { __device__ __forceinline__ int operator()(int n) const { return n; } };
struct RowGU { __device__ __forceinline__ int operator()(int n) const { const int m = n & 1023; return ((m >> 7) << 8) + (n >> 10) * 128 + (m & 127); } };
__device__ __forceinline__ void p0_prologue(Frame& F) {
    LAS float* tile = (LAS float*)F.lds;
    constexpr int B_GU = 32 * 8 * 8, B_IN = 8 * 10, B_OUT = 8 * 4, NB = B_GU + B_IN + B_OUT;
    for (int it = F.vcu; it < NB; it += F.G) {
        int r = it;
        if (r < B_GU) { const int e = r >> 6, q = r & 63, kb = q >> 3, nb = q & 7; p0_block_item<2>(F.w_gu + (size_t)e * 1024 * 2048, 2048, F.Wgu8 + (size_t)e * 2048 * 1024, 1024, tile, kb * 128, nb * 256, F.wave, F.lane, RowGU()); continue; } r -= B_GU;
        if (r < B_IN) { const int kb = r / 10, nb = r % 10; p0_block_item<0>(F.w_in, DIN, F.Win_t, 1024, tile, kb * 128, nb * 256, F.wave, F.lane, RowId()); continue; } r -= B_IN;
        { const int kb = r >> 2, nb = r & 3; p0_block_item<0>(F.w_out, 1024, F.Wout_t, 1024, tile, kb * 128, nb * 256, F.wave, F.lane, RowId()); }
    }
    LAS float* scr = (LAS float*)(F.lds + F.wave * 16384);
    const int gw = F.vcu * NWAVES + F.wave, NGW = F.G * NWAVES;
    constexpr int I_POOL = 16, I_R = 8;
    for (int it = gw; it < I_POOL + I_R; it += NGW) {
        if (it < I_POOL) { const int g = it / 4, nb = it % 4; p0_item<0>(F.w_pool + g * 16384, 128, F.Wpool_t + g * 16384, nullptr, 128, scr, 0, nb * 32, nb * 32, F.lane); }
        else { const int kb = it - I_POOL; p0_item<1>(F.w_router, 32, F.Wr_hi, F.Wr_lo, 1024, scr, kb * 128, 0, 0, F.lane); }
    }
    for (int m = gw; m < NTOK / 4; m += NGW) rms_rows4_to_bf16(F.lane, F.x, F.norm_mix_w, F.XN, m, NTOK / 4);
}

constexpr int CONV_ITEMS = 32 * 8 * 4;
__device__ __forceinline__ void conv_pull(Frame& F, int budget) {
    LAS float* tile = (LAS float*)F.lds;
    for (int n = 0; n < budget; ++n) {
        if (F.tid == 0) F.MISC[44 + (n & 1)] = atomicAdd((unsigned*)(F.ctl + CW_Q), 1u);
        __syncthreads();
        const int it = (int)F.MISC[44 + (n & 1)];
        if (it >= CONV_ITEMS) break;
        const int e = it >> 5, q = it & 31, kb = q >> 2, nb = q & 3;
        p0_block_item<2>(F.w_down + (size_t)e * 1024 * 1024, 1024, F.Wd8 + (size_t)e * 1024 * 1024, 1024, tile, kb * 128, nb * 256, F.wave, F.lane, RowId());
    }
}

__device__ __forceinline__ void rope_cs(int pos, int j, float& cs, float& sn) {
    const float inv = __builtin_amdgcn_exp2f((float)j * (-13.287712379549449f / 64.0f));
    const double revd = (double)pos * (double)inv * 0.15915494309189535;
    const float rev = (float)(revd - __builtin_floor(revd));
    sn = __builtin_amdgcn_sinf(rev); cs = __builtin_amdgcn_cosf(rev);
}

__device__ __forceinline__ int tr_idx(int d, int m) { return d * 72 + 8 * ((m >> 3) ^ ((d >> 3) & 7)) + (m & 7); }
__device__ __forceinline__ int tr_frag(int r, int chunk) { return r * 72 + 8 * (chunk ^ ((r >> 3) & 7)); }

struct RawKV { u32x4 klo, khi, vlo, vhi; };
__device__ __forceinline__ void retA_load(const Frame& F, int unit, RawKV& r) {
    const int c = unit & 63, bh = unit >> 6, h = bh & 3, b = bh >> 2, m = F.tid >> 3, o = F.tid & 7;
    const bf16_t* zrow = F.Z + (size_t)(b * SEQ + c * 64 + m) * DIN + h * 128 + 8 * o;
    r.klo = *(const u32x4*)(zrow + 512); r.khi = *(const u32x4*)(zrow + 512 + 64); r.vlo = *(const u32x4*)(zrow + 1024); r.vhi = *(const u32x4*)(zrow + 1024 + 64);
}
__device__ __forceinline__ void retA_stage(const Frame& F, int unit, const RawKV& r) {
    const int c = unit & 63, h = (unit >> 6) & 3, m = F.tid >> 3, o = F.tid & 7;
    LAS bf16_t* KT = (LAS bf16_t*)(F.lds);
    LAS bf16_t* VT = KT + 128 * 72;
    const float ksc = __builtin_amdgcn_exp2f(F.lg2(h) * (float)(63 - m)) * 0.08838834764831845f;
    const int pos = c * 64 + m;
#pragma unroll
    for (int i = 0; i < 8; ++i) {
        const unsigned wl = r.klo[i >> 1], wh = r.khi[i >> 1];
        const float lo = (i & 1) ? bf_hi(wl) : bf_lo(wl), hi = (i & 1) ? bf_hi(wh) : bf_lo(wh);
        float cs, sn; rope_cs(pos, 8 * o + i, cs, sn);
        const unsigned pk = cvt_pk_bf16((lo * cs - hi * sn) * ksc, (lo * sn + hi * cs) * ksc);
        KT[tr_idx(8 * o + i, m)] = (bf16_t)(pk & 0xffffu); KT[tr_idx(64 + 8 * o + i, m)] = (bf16_t)(pk >> 16);
        const unsigned vl = r.vlo[i >> 1], vh = r.vhi[i >> 1];
        VT[tr_idx(8 * o + i, m)] = (bf16_t)((i & 1) ? (vl >> 16) : (vl & 0xffffu)); VT[tr_idx(64 + 8 * o + i, m)] = (bf16_t)((i & 1) ? (vh >> 16) : (vh & 0xffffu));
    }
}
__device__ __forceinline__ void retA_compute(const Frame& F, int unit) {
    LAS bf16_t* KT = (LAS bf16_t*)(F.lds); LAS bf16_t* VT = KT + 128 * 72;
    const int w = F.wave, fr = F.lane & 15, fq = F.lane >> 4;
    bf16x8 vf[2];
#pragma unroll
    for (int ks = 0; ks < 2; ++ks) vf[ks] = *(const LAS bf16x8*)(VT + tr_frag(16 * w + fr, 4 * ks + fq));
    bf16_t* urow = F.U + ((size_t)unit * 128 + 16 * w + fr) * 128 + 4 * fq;
#pragma unroll
    for (int dt = 0; dt < 8; ++dt) {
        f32x4 acc = (f32x4){0.f, 0.f, 0.f, 0.f};
#pragma unroll
        for (int ks = 0; ks < 2; ++ks) { const bf16x8 kf = *(const LAS bf16x8*)(KT + tr_frag(16 * dt + fr, 4 * ks + fq)); acc = mfma16(kf, vf[ks], acc); }
        u32x2 pk; pk.x = cvt_pk_bf16(acc[0], acc[1]); pk.y = cvt_pk_bf16(acc[2], acc[3]);
        *(u32x2*)(urow + 16 * dt) = pk;
    }
}
__device__ __forceinline__ void retA_phase(Frame& F) {
    int u = F.vcu; if (u >= 1024) return;
    RawKV raw; retA_load(F, u, raw);
    for (; u < 1024; u += F.G) {
        retA_stage(F, u, raw);
        if (u + F.G < 1024) retA_load(F, u + F.G, raw);
        __syncthreads();
        retA_compute(F, u);
        __syncthreads();
    }
}

__device__ __forceinline__ void pool_load(const Frame& F, int unit, u32x4 (&raw)[3]) {
    const int g = unit & 3, tile = unit >> 2, st = (tile & 63) * 64, tok0 = tile * 64;
#pragma unroll
    for (int j = 0; j < 3; ++j) { const int idx = F.tid + 512 * j, r = idx >> 4, ch = idx & 15, s = st - 15 + r;
        raw[j] = (u32x4){0u, 0u, 0u, 0u};
        if (idx < 79 * 16 && s >= 0) raw[j] = *(const u32x4*)(F.Z + (size_t)(tok0 - 15 + r) * DIN + 2048 + g * 128 + 8 * ch); }
}
__device__ __forceinline__ void pool_phase(Frame& F) {
    int u = F.vcu; if (u >= 1024) return;
    LAS float* P = (LAS float*)(F.lds);
    LAS bf16_t* A = (LAS bf16_t*)(F.lds + 79 * 132 * 4);
    const int t = F.tid, w = F.wave, rt = w & 3, chf = w >> 2, fr = F.lane & 15, fq = F.lane >> 4;
    const bool fixed_g = (F.G & 3) == 0;
    bf16x8 wf[4][4]; f32x4 sc[4];
    { const int g = u & 3; const bf16_t* wp = F.Wpool_t + g * 16384;
#pragma unroll
      for (int dd = 0; dd < 4; ++dd) { const int dt = 4 * chf + dd; sc[dd] = *(const f32x4*)(F.pool_scale + g * 128 + 16 * dt + 4 * fq);
#pragma unroll
          for (int ks = 0; ks < 4; ++ks) wf[dd][ks] = *(const bf16x8*)(wp + (16 * dt + fr) * 128 + 32 * ks + 8 * fq); } }
    u32x4 raw[3]; pool_load(F, u, raw);
    for (; u < 1024; u += F.G) {
        const int g = u & 3, tile = u >> 2, st = (tile & 63) * 64, tok0 = tile * 64, win = 2 << g;
        if (!fixed_g) { const bf16_t* wp = F.Wpool_t + g * 16384;
#pragma unroll
            for (int dd = 0; dd < 4; ++dd) { const int dt = 4 * chf + dd; sc[dd] = *(const f32x4*)(F.pool_scale + g * 128 + 16 * dt + 4 * fq);
#pragma unroll
                for (int ks = 0; ks < 4; ++ks) wf[dd][ks] = *(const bf16x8*)(wp + (16 * dt + fr) * 128 + 32 * ks + 8 * fq); } }
#pragma unroll
        for (int j = 0; j < 3; ++j) { const int idx = t + 512 * j, r = idx >> 4, ch = idx & 15;
            if (idx < 79 * 16) { const u32x4 x = raw[j];
                *(LAS f32x4*)(P + r * 132 + 8 * ch) = (f32x4){bf_lo(x.x), bf_hi(x.x), bf_lo(x.y), bf_hi(x.y)}; *(LAS f32x4*)(P + r * 132 + 8 * ch + 4) = (f32x4){bf_lo(x.z), bf_hi(x.z), bf_lo(x.w), bf_hi(x.w)}; } }
        if (u + F.G < 1024) pool_load(F, u + F.G, raw);
        __syncthreads();
        {
            const int c4 = t & 31, n0 = 4 * (t >> 5);
            const LAS float* pc = P + (15 + n0) * 132 + 4 * c4;
            f32x4 sum = (f32x4){0.f, 0.f, 0.f, 0.f};
            for (int j = 0; j < win; ++j) sum += *(const LAS f32x4*)(pc - j * 132);
#pragma unroll
            for (int i = 0; i < 4; ++i) {
                const f32x4 self = *(const LAS f32x4*)(pc + i * 132);
                if (i > 0) sum += self - *(const LAS f32x4*)(pc + (i - win) * 132);
                const int sp = st + n0 + i;
                const float rc = 1.0f / (float)((sp + 1 < win) ? (sp + 1) : win);
                const f32x4 pv = sum * rc - self;
                u32x2 pk; pk.x = cvt_pk_bf16(pv[0], pv[1]); pk.y = cvt_pk_bf16(pv[2], pv[3]);
                *(LAS u32x2*)(A + (n0 + i) * 136 + 4 * c4) = pk;
            }
        }
        __syncthreads();
        {
            bf16x8 af[4];
#pragma unroll
            for (int ks = 0; ks < 4; ++ks) af[ks] = *(const LAS bf16x8*)(A + (16 * rt + fr) * 136 + 32 * ks + 8 * fq);
            bf16_t* orow = F.CAT + (size_t)(tok0 + 16 * rt + fr) * D + 512 + g * 128;
#pragma unroll
            for (int dd = 0; dd < 4; ++dd) { const int dt = 4 * chf + dd;
                f32x4 acc = (f32x4){0.f, 0.f, 0.f, 0.f};
#pragma unroll
                for (int ks = 0; ks < 4; ++ks) acc = mfma16(wf[dd][ks], af[ks], acc);
                u32x2 pk; pk.x = cvt_pk_bf16(acc[0] * sc[dd][0], acc[1] * sc[dd][1]); pk.y = cvt_pk_bf16(acc[2] * sc[dd][2], acc[3] * sc[dd][3]);
                *(u32x2*)(orow + 16 * dt + 4 * fq) = pk;
            }
        }
        __syncthreads();
    }
}

struct RawQKV { u32x4 qlo, qhi, klo, khi, vlo, vhi; };
__device__ __forceinline__ void retB_load(const Frame& F, int unit, RawQKV& r) {
    const int c = unit & 63, bh = unit >> 6, h = bh & 3, b = bh >> 2, m = F.tid >> 3, o = F.tid & 7;
    const bf16_t* zrow = F.Z + (size_t)(b * SEQ + c * 64 + m) * DIN + h * 128 + 8 * o;
    r.qlo = *(const u32x4*)(zrow); r.qhi = *(const u32x4*)(zrow + 64); r.klo = *(const u32x4*)(zrow + 512); r.khi = *(const u32x4*)(zrow + 512 + 64); r.vlo = *(const u32x4*)(zrow + 1024); r.vhi = *(const u32x4*)(zrow + 1024 + 64);
}
__device__ __forceinline__ void retB_phase(Frame& F) {
    int unit = F.vcu; if (unit >= 1024) return;
    LAS bf16_t* Q = (LAS bf16_t*)(F.lds);
    LAS bf16_t* Kr = Q + 64 * 136;
    LAS bf16_t* VT = Kr + 64 * 136;
    LAS bf16_t* Sm = VT + 128 * 72;
    LAS float* red = (LAS float*)(Sm + 64 * 72);
    const int t = F.tid, w = F.wave, fr = F.lane & 15, fq = F.lane >> 4;
    RawQKV raw; retB_load(F, unit, raw);
    for (; unit < 1024; unit += F.G) {
        const int c = unit & 63, bh = unit >> 6, h = bh & 3, b = bh >> 2, tok0 = b * SEQ + c * 64;
        const float lg = F.lg2(h);
        const int rt = w & 3, chf = w >> 2, n = 16 * rt + fr;
        bf16x8 rf[4][4]; u32x2 gw2[4];
#pragma unroll
        for (int dd = 0; dd < 4; ++dd) { const bf16_t* rrow = F.U + ((size_t)unit * 128 + 16 * (4 * chf + dd) + fr) * 128 + 8 * fq;
#pragma unroll
            for (int ks = 0; ks < 4; ++ks) rf[dd][ks] = *(const bf16x8*)(rrow + 32 * ks);
            gw2[dd] = *(const u32x2*)(F.Z + (size_t)(tok0 + n) * DIN + 1536 + h * 128 + 16 * (4 * chf + dd) + 4 * fq); }
        {
            const int m = t >> 3, o = t & 7, pos = c * 64 + m;
            unsigned ql[4], qh[4], kl[4], kh[4];
#pragma unroll
            for (int i = 0; i < 8; i += 2) {
                float cs0, sn0, cs1, sn1; rope_cs(pos, 8 * o + i, cs0, sn0); rope_cs(pos, 8 * o + i + 1, cs1, sn1);
                { const float l0 = bf_lo(raw.qlo[i >> 1]), l1 = bf_hi(raw.qlo[i >> 1]), h0 = bf_lo(raw.qhi[i >> 1]), h1 = bf_hi(raw.qhi[i >> 1]);
                  ql[i >> 1] = cvt_pk_bf16(l0 * cs0 - h0 * sn0, l1 * cs1 - h1 * sn1); qh[i >> 1] = cvt_pk_bf16(l0 * sn0 + h0 * cs0, l1 * sn1 + h1 * cs1); }
                { const float l0 = bf_lo(raw.klo[i >> 1]), l1 = bf_hi(raw.klo[i >> 1]), h0 = bf_lo(raw.khi[i >> 1]), h1 = bf_hi(raw.khi[i >> 1]); const float sc = 0.08838834764831845f;
                  kl[i >> 1] = cvt_pk_bf16((l0 * cs0 - h0 * sn0) * sc, (l1 * cs1 - h1 * sn1) * sc); kh[i >> 1] = cvt_pk_bf16((l0 * sn0 + h0 * cs0) * sc, (l1 * sn1 + h1 * cs1) * sc); }
            }
            *(LAS u32x4*)(Q + m * 136 + 8 * o) = (u32x4){ql[0], ql[1], ql[2], ql[3]}; *(LAS u32x4*)(Q + m * 136 + 64 + 8 * o) = (u32x4){qh[0], qh[1], qh[2], qh[3]};
            *(LAS u32x4*)(Kr + m * 136 + 8 * o) = (u32x4){kl[0], kl[1], kl[2], kl[3]}; *(LAS u32x4*)(Kr + m * 136 + 64 + 8 * o) = (u32x4){kh[0], kh[1], kh[2], kh[3]};
#pragma unroll
            for (int i = 0; i < 8; ++i) { const unsigned vl = raw.vlo[i >> 1], vh = raw.vhi[i >> 1];
                VT[tr_idx(8 * o + i, m)] = (bf16_t)((i & 1) ? (vl >> 16) : (vl & 0xffffu)); VT[tr_idx(64 + 8 * o + i, m)] = (bf16_t)((i & 1) ? (vh >> 16) : (vh & 0xffffu)); }
        }
        if (unit + F.G < 1024) retB_load(F, unit + F.G, raw);
        __syncthreads();
        {
            const int ntl = w >> 1;
            bf16x8 qf[4];
#pragma unroll
            for (int ks = 0; ks < 4; ++ks) qf[ks] = *(const LAS bf16x8*)(Q + (16 * ntl + fr) * 136 + 32 * ks + 8 * fq);
#pragma unroll
            for (int mm = 0; mm < 2; ++mm) { const int mt = 2 * (w & 1) + mm;
                f32x4 acc = (f32x4){0.f, 0.f, 0.f, 0.f};
#pragma unroll
                for (int ks = 0; ks < 4; ++ks) { const bf16x8 kf = *(const LAS bf16x8*)(Kr + (16 * mt + fr) * 136 + 32 * ks + 8 * fq); acc = mfma16(kf, qf[ks], acc); }
                const int nn = 16 * ntl + fr, m0 = 16 * mt + 4 * fq;
                float sv[4];
#pragma unroll
                for (int j = 0; j < 4; ++j) { const int dd = nn - (m0 + j); sv[j] = acc[j] * __builtin_amdgcn_exp2f(lg * (float)(dd < 0 ? -dd : dd)); }
                u32x2 pk; pk.x = cvt_pk_bf16(sv[0], sv[1]); pk.y = cvt_pk_bf16(sv[2], sv[3]);
                *(LAS u32x2*)(Sm + nn * 72 + m0) = pk;
            }
        }
        __syncthreads();
        {
            bf16x8 sf[2], qf[4];
#pragma unroll
            for (int ks = 0; ks < 2; ++ks) sf[ks] = *(const LAS bf16x8*)(Sm + n * 72 + 32 * ks + 8 * fq);
#pragma unroll
            for (int ks = 0; ks < 4; ++ks) qf[ks] = *(const LAS bf16x8*)(Q + n * 136 + 32 * ks + 8 * fq);
            const float qd = __builtin_amdgcn_exp2f(lg * (float)(n + 1));
            f32x4 ov[4]; float ss = 0.f;
#pragma unroll
            for (int dd = 0; dd < 4; ++dd) { const int vt = 4 * chf + dd;
                f32x4 ai = (f32x4){0.f, 0.f, 0.f, 0.f}, ac = ai;
#pragma unroll
                for (int ks = 0; ks < 2; ++ks) { const bf16x8 vf = *(const LAS bf16x8*)(VT + tr_frag(16 * vt + fr, 4 * ks + fq)); ai = mfma16(vf, sf[ks], ai); }
#pragma unroll
                for (int ks = 0; ks < 4; ++ks) ac = mfma16(rf[dd][ks], qf[ks], ac);
                ov[dd] = ai + ac * qd;
                ss += (ov[dd][0] * ov[dd][0] + ov[dd][1] * ov[dd][1]) + (ov[dd][2] * ov[dd][2] + ov[dd][3] * ov[dd][3]);
            }
            ss += __shfl_xor(ss, 16); ss += __shfl_xor(ss, 32);
            if (fq == 0) red[chf * 64 + n] = ss;
            __syncthreads();
            const float rstd = 1.f / sqrtf((red[n] + red[64 + n]) * (1.f / 128.f) + EPS);
            const size_t tok = (size_t)(tok0 + n);
#pragma unroll
            for (int dd = 0; dd < 4; ++dd) { const int v0 = 16 * (4 * chf + dd) + 4 * fq;
                const f32x4 rw = *(const f32x4*)(F.ret_norm_w + h * 128 + v0);
                const float gv[4] = {bf_lo(gw2[dd].x), bf_hi(gw2[dd].x), bf_lo(gw2[dd].y), bf_hi(gw2[dd].y)};
                float r[4];
#pragma unroll
                for (int j = 0; j < 4; ++j) { const float sg = gv[j] * __builtin_amdgcn_rcpf(1.0f + __builtin_amdgcn_exp2f(-1.4426950408889634f * gv[j])); r[j] = ov[dd][j] * rstd * rw[j] * sg; }
                u32x2 pk; pk.x = cvt_pk_bf16(r[0], r[1]); pk.y = cvt_pk_bf16(r[2], r[3]);
                *(u32x2*)(F.CAT + tok * D + h * 128 + v0) = pk;
            }
        }
        __syncthreads();
    }
}

struct Args { const float* in[15]; float* out; unsigned char* ws; float lg2g[4]; int ph_lo, ph_hi, li, pad; };

__global__ void __launch_bounds__(NWAVES * 64, 2) fwd_kernel(Args args) {
    extern __shared__ __attribute__((aligned(16))) unsigned char lds[];
    Frame F;
    F.lds = (LAS unsigned char*)lds;
    F.MISC = (volatile LAS unsigned*)(F.lds + MISC_OFF);
    F.tid = threadIdx.x; F.lane = F.tid & 63; F.wave = __builtin_amdgcn_readfirstlane(F.tid >> 6);
    F.G = gridDim.x; { const int bx = blockIdx.x; F.vcu = (F.G % 8 == 0) ? (bx % 8) * (F.G / 8) + bx / 8 : bx; }
#define REFRESH() do { const __attribute__((address_space(4))) Args* A_ = (const __attribute__((address_space(4))) Args*)__builtin_amdgcn_kernarg_segment_ptr(); asm volatile("" : "+s"(A_)); \
    unsigned char* ws_ = A_->ws; F.ctl = (gu32*)(ws_ + WS_CTL); \
    F.x = A_->in[0]; F.norm_mix_w = A_->in[1]; F.w_in = A_->in[2]; F.ret_norm_w = A_->in[3]; F.w_pool = A_->in[4]; F.pool_scale = A_->in[5]; F.w_out = A_->in[6]; F.norm_ffn_w = A_->in[7]; \
    F.w_router = A_->in[8]; F.b_router = A_->in[9]; F.w_gu = A_->in[10]; F.b_gu = A_->in[11]; F.w_down = A_->in[12]; F.b_down = A_->in[13]; F.norm_final_w = A_->in[14]; F.out = A_->out; \
    F.Wr_hi = (bf16_t*)(ws_ + WS_WR); F.Wr_lo = F.Wr_hi + 32 * 1024; F.Wpool_t = (bf16_t*)(ws_ + WS_WPOOL); F.Win_t = (bf16_t*)(ws_ + WS_WIN); F.Wout_t = (bf16_t*)(ws_ + WS_WOUT); \
    F.XN = (bf16_t*)(ws_ + WS_XN); F.CAT = (bf16_t*)(ws_ + WS_CAT); F.U = (bf16_t*)(ws_ + WS_U); F.Z = (bf16_t*)(ws_ + WS_Z); F.Y = (bf16_t*)(ws_ + WS_Y); \
    F.Wgu8 = ws_ + WS_WGU; F.Wd8 = ws_ + WS_WD; F.ACT8 = ws_ + WS_ACT; F.H8 = ws_ + WS_XN; F.list = (le_t*)(ws_ + WS_LIST); F.ssq = (float*)(ws_ + WS_SSQ); F.PL = (float*)(ws_ + WS_PL); \
    F.lg2g0 = A_->lg2g[0]; F.lg2g1 = A_->lg2g[1]; F.lg2g2 = A_->lg2g[2]; F.lg2g3 = A_->lg2g[3]; \
    { int t_ = threadIdx.x; asm volatile("" : "+v"(t_)); F.tid = t_; F.lane = t_ & 63; } } while (0)
    REFRESH();
    for (int u = F.tid; u < (LDS_BYTES - LDSCTL_OFF) / 4; u += NWAVES * 64) ((LAS unsigned*)(F.lds + LDSCTL_OFF))[u] = 0u;
    __syncthreads();
    XcdBarrier bar; bar.bar = (unsigned*)(F.ctl + CW_BAR); bar.x = 0; bar.st = nullptr;
    if (N_LAUNCHES != PER_PHASE) bar = xcd_barrier_post((unsigned*)(F.ctl + CW_BAR), F.MISC + 8);
    int n_stamp = 0;
#define STAMP() do { if (DBG_SPIN_A >= 0) { if (F.tid == 0) { const unsigned long long _t = __builtin_amdgcn_s_memrealtime(); F.MISC[16 + 2 * n_stamp] = (unsigned)_t; F.MISC[17 + 2 * n_stamp] = (unsigned)(_t >> 32); } ++n_stamp; } } while (0)
    STAMP();
#define GRID_BAR() do { if (N_LAUNCHES != PER_PHASE) xcd_barrier(bar); STAMP(); } while (0)
    const int lo = DBG_ONLY9 ? (args.ph_lo < 9 ? 9 : args.ph_lo) : args.ph_lo, hi = args.ph_hi;
#define IN(k) (lo <= (k) && (k) < hi)
#define BOTH(k) (IN(k) && IN((k) + 1))
    const int gw = F.vcu * NWAVES + F.wave, NGW = F.G * NWAVES;

    if (IN(0)) { REFRESH(); p0_prologue(F); if (BOTH(0)) GRID_BAR(); }

    if (IN(1)) {
        REFRESH();
        pg8::DenseSched S; S.init(F.XN, F.Win_t, NTOK, DIN, F.G, (int)blockIdx.x);
        pg8::EpiBf16 E{F.Z, DIN};
        pg8::gemm_phase<pg8::EpiBf16, pg8::DenseSched, true>(F.lds, S, E);
        { const int mine = (S.nwg - (int)blockIdx.x + F.G - 1) / F.G, most = (S.nwg + F.G - 1) / F.G; if (mine < most) conv_pull(F, 5 * (most - mine)); }
        if (BOTH(1)) GRID_BAR();
    }

    if (IN(2)) {
        REFRESH();
        retA_phase(F);
        pool_phase(F);
        if (BOTH(2)) GRID_BAR();
    }

    if (IN(3) && DBG_STAGE != 4) {
        REFRESH();
        const int gt = F.vcu * 512 + F.tid, NGT = F.G * 512;
        for (int p = gt; p < 16 * 8192; p += NGT) {
            const int bh = p >> 13, i = p & 8191;
            const float cd = __builtin_amdgcn_exp2f(F.lg2(bh & 3) * 64.0f);
            unsigned* up = (unsigned*)(F.U + (size_t)bh * 64 * 16384) + i;
            float s0 = 0.f, s1 = 0.f;
#pragma unroll
            for (int cb = 0; cb < 64; cb += 32) {
                unsigned uw[32];
#pragma unroll
                for (int c = 0; c < 32; ++c) uw[c] = up[(size_t)(cb + c) * 8192];
#pragma unroll
                for (int c = 0; c < 32; ++c) { up[(size_t)(cb + c) * 8192] = cvt_pk_bf16(s0, s1); s0 = cd * s0 + bf_lo(uw[c]); s1 = cd * s1 + bf_hi(uw[c]); }
            }
        }
        if (BOTH(3)) GRID_BAR();
    }

    if (IN(4) && DBG_STAGE != 4) {
        REFRESH();
        retB_phase(F);
        if (BOTH(4)) GRID_BAR();
    }

    if (IN(5) && !DBG_STAGE) {
        REFRESH();
        pg8::DenseSched S; S.init(F.CAT, F.Wout_t, NTOK, D, F.G, (int)blockIdx.x);
        pg8::EpiX1 E{F.x, F.out, F.ssq, F.PL, F.H8, F.norm_ffn_w, F.Wr_hi, F.Wr_lo, S.nwg == F.G};
        pg8::gemm_phase<pg8::EpiX1, pg8::DenseSched, false>(F.lds, S, E);
        if (BOTH(5)) GRID_BAR();
    }

    if (IN(6) && !DBG_SKIP_Y) {
        REFRESH();
        if (gw == 0) { GAS u32x4* z = (GAS u32x4*)(F.H8 + (size_t)NTOK * D) + F.lane; z[0] = (u32x4){0u, 0u, 0u, 0u}; }
        LAS unsigned* lcnt = (LAS unsigned*)(F.lds);
        LAS unsigned* lbase = lcnt + 32;
        if (F.tid < 32) lcnt[F.tid] = 0u;
        __syncthreads();
        const int half = F.lane >> 5, e = F.lane & 31;
        const float be = F.b_router[e];
        constexpr int MAXJ = 4;
        const int nsl = ((NTOK / 256) * (D / 256) == F.G) ? 4 : 16;
        for (int base = 0; base < NTOK / 2; base += NGW * MAXJ) {
            int srank[MAXJ], slp[MAXJ], srow[MAXJ]; float sgate[MAXJ], srstd[MAXJ];
#pragma unroll
            for (int j = 0; j < MAXJ; ++j) {
                const int rp = base + gw + NGW * j; srank[j] = -1; slp[j] = 0; srow[j] = 0; sgate[j] = 0.f; srstd[j] = 0.f;
                if (rp < NTOK / 2) {
                    const int row = 2 * rp + half;
                    float lg = 0.f, ss = 0.f;
                    if (nsl == 4) {
#pragma unroll
                        for (int p = 0; p < 4; ++p) lg += F.PL[((size_t)p * NTOK + row) * 32 + e];
                        if ((F.lane & 15) < 4) ss = F.ssq[(size_t)(F.lane & 15) * NTOK + row];
                    } else {
#pragma unroll
                        for (int p = 0; p < 16; ++p) lg += F.PL[((size_t)p * NTOK + row) * 32 + e];
                        ss = F.ssq[(size_t)(F.lane & 15) * NTOK + row];
                    }
                    ss += __shfl_xor(ss, 1); ss += __shfl_xor(ss, 2); ss += __shfl_xor(ss, 4); ss += __shfl_xor(ss, 8);
                    const float rstd = 1.f / sqrtf(ss * (1.f / D) + EPS);
                    float cur = lg * rstd + be;
                    float tv[4]; int ti[4]; int myrank = -1;
#pragma unroll
                    for (int k = 0; k < 4; ++k) {
                        float bv = cur; int bi = e;
#pragma unroll
                        for (int off = 16; off >= 1; off >>= 1) { const float ov = __shfl_xor(bv, off); const int oi = __shfl_xor(bi, off); if (ov > bv || (ov == bv && oi < bi)) { bv = ov; bi = oi; } }
                        tv[k] = bv; ti[k] = bi;
                        if (e == bi) { cur = -3.0e38f; myrank = k; }
                    }
                    (void)ti;
                    const float e1 = __expf(tv[1] - tv[0]), e2 = __expf(tv[2] - tv[0]), e3 = __expf(tv[3] - tv[0]), inv = 1.0f / (1.0f + e1 + e2 + e3);
                    if (myrank >= 0) {
                        srank[j] = myrank; srow[j] = row; srstd[j] = rstd;
                        sgate[j] = (myrank == 0 ? 1.0f : myrank == 1 ? e1 : myrank == 2 ? e2 : e3) * inv;
                        slp[j] = (int)__hip_atomic_fetch_add(lcnt + e, 1u, __ATOMIC_RELAXED, __HIP_MEMORY_SCOPE_WORKGROUP);
                    }
                }
            }
            __syncthreads();
            if (F.tid < 32) { const unsigned n = lcnt[F.tid]; lbase[F.tid] = n ? atomicAdd((unsigned*)(F.ctl + CW_CNT + 64 * F.tid), n) : 0u; }
            __syncthreads();
#pragma unroll
            for (int j = 0; j < MAXJ; ++j)
                if (srank[j] >= 0) F.list[e * LISTCAP + (int)lbase[e] + slp[j]] = (le_t){srow[j] * 4 + srank[j], __float_as_int(sgate[j]), __float_as_int(srstd[j]), 0};
            __syncthreads();
            if (F.tid < 32) lcnt[F.tid] = 0u;
            __syncthreads();
        }
        if (BOTH(6)) GRID_BAR();
    }

    if ((IN(7) || IN(8)) && !DBG_SKIP_Y) {
        REFRESH();
        LAS int* tab = (LAS int*)(F.lds + TAB_OFF);
        if (F.tid < 32) tab[F.tid] = (int)__hip_atomic_load(F.ctl + CW_CNT + 64 * F.tid, RLX_AGENT);
        __syncthreads();
        if (F.tid == 0) { int s = 0; for (int e = 0; e < 32; ++e) { tab[32 + e] = s; s += (tab[e] + 255) >> 8; } tab[64] = s; }
        __syncthreads();
    }
    if (IN(7) && !DBG_SKIP_Y) {
        REFRESH();
        pg8::MoeSched<true> S; S.init((const bf16_t*)F.H8, (const bf16_t*)F.Wgu8, F.list, F.b_gu, (const LAS int*)(F.lds + TAB_OFF), F.G, (int)blockIdx.x);
        pg8::EpiGU E{F.ACT8};
        pg8::gemm_phase<pg8::EpiGU, pg8::MoeSched<true>, true, true>(F.lds, S, E);
        { const int mine = (S.nwg - (int)blockIdx.x + F.G - 1) / F.G, most = (S.nwg + F.G - 1) / F.G; if (mine < most) conv_pull(F, 3 * (most - mine)); }
        conv_pull(F, CONV_ITEMS);
        if (BOTH(7)) GRID_BAR();
    }
    if (IN(8) && !DBG_SKIP_Y) {
        REFRESH();
        pg8::MoeSched<false> S; S.init((const bf16_t*)F.ACT8, (const bf16_t*)F.Wd8, F.list, F.b_down, (const LAS int*)(F.lds + TAB_OFF), F.G, (int)blockIdx.x);
        pg8::EpiDown E{(unsigned char*)F.Y};
        pg8::gemm_phase<pg8::EpiDown, pg8::MoeSched<false>, true, true>(F.lds, S, E);
        if (BOTH(8)) GRID_BAR();
    }
    if (IN(9) && DBG_STAGE) {
        REFRESH();
        for (int m = gw; m < NTOK; m += NGW) {
            const bf16_t* src = DBG_STAGE == 1 ? F.XN + (size_t)m * D : DBG_STAGE == 2 ? F.Z + (size_t)m * DIN + 1024 : DBG_STAGE == 3 ? F.CAT + (size_t)m * D : F.U + (size_t)m * D;
            for (int j = F.lane; j < D; j += 64) F.out[(size_t)m * D + j] = __uint_as_float(((unsigned)src[j]) << 16);
        }
    }
    if (IN(9) && !DBG_STAGE) {
        REFRESH();
        for (int m = gw; m < NTOK; m += NGW) {
            const GAS f32x4* xr = (const GAS f32x4*)((DBG_ONLY9 ? F.x : F.out) + (size_t)m * D) + F.lane; const GAS f32x4* wr = (const GAS f32x4*)F.norm_final_w + F.lane;
            f32x4 v[4]; float s = 0.f;
            if (DBG_ONLY9) {
#pragma unroll
            for (int j = 0; j < 4; ++j) v[j] = xr[64 * j];
            } else { const GAS u32x2* xb = (const GAS u32x2*)(F.out + (size_t)m * D) + F.lane;
#pragma unroll
            for (int j = 0; j < 4; ++j) { const u32x2 x = xb[64 * j]; v[j] = (f32x4){bf_lo(x.x), bf_hi(x.x), bf_lo(x.y), bf_hi(x.y)}; } }
#pragma unroll
            for (int k = 0; k < (DBG_SKIP_Y ? 0 : 4); ++k) { const GAS unsigned* yr = (const GAS unsigned*)((const unsigned char*)F.Y + ((size_t)m * 4 + k) * D) + F.lane;
#pragma unroll
                for (int j = 0; j < 4; ++j) { const unsigned y = __builtin_nontemporal_load(yr + 64 * j);
                    const f32x2 lo = __builtin_amdgcn_cvt_pk_f32_fp8((int)y, false), hi = __builtin_amdgcn_cvt_pk_f32_fp8((int)y, true); v[j] += (f32x4){lo[0], lo[1], hi[0], hi[1]} * 0.0625f; } }
#pragma unroll
            for (int j = 0; j < 4; ++j) s += (v[j].x * v[j].x + v[j].y * v[j].y) + (v[j].z * v[j].z + v[j].w * v[j].w);
            const float rstd = 1.f / sqrtf(wave_sum(s) * (1.f / D) + EPS);
            GAS f32x4* orow = (GAS f32x4*)(F.out + (size_t)m * D) + F.lane;
#pragma unroll
            for (int j = 0; j < 4; ++j) __builtin_nontemporal_store(v[j] * rstd * wr[64 * j], orow + 64 * j);
        }
    }
    if (DBG_SPIN_A >= 0) { STAMP();
        if (blockIdx.x == 0 && F.tid == 0) {
            const unsigned long long ta = ((unsigned long long)F.MISC[17 + 2 * DBG_SPIN_A] << 32) | F.MISC[16 + 2 * DBG_SPIN_A], tb = ((unsigned long long)F.MISC[17 + 2 * DBG_SPIN_B] << 32) | F.MISC[16 + 2 * DBG_SPIN_B];
            const unsigned long long t0 = __builtin_amdgcn_s_memrealtime(), want = (tb - ta) * DBG_SPIN_W;
            while (__builtin_amdgcn_s_memrealtime() - t0 < want) __builtin_amdgcn_s_sleep(8);
        } }
#undef IN
#undef BOTH
#undef GRID_BAR
#undef STAMP
#undef REFRESH
}

extern "C" void kernel_launch(void* const* d_in, const int* in_sizes, int n_in, void* d_out, int out_size, void* d_ws, size_t ws_size, hipStream_t stream) {
    static int grid = 0;
    if (grid == 0) {
        if (n_in != 15 || in_sizes[0] != NTOK * D || out_size != NTOK * D || ws_size < WS_END) { fprintf(stderr, "kernel_launch: unexpected shapes / workspace (n_in %d, ws %zu); nothing launched\n", n_in, ws_size); grid = -1; return; }
        int dev = 0, cus = 0, per_cu = 0;
        if (hipGetDevice(&dev) != hipSuccess || hipDeviceGetAttribute(&cus, hipDeviceAttributeMultiprocessorCount, dev) != hipSuccess) { grid = -1; return; }
        if (hipFuncSetAttribute((const void*)fwd_kernel, hipFuncAttributeMaxDynamicSharedMemorySize, LDS_BYTES) != hipSuccess) { fprintf(stderr, "kernel_launch: hipFuncSetAttribute failed\n"); grid = -1; return; }
        if (hipOccupancyMaxActiveBlocksPerMultiprocessor(&per_cu, (const void*)fwd_kernel, NWAVES * 64, LDS_BYTES) != hipSuccess || per_cu < 1)
            fprintf(stderr, "kernel_launch: note: occupancy query reports %d workgroups per CU\n", per_cu);
        (void)hipGetLastError();
        grid = cus;
    }
    if (grid < 0) return;
    if (hipMemsetAsync((char*)d_ws + WS_CTL, 0, CTL_ZERO_BYTES, stream) != hipSuccess) { fprintf(stderr, "kernel_launch: memset failed\n"); return; }
    Args a{};
    for (int i = 0; i < 15; ++i) a.in[i] = (const float*)d_in[i];
    a.out = (float*)d_out; a.ws = (unsigned char*)d_ws;
    for (int h = 0; h < 4; ++h) a.lg2g[h] = (float)(log1p(-exp2(-5.0 - (double)h)) / log(2.0));
    for (int li = 0; li < N_LAUNCHES; ++li) {
        a.ph_lo = (N_LAUNCHES == PER_PHASE) ? li : 0; a.ph_hi = (N_LAUNCHES == PER_PHASE) ? li + 1 : PER_PHASE; a.li = li; a.pad = 0;
        hipLaunchKernelGGL(fwd_kernel, dim3(grid), dim3(NWAVES * 64), LDS_BYTES, stream, a);
        const hipError_t le = hipPeekAtLastError();
        if (le != hipSuccess) { fprintf(stderr, "kernel_launch: launch %d failed: %s\n", li, hipGetErrorName(le)); break; }
    }
}
```

```cpp
#include <hip/hip_runtime.h>
#include <cstdio>
#include <cstdint>
#include <cmath>

#ifndef DBG_ONLY9
#define DBG_ONLY9 0
#define DBG_STAGE 0
#endif
#ifndef DBG_SPIN_A
#define DBG_SPIN_A -1
#define DBG_SPIN_B -1
#define DBG_SPIN_W 2
#endif
#ifndef DBG_SKIP_Y
#define DBG_SKIP_Y 0
#endif
#ifndef MK_N_LAUNCHES
#define MK_N_LAUNCHES 1
#endif
constexpr int PER_PHASE = 10;
constexpr int N_LAUNCHES = MK_N_LAUNCHES;

#define LAS __attribute__((address_space(3)))
#define GAS __attribute__((address_space(1)))
typedef unsigned short bf16_t;
typedef short bf16x8 __attribute__((ext_vector_type(8)));
typedef float f32x4 __attribute__((ext_vector_type(4)));
typedef float f32x2 __attribute__((ext_vector_type(2)));
typedef unsigned u32x4 __attribute__((ext_vector_type(4)));
typedef unsigned u32x2 __attribute__((ext_vector_type(2)));
typedef GAS unsigned gu32;
typedef int i32x2 __attribute__((ext_vector_type(2)));
typedef int le_t __attribute__((ext_vector_type(4)));

constexpr int NTOK = 16384, D = 1024, SEQ = 4096, DIN = 2560, NE = 32, FF = 1024, LISTCAP = 16384;
constexpr int NWAVES = 8;
constexpr float EPS = 1e-6f;

constexpr size_t MiB = 1u << 20;
constexpr size_t WS_CTL = 0, CTL_ZERO_BYTES = 32 * 1024;
constexpr size_t WS_LIST = 360 * MiB;
constexpr size_t WS_PL = 368 * MiB;
constexpr size_t WS_SSQ = 5 * MiB + 512 * 1024;
constexpr size_t WS_WR = 6 * MiB + 512 * 1024;
constexpr size_t WS_WPOOL = 6 * MiB + 768 * 1024;
constexpr size_t WS_WIN = 7 * MiB;
constexpr size_t WS_WOUT = 12 * MiB;
constexpr size_t WS_XN = 14 * MiB;
constexpr size_t WS_CAT = 47 * MiB;
constexpr size_t WS_U = 79 * MiB;
constexpr size_t WS_Z = 111 * MiB;
constexpr size_t WS_Y = 47 * MiB;
constexpr size_t WS_WGU = 192 * MiB;
constexpr size_t WS_WD = 256 * MiB;
constexpr size_t WS_ACT = 288 * MiB;
constexpr size_t WS_END = 400 * MiB;
static_assert(WS_Y + (size_t)65536 * 1024 * 2 <= WS_WGU && WS_Z + (size_t)16384 * 2560 * 2 <= WS_WGU, "Y overlay / Z");
constexpr int CW_TMO = 0, CW_CODE = 1;
constexpr int CW_Q = 512;
constexpr int CW_CNT = 1024;
constexpr int CW_BAR = 4096;
static_assert((CW_BAR + 3456) * 4 <= (int)CTL_ZERO_BYTES, "control words inside the memset");

constexpr int RING_BYTES = 131072;
constexpr int LDSCTL_OFF = RING_BYTES, MISC_OFF = LDSCTL_OFF + 320, TAB_OFF = LDSCTL_OFF + 512;
constexpr int MB_OFF = LDSCTL_OFF + 1024;
constexpr int LDS_BYTES = 147456;

#define RLX_AGENT __ATOMIC_RELAXED, __HIP_MEMORY_SCOPE_AGENT
#define LDS_WAIT() asm volatile("s_waitcnt lgkmcnt(0)" ::: "memory")
#define VM_WAIT() asm volatile("s_waitcnt vmcnt(0)" ::: "memory")
typedef __bf16 bf16x2_t __attribute__((ext_vector_type(2)));
__device__ __forceinline__ unsigned cvt_pk_bf16(float lo, float hi) { const f32x2 v = {lo, hi}; const bf16x2_t b = __builtin_convertvector(v, bf16x2_t); return __builtin_bit_cast(unsigned, b); }
__device__ __forceinline__ unsigned cvt4_fp8(float a, float b, float c, float d) { int r = __builtin_amdgcn_cvt_pk_fp8_f32(a, b, 0, false); r = __builtin_amdgcn_cvt_pk_fp8_f32(c, d, r, true); return (unsigned)r; }
typedef int i32x8 __attribute__((ext_vector_type(8)));
__device__ __forceinline__ float bf_lo(unsigned w) { return __uint_as_float(w << 16); }
__device__ __forceinline__ float bf_hi(unsigned w) { return __uint_as_float(w & 0xffff0000u); }
__device__ __forceinline__ float wave_sum(float v) {
#pragma unroll
    for (int o = 1; o < 64; o <<= 1) v += __shfl_xor(v, o);
    return v;
}
__device__ __forceinline__ f32x4 mfma16(bf16x8 a, bf16x8 b, f32x4 c) { return __builtin_amdgcn_mfma_f32_16x16x32_bf16(a, b, c, 0, 0, 0); }

namespace pg8 {
constexpr int BM = 256, BK = 64, HALF = 128, HTB = HALF * BK * 2, STAGE_BYTES = 8 * HTB, NXCD = 8, WGM = 8, KK = 1024;
__host__ __device__ __forceinline__ int lds_byte(int r, int c) { const int st = (r >> 4) * 2 + (c >> 5), rr = r & 15, cc = c & 31, ob = rr * 64 + cc * 2; return st * 1024 + (ob ^ (((ob >> 9) & 1) << 5)); }
__host__ __device__ __forceinline__ void stage_rc(int b, int& R, int& C) { const int st = b / 1024, sb = b % 1024, swz = sb ^ (((sb >> 9) & 1) << 5); R = (st >> 1) * 16 + swz / 64; C = (st & 1) * 32 + (swz % 64) / 2; }
__host__ __device__ __forceinline__ int perm32(int rho) { const int n = rho >> 4, i = rho & 15; return 8 * (i >> 2) + 4 * n + (i & 3); }

struct Unit { int pm, pn, e, rows, arow; };

__device__ __forceinline__ int xcd_remap(int L, int nwg) { const int q = nwg / NXCD, r = nwg % NXCD, xcd = L % NXCD, off = L / NXCD; return (xcd < r ? xcd * (q + 1) : r * (q + 1) + (xcd - r) * q) + off; }

struct DenseSched {
    const bf16_t* A; const bf16_t* Bt; int nM, nN, nwg, G, c;
    __device__ __forceinline__ void init(const bf16_t* A_, const bf16_t* Bt_, int M, int N, int G_, int c_) { A = A_; Bt = Bt_; nM = M / BM; nN = N / BM; nwg = nM * nN; G = G_; c = c_; }
    __device__ __forceinline__ bool next(int i, Unit& u) const {
        const int L = i * G + c; if (L >= nwg) return false;
        const int wgid = xcd_remap(L, nwg);
        const int nig = WGM * nN, gid = wgid / nig, fm = gid * WGM, gsz = (nM - fm) < WGM ? (nM - fm) : WGM;
        u.pm = fm + ((wgid % nig) % gsz); u.pn = (wgid % nig) / gsz; u.e = 0; u.rows = 256; u.arow = u.pm * 256; return true;
    }
    __device__ __forceinline__ const char* a_base(const Unit& u) const { return (const char*)A + (size_t)u.pm * (2 * HALF * KK * 2); }
    __device__ __forceinline__ const char* b_base(const Unit& u) const { return (const char*)Bt + (size_t)u.pn * (2 * HALF * KK * 2); }
    static constexpr bool MB = false;
    __device__ __forceinline__ void mb_issue(LAS unsigned char*, const Unit&, int, int) const {}
    __device__ __forceinline__ void a_offs(const Unit&, int tid, unsigned (&go)[2][2], const LAS le_t*) const {
#pragma unroll
        for (int i = 0; i < 2; ++i) { int R, C; stage_rc(tid * 16 + i * 8192, R, C);
#pragma unroll
            for (int h = 0; h < 2; ++h) go[h][i] = (unsigned)((h * HALF + R) * KK + C) * 2u; }
    }
};
constexpr int KU8 = 512;
template <bool GU> struct MoeSched {
    const bf16_t* A; const bf16_t* Bt; const le_t* list; const float* bias; const LAS int* tab; int nN, nwg, G, c;
    __device__ __forceinline__ void init(const bf16_t* A_, const bf16_t* Bt_, const le_t* list_, const float* bias_, const LAS int* tab_, int G_, int c_) { A = A_; Bt = Bt_; list = list_; bias = bias_; tab = tab_; nN = GU ? 8 : 4; nwg = __builtin_amdgcn_readfirstlane(tab_[32 + 32]) * nN; G = G_; c = c_; }
    __device__ __forceinline__ bool next(int i, Unit& u) const {
        const int L = i * G + c; if (L >= nwg) return false;
        const int wgid = xcd_remap(L, nwg);
        int ln = (int)(threadIdx.x & 31u); asm volatile("" : "+v"(ln));
        const unsigned long long bal = __ballot(tab[32 + ln] * nN <= wgid);
        const int e = 31 - __builtin_clz((unsigned)(bal & 0xffffffffull));
        const int tb0 = tab[32 + e], T = tab[32 + e + 1] - tb0, local = wgid - tb0 * nN;
        int rows = tab[e] - (local % T) * 256; if (rows > 256) rows = 256;
        u.e = __builtin_amdgcn_readfirstlane(e); u.pm = __builtin_amdgcn_readfirstlane(local % T); u.pn = __builtin_amdgcn_readfirstlane(local / T); u.rows = __builtin_amdgcn_readfirstlane(rows); u.arow = __builtin_amdgcn_readfirstlane((tb0 + local % T) * 256); return true;
    }
    __device__ __forceinline__ const char* a_base(const Unit& u) const { return GU ? (const char*)A : (const char*)A + (size_t)u.arow * (KU8 * 2); }
    __device__ __forceinline__ const char* b_base(const Unit& u) const { return (const char*)Bt + ((size_t)u.e * (GU ? 2048 : 1024) + (size_t)u.pn * 256) * (KU8 * 2); }
    static constexpr bool MB = true;
    __device__ __forceinline__ void mb_issue(LAS unsigned char* mb, const Unit& u, int wid, int lane) const {
        asm volatile("" : "+v"(lane));
        if (wid < 4) __builtin_amdgcn_global_load_lds((const unsigned*)(list + u.e * LISTCAP + u.pm * 256 + wid * 64 + lane), (LAS unsigned*)(mb + wid * 1024), 16, 0, 0);
        else if (wid == 4) {
            const float* bp = GU ? bias + (size_t)u.e * 2048 + u.pn * 128 + (lane >> 5) * 1024 + (lane & 31) * 4 : bias + (size_t)u.e * 1024 + u.pn * 256 + lane * 4;
            __builtin_amdgcn_global_load_lds((const unsigned*)bp, (LAS unsigned*)(mb + 4096), 16, 0, 0); }
    }
    __device__ __forceinline__ void a_offs(const Unit& u, int tid, unsigned (&go)[2][2], const LAS le_t* mb) const {
#pragma unroll
        for (int i = 0; i < 2; ++i) { int R, C; stage_rc(tid * 16 + i * 8192, R, C);
#pragma unroll
            for (int h = 0; h < 2; ++h) {
                if (GU) { const int r = h * HALF + R; const int raw = mb[r].x; const int tok = r < u.rows ? (raw >> 2) : NTOK; go[h][i] = (unsigned)(tok * KU8 + C) * 2u; }
                else go[h][i] = (unsigned)((h * HALF + R) * KU8 + C) * 2u;
            } }
    }
};

struct EpiBf16 {
    static constexpr bool PERM = true, HAS_INIT = false, AFTER_DRAIN = false;
    bf16_t* O; int ldc;
    __device__ __forceinline__ void operator()(const f32x4 (&acc)[2][2][4][2], const Unit& u, int wr, int wc, int fr, int fq, const LAS le_t*) const {
        const int row0 = u.pm * BM + wr * 64 + fr, col0 = u.pn * BM + wc * 32 + 8 * fq;
#pragma unroll
        for (int ai = 0; ai < 2; ++ai)
#pragma unroll
            for (int m = 0; m < 4; ++m) { bf16_t* rowp = O + (size_t)(row0 + ai * HALF + m * 16) * ldc + col0;
#pragma unroll
                for (int bj = 0; bj < 2; ++bj) { const f32x4 v0 = acc[ai][bj][m][0], v1 = acc[ai][bj][m][1];
                    u32x4 w; w.x = cvt_pk_bf16(v0[0], v0[1]); w.y = cvt_pk_bf16(v0[2], v0[3]); w.z = cvt_pk_bf16(v1[0], v1[1]); w.w = cvt_pk_bf16(v1[2], v1[3]);
                    *(u32x4*)(rowp + bj * HALF) = w; } }
    }
};
struct EpiX1 {
    static constexpr bool PERM = true, HAS_INIT = true, AFTER_DRAIN = true;
    const float* base; float* C; float* ssq; float* PL; unsigned char* H8; const float* nw; const bf16_t* wrh; const bf16_t* wrl;
    bool one;
    __device__ __forceinline__ void init_acc(f32x4 (&acc)[2][2][4][2], const Unit& u, int wr, int wc, int fr, int fq) const {
        const int row0 = u.pm * BM + wr * 64 + fr, col0 = u.pn * BM + wc * 32 + 8 * fq;
#pragma unroll
        for (int ai = 0; ai < 2; ++ai)
#pragma unroll
            for (int m = 0; m < 4; ++m) { const size_t off = (size_t)(row0 + ai * HALF + m * 16) * D + col0;
#pragma unroll
                for (int bj = 0; bj < 2; ++bj)
#pragma unroll
                    for (int n = 0; n < 2; ++n) acc[ai][bj][m][n] = *(const f32x4*)(base + off + bj * HALF + n * 4); }
    }
    __device__ __forceinline__ void operator()(const f32x4 (&acc)[2][2][4][2], const Unit& u, int wr, int wc, int fr, int fq, const LAS le_t*) const {
        const int row0 = u.pm * BM + wr * 64 + fr, col0 = u.pn * BM + wc * 32 + 8 * fq, p = u.pn * 4 + wc;
        f32x4 wv[2][2]; bf16x8 fh[2][2], fl[2][2];
#pragma unroll
        for (int bj = 0; bj < 2; ++bj) { wv[bj][0] = *(const f32x4*)(nw + col0 + bj * HALF); wv[bj][1] = *(const f32x4*)(nw + col0 + bj * HALF + 4);
#pragma unroll
            for (int et = 0; et < 2; ++et) { fh[bj][et] = *(const bf16x8*)(wrh + (16 * et + fr) * 1024 + col0 + bj * HALF); fl[bj][et] = *(const bf16x8*)(wrl + (16 * et + fr) * 1024 + col0 + bj * HALF); } }
        float* sp = ssq + (size_t)p * NTOK; float* plp = PL + (size_t)p * NTOK * 32 + 4 * fq;
#pragma unroll
        for (int ai = 0; ai < 2; ++ai)
#pragma unroll
            for (int m = 0; m < 4; ++m) { const int row = row0 + ai * HALF + m * 16; const size_t off = (size_t)row * D + col0; float s2 = 0.f;
                f32x4 pl0 = (f32x4){0.f, 0.f, 0.f, 0.f}, pl1 = pl0;
#pragma unroll
                for (int bj = 0; bj < 2; ++bj) { const f32x4 v0 = acc[ai][bj][m][0], v1 = acc[ai][bj][m][1];
                    { u32x4 xb; xb.x = cvt_pk_bf16(v0[0], v0[1]); xb.y = cvt_pk_bf16(v0[2], v0[3]); xb.z = cvt_pk_bf16(v1[0], v1[1]); xb.w = cvt_pk_bf16(v1[2], v1[3]);
                      *(u32x4*)((bf16_t*)(C + (size_t)row * D) + col0 + bj * HALF) = xb; }
                    s2 += (v0[0] * v0[0] + v0[1] * v0[1]) + (v0[2] * v0[2] + v0[3] * v0[3]) + (v1[0] * v1[0] + v1[1] * v1[1]) + (v1[2] * v1[2] + v1[3] * v1[3]);
                    const f32x4 h0 = v0 * wv[bj][0], h1 = v1 * wv[bj][1];
                    u32x4 hh, hl;
                    hh.x = cvt_pk_bf16(h0[0], h0[1]); hh.y = cvt_pk_bf16(h0[2], h0[3]); hh.z = cvt_pk_bf16(h1[0], h1[1]); hh.w = cvt_pk_bf16(h1[2], h1[3]);
                    hl.x = cvt_pk_bf16(h0[0] - bf_lo(hh.x), h0[1] - bf_hi(hh.x)); hl.y = cvt_pk_bf16(h0[2] - bf_lo(hh.y), h0[3] - bf_hi(hh.y));
                    hl.z = cvt_pk_bf16(h1[0] - bf_lo(hh.z), h1[1] - bf_hi(hh.z)); hl.w = cvt_pk_bf16(h1[2] - bf_lo(hh.w), h1[3] - bf_hi(hh.w));
                    u32x2 h8; h8.x = cvt4_fp8(h0[0], h0[1], h0[2], h0[3]); h8.y = cvt4_fp8(h1[0], h1[1], h1[2], h1[3]);
                    *(u32x2*)(H8 + off + bj * HALF) = h8;
                    const bf16x8 bhh = __builtin_bit_cast(bf16x8, hh), bhl = __builtin_bit_cast(bf16x8, hl);
                    pl0 = mfma16(fh[bj][0], bhh, pl0); pl0 = mfma16(fh[bj][0], bhl, pl0); pl0 = mfma16(fl[bj][0], bhh, pl0);
                    pl1 = mfma16(fh[bj][1], bhh, pl1); pl1 = mfma16(fh[bj][1], bhl, pl1); pl1 = mfma16(fl[bj][1], bhh, pl1); }
                s2 += __shfl_xor(s2, 16); s2 += __shfl_xor(s2, 32);
                if (fq == 0) sp[row] = s2;
                *(f32x4*)(plp + (size_t)row * 32) = pl0; *(f32x4*)(plp + (size_t)row * 32 + 16) = pl1; }
    }
    __device__ __forceinline__ void fused(const f32x4 (&acc)[2][2][4][2], const Unit& u, int wr, int wc, int fr, int fq, LAS unsigned char* lds, int tid) const {
        const int row0 = u.pm * BM + wr * 64 + fr, col0 = u.pn * BM + wc * 32 + 8 * fq;
        f32x4 wv[2][2]; bf16x8 fh[2][2], fl[2][2];
#pragma unroll
        for (int bj = 0; bj < 2; ++bj) { wv[bj][0] = *(const f32x4*)(nw + col0 + bj * HALF); wv[bj][1] = *(const f32x4*)(nw + col0 + bj * HALF + 4);
#pragma unroll
            for (int et = 0; et < 2; ++et) { fh[bj][et] = *(const bf16x8*)(wrh + (16 * et + fr) * 1024 + col0 + bj * HALF); fl[bj][et] = *(const bf16x8*)(wrl + (16 * et + fr) * 1024 + col0 + bj * HALF); } }
        LAS float* PLs = (LAS float*)lds + wc * (256 * 32); LAS float* SSs = (LAS float*)(lds + MB_OFF) + wc * 256;
#pragma unroll
        for (int ai = 0; ai < 2; ++ai)
#pragma unroll
            for (int m = 0; m < 4; ++m) { const int rl = ai * HALF + wr * 64 + m * 16 + fr, row = u.pm * BM + rl; const size_t off = (size_t)row * D + col0; float s2 = 0.f;
                f32x4 pl0 = (f32x4){0.f, 0.f, 0.f, 0.f}, pl1 = pl0;
#pragma unroll
                for (int bj = 0; bj < 2; ++bj) { const f32x4 v0 = acc[ai][bj][m][0], v1 = acc[ai][bj][m][1];
                    { u32x4 xb; xb.x = cvt_pk_bf16(v0[0], v0[1]); xb.y = cvt_pk_bf16(v0[2], v0[3]); xb.z = cvt_pk_bf16(v1[0], v1[1]); xb.w = cvt_pk_bf16(v1[2], v1[3]);
                      *(u32x4*)((bf16_t*)(C + (size_t)row * D) + col0 + bj * HALF) = xb; }
                    s2 += (v0[0] * v0[0] + v0[1] * v0[1]) + (v0[2] * v0[2] + v0[3] * v0[3]) + (v1[0] * v1[0] + v1[1] * v1[1]) + (v1[2] * v1[2] + v1[3] * v1[3]);
                    const f32x4 h0 = v0 * wv[bj][0], h1 = v1 * wv[bj][1];
                    u32x4 hh, hl;
                    hh.x = cvt_pk_bf16(h0[0], h0[1]); hh.y = cvt_pk_bf16(h0[2], h0[3]); hh.z = cvt_pk_bf16(h1[0], h1[1]); hh.w = cvt_pk_bf16(h1[2], h1[3]);
                    hl.x = cvt_pk_bf16(h0[0] - bf_lo(hh.x), h0[1] - bf_hi(hh.x)); hl.y = cvt_pk_bf16(h0[2] - bf_lo(hh.y), h0[3] - bf_hi(hh.y));
                    hl.z = cvt_pk_bf16(h1[0] - bf_lo(hh.z), h1[1] - bf_hi(hh.z)); hl.w = cvt_pk_bf16(h1[2] - bf_lo(hh.w), h1[3] - bf_hi(hh.w));
                    u32x2 h8; h8.x = cvt4_fp8(h0[0], h0[1], h0[2], h0[3]); h8.y = cvt4_fp8(h1[0], h1[1], h1[2], h1[3]);
                    *(u32x2*)(H8 + off + bj * HALF) = h8;
                    const bf16x8 bhh = __builtin_bit_cast(bf16x8, hh), bhl = __builtin_bit_cast(bf16x8, hl);
                    pl0 = mfma16(fh[bj][0], bhh, pl0); pl0 = mfma16(fh[bj][0], bhl, pl0); pl0 = mfma16(fl[bj][0], bhh, pl0);
                    pl1 = mfma16(fh[bj][1], bhh, pl1); pl1 = mfma16(fh[bj][1], bhl, pl1); pl1 = mfma16(fl[bj][1], bhh, pl1); }
                s2 += __shfl_xor(s2, 16); s2 += __shfl_xor(s2, 32);
                if (fq == 0) SSs[rl] = s2;
                *(LAS f32x4*)(PLs + rl * 32 + 4 * (fq ^ (rl & 7))) = pl0; *(LAS f32x4*)(PLs + rl * 32 + 4 * ((4 + fq) ^ (rl & 7))) = pl1; }
        asm volatile("s_waitcnt lgkmcnt(0)" ::: "memory"); __builtin_amdgcn_s_barrier(); asm volatile("" ::: "memory");
        {
            const int rl = tid >> 1, hf = tid & 1, row = u.pm * BM + rl;
            f32x4 sum[4];
#pragma unroll
            for (int q = 0; q < 4; ++q) { sum[q] = (f32x4){0.f, 0.f, 0.f, 0.f};
#pragma unroll
                for (int c4 = 0; c4 < 4; ++c4) sum[q] += *(const LAS f32x4*)((const LAS float*)lds + c4 * (256 * 32) + rl * 32 + 4 * ((4 * hf + q) ^ (rl & 7))); }
            float* dst = PL + ((size_t)u.pn * NTOK + row) * 32 + 16 * hf;
#pragma unroll
            for (int q = 0; q < 4; ++q) *(f32x4*)(dst + 4 * q) = sum[q];
            if (hf == 0) { const LAS float* S0 = (const LAS float*)(lds + MB_OFF); ssq[(size_t)u.pn * NTOK + row] = ((S0[rl] + S0[256 + rl]) + S0[512 + rl]) + S0[768 + rl]; }
        }
    }
};
constexpr float WSCL = 1.0f / 32.0f;
__device__ __forceinline__ float swiglu(float g, float l) {
    g = fminf(g, 7.0f); l = fminf(fmaxf(l, -7.0f), 7.0f);
    const float s = __builtin_amdgcn_rcpf(1.0f + __builtin_amdgcn_exp2f(-1.702f * 1.4426950408889634f * g));
    return g * s * (l + 1.0f);
}
struct EpiGU {
    static constexpr bool PERM = true, HAS_INIT = false, AFTER_DRAIN = false;
    unsigned char* ACT;
    __device__ __forceinline__ void operator()(const f32x4 (&acc)[2][2][4][2], const Unit& u, int wr, int wc, int fr, int fq, const LAS le_t* mb) const {
        const int row0 = u.arow + wr * 64 + fr, cl = wc * 32 + 8 * fq, colg = u.pn * 128 + cl;
        const LAS float* bl = (const LAS float*)mb + 1024 + cl;
        const f32x4 bg0 = *(const LAS f32x4*)(bl), bg1 = *(const LAS f32x4*)(bl + 4), bl0 = *(const LAS f32x4*)(bl + 128), bl1 = *(const LAS f32x4*)(bl + 128 + 4);
        int rb = wr * 64 + fr; asm volatile("" : "+v"(rb));
#pragma unroll
        for (int ai = 0; ai < 2; ++ai)
#pragma unroll
            for (int m = 0; m < 4; ++m) {
                const float rs = __int_as_float(mb[ai * HALF + m * 16 + rb].z) * WSCL;
                const f32x4 g0 = acc[ai][0][m][0] * rs + bg0, g1 = acc[ai][0][m][1] * rs + bg1, l0 = acc[ai][1][m][0] * rs + bl0, l1 = acc[ai][1][m][1] * rs + bl1;
                u32x2 w; w.x = cvt4_fp8(swiglu(g0[0], l0[0]), swiglu(g0[1], l0[1]), swiglu(g0[2], l0[2]), swiglu(g0[3], l0[3]));
                w.y = cvt4_fp8(swiglu(g1[0], l1[0]), swiglu(g1[1], l1[1]), swiglu(g1[2], l1[2]), swiglu(g1[3], l1[3]));
                *(u32x2*)(ACT + (size_t)(row0 + ai * HALF + m * 16) * FF + colg) = w; }
    }
};
struct EpiDown {
    static constexpr bool PERM = true, HAS_INIT = false, AFTER_DRAIN = false;
    unsigned char* Y;
    __device__ __forceinline__ void operator()(const f32x4 (&acc)[2][2][4][2], const Unit& u, int wr, int wc, int fr, int fq, const LAS le_t* mb) const {
        const int cl = wc * 32 + 8 * fq, col0 = u.pn * BM + cl;
        const LAS float* bl = (const LAS float*)mb + 1024 + cl;
        int rb = wr * 64 + fr; asm volatile("" : "+v"(rb));
#pragma unroll
        for (int bj = 0; bj < 2; ++bj) {
            const f32x4 b0 = *(const LAS f32x4*)(bl + bj * HALF), b1 = *(const LAS f32x4*)(bl + bj * HALF + 4);
#pragma unroll
            for (int ai = 0; ai < 2; ++ai)
#pragma unroll
                for (int m = 0; m < 4; ++m) { const int r = ai * HALF + m * 16 + rb;
                    if (r < u.rows) { const le_t sg = mb[r]; const int slot = sg.x; const float gt = __int_as_float(sg.y) * 16.0f;
                        const f32x4 v0 = (acc[ai][bj][m][0] * WSCL + b0) * gt, v1 = (acc[ai][bj][m][1] * WSCL + b1) * gt;
                        u32x2 w; w.x = cvt4_fp8(v0[0], v0[1], v0[2], v0[3]); w.y = cvt4_fp8(v1[0], v1[1], v1[2], v1[3]);
                        *(u32x2*)(Y + (size_t)slot * D + col0 + bj * HALF) = w; } }
        }
    }
};

typedef int i32x4 __attribute__((ext_vector_type(4)));
__device__ __forceinline__ bf16x8 lo8(i32x8 a) { return __builtin_bit_cast(bf16x8, __builtin_shufflevector(a, a, 0, 1, 2, 3)); }
__device__ __forceinline__ bf16x8 hi8(i32x8 a) { return __builtin_bit_cast(bf16x8, __builtin_shufflevector(a, a, 4, 5, 6, 7)); }
__device__ __forceinline__ void glds_s(unsigned voff, const char* sbase, unsigned lds_dst) { unsigned keep;
    asm volatile("s_mov_b32 %0, m0\n\ts_mov_b32 m0, %2\n\ts_nop 0\n\tglobal_load_lds_dwordx4 %1, %3\n\ts_mov_b32 m0, %0" : "=&s"(keep) : "v"(voff), "s"(lds_dst), "s"(sbase) : "memory"); }
template <class Epi, class Sched, bool ALIGN_EPI, bool FP8 = false>
__device__ __forceinline__ void gemm_phase(LAS unsigned char* lds, const Sched& S, const Epi& E) {
    const int tid = threadIdx.x, wid = __builtin_amdgcn_readfirstlane(tid >> 6), lane = tid & 63, wr = wid >> 2, wc = wid & 3, fr = lane & 15, fq = lane >> 4;
    constexpr int K = FP8 ? 512 : KK;
    int nt = K / BK; asm volatile("" : "+s"(nt));
    unsigned voffB[2];
#pragma unroll
    for (int i = 0; i < 2; ++i) { int R, C; stage_rc(tid * 16 + i * 8192, R, C); const int Rb = Epi::PERM ? ((R & ~31) + perm32(R & 31)) : R;
        voffB[i] = (unsigned)(Rb * K + C) * 2u; }
    constexpr size_t kstep = (size_t)(BK * 2);
    constexpr size_t hstep = (size_t)HALF * K * 2;
    const unsigned ldsw = (unsigned)wid * 1024u;
    const unsigned ldsb = (unsigned)__builtin_amdgcn_readfirstlane((int)((unsigned)(size_t)lds + ldsw));
    const int aoff = lds_byte(wr * 64 + fr, fq * 8), boff = lds_byte(wc * 32 + fr, fq * 8);
#define PG8_SA(b, h) (((b) * 2 + (h)) * HTB)
#define PG8_SB(b, h) ((4 + (b) * 2 + (h)) * HTB)
#define PG8_STAGE(bufoff, gbase, voff) do { _Pragma("unroll") for (int _i = 0; _i < 2; ++_i) glds_s((voff)[_i], (const char*)(gbase), ldsb + (unsigned)((bufoff) + _i * 8192)); } while (0)
#define PG8_LDA(dst, b, h) do { _Pragma("unroll") for (int m = 0; m < 4; ++m) { const u32x4 _x = *(const LAS u32x4*)(lds + PG8_SA(b, h) + aoff + m * 2048), _y = *(const LAS u32x4*)(lds + PG8_SA(b, h) + aoff + m * 2048 + 1024); \
        dst[m] = (i32x8){(int)_x[0], (int)_x[1], (int)_x[2], (int)_x[3], (int)_y[0], (int)_y[1], (int)_y[2], (int)_y[3]}; } } while (0)
#define PG8_LDB(dst, b, h) do { _Pragma("unroll") for (int n = 0; n < 2; ++n) { const u32x4 _x = *(const LAS u32x4*)(lds + PG8_SB(b, h) + boff + n * 2048), _y = *(const LAS u32x4*)(lds + PG8_SB(b, h) + boff + n * 2048 + 1024); \
        dst[n] = (i32x8){(int)_x[0], (int)_x[1], (int)_x[2], (int)_x[3], (int)_y[0], (int)_y[1], (int)_y[2], (int)_y[3]}; } } while (0)
#define PG8_MMA(ai, bj, At, Bt) do { __builtin_amdgcn_s_setprio(1); _Pragma("unroll") for (int m = 0; m < 4; ++m) _Pragma("unroll") for (int n = 0; n < 2; ++n) { \
        if constexpr (FP8) { acc[ai][bj][m][n] = __builtin_amdgcn_mfma_scale_f32_16x16x128_f8f6f4(Bt[n], At[m], acc[ai][bj][m][n], 0, 0, 0, 0, 0, 0); } \
        else { acc[ai][bj][m][n] = __builtin_amdgcn_mfma_f32_16x16x32_bf16(lo8(Bt[n]), lo8(At[m]), acc[ai][bj][m][n], 0, 0, 0); acc[ai][bj][m][n] = __builtin_amdgcn_mfma_f32_16x16x32_bf16(hi8(Bt[n]), hi8(At[m]), acc[ai][bj][m][n], 0, 0, 0); } } __builtin_amdgcn_s_setprio(0); } while (0)
#define PG8_WAIT_V(n) asm volatile("s_waitcnt vmcnt(" #n ")" ::: "memory")
#define PG8_WAIT_L(n) asm volatile("s_waitcnt lgkmcnt(" #n ")" ::: "memory")
#define PG8_BAR __builtin_amdgcn_s_barrier()
#define PG8_SCHED __builtin_amdgcn_sched_barrier(0)
    Unit cur, nxt; int ui = 0;
    if (!S.next(0, cur)) return;
    f32x4 acc[2][2][4][2];
    if constexpr (Epi::HAS_INIT) E.init_acc(acc, cur, wr, wc, fr, fq);
    else {
#pragma unroll
    for (int a = 0; a < 2; ++a)
#pragma unroll
        for (int b = 0; b < 2; ++b)
#pragma unroll
            for (int m = 0; m < 4; ++m)
#pragma unroll
                for (int n = 0; n < 2; ++n) acc[a][b][m][n] = (f32x4){0.f, 0.f, 0.f, 0.f};
    }
    i32x8 At[4], B0[2], B1[2];
    const char* cA = S.a_base(cur); const char* cB = S.b_base(cur);
    unsigned go[2][2];
    LAS unsigned char* const mbx = lds + (MB_OFF - 0);
    if constexpr (Sched::MB) { S.mb_issue(mbx, cur, wid, lane); asm volatile("s_waitcnt vmcnt(0)" ::: "memory"); __builtin_amdgcn_s_barrier(); asm volatile("" ::: "memory"); }
    { int t2 = tid; asm volatile("" : "+v"(t2)); S.a_offs(cur, t2, go, (const LAS le_t*)mbx); }
    PG8_STAGE(PG8_SB(0, 0), cB, voffB); PG8_STAGE(PG8_SB(0, 1), cB + hstep, voffB); PG8_STAGE(PG8_SA(0, 0), cA, go[0]); PG8_STAGE(PG8_SA(0, 1), cA, go[1]);
    if (wr == 1) PG8_BAR;
    PG8_WAIT_V(2); PG8_BAR;
    PG8_STAGE(PG8_SB(1, 0), cB + kstep, voffB); PG8_STAGE(PG8_SA(1, 0), cA + kstep, go[0]); PG8_STAGE(PG8_SB(1, 1), cB + hstep + kstep, voffB);
    PG8_WAIT_V(6); PG8_BAR;
    asm volatile("" : "+v"(voffB[0]), "+v"(voffB[1]), "+v"(go[0][0]), "+v"(go[0][1]), "+v"(go[1][0]), "+v"(go[1][1]));
    for (;;) {
        const bool has_next = S.next(ui + 1, nxt);
        const char* nA = has_next ? S.a_base(nxt) : cA; const char* nB = has_next ? S.b_base(nxt) : cB;
#pragma clang loop unroll(disable)
        for (int t = 0; t < nt; t += 2) {
            const bool last = (t == nt - 2);
            asm volatile("" : "+v"(voffB[0]), "+v"(voffB[1]));
            const char* a1 = cA + (size_t)(t + 1) * kstep;
            const char* a2 = last ? nA : cA + (size_t)(t + 2) * kstep; const char* b2 = last ? nB : cB + (size_t)(t + 2) * kstep;
            const char* a3 = a2 + kstep; const char* b3 = b2 + kstep;
            PG8_LDB(B0, 0, 0); PG8_LDB(B1, 0, 1); PG8_SCHED; PG8_LDA(At, 0, 0); PG8_STAGE(PG8_SA(1, 1), a1, go[1]);
            if (last && has_next) { int t2 = tid; asm volatile("" : "+v"(t2)); S.a_offs(nxt, t2, go, (const LAS le_t*)(mbx + ((ui + 1) & 1) * 5120)); }
            PG8_WAIT_V(8); PG8_WAIT_L(0); PG8_BAR; PG8_MMA(0, 0, At, B0); PG8_MMA(0, 1, At, B1); PG8_BAR; PG8_SCHED;
            if constexpr (Sched::MB) { if (t == 0 && has_next) S.mb_issue(mbx + ((ui + 1) & 1) * 5120, nxt, wid, lane); }
            PG8_LDA(At, 0, 1); PG8_STAGE(PG8_SB(0, 0), b2, voffB); PG8_STAGE(PG8_SB(0, 1), b2 + hstep, voffB); PG8_STAGE(PG8_SA(0, 0), a2, go[0]);
            PG8_WAIT_V(8); PG8_WAIT_L(0); PG8_BAR; PG8_MMA(1, 0, At, B0); PG8_MMA(1, 1, At, B1); PG8_BAR; PG8_SCHED;
            PG8_LDB(B0, 1, 0); PG8_LDB(B1, 1, 1); PG8_SCHED; PG8_LDA(At, 1, 0); PG8_STAGE(PG8_SA(0, 1), a2, go[1]);
            PG8_WAIT_V(8); PG8_WAIT_L(0); PG8_BAR; PG8_MMA(0, 0, At, B0); PG8_MMA(0, 1, At, B1); PG8_BAR; PG8_SCHED;
            PG8_LDA(At, 1, 1); PG8_STAGE(PG8_SB(1, 0), b3, voffB); PG8_STAGE(PG8_SB(1, 1), b3 + hstep, voffB); PG8_STAGE(PG8_SA(1, 0), a3, go[0]);
            PG8_WAIT_V(8); PG8_WAIT_L(0); PG8_BAR; PG8_MMA(1, 0, At, B0); PG8_MMA(1, 1, At, B1); PG8_BAR; PG8_SCHED;
        }
        if constexpr (ALIGN_EPI) { if (wr == 0) PG8_BAR; }
        bool epi_now = true; if constexpr (Epi::AFTER_DRAIN) epi_now = !E.one;
        if (epi_now) { int t2 = tid; asm volatile("" : "+v"(t2)); const int l2 = t2 & 63; E(acc, cur, wr, wc, l2 & 15, l2 >> 4, (const LAS le_t*)(mbx + (ui & 1) * 5120)); }
        if (!has_next) break;
        if constexpr (Epi::HAS_INIT) { int t2 = tid; asm volatile("" : "+v"(t2)); const int l2 = t2 & 63; E.init_acc(acc, nxt, wr, wc, l2 & 15, l2 >> 4); }
        else {
#pragma unroll
        for (int a = 0; a < 2; ++a)
#pragma unroll
            for (int b = 0; b < 2; ++b)
#pragma unroll
                for (int m = 0; m < 4; ++m)
#pragma unroll
                    for (int n = 0; n < 2; ++n) acc[a][b][m][n] = (f32x4){0.f, 0.f, 0.f, 0.f};
        }
        cur = nxt; cA = nA; cB = nB; ++ui;
        if constexpr (ALIGN_EPI) { if (wr == 1) PG8_BAR; }
    }
    PG8_WAIT_V(0);
    if constexpr (!ALIGN_EPI) { if (wr == 0) PG8_BAR; }
    PG8_BAR;
    if constexpr (Epi::AFTER_DRAIN) { if (E.one) { int t2 = tid; asm volatile("" : "+v"(t2)); const int l2 = t2 & 63; E.fused(acc, cur, wr, wc, l2 & 15, l2 >> 4, lds, t2); } }
#undef PG8_SA
#undef PG8_SB
#undef PG8_STAGE
#undef PG8_LDA
#undef PG8_LDB
#undef PG8_MMA
#undef PG8_WAIT_V
#undef PG8_WAIT_L
#undef PG8_BAR
#undef PG8_SCHED
}
}

#define XB_TMO      128
#define XB_XCNT(j)  (256  + 64 * (j))
#define XB_XSUB(j)  (1280 + 64 * (j))
#define XB_XGEN(j)  (2304 + 64 * (j))
#define XB_TOP      3328
#define XB_TOPGEN   3392
#define XCD_BAR_WORDS 3456
#define XB_SPIN_CAP (1u << 18)
__device__ __forceinline__ unsigned xb_ld(unsigned* p)              { return __hip_atomic_load(p, __ATOMIC_RELAXED, __HIP_MEMORY_SCOPE_AGENT); }
__device__ __forceinline__ unsigned xb_add(unsigned* p, unsigned v) { return __hip_atomic_fetch_add(p, v, __ATOMIC_RELAXED, __HIP_MEMORY_SCOPE_AGENT); }
__device__ __forceinline__ unsigned xb_xcc_id() { return (unsigned)__builtin_amdgcn_s_getreg((3 << 11) | 20) & 0xFu; }
#define XB_SPIN(cond, bar) do { unsigned _sp = 0; while (cond) { __builtin_amdgcn_s_sleep(1); \
    if ((++_sp & 255u) == 0u) { if (xb_ld(&(bar)[XB_TMO])) break; if (_sp > XB_SPIN_CAP) { atomicAdd(&(bar)[XB_TMO], 1u); break; } } } } while (0)
struct XcdBarrier { unsigned* bar; unsigned x; volatile LAS unsigned* st; };
__device__ __forceinline__ XcdBarrier xcd_barrier_post(unsigned* bar, volatile LAS unsigned* st) {
    XcdBarrier b; b.bar = bar; b.x = xb_xcc_id(); b.st = st;
    if (threadIdx.x == 0) (void)xb_add(&bar[XB_XCNT(b.x)], 1u);
    return b;
}
__device__ __forceinline__ void xcd_barrier_complete(unsigned* bar, unsigned x, unsigned& nloc, unsigned& nx) {
    const unsigned G = gridDim.x * gridDim.y * gridDim.z;
    unsigned sum, cnt, mine, sp = 0u;
    for (;;) {
        sum = 0u; cnt = 0u; mine = 0u;
#pragma unroll
        for (unsigned j = 0; j < 16; ++j) { const unsigned c = xb_ld(&bar[XB_XCNT(j)]); sum += c; cnt += (c > 0u) ? 1u : 0u; mine = (j == x) ? c : mine; }
        if (sum == G) break;
        __builtin_amdgcn_s_sleep(1);
        if ((++sp & 255u) == 0u) { if (xb_ld(&bar[XB_TMO])) break; if (sp > XB_SPIN_CAP) { atomicAdd(&bar[XB_TMO], 1u); break; } }
    }
    nloc = mine > 0u ? mine : 1u; nx = cnt > 0u ? cnt : 1u;
}
__device__ __forceinline__ void xcd_barrier(const XcdBarrier& b) {
    asm volatile("s_waitcnt vmcnt(0)" ::: "memory");
    __syncthreads();
    if (threadIdx.x == 0) {
        unsigned* bar = b.bar;
        __builtin_amdgcn_s_waitcnt(0);
        unsigned nloc = b.st[0], nx = b.st[1];
        if (nloc == 0u) { xcd_barrier_complete(bar, b.x, nloc, nx); b.st[0] = nloc; b.st[1] = nx; }
        const unsigned old = xb_add(&bar[XB_XSUB(b.x)], 1u);
        const unsigned gen = old / nloc;
        if (old + 1u == (gen + 1u) * nloc) {
            __builtin_amdgcn_fence(__ATOMIC_RELEASE, "agent");
            asm volatile("s_waitcnt vmcnt(0)" ::: "memory");
            const unsigned og = xb_add(&bar[XB_TOP], 1u);
            const unsigned tg = og / nx;
            if (og + 1u == (tg + 1u) * nx) xb_add(&bar[XB_TOPGEN], 1u);
            else XB_SPIN(xb_ld(&bar[XB_TOPGEN]) == tg, bar);
            __builtin_amdgcn_fence(__ATOMIC_ACQUIRE, "agent");
            xb_add(&bar[XB_XGEN(b.x)], 1u);
            asm volatile("s_waitcnt vmcnt(0)" ::: "memory");
        } else {
            XB_SPIN(xb_ld(&bar[XB_XGEN(b.x)]) == gen, bar);
            __builtin_amdgcn_fence(__ATOMIC_ACQUIRE, "agent");
            asm volatile("s_waitcnt vmcnt(0)" ::: "memory");
        }
    }
    __syncthreads();
}

struct Frame {
    LAS unsigned char* lds;
    volatile LAS unsigned* MISC;
    gu32* ctl;
    int tid, lane, wave, vcu, G;
    const float *x, *norm_mix_w, *w_in, *ret_norm_w, *w_pool, *pool_scale, *w_out, *norm_ffn_w, *w_router, *b_router, *w_gu, *b_gu, *w_down, *b_down, *norm_final_w;
    float* out;
    bf16_t *Wr_hi, *Wr_lo, *Wpool_t, *Win_t, *Wout_t, *XN, *CAT, *U, *Z, *Y;
    unsigned char *Wgu8, *Wd8, *ACT8, *H8;
    le_t* list; float* ssq; float* PL;
    float lg2g0, lg2g1, lg2g2, lg2g3;
    __device__ __forceinline__ float lg2(int h) const { return h == 0 ? lg2g0 : (h == 1 ? lg2g1 : (h == 2 ? lg2g2 : lg2g3)); }
};

template <int MODE>
__device__ __forceinline__ void p0_item(const float* W, int ldw, void* WT, void* WT2, int ldo, LAS float* scr, int k0, int n0, int orow0, int lane) {
    f32x4 v[16];
    const float* src = W + (size_t)(k0 + (lane >> 3)) * ldw + n0 + 4 * (lane & 7);
#pragma unroll
    for (int i = 0; i < 16; ++i) v[i] = *(const GAS f32x4*)(src + (size_t)(8 * i) * ldw);
#pragma unroll
    for (int i = 0; i < 16; ++i) *(LAS f32x4*)(scr + (8 * i + (lane >> 3)) * 32 + 4 * ((lane & 7) ^ (i & 7))) = v[i];
    LDS_WAIT(); asm volatile("" ::: "memory");
    const int c = lane & 15, ns = lane >> 4;
#pragma unroll
    for (int J = 0; J < 8; ++J) {
        const LAS float* sp = scr + (8 * c) * 32 + 4 * (J ^ (c & 7)) + ns;
        float x[8];
#pragma unroll
        for (int q = 0; q < 8; ++q) x[q] = sp[q * 32];
        const int n = 4 * J + ns;
        if (MODE == 2) { u32x2 o; o.x = cvt4_fp8(x[0] * 32.f, x[1] * 32.f, x[2] * 32.f, x[3] * 32.f); o.y = cvt4_fp8(x[4] * 32.f, x[5] * 32.f, x[6] * 32.f, x[7] * 32.f);
            *(GAS u32x2*)((unsigned char*)WT + (size_t)(orow0 + n) * 1024 + k0 + 8 * c) = o; }
        else { u32x4 o; o.x = cvt_pk_bf16(x[0], x[1]); o.y = cvt_pk_bf16(x[2], x[3]); o.z = cvt_pk_bf16(x[4], x[5]); o.w = cvt_pk_bf16(x[6], x[7]);
            *(GAS u32x4*)((bf16_t*)WT + (size_t)(orow0 + n) * ldo + k0 + 8 * c) = o;
            if (MODE == 1) { u32x4 o2; o2.x = cvt_pk_bf16(x[0] - bf_lo(o.x), x[1] - bf_hi(o.x)); o2.y = cvt_pk_bf16(x[2] - bf_lo(o.y), x[3] - bf_hi(o.y));
                o2.z = cvt_pk_bf16(x[4] - bf_lo(o.z), x[5] - bf_hi(o.z)); o2.w = cvt_pk_bf16(x[6] - bf_lo(o.w), x[7] - bf_hi(o.w));
                *(GAS u32x4*)((bf16_t*)WT2 + (size_t)(orow0 + n) * ldo + k0 + 8 * c) = o2; } }
    }
    LDS_WAIT(); asm volatile("" ::: "memory");
}
__device__ __forceinline__ void rms_rows4_to_bf16(int lane, const float* x, const float* w, bf16_t* o, int m, int rs) {
    f32x4 v[4][4];
#pragma unroll
    for (int r = 0; r < 4; ++r) { const GAS f32x4* xr = (const GAS f32x4*)(x + (size_t)(m + r * rs) * D) + lane;
#pragma unroll
        for (int j = 0; j < 4; ++j) v[r][j] = __builtin_nontemporal_load(xr + 64 * j); }
    const GAS f32x4* wr = (const GAS f32x4*)w + lane;
    f32x4 ww[4];
#pragma unroll
    for (int j = 0; j < 4; ++j) ww[j] = wr[64 * j];
#pragma unroll
    for (int r = 0; r < 4; ++r) { float s = 0.f;
#pragma unroll
        for (int j = 0; j < 4; ++j) s += (v[r][j].x * v[r][j].x + v[r][j].y * v[r][j].y) + (v[r][j].z * v[r][j].z + v[r][j].w * v[r][j].w);
        const float rstd = 1.f / sqrtf(wave_sum(s) * (1.f / D) + EPS);
        GAS u32x2* o8 = (GAS u32x2*)(o + (size_t)(m + r * rs) * D) + lane;
#pragma unroll
        for (int j = 0; j < 4; ++j) { u32x2 p; p.x = cvt_pk_bf16(v[r][j].x * rstd * ww[j].x, v[r][j].y * rstd * ww[j].y); p.y = cvt_pk_bf16(v[r][j].z * rstd * ww[j].z, v[r][j].w * rstd * ww[j].w); o8[64 * j] = p; } }
}
template <int MODE, class RM>
__device__ __forceinline__ void p0_block_item(const float* W, int ldw, void* WT, int ldo, LAS float* tile, int k0, int n0, int wave, int lane, RM rowmap) {
    f32x4 v[16];
    const float* src = W + (size_t)(k0 + 16 * wave) * ldw + n0 + 4 * lane;
#pragma unroll
    for (int i = 0; i < 16; ++i) v[i] = __builtin_nontemporal_load((const GAS f32x4*)(src + (size_t)i * ldw));
#pragma unroll
    for (int i = 0; i < 16; ++i) { const int kl = 16 * wave + i; *(LAS f32x4*)(tile + kl * 256 + 4 * (lane ^ ((kl >> 3) & 7))) = v[i]; }
    __syncthreads();
    const int c = lane & 15, ns = lane >> 4;
#pragma unroll
    for (int J = 0; J < 8; ++J) {
        const LAS float* sp = tile + (8 * c) * 256 + 4 * ((8 * wave + J) ^ (c & 7)) + ns;
        float x[8];
#pragma unroll
        for (int q = 0; q < 8; ++q) x[q] = sp[q * 256];
        const int orow = rowmap(n0 + 32 * wave + 4 * J + ns);
        if (MODE == 2) { u32x2 o; o.x = cvt4_fp8(x[0] * 32.f, x[1] * 32.f, x[2] * 32.f, x[3] * 32.f); o.y = cvt4_fp8(x[4] * 32.f, x[5] * 32.f, x[6] * 32.f, x[7] * 32.f);
            __builtin_nontemporal_store(o, (GAS u32x2*)((unsigned char*)WT + (size_t)orow * 1024 + k0 + 8 * c)); }
        else { u32x4 o; o.x = cvt_pk_bf16(x[0], x[1]); o.y = cvt_pk_bf16(x[2], x[3]); o.z = cvt_pk_bf16(x[4], x[5]); o.w = cvt_pk_bf16(x[6], x[7]);
            *(GAS u32x4*)((bf16_t*)WT + (size_t)orow * ldo + k0 + 8 * c) = o; }
    }
    __syncthreads();
}
struct RowId { __device__ __forceinline__ int operator()(int n) const { return n; } };
struct RowGU { __device__ __forceinline__ int operator()(int n) const { const int m = n & 1023; return ((m >> 7) << 8) + (n >> 10) * 128 + (m & 127); } };
__device__ __forceinline__ void p0_prologue(Frame& F) {
    LAS float* tile = (LAS float*)F.lds;
    constexpr int B_IN = 8 * 10, B_OUT = 8 * 4, NB = B_IN + B_OUT;
    for (int it = F.vcu; it < NB; it += F.G) {
        int r = it;
        if (r < B_IN) { const int kb = r / 10, nb = r % 10; p0_block_item<0>(F.w_in, DIN, F.Win_t, 1024, tile, kb * 128, nb * 256, F.wave, F.lane, RowId()); continue; } r -= B_IN;
        { const int kb = r >> 2, nb = r & 3; p0_block_item<0>(F.w_out, 1024, F.Wout_t, 1024, tile, kb * 128, nb * 256, F.wave, F.lane, RowId()); }
    }
    LAS float* scr = (LAS float*)(F.lds + F.wave * 16384);
    const int gw = F.vcu * NWAVES + F.wave, NGW = F.G * NWAVES;
    constexpr int I_POOL = 16, I_R = 8;
    for (int it = gw; it < I_POOL + I_R; it += NGW) {
        if (it < I_POOL) { const int g = it / 4, nb = it % 4; p0_item<0>(F.w_pool + g * 16384, 128, F.Wpool_t + g * 16384, nullptr, 128, scr, 0, nb * 32, nb * 32, F.lane); }
        else { const int kb = it - I_POOL; p0_item<1>(F.w_router, 32, F.Wr_hi, F.Wr_lo, 1024, scr, kb * 128, 0, 0, F.lane); }
    }
    for (int m = gw; m < NTOK / 4; m += NGW) rms_rows4_to_bf16(F.lane, F.x, F.norm_mix_w, F.XN, m, NTOK / 4);
}

constexpr int CONV_GU = 32 * 8 * 8, CONV_ITEMS = CONV_GU + 32 * 8 * 4;
struct ConvItem { const float* src; unsigned char* dst; int ldw, k0, n0, gu; };
__device__ __forceinline__ ConvItem conv_decode(const Frame& F, int it) {
    ConvItem c;
    if (it < CONV_GU) { const int e = it >> 6, q = it & 63, kb = q >> 3, nb = q & 7; c.src = F.w_gu + (size_t)e * 1024 * 2048; c.dst = F.Wgu8 + (size_t)e * 2048 * 1024; c.ldw = 2048; c.k0 = kb * 128; c.n0 = nb * 256; c.gu = 1; }
    else { const int r = it - CONV_GU, e = r >> 5, q = r & 31, kb = q >> 2, nb = q & 3; c.src = F.w_down + (size_t)e * 1024 * 1024; c.dst = F.Wd8 + (size_t)e * 1024 * 1024; c.ldw = 1024; c.k0 = kb * 128; c.n0 = nb * 256; c.gu = 0; }
    return c;
}
__device__ __forceinline__ void conv_load(const ConvItem& c, int wave, int lane, f32x4 (&v)[16]) {
    const float* src = c.src + (size_t)(c.k0 + 16 * wave) * c.ldw + c.n0 + 4 * lane;
#pragma unroll
    for (int i = 0; i < 16; ++i) v[i] = __builtin_nontemporal_load((const GAS f32x4*)(src + (size_t)i * c.ldw));
}
__device__ __forceinline__ void conv_pull(Frame& F, int budget, int q) {
    if (budget <= 0) return;
    gu32* head = F.ctl + CW_Q + 64 * q; const int ibase = q ? CONV_GU : 0, iend = q ? CONV_ITEMS : CONV_GU;
    LAS float* tile = (LAS float*)F.lds;
    const int wave = F.wave, lane = F.lane, c16 = lane & 15, ns = lane >> 4;
    if (F.tid == 0) F.MISC[44] = atomicAdd((unsigned*)head, 1u);
    __syncthreads();
    int it = ibase + (int)F.MISC[44];
    if (it >= iend) return;
    ConvItem cur = conv_decode(F, it);
    f32x4 v[16]; conv_load(cur, wave, lane, v);
    for (int n = 0;; ++n) {
#pragma unroll
        for (int i = 0; i < 16; ++i) { const int kl = 16 * wave + i; *(LAS f32x4*)(tile + kl * 256 + 4 * (lane ^ ((kl >> 3) & 7))) = v[i]; }
        if (F.tid == 0) F.MISC[45 - (n & 1)] = (n + 1 < budget) ? atomicAdd((unsigned*)head, 1u) : (unsigned)CONV_ITEMS;
        __syncthreads();
        const int itn = ibase + (int)F.MISC[45 - (n & 1)];
        ConvItem nxt = cur;
        if (itn < iend) { nxt = conv_decode(F, itn); conv_load(nxt, wave, lane, v); }
#pragma unroll
        for (int J = 0; J < 8; ++J) {
            const LAS float* sp = tile + (8 * c16) * 256 + 4 * ((8 * wave + J) ^ (c16 & 7)) + ns;
            float x[8];
#pragma unroll
            for (int q = 0; q < 8; ++q) x[q] = sp[q * 256];
            const int nn = cur.n0 + 32 * wave + 4 * J + ns, orow = cur.gu ? RowGU()(nn) : nn;
            u32x2 o; o.x = cvt4_fp8(x[0] * 32.f, x[1] * 32.f, x[2] * 32.f, x[3] * 32.f); o.y = cvt4_fp8(x[4] * 32.f, x[5] * 32.f, x[6] * 32.f, x[7] * 32.f);
            __builtin_nontemporal_store(o, (GAS u32x2*)(cur.dst + (size_t)orow * 1024 + cur.k0 + 8 * c16));
        }
        __syncthreads();
        if (itn >= iend) break;
        cur = nxt;
    }
}

__device__ __forceinline__ void rope_cs(int pos, int j, float& cs, float& sn) {
    const float inv = __builtin_amdgcn_exp2f((float)j * (-13.287712379549449f / 64.0f));
    const double revd = (double)pos * (double)inv * 0.15915494309189535;
    const float rev = (float)(revd - __builtin_floor(revd));
    sn = __builtin_amdgcn_sinf(rev); cs = __builtin_amdgcn_cosf(rev);
}

__device__ __forceinline__ int tr_idx(int d, int m) { return d * 72 + 8 * ((m >> 3) ^ ((d >> 3) & 7)) + (m & 7); }
__device__ __forceinline__ int tr_frag(int r, int chunk) { return r * 72 + 8 * (chunk ^ ((r >> 3) & 7)); }

struct RawKV { u32x4 klo, khi, vlo, vhi; };
__device__ __forceinline__ void retA_load(const Frame& F, int unit, RawKV& r) {
    const int c = unit & 63, bh = unit >> 6, h = bh & 3, b = bh >> 2, m = F.tid >> 3, o = F.tid & 7;
    const bf16_t* zrow = F.Z + (size_t)(b * SEQ + c * 64 + m) * DIN + h * 128 + 8 * o;
    r.klo = *(const u32x4*)(zrow + 512); r.khi = *(const u32x4*)(zrow + 512 + 64); r.vlo = *(const u32x4*)(zrow + 1024); r.vhi = *(const u32x4*)(zrow + 1024 + 64);
}
__device__ __forceinline__ void retA_stage(const Frame& F, int unit, const RawKV& r) {
    const int c = unit & 63, h = (unit >> 6) & 3, m = F.tid >> 3, o = F.tid & 7;
    LAS bf16_t* KT = (LAS bf16_t*)(F.lds);
    LAS bf16_t* VT = KT + 128 * 72;
    const float ksc = __builtin_amdgcn_exp2f(F.lg2(h) * (float)(63 - m)) * 0.08838834764831845f;
    const int pos = c * 64 + m;
#pragma unroll
    for (int i = 0; i < 8; ++i) {
        const unsigned wl = r.klo[i >> 1], wh = r.khi[i >> 1];
        const float lo = (i & 1) ? bf_hi(wl) : bf_lo(wl), hi = (i & 1) ? bf_hi(wh) : bf_lo(wh);
        float cs, sn; rope_cs(pos, 8 * o + i, cs, sn);
        const unsigned pk = cvt_pk_bf16((lo * cs - hi * sn) * ksc, (lo * sn + hi * cs) * ksc);
        KT[tr_idx(8 * o + i, m)] = (bf16_t)(pk & 0xffffu); KT[tr_idx(64 + 8 * o + i, m)] = (bf16_t)(pk >> 16);
        const unsigned vl = r.vlo[i >> 1], vh = r.vhi[i >> 1];
        VT[tr_idx(8 * o + i, m)] = (bf16_t)((i & 1) ? (vl >> 16) : (vl & 0xffffu)); VT[tr_idx(64 + 8 * o + i, m)] = (bf16_t)((i & 1) ? (vh >> 16) : (vh & 0xffffu));
    }
}
__device__ __forceinline__ void retA_compute(const Frame& F, int unit) {
    LAS bf16_t* KT = (LAS bf16_t*)(F.lds); LAS bf16_t* VT = KT + 128 * 72;
    const int w = F.wave, fr = F.lane & 15, fq = F.lane >> 4;
    bf16x8 vf[2];
#pragma unroll
    for (int ks = 0; ks < 2; ++ks) vf[ks] = *(const LAS bf16x8*)(VT + tr_frag(16 * w + fr, 4 * ks + fq));
    bf16_t* urow = F.U + ((size_t)unit * 128 + 16 * w + fr) * 128 + 4 * fq;
#pragma unroll
    for (int dt = 0; dt < 8; ++dt) {
        f32x4 acc = (f32x4){0.f, 0.f, 0.f, 0.f};
#pragma unroll
        for (int ks = 0; ks < 2; ++ks) { const bf16x8 kf = *(const LAS bf16x8*)(KT + tr_frag(16 * dt + fr, 4 * ks + fq)); acc = mfma16(kf, vf[ks], acc); }
        u32x2 pk; pk.x = cvt_pk_bf16(acc[0], acc[1]); pk.y = cvt_pk_bf16(acc[2], acc[3]);
        *(u32x2*)(urow + 16 * dt) = pk;
    }
}
__device__ __forceinline__ void retA_phase(Frame& F) {
    int u = F.vcu; if (u >= 1024) return;
    RawKV raw; retA_load(F, u, raw);
    for (; u < 1024; u += F.G) {
        retA_stage(F, u, raw);
        if (u + F.G < 1024) retA_load(F, u + F.G, raw);
        __syncthreads();
        retA_compute(F, u);
        __syncthreads();
    }
}

__device__ __forceinline__ void pool_load(const Frame& F, int unit, u32x4 (&raw)[3]) {
    const int g = unit & 3, tile = unit >> 2, st = (tile & 63) * 64, tok0 = tile * 64;
#pragma unroll
    for (int j = 0; j < 3; ++j) { const int idx = F.tid + 512 * j, r = idx >> 4, ch = idx & 15, s = st - 15 + r;
        raw[j] = (u32x4){0u, 0u, 0u, 0u};
        if (idx < 79 * 16 && s >= 0) raw[j] = *(const u32x4*)(F.Z + (size_t)(tok0 - 15 + r) * DIN + 2048 + g * 128 + 8 * ch); }
}
__device__ __forceinline__ void pool_phase(Frame& F) {
    int u = F.vcu; if (u >= 1024) return;
    LAS float* P = (LAS float*)(F.lds);
    LAS bf16_t* A = (LAS bf16_t*)(F.lds + 79 * 132 * 4);
    const int t = F.tid, w = F.wave, rt = w & 3, chf = w >> 2, fr = F.lane & 15, fq = F.lane >> 4;
    const bool fixed_g = (F.G & 3) == 0;
    bf16x8 wf[4][4]; f32x4 sc[4];
    { const int g = u & 3; const bf16_t* wp = F.Wpool_t + g * 16384;
#pragma unroll
      for (int dd = 0; dd < 4; ++dd) { const int dt = 4 * chf + dd; sc[dd] = *(const f32x4*)(F.pool_scale + g * 128 + 16 * dt + 4 * fq);
#pragma unroll
          for (int ks = 0; ks < 4; ++ks) wf[dd][ks] = *(const bf16x8*)(wp + (16 * dt + fr) * 128 + 32 * ks + 8 * fq); } }
    u32x4 raw[3]; pool_load(F, u, raw);
    for (; u < 1024; u += F.G) {
        const int g = u & 3, tile = u >> 2, st = (tile & 63) * 64, tok0 = tile * 64, win = 2 << g;
        if (!fixed_g) { const bf16_t* wp = F.Wpool_t + g * 16384;
#pragma unroll
            for (int dd = 0; dd < 4; ++dd) { const int dt = 4 * chf + dd; sc[dd] = *(const f32x4*)(F.pool_scale + g * 128 + 16 * dt + 4 * fq);
#pragma unroll
                for (int ks = 0; ks < 4; ++ks) wf[dd][ks] = *(const bf16x8*)(wp + (16 * dt + fr) * 128 + 32 * ks + 8 * fq); } }
#pragma unroll
        for (int j = 0; j < 3; ++j) { const int idx = t + 512 * j, r = idx >> 4, ch = idx & 15;
            if (idx < 79 * 16) { const u32x4 x = raw[j];
                *(LAS f32x4*)(P + r * 132 + 8 * ch) = (f32x4){bf_lo(x.x), bf_hi(x.x), bf_lo(x.y), bf_hi(x.y)}; *(LAS f32x4*)(P + r * 132 + 8 * ch + 4) = (f32x4){bf_lo(x.z), bf_hi(x.z), bf_lo(x.w), bf_hi(x.w)}; } }
        if (u + F.G < 1024) pool_load(F, u + F.G, raw);
        __syncthreads();
        {
            const int c4 = t & 31, n0 = 4 * (t >> 5);
            const LAS float* pc = P + (15 + n0) * 132 + 4 * c4;
            f32x4 sum = (f32x4){0.f, 0.f, 0.f, 0.f};
            for (int j = 0; j < win; ++j) sum += *(const LAS f32x4*)(pc - j * 132);
#pragma unroll
            for (int i = 0; i < 4; ++i) {
                const f32x4 self = *(const LAS f32x4*)(pc + i * 132);
                if (i > 0) sum += self - *(const LAS f32x4*)(pc + (i - win) * 132);
                const int sp = st + n0 + i;
                const float rc = 1.0f / (float)((sp + 1 < win) ? (sp + 1) : win);
                const f32x4 pv = sum * rc - self;
                u32x2 pk; pk.x = cvt_pk_bf16(pv[0], pv[1]); pk.y = cvt_pk_bf16(pv[2], pv[3]);
                *(LAS u32x2*)(A + (n0 + i) * 136 + 4 * c4) = pk;
            }
        }
        __syncthreads();
        {
            bf16x8 af[4];
#pragma unroll
            for (int ks = 0; ks < 4; ++ks) af[ks] = *(const LAS bf16x8*)(A + (16 * rt + fr) * 136 + 32 * ks + 8 * fq);
            bf16_t* orow = F.CAT + (size_t)(tok0 + 16 * rt + fr) * D + 512 + g * 128;
#pragma unroll
            for (int dd = 0; dd < 4; ++dd) { const int dt = 4 * chf + dd;
                f32x4 acc = (f32x4){0.f, 0.f, 0.f, 0.f};
#pragma unroll
                for (int ks = 0; ks < 4; ++ks) acc = mfma16(wf[dd][ks], af[ks], acc);
                u32x2 pk; pk.x = cvt_pk_bf16(acc[0] * sc[dd][0], acc[1] * sc[dd][1]); pk.y = cvt_pk_bf16(acc[2] * sc[dd][2], acc[3] * sc[dd][3]);
                *(u32x2*)(orow + 16 * dt + 4 * fq) = pk;
            }
        }
        __syncthreads();
    }
}

struct RawQKV { u32x4 qlo, qhi, klo, khi, vlo, vhi; };
__device__ __forceinline__ void retB_load(const Frame& F, int unit, RawQKV& r) {
    const int c = unit & 63, bh = unit >> 6, h = bh & 3, b = bh >> 2, m = F.tid >> 3, o = F.tid & 7;
    const bf16_t* zrow = F.Z + (size_t)(b * SEQ + c * 64 + m) * DIN + h * 128 + 8 * o;
    r.qlo = *(const u32x4*)(zrow); r.qhi = *(const u32x4*)(zrow + 64); r.klo = *(const u32x4*)(zrow + 512); r.khi = *(const u32x4*)(zrow + 512 + 64); r.vlo = *(const u32x4*)(zrow + 1024); r.vhi = *(const u32x4*)(zrow + 1024 + 64);
}
__device__ __forceinline__ void retB_phase(Frame& F) {
    int unit = F.vcu; if (unit >= 1024) return;
    LAS bf16_t* Q = (LAS bf16_t*)(F.lds);
    LAS bf16_t* Kr = Q + 64 * 136;
    LAS bf16_t* VT = Kr + 64 * 136;
    LAS bf16_t* Sm = VT + 128 * 72;
    LAS float* red = (LAS float*)(Sm + 64 * 72);
    const int t = F.tid, w = F.wave, fr = F.lane & 15, fq = F.lane >> 4;
    RawQKV raw; retB_load(F, unit, raw);
    for (; unit < 1024; unit += F.G) {
        const int c = unit & 63, bh = unit >> 6, h = bh & 3, b = bh >> 2, tok0 = b * SEQ + c * 64;
        const float lg = F.lg2(h);
        const int rt = w & 3, chf = w >> 2, n = 16 * rt + fr;
        bf16x8 rf[4][4]; u32x2 gw2[4];
#pragma unroll
        for (int dd = 0; dd < 4; ++dd) { const bf16_t* rrow = F.U + ((size_t)unit * 128 + 16 * (4 * chf + dd) + fr) * 128 + 8 * fq;
#pragma unroll
            for (int ks = 0; ks < 4; ++ks) rf[dd][ks] = *(const bf16x8*)(rrow + 32 * ks);
            gw2[dd] = *(const u32x2*)(F.Z + (size_t)(tok0 + n) * DIN + 1536 + h * 128 + 16 * (4 * chf + dd) + 4 * fq); }
        {
            const int m = t >> 3, o = t & 7, pos = c * 64 + m;
            unsigned ql[4], qh[4], kl[4], kh[4];
#pragma unroll
            for (int i = 0; i < 8; i += 2) {
                float cs0, sn0, cs1, sn1; rope_cs(pos, 8 * o + i, cs0, sn0); rope_cs(pos, 8 * o + i + 1, cs1, sn1);
                { const float l0 = bf_lo(raw.qlo[i >> 1]), l1 = bf_hi(raw.qlo[i >> 1]), h0 = bf_lo(raw.qhi[i >> 1]), h1 = bf_hi(raw.qhi[i >> 1]);
                  ql[i >> 1] = cvt_pk_bf16(l0 * cs0 - h0 * sn0, l1 * cs1 - h1 * sn1); qh[i >> 1] = cvt_pk_bf16(l0 * sn0 + h0 * cs0, l1 * sn1 + h1 * cs1); }
                { const float l0 = bf_lo(raw.klo[i >> 1]), l1 = bf_hi(raw.klo[i >> 1]), h0 = bf_lo(raw.khi[i >> 1]), h1 = bf_hi(raw.khi[i >> 1]); const float sc = 0.08838834764831845f;
                  kl[i >> 1] = cvt_pk_bf16((l0 * cs0 - h0 * sn0) * sc, (l1 * cs1 - h1 * sn1) * sc); kh[i >> 1] = cvt_pk_bf16((l0 * sn0 + h0 * cs0) * sc, (l1 * sn1 + h1 * cs1) * sc); }
            }
            *(LAS u32x4*)(Q + m * 136 + 8 * o) = (u32x4){ql[0], ql[1], ql[2], ql[3]}; *(LAS u32x4*)(Q + m * 136 + 64 + 8 * o) = (u32x4){qh[0], qh[1], qh[2], qh[3]};
            *(LAS u32x4*)(Kr + m * 136 + 8 * o) = (u32x4){kl[0], kl[1], kl[2], kl[3]}; *(LAS u32x4*)(Kr + m * 136 + 64 + 8 * o) = (u32x4){kh[0], kh[1], kh[2], kh[3]};
#pragma unroll
            for (int i = 0; i < 8; ++i) { const unsigned vl = raw.vlo[i >> 1], vh = raw.vhi[i >> 1];
                VT[tr_idx(8 * o + i, m)] = (bf16_t)((i & 1) ? (vl >> 16) : (vl & 0xffffu)); VT[tr_idx(64 + 8 * o + i, m)] = (bf16_t)((i & 1) ? (vh >> 16) : (vh & 0xffffu)); }
        }
        if (unit + F.G < 1024) retB_load(F, unit + F.G, raw);
        __syncthreads();
        {
            const int ntl = w >> 1;
            bf16x8 qf[4];
#pragma unroll
            for (int ks = 0; ks < 4; ++ks) qf[ks] = *(const LAS bf16x8*)(Q + (16 * ntl + fr) * 136 + 32 * ks + 8 * fq);
#pragma unroll
            for (int mm = 0; mm < 2; ++mm) { const int mt = 2 * (w & 1) + mm;
                f32x4 acc = (f32x4){0.f, 0.f, 0.f, 0.f};
#pragma unroll
                for (int ks = 0; ks < 4; ++ks) { const bf16x8 kf = *(const LAS bf16x8*)(Kr + (16 * mt + fr) * 136 + 32 * ks + 8 * fq); acc = mfma16(kf, qf[ks], acc); }
                const int nn = 16 * ntl + fr, m0 = 16 * mt + 4 * fq;
                float sv[4];
#pragma unroll
                for (int j = 0; j < 4; ++j) { const int dd = nn - (m0 + j); sv[j] = acc[j] * __builtin_amdgcn_exp2f(lg * (float)(dd < 0 ? -dd : dd)); }
                u32x2 pk; pk.x = cvt_pk_bf16(sv[0], sv[1]); pk.y = cvt_pk_bf16(sv[2], sv[3]);
                *(LAS u32x2*)(Sm + nn * 72 + m0) = pk;
            }
        }
        __syncthreads();
        {
            bf16x8 sf[2], qf[4];
#pragma unroll
            for (int ks = 0; ks < 2; ++ks) sf[ks] = *(const LAS bf16x8*)(Sm + n * 72 + 32 * ks + 8 * fq);
#pragma unroll
            for (int ks = 0; ks < 4; ++ks) qf[ks] = *(const LAS bf16x8*)(Q + n * 136 + 32 * ks + 8 * fq);
            const float qd = __builtin_amdgcn_exp2f(lg * (float)(n + 1));
            f32x4 ov[4]; float ss = 0.f;
#pragma unroll
            for (int dd = 0; dd < 4; ++dd) { const int vt = 4 * chf + dd;
                f32x4 ai = (f32x4){0.f, 0.f, 0.f, 0.f}, ac = ai;
#pragma unroll
                for (int ks = 0; ks < 2; ++ks) { const bf16x8 vf = *(const LAS bf16x8*)(VT + tr_frag(16 * vt + fr, 4 * ks + fq)); ai = mfma16(vf, sf[ks], ai); }
#pragma unroll
                for (int ks = 0; ks < 4; ++ks) ac = mfma16(rf[dd][ks], qf[ks], ac);
                ov[dd] = ai + ac * qd;
                ss += (ov[dd][0] * ov[dd][0] + ov[dd][1] * ov[dd][1]) + (ov[dd][2] * ov[dd][2] + ov[dd][3] * ov[dd][3]);
            }
            ss += __shfl_xor(ss, 16); ss += __shfl_xor(ss, 32);
            if (fq == 0) red[chf * 64 + n] = ss;
            __syncthreads();
            const float rstd = 1.f / sqrtf((red[n] + red[64 + n]) * (1.f / 128.f) + EPS);
            const size_t tok = (size_t)(tok0 + n);
#pragma unroll
            for (int dd = 0; dd < 4; ++dd) { const int v0 = 16 * (4 * chf + dd) + 4 * fq;
                const f32x4 rw = *(const f32x4*)(F.ret_norm_w + h * 128 + v0);
                const float gv[4] = {bf_lo(gw2[dd].x), bf_hi(gw2[dd].x), bf_lo(gw2[dd].y), bf_hi(gw2[dd].y)};
                float r[4];
#pragma unroll
                for (int j = 0; j < 4; ++j) { const float sg = gv[j] * __builtin_amdgcn_rcpf(1.0f + __builtin_amdgcn_exp2f(-1.4426950408889634f * gv[j])); r[j] = ov[dd][j] * rstd * rw[j] * sg; }
                u32x2 pk; pk.x = cvt_pk_bf16(r[0], r[1]); pk.y = cvt_pk_bf16(r[2], r[3]);
                *(u32x2*)(F.CAT + tok * D + h * 128 + v0) = pk;
            }
        }
        __syncthreads();
    }
}

struct Args { const float* in[15]; float* out; unsigned char* ws; float lg2g[4]; int ph_lo, ph_hi, li, pad; };

__global__ void __launch_bounds__(NWAVES * 64, 2) fwd_kernel(Args args) {
    extern __shared__ __attribute__((aligned(16))) unsigned char lds[];
    Frame F;
    F.lds = (LAS unsigned char*)lds;
    F.MISC = (volatile LAS unsigned*)(F.lds + MISC_OFF);
    F.tid = threadIdx.x; F.lane = F.tid & 63; F.wave = __builtin_amdgcn_readfirstlane(F.tid >> 6);
    F.G = gridDim.x; { const int bx = blockIdx.x; F.vcu = (F.G % 8 == 0) ? (bx % 8) * (F.G / 8) + bx / 8 : bx; }
#define REFRESH() do { const __attribute__((address_space(4))) Args* A_ = (const __attribute__((address_space(4))) Args*)__builtin_amdgcn_kernarg_segment_ptr(); asm volatile("" : "+s"(A_)); \
    unsigned char* ws_ = A_->ws; F.ctl = (gu32*)(ws_ + WS_CTL); \
    F.x = A_->in[0]; F.norm_mix_w = A_->in[1]; F.w_in = A_->in[2]; F.ret_norm_w = A_->in[3]; F.w_pool = A_->in[4]; F.pool_scale = A_->in[5]; F.w_out = A_->in[6]; F.norm_ffn_w = A_->in[7]; \
    F.w_router = A_->in[8]; F.b_router = A_->in[9]; F.w_gu = A_->in[10]; F.b_gu = A_->in[11]; F.w_down = A_->in[12]; F.b_down = A_->in[13]; F.norm_final_w = A_->in[14]; F.out = A_->out; \
    F.Wr_hi = (bf16_t*)(ws_ + WS_WR); F.Wr_lo = F.Wr_hi + 32 * 1024; F.Wpool_t = (bf16_t*)(ws_ + WS_WPOOL); F.Win_t = (bf16_t*)(ws_ + WS_WIN); F.Wout_t = (bf16_t*)(ws_ + WS_WOUT); \
    F.XN = (bf16_t*)(ws_ + WS_XN); F.CAT = (bf16_t*)(ws_ + WS_CAT); F.U = (bf16_t*)(ws_ + WS_U); F.Z = (bf16_t*)(ws_ + WS_Z); F.Y = (bf16_t*)(ws_ + WS_Y); \
    F.Wgu8 = ws_ + WS_WGU; F.Wd8 = ws_ + WS_WD; F.ACT8 = ws_ + WS_ACT; F.H8 = ws_ + WS_XN; F.list = (le_t*)(ws_ + WS_LIST); F.ssq = (float*)(ws_ + WS_SSQ); F.PL = (float*)(ws_ + WS_PL); \
    F.lg2g0 = A_->lg2g[0]; F.lg2g1 = A_->lg2g[1]; F.lg2g2 = A_->lg2g[2]; F.lg2g3 = A_->lg2g[3]; \
    { int t_ = threadIdx.x; asm volatile("" : "+v"(t_)); F.tid = t_; F.lane = t_ & 63; } } while (0)
    REFRESH();
    for (int u = F.tid; u < (LDS_BYTES - LDSCTL_OFF) / 4; u += NWAVES * 64) ((LAS unsigned*)(F.lds + LDSCTL_OFF))[u] = 0u;
    __syncthreads();
    XcdBarrier bar; bar.bar = (unsigned*)(F.ctl + CW_BAR); bar.x = 0; bar.st = nullptr;
    if (N_LAUNCHES != PER_PHASE) bar = xcd_barrier_post((unsigned*)(F.ctl + CW_BAR), F.MISC + 8);
    int n_stamp = 0;
#define STAMP() do { if (DBG_SPIN_A >= 0) { if (F.tid == 0) { const unsigned long long _t = __builtin_amdgcn_s_memrealtime(); F.MISC[16 + 2 * n_stamp] = (unsigned)_t; F.MISC[17 + 2 * n_stamp] = (unsigned)(_t >> 32); } ++n_stamp; } } while (0)
    STAMP();
#define GRID_BAR() do { if (N_LAUNCHES != PER_PHASE) xcd_barrier(bar); STAMP(); } while (0)
    const int lo = DBG_ONLY9 ? (args.ph_lo < 9 ? 9 : args.ph_lo) : args.ph_lo, hi = args.ph_hi;
#define IN(k) (lo <= (k) && (k) < hi)
#define BOTH(k) (IN(k) && IN((k) + 1))
    const int gw = F.vcu * NWAVES + F.wave, NGW = F.G * NWAVES;

    if (IN(0)) { REFRESH(); p0_prologue(F); conv_pull(F, CONV_GU, 0); if (BOTH(0)) GRID_BAR(); }

    if (IN(1)) {
        REFRESH();
        pg8::DenseSched S; S.init(F.XN, F.Win_t, NTOK, DIN, F.G, (int)blockIdx.x);
        pg8::EpiBf16 E{F.Z, DIN};
        pg8::gemm_phase<pg8::EpiBf16, pg8::DenseSched, true>(F.lds, S, E);
        { const int mine = (S.nwg - (int)blockIdx.x + F.G - 1) / F.G, most = (S.nwg + F.G - 1) / F.G; if (mine < most) conv_pull(F, 5 * (most - mine), 1); }
        if (BOTH(1)) GRID_BAR();
    }

    if (IN(2)) {
        REFRESH();
        retA_phase(F);
        pool_phase(F);
        if (BOTH(2)) GRID_BAR();
    }

    if (IN(3) && DBG_STAGE != 4) {
        REFRESH();
        const int gt = F.vcu * 512 + F.tid, NGT = F.G * 512;
        for (int p = gt; p < 16 * 8192; p += NGT) {
            const int bh = p >> 13, i = p & 8191;
            const float cd = __builtin_amdgcn_exp2f(F.lg2(bh & 3) * 64.0f);
            unsigned* up = (unsigned*)(F.U + (size_t)bh * 64 * 16384) + i;
            float s0 = 0.f, s1 = 0.f;
#pragma unroll
            for (int cb = 0; cb < 64; cb += 32) {
                unsigned uw[32];
#pragma unroll
                for (int c = 0; c < 32; ++c) uw[c] = up[(size_t)(cb + c) * 8192];
#pragma unroll
                for (int c = 0; c < 32; ++c) { up[(size_t)(cb + c) * 8192] = cvt_pk_bf16(s0, s1); s0 = cd * s0 + bf_lo(uw[c]); s1 = cd * s1 + bf_hi(uw[c]); }
            }
        }
        if (BOTH(3)) GRID_BAR();
    }

    if (IN(4) && DBG_STAGE != 4) {
        REFRESH();
        retB_phase(F);
        if (BOTH(4)) GRID_BAR();
    }

    if (IN(5) && !DBG_STAGE) {
        REFRESH();
        pg8::DenseSched S; S.init(F.CAT, F.Wout_t, NTOK, D, F.G, (int)blockIdx.x);
        pg8::EpiX1 E{F.x, F.out, F.ssq, F.PL, F.H8, F.norm_ffn_w, F.Wr_hi, F.Wr_lo, S.nwg == F.G};
        pg8::gemm_phase<pg8::EpiX1, pg8::DenseSched, false>(F.lds, S, E);
        if (BOTH(5)) GRID_BAR();
    }

    if (IN(6) && !DBG_SKIP_Y) {
        REFRESH();
        if (gw == 0) { GAS u32x4* z = (GAS u32x4*)(F.H8 + (size_t)NTOK * D) + F.lane; z[0] = (u32x4){0u, 0u, 0u, 0u}; }
        LAS unsigned* lcnt = (LAS unsigned*)(F.lds);
        LAS unsigned* lbase = lcnt + 32;
        if (F.tid < 32) lcnt[F.tid] = 0u;
        __syncthreads();
        const int half = F.lane >> 5, e = F.lane & 31;
        const float be = F.b_router[e];
        constexpr int MAXJ = 4;
        const int nsl = ((NTOK / 256) * (D / 256) == F.G) ? 4 : 16;
        for (int base = 0; base < NTOK / 2; base += NGW * MAXJ) {
            int srank[MAXJ], slp[MAXJ], srow[MAXJ]; float sgate[MAXJ], srstd[MAXJ];
#pragma unroll
            for (int j = 0; j < MAXJ; ++j) {
                const int rp = base + gw + NGW * j; srank[j] = -1; slp[j] = 0; srow[j] = 0; sgate[j] = 0.f; srstd[j] = 0.f;
                if (rp < NTOK / 2) {
                    const int row = 2 * rp + half;
                    float lg = 0.f, ss = 0.f;
                    if (nsl == 4) {
#pragma unroll
                        for (int p = 0; p < 4; ++p) lg += F.PL[((size_t)p * NTOK + row) * 32 + e];
                        if ((F.lane & 15) < 4) ss = F.ssq[(size_t)(F.lane & 15) * NTOK + row];
                    } else {
#pragma unroll
                        for (int p = 0; p < 16; ++p) lg += F.PL[((size_t)p * NTOK + row) * 32 + e];
                        ss = F.ssq[(size_t)(F.lane & 15) * NTOK + row];
                    }
                    ss += __shfl_xor(ss, 1); ss += __shfl_xor(ss, 2); ss += __shfl_xor(ss, 4); ss += __shfl_xor(ss, 8);
                    const float rstd = 1.f / sqrtf(ss * (1.f / D) + EPS);
                    float cur = lg * rstd + be;
                    float tv[4]; int ti[4]; int myrank = -1;
#pragma unroll
                    for (int k = 0; k < 4; ++k) {
                        float bv = cur; int bi = e;
#pragma unroll
                        for (int off = 16; off >= 1; off >>= 1) { const float ov = __shfl_xor(bv, off); const int oi = __shfl_xor(bi, off); if (ov > bv || (ov == bv && oi < bi)) { bv = ov; bi = oi; } }
                        tv[k] = bv; ti[k] = bi;
                        if (e == bi) { cur = -3.0e38f; myrank = k; }
                    }
                    (void)ti;
                    const float e1 = __expf(tv[1] - tv[0]), e2 = __expf(tv[2] - tv[0]), e3 = __expf(tv[3] - tv[0]), inv = 1.0f / (1.0f + e1 + e2 + e3);
                    if (myrank >= 0) {
                        srank[j] = myrank; srow[j] = row; srstd[j] = rstd;
                        sgate[j] = (myrank == 0 ? 1.0f : myrank == 1 ? e1 : myrank == 2 ? e2 : e3) * inv;
                        slp[j] = (int)__hip_atomic_fetch_add(lcnt + e, 1u, __ATOMIC_RELAXED, __HIP_MEMORY_SCOPE_WORKGROUP);
                    }
                }
            }
            __syncthreads();
            if (F.tid < 32) { const unsigned n = lcnt[F.tid]; lbase[F.tid] = n ? atomicAdd((unsigned*)(F.ctl + CW_CNT + 64 * F.tid), n) : 0u; }
            __syncthreads();
#pragma unroll
            for (int j = 0; j < MAXJ; ++j)
                if (srank[j] >= 0) F.list[e * LISTCAP + (int)lbase[e] + slp[j]] = (le_t){srow[j] * 4 + srank[j], __float_as_int(sgate[j]), __float_as_int(srstd[j]), 0};
            __syncthreads();
            if (F.tid < 32) lcnt[F.tid] = 0u;
            __syncthreads();
        }
        if (BOTH(6)) GRID_BAR();
    }

    if ((IN(7) || IN(8)) && !DBG_SKIP_Y) {
        REFRESH();
        LAS int* tab = (LAS int*)(F.lds + TAB_OFF);
        if (F.tid < 32) tab[F.tid] = (int)__hip_atomic_load(F.ctl + CW_CNT + 64 * F.tid, RLX_AGENT);
        __syncthreads();
        if (F.tid == 0) { int s = 0; for (int e = 0; e < 32; ++e) { tab[32 + e] = s; s += (tab[e] + 255) >> 8; } tab[64] = s; }
        __syncthreads();
    }
    if (IN(7) && !DBG_SKIP_Y) {
        REFRESH();
        pg8::MoeSched<true> S; S.init((const bf16_t*)F.H8, (const bf16_t*)F.Wgu8, F.list, F.b_gu, (const LAS int*)(F.lds + TAB_OFF), F.G, (int)blockIdx.x);
        pg8::EpiGU E{F.ACT8};
        pg8::gemm_phase<pg8::EpiGU, pg8::MoeSched<true>, true, true>(F.lds, S, E);
        { const int mine = (S.nwg - (int)blockIdx.x + F.G - 1) / F.G, most = (S.nwg + F.G - 1) / F.G; if (mine < most) conv_pull(F, 3 * (most - mine), 1); }
        conv_pull(F, CONV_ITEMS, 1);
        if (BOTH(7)) GRID_BAR();
    }
    if (IN(8) && !DBG_SKIP_Y) {
        REFRESH();
        pg8::MoeSched<false> S; S.init((const bf16_t*)F.ACT8, (const bf16_t*)F.Wd8, F.list, F.b_down, (const LAS int*)(F.lds + TAB_OFF), F.G, (int)blockIdx.x);
        pg8::EpiDown E{(unsigned char*)F.Y};
        pg8::gemm_phase<pg8::EpiDown, pg8::MoeSched<false>, true, true>(F.lds, S, E);
        if (BOTH(8)) GRID_BAR();
    }
    if (IN(9) && DBG_STAGE) {
        REFRESH();
        for (int m = gw; m < NTOK; m += NGW) {
            const bf16_t* src = DBG_STAGE == 1 ? F.XN + (size_t)m * D : DBG_STAGE == 2 ? F.Z + (size_t)m * DIN + 1024 : DBG_STAGE == 3 ? F.CAT + (size_t)m * D : F.U + (size_t)m * D;
            for (int j = F.lane; j < D; j += 64) F.out[(size_t)m * D + j] = __uint_as_float(((unsigned)src[j]) << 16);
        }
    }
    if (IN(9) && !DBG_STAGE) {
        REFRESH();
        for (int m = gw; m < NTOK; m += NGW) {
            const GAS f32x4* xr = (const GAS f32x4*)((DBG_ONLY9 ? F.x : F.out) + (size_t)m * D) + F.lane; const GAS f32x4* wr = (const GAS f32x4*)F.norm_final_w + F.lane;
            f32x4 v[4]; float s = 0.f;
            if (DBG_ONLY9) {
#pragma unroll
            for (int j = 0; j < 4; ++j) v[j] = xr[64 * j];
            } else { const GAS u32x2* xb = (const GAS u32x2*)(F.out + (size_t)m * D) + F.lane;
#pragma unroll
            for (int j = 0; j < 4; ++j) { const u32x2 x = xb[64 * j]; v[j] = (f32x4){bf_lo(x.x), bf_hi(x.x), bf_lo(x.y), bf_hi(x.y)}; } }
#pragma unroll
            for (int k = 0; k < (DBG_SKIP_Y ? 0 : 4); ++k) { const GAS unsigned* yr = (const GAS unsigned*)((const unsigned char*)F.Y + ((size_t)m * 4 + k) * D) + F.lane;
#pragma unroll
                for (int j = 0; j < 4; ++j) { const unsigned y = __builtin_nontemporal_load(yr + 64 * j);
                    const f32x2 lo = __builtin_amdgcn_cvt_pk_f32_fp8((int)y, false), hi = __builtin_amdgcn_cvt_pk_f32_fp8((int)y, true); v[j] += (f32x4){lo[0], lo[1], hi[0], hi[1]} * 0.0625f; } }
#pragma unroll
            for (int j = 0; j < 4; ++j) s += (v[j].x * v[j].x + v[j].y * v[j].y) + (v[j].z * v[j].z + v[j].w * v[j].w);
            const float rstd = 1.f / sqrtf(wave_sum(s) * (1.f / D) + EPS);
            GAS f32x4* orow = (GAS f32x4*)(F.out + (size_t)m * D) + F.lane;
#pragma unroll
            for (int j = 0; j < 4; ++j) __builtin_nontemporal_store(v[j] * rstd * wr[64 * j], orow + 64 * j);
        }
    }
    if (DBG_SPIN_A >= 0) { STAMP();
        if (blockIdx.x == 0 && F.tid == 0) {
            const unsigned long long ta = ((unsigned long long)F.MISC[17 + 2 * DBG_SPIN_A] << 32) | F.MISC[16 + 2 * DBG_SPIN_A], tb = ((unsigned long long)F.MISC[17 + 2 * DBG_SPIN_B] << 32) | F.MISC[16 + 2 * DBG_SPIN_B];
            const unsigned long long t0 = __builtin_amdgcn_s_memrealtime(), want = (tb - ta) * DBG_SPIN_W;
            while (__builtin_amdgcn_s_memrealtime() - t0 < want) __builtin_amdgcn_s_sleep(8);
        } }
#undef IN
#undef BOTH
#undef GRID_BAR
#undef STAMP
#undef REFRESH
}

extern "C" void kernel_launch(void* const* d_in, const int* in_sizes, int n_in, void* d_out, int out_size, void* d_ws, size_t ws_size, hipStream_t stream) {
    static int grid = 0;
    if (grid == 0) {
        if (n_in != 15 || in_sizes[0] != NTOK * D || out_size != NTOK * D || ws_size < WS_END) { fprintf(stderr, "kernel_launch: unexpected shapes / workspace (n_in %d, ws %zu); nothing launched\n", n_in, ws_size); grid = -1; return; }
        int dev = 0, cus = 0, per_cu = 0;
        if (hipGetDevice(&dev) != hipSuccess || hipDeviceGetAttribute(&cus, hipDeviceAttributeMultiprocessorCount, dev) != hipSuccess) { grid = -1; return; }
        if (hipFuncSetAttribute((const void*)fwd_kernel, hipFuncAttributeMaxDynamicSharedMemorySize, LDS_BYTES) != hipSuccess) { fprintf(stderr, "kernel_launch: hipFuncSetAttribute failed\n"); grid = -1; return; }
        if (hipOccupancyMaxActiveBlocksPerMultiprocessor(&per_cu, (const void*)fwd_kernel, NWAVES * 64, LDS_BYTES) != hipSuccess || per_cu < 1)
            fprintf(stderr, "kernel_launch: note: occupancy query reports %d workgroups per CU\n", per_cu);
        (void)hipGetLastError();
        grid = cus;
    }
    if (grid < 0) return;
    if (hipMemsetAsync((char*)d_ws + WS_CTL, 0, CTL_ZERO_BYTES, stream) != hipSuccess) { fprintf(stderr, "kernel_launch: memset failed\n"); return; }
    Args a{};
    for (int i = 0; i < 15; ++i) a.in[i] = (const float*)d_in[i];
    a.out = (float*)d_out; a.ws = (unsigned char*)d_ws;
    for (int h = 0; h < 4; ++h) a.lg2g[h] = (float)(log1p(-exp2(-5.0 - (double)h)) / log(2.0));
    for (int li = 0; li < N_LAUNCHES; ++li) {
        a.ph_lo = (N_LAUNCHES == PER_PHASE) ? li : 0; a.ph_hi = (N_LAUNCHES == PER_PHASE) ? li + 1 : PER_PHASE; a.li = li; a.pad = 0;
        hipLaunchKernelGGL(fwd_kernel, dim3(grid), dim3(NWAVES * 64), LDS_BYTES, stream, a);
        const hipError_t le = hipPeekAtLastError();
        if (le != hipSuccess) { fprintf(stderr, "kernel_launch: launch %d failed: %s\n", li, hipGetErrorName(le)); break; }
    }
}
```

```cpp
#include <hip/hip_runtime.h>
#include <cstdio>
#include <cstdint>
#include <cmath>

#ifndef DBG_ONLY9
#define DBG_ONLY9 0
#define DBG_STAGE 0
#endif
#ifndef DBG_SPIN_A
#define DBG_SPIN_A -1
#define DBG_SPIN_B -1
#define DBG_SPIN_W 2
#endif
#ifndef DBG_SKIP_Y
#define DBG_SKIP_Y 0
#endif
#ifndef MK_N_LAUNCHES
#define MK_N_LAUNCHES 1
#endif
constexpr int PER_PHASE = 10;
constexpr int N_LAUNCHES = MK_N_LAUNCHES;

#define LAS __attribute__((address_space(3)))
#define GAS __attribute__((address_space(1)))
typedef unsigned short bf16_t;
typedef short bf16x8 __attribute__((ext_vector_type(8)));
typedef float f32x4 __attribute__((ext_vector_type(4)));
typedef float f32x2 __attribute__((ext_vector_type(2)));
typedef unsigned u32x4 __attribute__((ext_vector_type(4)));
typedef unsigned u32x2 __attribute__((ext_vector_type(2)));
typedef GAS unsigned gu32;
typedef int i32x2 __attribute__((ext_vector_type(2)));
typedef int le_t __attribute__((ext_vector_type(4)));

constexpr int NTOK = 16384, D = 1024, SEQ = 4096, DIN = 2560, NE = 32, FF = 1024, LISTCAP = 16384;
constexpr int NWAVES = 8;
constexpr float EPS = 1e-6f;

constexpr size_t MiB = 1u << 20;
constexpr size_t WS_CTL = 0, CTL_ZERO_BYTES = 32 * 1024;
constexpr size_t WS_LIST = 360 * MiB;
constexpr size_t WS_PL = 368 * MiB;
constexpr size_t WS_RS1 = 1 * MiB;
constexpr size_t WS_SSQ = 5 * MiB + 512 * 1024;
constexpr size_t WS_WR = 6 * MiB + 512 * 1024;
constexpr size_t WS_WPOOL = 6 * MiB + 768 * 1024;
constexpr size_t WS_WIN = 7 * MiB;
constexpr size_t WS_WOUT = 12 * MiB;
constexpr size_t WS_XN = 14 * MiB;
constexpr size_t WS_CAT = 47 * MiB;
constexpr size_t WS_U = 79 * MiB;
constexpr size_t WS_Z = 111 * MiB;
constexpr size_t WS_Y = 47 * MiB;
constexpr size_t WS_WGU = 192 * MiB;
constexpr size_t WS_WD = 256 * MiB;
constexpr size_t WS_ACT = 288 * MiB;
constexpr size_t WS_END = 400 * MiB;
static_assert(WS_Y + (size_t)65536 * 1024 * 2 <= WS_WGU && WS_Z + (size_t)16384 * 2560 * 2 <= WS_WGU, "Y overlay / Z");
constexpr int CW_TMO = 0, CW_CODE = 1;
constexpr int CW_Q = 512;
constexpr int CW_CNT = 1024;
constexpr int CW_BAR = 4096;
static_assert((CW_BAR + 3456) * 4 <= (int)CTL_ZERO_BYTES, "control words inside the memset");

constexpr int RING_BYTES = 131072;
constexpr int LDSCTL_OFF = RING_BYTES, MISC_OFF = LDSCTL_OFF + 320, TAB_OFF = LDSCTL_OFF + 512;
constexpr int MB_OFF = LDSCTL_OFF + 1024;
constexpr int LDS_BYTES = 147456;

#define RLX_AGENT __ATOMIC_RELAXED, __HIP_MEMORY_SCOPE_AGENT
#define LDS_WAIT() asm volatile("s_waitcnt lgkmcnt(0)" ::: "memory")
#define VM_WAIT() asm volatile("s_waitcnt vmcnt(0)" ::: "memory")
typedef __bf16 bf16x2_t __attribute__((ext_vector_type(2)));
__device__ __forceinline__ unsigned cvt_pk_bf16(float lo, float hi) { const f32x2 v = {lo, hi}; const bf16x2_t b = __builtin_convertvector(v, bf16x2_t); return __builtin_bit_cast(unsigned, b); }
__device__ __forceinline__ unsigned cvt4_fp8(float a, float b, float c, float d) { int r = __builtin_amdgcn_cvt_pk_fp8_f32(a, b, 0, false); r = __builtin_amdgcn_cvt_pk_fp8_f32(c, d, r, true); return (unsigned)r; }
typedef int i32x8 __attribute__((ext_vector_type(8)));
__device__ __forceinline__ float bf_lo(unsigned w) { return __uint_as_float(w << 16); }
__device__ __forceinline__ float bf_hi(unsigned w) { return __uint_as_float(w & 0xffff0000u); }
__device__ __forceinline__ float wave_sum(float v) {
#pragma unroll
    for (int o = 1; o < 64; o <<= 1) v += __shfl_xor(v, o);
    return v;
}
__device__ __forceinline__ f32x4 mfma16(bf16x8 a, bf16x8 b, f32x4 c) { return __builtin_amdgcn_mfma_f32_16x16x32_bf16(a, b, c, 0, 0, 0); }

namespace pg8 {
constexpr int BM = 256, BK = 64, HALF = 128, HTB = HALF * BK * 2, STAGE_BYTES = 8 * HTB, NXCD = 8, WGM = 8, KK = 1024;
__host__ __device__ __forceinline__ int lds_byte(int r, int c) { const int st = (r >> 4) * 2 + (c >> 5), rr = r & 15, cc = c & 31, ob = rr * 64 + cc * 2; return st * 1024 + (ob ^ (((ob >> 9) & 1) << 5)); }
__host__ __device__ __forceinline__ void stage_rc(int b, int& R, int& C) { const int st = b / 1024, sb = b % 1024, swz = sb ^ (((sb >> 9) & 1) << 5); R = (st >> 1) * 16 + swz / 64; C = (st & 1) * 32 + (swz % 64) / 2; }
__host__ __device__ __forceinline__ int perm32(int rho) { const int n = rho >> 4, i = rho & 15; return 8 * (i >> 2) + 4 * n + (i & 3); }

struct Unit { int pm, pn, e, rows, arow; };

__device__ __forceinline__ int xcd_remap(int L, int nwg) { const int q = nwg / NXCD, r = nwg % NXCD, xcd = L % NXCD, off = L / NXCD; return (xcd < r ? xcd * (q + 1) : r * (q + 1) + (xcd - r) * q) + off; }

struct DenseSched {
    const bf16_t* A; const bf16_t* Bt; int nM, nN, nwg, G, c;
    __device__ __forceinline__ void init(const bf16_t* A_, const bf16_t* Bt_, int M, int N, int G_, int c_) { A = A_; Bt = Bt_; nM = M / BM; nN = N / BM; nwg = nM * nN; G = G_; c = c_; }
    __device__ __forceinline__ bool next(int i, Unit& u) const {
        const int L = i * G + c; if (L >= nwg) return false;
        const int wgid = xcd_remap(L, nwg);
        const int nig = WGM * nN, gid = wgid / nig, fm = gid * WGM, gsz = (nM - fm) < WGM ? (nM - fm) : WGM;
        u.pm = fm + ((wgid % nig) % gsz); u.pn = (wgid % nig) / gsz; u.e = 0; u.rows = 256; u.arow = u.pm * 256; return true;
    }
    __device__ __forceinline__ const char* a_base(const Unit& u) const { return (const char*)A + (size_t)u.pm * (2 * HALF * KK * 2); }
    __device__ __forceinline__ const char* b_base(const Unit& u) const { return (const char*)Bt + (size_t)u.pn * (2 * HALF * KK * 2); }
    static constexpr bool MB = false;
    __device__ __forceinline__ void mb_issue(LAS unsigned char*, const Unit&, int, int) const {}
    __device__ __forceinline__ void a_offs(const Unit&, int tid, unsigned (&go)[2][2], const LAS le_t*) const {
#pragma unroll
        for (int i = 0; i < 2; ++i) { int R, C; stage_rc(tid * 16 + i * 8192, R, C);
#pragma unroll
            for (int h = 0; h < 2; ++h) go[h][i] = (unsigned)((h * HALF + R) * KK + C) * 2u; }
    }
};
constexpr int KU8 = 512;
template <bool GU> struct MoeSched {
    const bf16_t* A; const bf16_t* Bt; const le_t* list; const float* bias; const LAS int* tab; int nN, nwg, G, c;
    __device__ __forceinline__ void init(const bf16_t* A_, const bf16_t* Bt_, const le_t* list_, const float* bias_, const LAS int* tab_, int G_, int c_) { A = A_; Bt = Bt_; list = list_; bias = bias_; tab = tab_; nN = GU ? 8 : 4; nwg = __builtin_amdgcn_readfirstlane(tab_[32 + 32]) * nN; G = G_; c = c_; }
    __device__ __forceinline__ bool next(int i, Unit& u) const {
        const int L = i * G + c; if (L >= nwg) return false;
        const int wgid = xcd_remap(L, nwg);
        int ln = (int)(threadIdx.x & 31u); asm volatile("" : "+v"(ln));
        const unsigned long long bal = __ballot(tab[32 + ln] * nN <= wgid);
        const int e = 31 - __builtin_clz((unsigned)(bal & 0xffffffffull));
        const int tb0 = tab[32 + e], T = tab[32 + e + 1] - tb0, local = wgid - tb0 * nN;
        int rows = tab[e] - (local % T) * 256; if (rows > 256) rows = 256;
        u.e = __builtin_amdgcn_readfirstlane(e); u.pm = __builtin_amdgcn_readfirstlane(local % T); u.pn = __builtin_amdgcn_readfirstlane(local / T); u.rows = __builtin_amdgcn_readfirstlane(rows); u.arow = __builtin_amdgcn_readfirstlane((tb0 + local % T) * 256); return true;
    }
    __device__ __forceinline__ const char* a_base(const Unit& u) const { return GU ? (const char*)A : (const char*)A + (size_t)u.arow * (KU8 * 2); }
    __device__ __forceinline__ const char* b_base(const Unit& u) const { return (const char*)Bt + ((size_t)u.e * (GU ? 2048 : 1024) + (size_t)u.pn * 256) * (KU8 * 2); }
    static constexpr bool MB = true;
    __device__ __forceinline__ void mb_issue(LAS unsigned char* mb, const Unit& u, int wid, int lane) const {
        asm volatile("" : "+v"(lane));
        if (wid < 4) __builtin_amdgcn_global_load_lds((const unsigned*)(list + u.e * LISTCAP + u.pm * 256 + wid * 64 + lane), (LAS unsigned*)(mb + wid * 1024), 16, 0, 0);
        else if (wid == 4) {
            const float* bp = GU ? bias + (size_t)u.e * 2048 + u.pn * 128 + (lane >> 5) * 1024 + (lane & 31) * 4 : bias + (size_t)u.e * 1024 + u.pn * 256 + lane * 4;
            __builtin_amdgcn_global_load_lds((const unsigned*)bp, (LAS unsigned*)(mb + 4096), 16, 0, 0); }
    }
    __device__ __forceinline__ void a_offs(const Unit& u, int tid, unsigned (&go)[2][2], const LAS le_t* mb) const {
#pragma unroll
        for (int i = 0; i < 2; ++i) { int R, C; stage_rc(tid * 16 + i * 8192, R, C);
#pragma unroll
            for (int h = 0; h < 2; ++h) {
                if (GU) { const int r = h * HALF + R; const int raw = mb[r].x; const int tok = r < u.rows ? (raw >> 2) : NTOK; go[h][i] = (unsigned)(tok * KU8 + C) * 2u; }
                else go[h][i] = (unsigned)((h * HALF + R) * KU8 + C) * 2u;
            } }
    }
};

struct EpiBf16 {
    static constexpr bool PERM = true, HAS_INIT = false, AFTER_DRAIN = false;
    bf16_t* O; int ldc; const float* rs;
    __device__ __forceinline__ void operator()(const f32x4 (&acc)[2][2][4][2], const Unit& u, int wr, int wc, int fr, int fq, const LAS le_t*) const {
        const int row0 = u.pm * BM + wr * 64 + fr, col0 = u.pn * BM + wc * 32 + 8 * fq;
#pragma unroll
        for (int ai = 0; ai < 2; ++ai)
#pragma unroll
            for (int m = 0; m < 4; ++m) { bf16_t* rowp = O + (size_t)(row0 + ai * HALF + m * 16) * ldc + col0; const float sc = rs[row0 + ai * HALF + m * 16];
#pragma unroll
                for (int bj = 0; bj < 2; ++bj) { const f32x4 v0 = acc[ai][bj][m][0] * sc, v1 = acc[ai][bj][m][1] * sc;
                    u32x4 w; w.x = cvt_pk_bf16(v0[0], v0[1]); w.y = cvt_pk_bf16(v0[2], v0[3]); w.z = cvt_pk_bf16(v1[0], v1[1]); w.w = cvt_pk_bf16(v1[2], v1[3]);
                    *(u32x4*)(rowp + bj * HALF) = w; } }
    }
};
struct EpiX1 {
    static constexpr bool PERM = true, HAS_INIT = true, AFTER_DRAIN = true;
    const bf16_t* base; float* C; float* ssq; float* PL; unsigned char* H8; const float* nw; const bf16_t* wrh; const bf16_t* wrl;
    bool one;
    __device__ __forceinline__ void init_acc(f32x4 (&acc)[2][2][4][2], const Unit& u, int wr, int wc, int fr, int fq) const {
        const int row0 = u.pm * BM + wr * 64 + fr, col0 = u.pn * BM + wc * 32 + 8 * fq;
#pragma unroll
        for (int ai = 0; ai < 2; ++ai)
#pragma unroll
            for (int m = 0; m < 4; ++m) { const size_t off = (size_t)(row0 + ai * HALF + m * 16) * D + col0;
#pragma unroll
                for (int bj = 0; bj < 2; ++bj) { const u32x4 xb = *(const u32x4*)(base + off + bj * HALF);
                    acc[ai][bj][m][0] = (f32x4){bf_lo(xb.x), bf_hi(xb.x), bf_lo(xb.y), bf_hi(xb.y)}; acc[ai][bj][m][1] = (f32x4){bf_lo(xb.z), bf_hi(xb.z), bf_lo(xb.w), bf_hi(xb.w)}; } }
    }
    __device__ __forceinline__ void operator()(const f32x4 (&acc)[2][2][4][2], const Unit& u, int wr, int wc, int fr, int fq, const LAS le_t*) const {
        const int row0 = u.pm * BM + wr * 64 + fr, col0 = u.pn * BM + wc * 32 + 8 * fq, p = u.pn * 4 + wc;
        f32x4 wv[2][2]; bf16x8 fh[2][2], fl[2][2];
#pragma unroll
        for (int bj = 0; bj < 2; ++bj) { wv[bj][0] = *(const f32x4*)(nw + col0 + bj * HALF); wv[bj][1] = *(const f32x4*)(nw + col0 + bj * HALF + 4);
#pragma unroll
            for (int et = 0; et < 2; ++et) { fh[bj][et] = *(const bf16x8*)(wrh + (16 * et + fr) * 1024 + col0 + bj * HALF); fl[bj][et] = *(const bf16x8*)(wrl + (16 * et + fr) * 1024 + col0 + bj * HALF); } }
        float* sp = ssq + (size_t)p * NTOK; float* plp = PL + (size_t)p * NTOK * 32 + 4 * fq;
#pragma unroll
        for (int ai = 0; ai < 2; ++ai)
#pragma unroll
            for (int m = 0; m < 4; ++m) { const int row = row0 + ai * HALF + m * 16; const size_t off = (size_t)row * D + col0; float s2 = 0.f;
                f32x4 pl0 = (f32x4){0.f, 0.f, 0.f, 0.f}, pl1 = pl0;
#pragma unroll
                for (int bj = 0; bj < 2; ++bj) { const f32x4 v0 = acc[ai][bj][m][0], v1 = acc[ai][bj][m][1];
                    { u32x4 xb; xb.x = cvt_pk_bf16(v0[0], v0[1]); xb.y = cvt_pk_bf16(v0[2], v0[3]); xb.z = cvt_pk_bf16(v1[0], v1[1]); xb.w = cvt_pk_bf16(v1[2], v1[3]);
                      *(u32x4*)((bf16_t*)(C + (size_t)row * D) + col0 + bj * HALF) = xb; }
                    s2 += (v0[0] * v0[0] + v0[1] * v0[1]) + (v0[2] * v0[2] + v0[3] * v0[3]) + (v1[0] * v1[0] + v1[1] * v1[1]) + (v1[2] * v1[2] + v1[3] * v1[3]);
                    const f32x4 h0 = v0 * wv[bj][0], h1 = v1 * wv[bj][1];
                    u32x4 hh, hl;
                    hh.x = cvt_pk_bf16(h0[0], h0[1]); hh.y = cvt_pk_bf16(h0[2], h0[3]); hh.z = cvt_pk_bf16(h1[0], h1[1]); hh.w = cvt_pk_bf16(h1[2], h1[3]);
                    hl.x = cvt_pk_bf16(h0[0] - bf_lo(hh.x), h0[1] - bf_hi(hh.x)); hl.y = cvt_pk_bf16(h0[2] - bf_lo(hh.y), h0[3] - bf_hi(hh.y));
                    hl.z = cvt_pk_bf16(h1[0] - bf_lo(hh.z), h1[1] - bf_hi(hh.z)); hl.w = cvt_pk_bf16(h1[2] - bf_lo(hh.w), h1[3] - bf_hi(hh.w));
                    u32x2 h8; h8.x = cvt4_fp8(h0[0], h0[1], h0[2], h0[3]); h8.y = cvt4_fp8(h1[0], h1[1], h1[2], h1[3]);
                    *(u32x2*)(H8 + off + bj * HALF) = h8;
                    const bf16x8 bhh = __builtin_bit_cast(bf16x8, hh), bhl = __builtin_bit_cast(bf16x8, hl);
                    pl0 = mfma16(fh[bj][0], bhh, pl0); pl0 = mfma16(fh[bj][0], bhl, pl0); pl0 = mfma16(fl[bj][0], bhh, pl0);
                    pl1 = mfma16(fh[bj][1], bhh, pl1); pl1 = mfma16(fh[bj][1], bhl, pl1); pl1 = mfma16(fl[bj][1], bhh, pl1); }
                s2 += __shfl_xor(s2, 16); s2 += __shfl_xor(s2, 32);
                if (fq == 0) sp[row] = s2;
                *(f32x4*)(plp + (size_t)row * 32) = pl0; *(f32x4*)(plp + (size_t)row * 32 + 16) = pl1; }
    }
    __device__ __forceinline__ void fused(const f32x4 (&acc)[2][2][4][2], const Unit& u, int wr, int wc, int fr, int fq, LAS unsigned char* lds, int tid) const {
        const int row0 = u.pm * BM + wr * 64 + fr, col0 = u.pn * BM + wc * 32 + 8 * fq;
        f32x4 wv[2][2]; bf16x8 fh[2][2], fl[2][2];
#pragma unroll
        for (int bj = 0; bj < 2; ++bj) { wv[bj][0] = *(const f32x4*)(nw + col0 + bj * HALF); wv[bj][1] = *(const f32x4*)(nw + col0 + bj * HALF + 4);
#pragma unroll
            for (int et = 0; et < 2; ++et) { fh[bj][et] = *(const bf16x8*)(wrh + (16 * et + fr) * 1024 + col0 + bj * HALF); fl[bj][et] = *(const bf16x8*)(wrl + (16 * et + fr) * 1024 + col0 + bj * HALF); } }
        LAS float* PLs = (LAS float*)lds + wc * (256 * 32); LAS float* SSs = (LAS float*)(lds + MB_OFF) + wc * 256;
#pragma unroll
        for (int ai = 0; ai < 2; ++ai)
#pragma unroll
            for (int m = 0; m < 4; ++m) { const int rl = ai * HALF + wr * 64 + m * 16 + fr, row = u.pm * BM + rl; const size_t off = (size_t)row * D + col0; float s2 = 0.f;
                f32x4 pl0 = (f32x4){0.f, 0.f, 0.f, 0.f}, pl1 = pl0;
#pragma unroll
                for (int bj = 0; bj < 2; ++bj) { const f32x4 v0 = acc[ai][bj][m][0], v1 = acc[ai][bj][m][1];
                    { u32x4 xb; xb.x = cvt_pk_bf16(v0[0], v0[1]); xb.y = cvt_pk_bf16(v0[2], v0[3]); xb.z = cvt_pk_bf16(v1[0], v1[1]); xb.w = cvt_pk_bf16(v1[2], v1[3]);
                      *(u32x4*)((bf16_t*)(C + (size_t)row * D) + col0 + bj * HALF) = xb; }
                    s2 += (v0[0] * v0[0] + v0[1] * v0[1]) + (v0[2] * v0[2] + v0[3] * v0[3]) + (v1[0] * v1[0] + v1[1] * v1[1]) + (v1[2] * v1[2] + v1[3] * v1[3]);
                    const f32x4 h0 = v0 * wv[bj][0], h1 = v1 * wv[bj][1];
                    u32x4 hh, hl;
                    hh.x = cvt_pk_bf16(h0[0], h0[1]); hh.y = cvt_pk_bf16(h0[2], h0[3]); hh.z = cvt_pk_bf16(h1[0], h1[1]); hh.w = cvt_pk_bf16(h1[2], h1[3]);
                    hl.x = cvt_pk_bf16(h0[0] - bf_lo(hh.x), h0[1] - bf_hi(hh.x)); hl.y = cvt_pk_bf16(h0[2] - bf_lo(hh.y), h0[3] - bf_hi(hh.y));
                    hl.z = cvt_pk_bf16(h1[0] - bf_lo(hh.z), h1[1] - bf_hi(hh.z)); hl.w = cvt_pk_bf16(h1[2] - bf_lo(hh.w), h1[3] - bf_hi(hh.w));
                    u32x2 h8; h8.x = cvt4_fp8(h0[0], h0[1], h0[2], h0[3]); h8.y = cvt4_fp8(h1[0], h1[1], h1[2], h1[3]);
                    *(u32x2*)(H8 + off + bj * HALF) = h8;
                    const bf16x8 bhh = __builtin_bit_cast(bf16x8, hh), bhl = __builtin_bit_cast(bf16x8, hl);
                    pl0 = mfma16(fh[bj][0], bhh, pl0); pl0 = mfma16(fh[bj][0], bhl, pl0); pl0 = mfma16(fl[bj][0], bhh, pl0);
                    pl1 = mfma16(fh[bj][1], bhh, pl1); pl1 = mfma16(fh[bj][1], bhl, pl1); pl1 = mfma16(fl[bj][1], bhh, pl1); }
                s2 += __shfl_xor(s2, 16); s2 += __shfl_xor(s2, 32);
                if (fq == 0) SSs[rl] = s2;
                *(LAS f32x4*)(PLs + rl * 32 + 4 * (fq ^ (rl & 7))) = pl0; *(LAS f32x4*)(PLs + rl * 32 + 4 * ((4 + fq) ^ (rl & 7))) = pl1; }
        asm volatile("s_waitcnt lgkmcnt(0)" ::: "memory"); __builtin_amdgcn_s_barrier(); asm volatile("" ::: "memory");
        {
            const int rl = tid >> 1, hf = tid & 1, row = u.pm * BM + rl;
            f32x4 sum[4];
#pragma unroll
            for (int q = 0; q < 4; ++q) { sum[q] = (f32x4){0.f, 0.f, 0.f, 0.f};
#pragma unroll
                for (int c4 = 0; c4 < 4; ++c4) sum[q] += *(const LAS f32x4*)((const LAS float*)lds + c4 * (256 * 32) + rl * 32 + 4 * ((4 * hf + q) ^ (rl & 7))); }
            float* dst = PL + ((size_t)u.pn * NTOK + row) * 32 + 16 * hf;
#pragma unroll
            for (int q = 0; q < 4; ++q) *(f32x4*)(dst + 4 * q) = sum[q];
            if (hf == 0) { const LAS float* S0 = (const LAS float*)(lds + MB_OFF); ssq[(size_t)u.pn * NTOK + row] = ((S0[rl] + S0[256 + rl]) + S0[512 + rl]) + S0[768 + rl]; }
        }
    }
};
constexpr float WSCL = 1.0f / 32.0f;
__device__ __forceinline__ float swiglu(float g, float l) {
    g = fminf(g, 7.0f); l = fminf(fmaxf(l, -7.0f), 7.0f);
    const float s = __builtin_amdgcn_rcpf(1.0f + __builtin_amdgcn_exp2f(-1.702f * 1.4426950408889634f * g));
    return g * s * (l + 1.0f);
}
struct EpiGU {
    static constexpr bool PERM = true, HAS_INIT = false, AFTER_DRAIN = false;
    unsigned char* ACT;
    __device__ __forceinline__ void operator()(const f32x4 (&acc)[2][2][4][2], const Unit& u, int wr, int wc, int fr, int fq, const LAS le_t* mb) const {
        const int row0 = u.arow + wr * 64 + fr, cl = wc * 32 + 8 * fq, colg = u.pn * 128 + cl;
        const LAS float* bl = (const LAS float*)mb + 1024 + cl;
        const f32x4 bg0 = *(const LAS f32x4*)(bl), bg1 = *(const LAS f32x4*)(bl + 4), bl0 = *(const LAS f32x4*)(bl + 128), bl1 = *(const LAS f32x4*)(bl + 128 + 4);
        int rb = wr * 64 + fr; asm volatile("" : "+v"(rb));
#pragma unroll
        for (int ai = 0; ai < 2; ++ai)
#pragma unroll
            for (int m = 0; m < 4; ++m) {
                const float rs = __int_as_float(mb[ai * HALF + m * 16 + rb].z) * WSCL;
                const f32x4 g0 = acc[ai][0][m][0] * rs + bg0, g1 = acc[ai][0][m][1] * rs + bg1, l0 = acc[ai][1][m][0] * rs + bl0, l1 = acc[ai][1][m][1] * rs + bl1;
                u32x2 w; w.x = cvt4_fp8(swiglu(g0[0], l0[0]), swiglu(g0[1], l0[1]), swiglu(g0[2], l0[2]), swiglu(g0[3], l0[3]));
                w.y = cvt4_fp8(swiglu(g1[0], l1[0]), swiglu(g1[1], l1[1]), swiglu(g1[2], l1[2]), swiglu(g1[3], l1[3]));
                *(u32x2*)(ACT + (size_t)(row0 + ai * HALF + m * 16) * FF + colg) = w; }
    }
};
struct EpiDown {
    static constexpr bool PERM = true, HAS_INIT = false, AFTER_DRAIN = false;
    unsigned char* Y;
    __device__ __forceinline__ void operator()(const f32x4 (&acc)[2][2][4][2], const Unit& u, int wr, int wc, int fr, int fq, const LAS le_t* mb) const {
        const int cl = wc * 32 + 8 * fq, col0 = u.pn * BM + cl;
        const LAS float* bl = (const LAS float*)mb + 1024 + cl;
        int rb = wr * 64 + fr; asm volatile("" : "+v"(rb));
#pragma unroll
        for (int bj = 0; bj < 2; ++bj) {
            const f32x4 b0 = *(const LAS f32x4*)(bl + bj * HALF), b1 = *(const LAS f32x4*)(bl + bj * HALF + 4);
#pragma unroll
            for (int ai = 0; ai < 2; ++ai)
#pragma unroll
                for (int m = 0; m < 4; ++m) { const int r = ai * HALF + m * 16 + rb;
                    if (r < u.rows) { const le_t sg = mb[r]; const int slot = sg.x; const float gt = __int_as_float(sg.y) * 16.0f;
                        const f32x4 v0 = (acc[ai][bj][m][0] * WSCL + b0) * gt, v1 = (acc[ai][bj][m][1] * WSCL + b1) * gt;
                        u32x2 w; w.x = cvt4_fp8(v0[0], v0[1], v0[2], v0[3]); w.y = cvt4_fp8(v1[0], v1[1], v1[2], v1[3]);
                        *(u32x2*)(Y + (size_t)slot * D + col0 + bj * HALF) = w; } }
        }
    }
};

typedef int i32x4 __attribute__((ext_vector_type(4)));
__device__ __forceinline__ bf16x8 lo8(i32x8 a) { return __builtin_bit_cast(bf16x8, __builtin_shufflevector(a, a, 0, 1, 2, 3)); }
__device__ __forceinline__ bf16x8 hi8(i32x8 a) { return __builtin_bit_cast(bf16x8, __builtin_shufflevector(a, a, 4, 5, 6, 7)); }
__device__ __forceinline__ void glds_s(unsigned voff, const char* sbase, unsigned lds_dst) { unsigned keep;
    asm volatile("s_mov_b32 %0, m0\n\ts_mov_b32 m0, %2\n\ts_nop 0\n\tglobal_load_lds_dwordx4 %1, %3\n\ts_mov_b32 m0, %0" : "=&s"(keep) : "v"(voff), "s"(lds_dst), "s"(sbase) : "memory"); }
template <class Epi, class Sched, bool ALIGN_EPI, bool FP8 = false>
__device__ __forceinline__ void gemm_phase(LAS unsigned char* lds, const Sched& S, const Epi& E) {
    const int tid = threadIdx.x, wid = __builtin_amdgcn_readfirstlane(tid >> 6), lane = tid & 63, wr = wid >> 2, wc = wid & 3, fr = lane & 15, fq = lane >> 4;
    constexpr int K = FP8 ? 512 : KK;
    int nt = K / BK; asm volatile("" : "+s"(nt));
    unsigned voffB[2];
#pragma unroll
    for (int i = 0; i < 2; ++i) { int R, C; stage_rc(tid * 16 + i * 8192, R, C); const int Rb = Epi::PERM ? ((R & ~31) + perm32(R & 31)) : R;
        voffB[i] = (unsigned)(Rb * K + C) * 2u; }
    constexpr size_t kstep = (size_t)(BK * 2);
    constexpr size_t hstep = (size_t)HALF * K * 2;
    const unsigned ldsw = (unsigned)wid * 1024u;
    const unsigned ldsb = (unsigned)__builtin_amdgcn_readfirstlane((int)((unsigned)(size_t)lds + ldsw));
    const int aoff = lds_byte(wr * 64 + fr, fq * 8), boff = lds_byte(wc * 32 + fr, fq * 8);
#define PG8_SA(b, h) (((b) * 2 + (h)) * HTB)
#define PG8_SB(b, h) ((4 + (b) * 2 + (h)) * HTB)
#define PG8_STAGE(bufoff, gbase, voff) do { _Pragma("unroll") for (int _i = 0; _i < 2; ++_i) glds_s((voff)[_i], (const char*)(gbase), ldsb + (unsigned)((bufoff) + _i * 8192)); } while (0)
#define PG8_LDA(dst, b, h) do { _Pragma("unroll") for (int m = 0; m < 4; ++m) { const u32x4 _x = *(const LAS u32x4*)(lds + PG8_SA(b, h) + aoff + m * 2048), _y = *(const LAS u32x4*)(lds + PG8_SA(b, h) + aoff + m * 2048 + 1024); \
        dst[m] = (i32x8){(int)_x[0], (int)_x[1], (int)_x[2], (int)_x[3], (int)_y[0], (int)_y[1], (int)_y[2], (int)_y[3]}; } } while (0)
#define PG8_LDB(dst, b, h) do { _Pragma("unroll") for (int n = 0; n < 2; ++n) { const u32x4 _x = *(const LAS u32x4*)(lds + PG8_SB(b, h) + boff + n * 2048), _y = *(const LAS u32x4*)(lds + PG8_SB(b, h) + boff + n * 2048 + 1024); \
        dst[n] = (i32x8){(int)_x[0], (int)_x[1], (int)_x[2], (int)_x[3], (int)_y[0], (int)_y[1], (int)_y[2], (int)_y[3]}; } } while (0)
#define PG8_MMA(ai, bj, At, Bt) do { __builtin_amdgcn_s_setprio(1); _Pragma("unroll") for (int m = 0; m < 4; ++m) _Pragma("unroll") for (int n = 0; n < 2; ++n) { \
        if constexpr (FP8) { acc[ai][bj][m][n] = __builtin_amdgcn_mfma_scale_f32_16x16x128_f8f6f4(Bt[n], At[m], acc[ai][bj][m][n], 0, 0, 0, 0, 0, 0); } \
        else { acc[ai][bj][m][n] = __builtin_amdgcn_mfma_f32_16x16x32_bf16(lo8(Bt[n]), lo8(At[m]), acc[ai][bj][m][n], 0, 0, 0); acc[ai][bj][m][n] = __builtin_amdgcn_mfma_f32_16x16x32_bf16(hi8(Bt[n]), hi8(At[m]), acc[ai][bj][m][n], 0, 0, 0); } } __builtin_amdgcn_s_setprio(0); } while (0)
#define PG8_WAIT_V(n) asm volatile("s_waitcnt vmcnt(" #n ")" ::: "memory")
#define PG8_WAIT_L(n) asm volatile("s_waitcnt lgkmcnt(" #n ")" ::: "memory")
#define PG8_BAR __builtin_amdgcn_s_barrier()
#define PG8_SCHED __builtin_amdgcn_sched_barrier(0)
    Unit cur, nxt; int ui = 0;
    if (!S.next(0, cur)) return;
    f32x4 acc[2][2][4][2];
    if constexpr (Epi::HAS_INIT) E.init_acc(acc, cur, wr, wc, fr, fq);
    else {
#pragma unroll
    for (int a = 0; a < 2; ++a)
#pragma unroll
        for (int b = 0; b < 2; ++b)
#pragma unroll
            for (int m = 0; m < 4; ++m)
#pragma unroll
                for (int n = 0; n < 2; ++n) acc[a][b][m][n] = (f32x4){0.f, 0.f, 0.f, 0.f};
    }
    i32x8 At[4], B0[2], B1[2];
    const char* cA = S.a_base(cur); const char* cB = S.b_base(cur);
    unsigned go[2][2];
    LAS unsigned char* const mbx = lds + (MB_OFF - 0);
    if constexpr (Sched::MB) { S.mb_issue(mbx, cur, wid, lane); asm volatile("s_waitcnt vmcnt(0)" ::: "memory"); __builtin_amdgcn_s_barrier(); asm volatile("" ::: "memory"); }
    { int t2 = tid; asm volatile("" : "+v"(t2)); S.a_offs(cur, t2, go, (const LAS le_t*)mbx); }
    PG8_STAGE(PG8_SB(0, 0), cB, voffB); PG8_STAGE(PG8_SB(0, 1), cB + hstep, voffB); PG8_STAGE(PG8_SA(0, 0), cA, go[0]); PG8_STAGE(PG8_SA(0, 1), cA, go[1]);
    if (wr == 1) PG8_BAR;
    PG8_WAIT_V(2); PG8_BAR;
    PG8_STAGE(PG8_SB(1, 0), cB + kstep, voffB); PG8_STAGE(PG8_SA(1, 0), cA + kstep, go[0]); PG8_STAGE(PG8_SB(1, 1), cB + hstep + kstep, voffB);
    PG8_WAIT_V(6); PG8_BAR;
    asm volatile("" : "+v"(voffB[0]), "+v"(voffB[1]), "+v"(go[0][0]), "+v"(go[0][1]), "+v"(go[1][0]), "+v"(go[1][1]));
    for (;;) {
        const bool has_next = S.next(ui + 1, nxt);
        const char* nA = has_next ? S.a_base(nxt) : cA; const char* nB = has_next ? S.b_base(nxt) : cB;
#pragma clang loop unroll(disable)
        for (int t = 0; t < nt; t += 2) {
            const bool last = (t == nt - 2);
            asm volatile("" : "+v"(voffB[0]), "+v"(voffB[1]));
            const char* a1 = cA + (size_t)(t + 1) * kstep;
            const char* a2 = last ? nA : cA + (size_t)(t + 2) * kstep; const char* b2 = last ? nB : cB + (size_t)(t + 2) * kstep;
            const char* a3 = a2 + kstep; const char* b3 = b2 + kstep;
            PG8_LDB(B0, 0, 0); PG8_LDB(B1, 0, 1); PG8_SCHED; PG8_LDA(At, 0, 0); PG8_STAGE(PG8_SA(1, 1), a1, go[1]);
            if (last && has_next) { int t2 = tid; asm volatile("" : "+v"(t2)); S.a_offs(nxt, t2, go, (const LAS le_t*)(mbx + ((ui + 1) & 1) * 5120)); }
            PG8_WAIT_V(8); PG8_WAIT_L(0); PG8_BAR; PG8_MMA(0, 0, At, B0); PG8_MMA(0, 1, At, B1); PG8_BAR; PG8_SCHED;
            if constexpr (Sched::MB) { if (t == 0 && has_next) S.mb_issue(mbx + ((ui + 1) & 1) * 5120, nxt, wid, lane); }
            PG8_LDA(At, 0, 1); PG8_STAGE(PG8_SB(0, 0), b2, voffB); PG8_STAGE(PG8_SB(0, 1), b2 + hstep, voffB); PG8_STAGE(PG8_SA(0, 0), a2, go[0]);
            PG8_WAIT_V(8); PG8_WAIT_L(0); PG8_BAR; PG8_MMA(1, 0, At, B0); PG8_MMA(1, 1, At, B1); PG8_BAR; PG8_SCHED;
            PG8_LDB(B0, 1, 0); PG8_LDB(B1, 1, 1); PG8_SCHED; PG8_LDA(At, 1, 0); PG8_STAGE(PG8_SA(0, 1), a2, go[1]);
            PG8_WAIT_V(8); PG8_WAIT_L(0); PG8_BAR; PG8_MMA(0, 0, At, B0); PG8_MMA(0, 1, At, B1); PG8_BAR; PG8_SCHED;
            PG8_LDA(At, 1, 1); PG8_STAGE(PG8_SB(1, 0), b3, voffB); PG8_STAGE(PG8_SB(1, 1), b3 + hstep, voffB); PG8_STAGE(PG8_SA(1, 0), a3, go[0]);
            PG8_WAIT_V(8); PG8_WAIT_L(0); PG8_BAR; PG8_MMA(1, 0, At, B0); PG8_MMA(1, 1, At, B1); PG8_BAR; PG8_SCHED;
        }
        if constexpr (ALIGN_EPI) { if (wr == 0) PG8_BAR; }
        bool epi_now = true; if constexpr (Epi::AFTER_DRAIN) epi_now = !E.one;
        if (epi_now) { int t2 = tid; asm volatile("" : "+v"(t2)); const int l2 = t2 & 63; E(acc, cur, wr, wc, l2 & 15, l2 >> 4, (const LAS le_t*)(mbx + (ui & 1) * 5120)); }
        if (!has_next) break;
        if constexpr (Epi::HAS_INIT) { int t2 = tid; asm volatile("" : "+v"(t2)); const int l2 = t2 & 63; E.init_acc(acc, nxt, wr, wc, l2 & 15, l2 >> 4); }
        else {
#pragma unroll
        for (int a = 0; a < 2; ++a)
#pragma unroll
            for (int b = 0; b < 2; ++b)
#pragma unroll
                for (int m = 0; m < 4; ++m)
#pragma unroll
                    for (int n = 0; n < 2; ++n) acc[a][b][m][n] = (f32x4){0.f, 0.f, 0.f, 0.f};
        }
        cur = nxt; cA = nA; cB = nB; ++ui;
        if constexpr (ALIGN_EPI) { if (wr == 1) PG8_BAR; }
    }
    PG8_WAIT_V(0);
    if constexpr (!ALIGN_EPI) { if (wr == 0) PG8_BAR; }
    PG8_BAR;
    if constexpr (Epi::AFTER_DRAIN) { if (E.one) { int t2 = tid; asm volatile("" : "+v"(t2)); const int l2 = t2 & 63; E.fused(acc, cur, wr, wc, l2 & 15, l2 >> 4, lds, t2); } }
#undef PG8_SA
#undef PG8_SB
#undef PG8_STAGE
#undef PG8_LDA
#undef PG8_LDB
#undef PG8_MMA
#undef PG8_WAIT_V
#undef PG8_WAIT_L
#undef PG8_BAR
#undef PG8_SCHED
}
}

#define XB_TMO      128
#define XB_XCNT(j)  (256  + 64 * (j))
#define XB_XSUB(j)  (1280 + 64 * (j))
#define XB_XGEN(j)  (2304 + 64 * (j))
#define XB_TOP      3328
#define XB_TOPGEN   3392
#define XCD_BAR_WORDS 3456
#define XB_SPIN_CAP (1u << 18)
__device__ __forceinline__ unsigned xb_ld(unsigned* p)              { return __hip_atomic_load(p, __ATOMIC_RELAXED, __HIP_MEMORY_SCOPE_AGENT); }
__device__ __forceinline__ unsigned xb_add(unsigned* p, unsigned v) { return __hip_atomic_fetch_add(p, v, __ATOMIC_RELAXED, __HIP_MEMORY_SCOPE_AGENT); }
__device__ __forceinline__ unsigned xb_xcc_id() { return (unsigned)__builtin_amdgcn_s_getreg((3 << 11) | 20) & 0xFu; }
#define XB_SPIN(cond, bar) do { unsigned _sp = 0; while (cond) { __builtin_amdgcn_s_sleep(1); \
    if ((++_sp & 255u) == 0u) { if (xb_ld(&(bar)[XB_TMO])) break; if (_sp > XB_SPIN_CAP) { atomicAdd(&(bar)[XB_TMO], 1u); break; } } } } while (0)
struct XcdBarrier { unsigned* bar; unsigned x; volatile LAS unsigned* st; };
__device__ __forceinline__ XcdBarrier xcd_barrier_post(unsigned* bar, volatile LAS unsigned* st) {
    XcdBarrier b; b.bar = bar; b.x = xb_xcc_id(); b.st = st;
    if (threadIdx.x == 0) (void)xb_add(&bar[XB_XCNT(b.x)], 1u);
    return b;
}
__device__ __forceinline__ void xcd_barrier_complete(unsigned* bar, unsigned x, unsigned& nloc, unsigned& nx) {
    const unsigned G = gridDim.x * gridDim.y * gridDim.z;
    unsigned sum, cnt, mine, sp = 0u;
    for (;;) {
        sum = 0u; cnt = 0u; mine = 0u;
#pragma unroll
        for (unsigned j = 0; j < 16; ++j) { const unsigned c = xb_ld(&bar[XB_XCNT(j)]); sum += c; cnt += (c > 0u) ? 1u : 0u; mine = (j == x) ? c : mine; }
        if (sum == G) break;
        __builtin_amdgcn_s_sleep(1);
        if ((++sp & 255u) == 0u) { if (xb_ld(&bar[XB_TMO])) break; if (sp > XB_SPIN_CAP) { atomicAdd(&bar[XB_TMO], 1u); break; } }
    }
    nloc = mine > 0u ? mine : 1u; nx = cnt > 0u ? cnt : 1u;
}
__device__ __forceinline__ void xcd_barrier(const XcdBarrier& b) {
    asm volatile("s_waitcnt vmcnt(0)" ::: "memory");
    __syncthreads();
    if (threadIdx.x == 0) {
        unsigned* bar = b.bar;
        __builtin_amdgcn_s_waitcnt(0);
        unsigned nloc = b.st[0], nx = b.st[1];
        if (nloc == 0u) { xcd_barrier_complete(bar, b.x, nloc, nx); b.st[0] = nloc; b.st[1] = nx; }
        const unsigned old = xb_add(&bar[XB_XSUB(b.x)], 1u);
        const unsigned gen = old / nloc;
        if (old + 1u == (gen + 1u) * nloc) {
            __builtin_amdgcn_fence(__ATOMIC_RELEASE, "agent");
            asm volatile("s_waitcnt vmcnt(0)" ::: "memory");
            const unsigned og = xb_add(&bar[XB_TOP], 1u);
            const unsigned tg = og / nx;
            if (og + 1u == (tg + 1u) * nx) xb_add(&bar[XB_TOPGEN], 1u);
            else XB_SPIN(xb_ld(&bar[XB_TOPGEN]) == tg, bar);
            __builtin_amdgcn_fence(__ATOMIC_ACQUIRE, "agent");
            xb_add(&bar[XB_XGEN(b.x)], 1u);
            asm volatile("s_waitcnt vmcnt(0)" ::: "memory");
        } else {
            XB_SPIN(xb_ld(&bar[XB_XGEN(b.x)]) == gen, bar);
            __builtin_amdgcn_fence(__ATOMIC_ACQUIRE, "agent");
            asm volatile("s_waitcnt vmcnt(0)" ::: "memory");
        }
    }
    __syncthreads();
}

struct Frame {
    LAS unsigned char* lds;
    volatile LAS unsigned* MISC;
    gu32* ctl;
    int tid, lane, wave, vcu, G;
    const float *x, *norm_mix_w, *w_in, *ret_norm_w, *w_pool, *pool_scale, *w_out, *norm_ffn_w, *w_router, *b_router, *w_gu, *b_gu, *w_down, *b_down, *norm_final_w;
    float* out;
    bf16_t *Wr_hi, *Wr_lo, *Wpool_t, *Win_t, *Wout_t, *XN, *CAT, *U, *Z, *Y;
    unsigned char *Wgu8, *Wd8, *ACT8, *H8;
    le_t* list; float* ssq; float* PL; float* rs1;
    float lg2g0, lg2g1, lg2g2, lg2g3;
    __device__ __forceinline__ float lg2(int h) const { return h == 0 ? lg2g0 : (h == 1 ? lg2g1 : (h == 2 ? lg2g2 : lg2g3)); }
};

template <int MODE>
__device__ __forceinline__ void p0_item(const float* W, int ldw, void* WT, void* WT2, int ldo, LAS float* scr, int k0, int n0, int orow0, int lane) {
    f32x4 v[16];
    const float* src = W + (size_t)(k0 + (lane >> 3)) * ldw + n0 + 4 * (lane & 7);
#pragma unroll
    for (int i = 0; i < 16; ++i) v[i] = *(const GAS f32x4*)(src + (size_t)(8 * i) * ldw);
#pragma unroll
    for (int i = 0; i < 16; ++i) *(LAS f32x4*)(scr + (8 * i + (lane >> 3)) * 32 + 4 * ((lane & 7) ^ (i & 7))) = v[i];
    LDS_WAIT(); asm volatile("" ::: "memory");
    const int c = lane & 15, ns = lane >> 4;
#pragma unroll
    for (int J = 0; J < 8; ++J) {
        const LAS float* sp = scr + (8 * c) * 32 + 4 * (J ^ (c & 7)) + ns;
        float x[8];
#pragma unroll
        for (int q = 0; q < 8; ++q) x[q] = sp[q * 32];
        const int n = 4 * J + ns;
        if (MODE == 2) { u32x2 o; o.x = cvt4_fp8(x[0] * 32.f, x[1] * 32.f, x[2] * 32.f, x[3] * 32.f); o.y = cvt4_fp8(x[4] * 32.f, x[5] * 32.f, x[6] * 32.f, x[7] * 32.f);
            *(GAS u32x2*)((unsigned char*)WT + (size_t)(orow0 + n) * 1024 + k0 + 8 * c) = o; }
        else { u32x4 o; o.x = cvt_pk_bf16(x[0], x[1]); o.y = cvt_pk_bf16(x[2], x[3]); o.z = cvt_pk_bf16(x[4], x[5]); o.w = cvt_pk_bf16(x[6], x[7]);
            *(GAS u32x4*)((bf16_t*)WT + (size_t)(orow0 + n) * ldo + k0 + 8 * c) = o;
            if (MODE == 1) { u32x4 o2; o2.x = cvt_pk_bf16(x[0] - bf_lo(o.x), x[1] - bf_hi(o.x)); o2.y = cvt_pk_bf16(x[2] - bf_lo(o.y), x[3] - bf_hi(o.y));
                o2.z = cvt_pk_bf16(x[4] - bf_lo(o.z), x[5] - bf_hi(o.z)); o2.w = cvt_pk_bf16(x[6] - bf_lo(o.w), x[7] - bf_hi(o.w));
                *(GAS u32x4*)((bf16_t*)WT2 + (size_t)(orow0 + n) * ldo + k0 + 8 * c) = o2; } }
    }
    LDS_WAIT(); asm volatile("" ::: "memory");
}
__device__ __forceinline__ void rows4_to_bf16_rstd(int lane, const float* x, bf16_t* o, float* rs1, int m, int rs) {
    f32x4 v[4][4];
#pragma unroll
    for (int r = 0; r < 4; ++r) { const GAS f32x4* xr = (const GAS f32x4*)(x + (size_t)(m + r * rs) * D) + lane;
#pragma unroll
        for (int j = 0; j < 4; ++j) v[r][j] = __builtin_nontemporal_load(xr + 64 * j); }
#pragma unroll
    for (int r = 0; r < 4; ++r) { float s = 0.f;
#pragma unroll
        for (int j = 0; j < 4; ++j) s += (v[r][j].x * v[r][j].x + v[r][j].y * v[r][j].y) + (v[r][j].z * v[r][j].z + v[r][j].w * v[r][j].w);
        const float rstd = 1.f / sqrtf(wave_sum(s) * (1.f / D) + EPS);
        if (lane == 0) rs1[m + r * rs] = rstd;
        GAS u32x2* o8 = (GAS u32x2*)(o + (size_t)(m + r * rs) * D) + lane;
#pragma unroll
        for (int j = 0; j < 4; ++j) { u32x2 p; p.x = cvt_pk_bf16(v[r][j].x, v[r][j].y); p.y = cvt_pk_bf16(v[r][j].z, v[r][j].w); o8[64 * j] = p; } }
}
template <int MODE, class RM>
__device__ __forceinline__ void p0_block_item(const float* W, int ldw, void* WT, int ldo, LAS float* tile, int k0, int n0, int wave, int lane, RM rowmap, const float* ks = nullptr) {
    f32x4 v[16];
    const float* src = W + (size_t)(k0 + 16 * wave) * ldw + n0 + 4 * lane;
#pragma unroll
    for (int i = 0; i < 16; ++i) v[i] = __builtin_nontemporal_load((const GAS f32x4*)(src + (size_t)i * ldw));
#pragma unroll
    for (int i = 0; i < 16; ++i) { const int kl = 16 * wave + i; *(LAS f32x4*)(tile + kl * 256 + 4 * (lane ^ ((kl >> 3) & 7))) = v[i]; }
    __syncthreads();
    const int c = lane & 15, ns = lane >> 4;
    f32x4 ks0 = (f32x4){1.f, 1.f, 1.f, 1.f}, ks1 = ks0;
    if (ks) { ks0 = *(const f32x4*)(ks + k0 + 8 * c); ks1 = *(const f32x4*)(ks + k0 + 8 * c + 4); }
#pragma unroll
    for (int J = 0; J < 8; ++J) {
        const LAS float* sp = tile + (8 * c) * 256 + 4 * ((8 * wave + J) ^ (c & 7)) + ns;
        float x[8];
#pragma unroll
        for (int q = 0; q < 8; ++q) x[q] = sp[q * 256] * (q < 4 ? ks0[q] : ks1[q - 4]);
        const int orow = rowmap(n0 + 32 * wave + 4 * J + ns);
        if (MODE == 2) { u32x2 o; o.x = cvt4_fp8(x[0] * 32.f, x[1] * 32.f, x[2] * 32.f, x[3] * 32.f); o.y = cvt4_fp8(x[4] * 32.f, x[5] * 32.f, x[6] * 32.f, x[7] * 32.f);
            __builtin_nontemporal_store(o, (GAS u32x2*)((unsigned char*)WT + (size_t)orow * 1024 + k0 + 8 * c)); }
        else { u32x4 o; o.x = cvt_pk_bf16(x[0], x[1]); o.y = cvt_pk_bf16(x[2], x[3]); o.z = cvt_pk_bf16(x[4], x[5]); o.w = cvt_pk_bf16(x[6], x[7]);
            *(GAS u32x4*)((bf16_t*)WT + (size_t)orow * ldo + k0 + 8 * c) = o; }
    }
    __syncthreads();
}
struct RowId { __device__ __forceinline__ int operator()(int n) const { return n; } };
struct RowGU { __device__ __forceinline__ int operator()(int n) const { const int m = n & 1023; return ((m >> 7) << 8) + (n >> 10) * 128 + (m & 127); } };
__device__ __forceinline__ void p0_prologue(Frame& F) {
    LAS float* tile = (LAS float*)F.lds;
    constexpr int B_IN = 8 * 10, B_OUT = 8 * 4, NB = B_IN + B_OUT;
    for (int it = F.vcu; it < NB; it += F.G) {
        int r = it;
        if (r < B_IN) { const int kb = r / 10, nb = r % 10; p0_block_item<0>(F.w_in, DIN, F.Win_t, 1024, tile, kb * 128, nb * 256, F.wave, F.lane, RowId(), F.norm_mix_w); continue; } r -= B_IN;
        { const int kb = r >> 2, nb = r & 3; p0_block_item<0>(F.w_out, 1024, F.Wout_t, 1024, tile, kb * 128, nb * 256, F.wave, F.lane, RowId()); }
    }
    LAS float* scr = (LAS float*)(F.lds + F.wave * 16384);
    const int gw = F.vcu * NWAVES + F.wave, NGW = F.G * NWAVES;
    constexpr int I_POOL = 16, I_R = 8;
    for (int it = gw; it < I_POOL + I_R; it += NGW) {
        if (it < I_POOL) { const int g = it / 4, nb = it % 4; p0_item<0>(F.w_pool + g * 16384, 128, F.Wpool_t + g * 16384, nullptr, 128, scr, 0, nb * 32, nb * 32, F.lane); }
        else { const int kb = it - I_POOL; p0_item<1>(F.w_router, 32, F.Wr_hi, F.Wr_lo, 1024, scr, kb * 128, 0, 0, F.lane); }
    }
    for (int m = gw; m < NTOK / 4; m += NGW) rows4_to_bf16_rstd(F.lane, F.x, F.XN, F.rs1, m, NTOK / 4);
}

constexpr int CONV_GU = 32 * 8 * 8, CONV_ITEMS = CONV_GU + 32 * 8 * 4;
struct ConvItem { const float* src; unsigned char* dst; int ldw, k0, n0, gu; };
__device__ __forceinline__ ConvItem conv_decode(const Frame& F, int it) {
    ConvItem c;
    if (it < CONV_GU) { const int e = it >> 6, q = it & 63, kb = q >> 3, nb = q & 7; c.src = F.w_gu + (size_t)e * 1024 * 2048; c.dst = F.Wgu8 + (size_t)e * 2048 * 1024; c.ldw = 2048; c.k0 = kb * 128; c.n0 = nb * 256; c.gu = 1; }
    else { const int r = it - CONV_GU, e = r >> 5, q = r & 31, kb = q >> 2, nb = q & 3; c.src = F.w_down + (size_t)e * 1024 * 1024; c.dst = F.Wd8 + (size_t)e * 1024 * 1024; c.ldw = 1024; c.k0 = kb * 128; c.n0 = nb * 256; c.gu = 0; }
    return c;
}
__device__ __forceinline__ void conv_load(const ConvItem& c, int wave, int lane, f32x4 (&v)[16]) {
    const float* src = c.src + (size_t)(c.k0 + 16 * wave) * c.ldw + c.n0 + 4 * lane;
#pragma unroll
    for (int i = 0; i < 16; ++i) v[i] = __builtin_nontemporal_load((const GAS f32x4*)(src + (size_t)i * c.ldw));
}
__device__ __forceinline__ void conv_pull(Frame& F, int budget, int q) {
    if (budget <= 0) return;
    gu32* head = F.ctl + CW_Q + 64 * q; const int ibase = q ? CONV_GU : 0, iend = q ? CONV_ITEMS : CONV_GU;
    LAS float* tile = (LAS float*)F.lds;
    const int wave = F.wave, lane = F.lane, c16 = lane & 15, ns = lane >> 4;
    if (F.tid == 0) F.MISC[44] = atomicAdd((unsigned*)head, 1u);
    __syncthreads();
    int it = ibase + (int)F.MISC[44];
    if (it >= iend) return;
    ConvItem cur = conv_decode(F, it);
    f32x4 v[16]; conv_load(cur, wave, lane, v);
    for (int n = 0;; ++n) {
#pragma unroll
        for (int i = 0; i < 16; ++i) { const int kl = 16 * wave + i; *(LAS f32x4*)(tile + kl * 256 + 4 * (lane ^ ((kl >> 3) & 7))) = v[i]; }
        if (F.tid == 0) F.MISC[45 - (n & 1)] = (n + 1 < budget) ? atomicAdd((unsigned*)head, 1u) : (unsigned)CONV_ITEMS;
        __syncthreads();
        const int itn = ibase + (int)F.MISC[45 - (n & 1)];
        ConvItem nxt = cur;
        if (itn < iend) { nxt = conv_decode(F, itn); conv_load(nxt, wave, lane, v); }
#pragma unroll
        for (int J = 0; J < 8; ++J) {
            const LAS float* sp = tile + (8 * c16) * 256 + 4 * ((8 * wave + J) ^ (c16 & 7)) + ns;
            float x[8];
#pragma unroll
            for (int q = 0; q < 8; ++q) x[q] = sp[q * 256];
            const int nn = cur.n0 + 32 * wave + 4 * J + ns, orow = cur.gu ? RowGU()(nn) : nn;
            u32x2 o; o.x = cvt4_fp8(x[0] * 32.f, x[1] * 32.f, x[2] * 32.f, x[3] * 32.f); o.y = cvt4_fp8(x[4] * 32.f, x[5] * 32.f, x[6] * 32.f, x[7] * 32.f);
            __builtin_nontemporal_store(o, (GAS u32x2*)(cur.dst + (size_t)orow * 1024 + cur.k0 + 8 * c16));
        }
        __syncthreads();
        if (itn >= iend) break;
        cur = nxt;
    }
}

__device__ __forceinline__ void rope_cs(int pos, int j, float& cs, float& sn) {
    const float inv = __builtin_amdgcn_exp2f((float)j * (-13.287712379549449f / 64.0f));
    const double revd = (double)pos * (double)inv * 0.15915494309189535;
    const float rev = (float)(revd - __builtin_floor(revd));
    sn = __builtin_amdgcn_sinf(rev); cs = __builtin_amdgcn_cosf(rev);
}

__device__ __forceinline__ int tr_idx(int d, int m) { return d * 72 + 8 * ((m >> 3) ^ ((d >> 3) & 7)) + (m & 7); }
__device__ __forceinline__ int tr_frag(int r, int chunk) { return r * 72 + 8 * (chunk ^ ((r >> 3) & 7)); }

struct RawKV { u32x4 klo, khi, vlo, vhi; };
__device__ __forceinline__ void retA_load(const Frame& F, int unit, RawKV& r) {
    const int c = unit & 63, bh = unit >> 6, h = bh & 3, b = bh >> 2, m = F.tid >> 3, o = F.tid & 7;
    const bf16_t* zrow = F.Z + (size_t)(b * SEQ + c * 64 + m) * DIN + h * 128 + 8 * o;
    r.klo = *(const u32x4*)(zrow + 512); r.khi = *(const u32x4*)(zrow + 512 + 64); r.vlo = *(const u32x4*)(zrow + 1024); r.vhi = *(const u32x4*)(zrow + 1024 + 64);
}
__device__ __forceinline__ void retA_stage(const Frame& F, int unit, const RawKV& r) {
    const int c = unit & 63, h = (unit >> 6) & 3, m = F.tid >> 3, o = F.tid & 7;
    LAS bf16_t* KT = (LAS bf16_t*)(F.lds);
    LAS bf16_t* VT = KT + 128 * 72;
    const float ksc = __builtin_amdgcn_exp2f(F.lg2(h) * (float)(63 - m)) * 0.08838834764831845f;
    const int pos = c * 64 + m;
#pragma unroll
    for (int i = 0; i < 8; ++i) {
        const unsigned wl = r.klo[i >> 1], wh = r.khi[i >> 1];
        const float lo = (i & 1) ? bf_hi(wl) : bf_lo(wl), hi = (i & 1) ? bf_hi(wh) : bf_lo(wh);
        float cs, sn; rope_cs(pos, 8 * o + i, cs, sn);
        const unsigned pk = cvt_pk_bf16((lo * cs - hi * sn) * ksc, (lo * sn + hi * cs) * ksc);
        KT[tr_idx(8 * o + i, m)] = (bf16_t)(pk & 0xffffu); KT[tr_idx(64 + 8 * o + i, m)] = (bf16_t)(pk >> 16);
        const unsigned vl = r.vlo[i >> 1], vh = r.vhi[i >> 1];
        VT[tr_idx(8 * o + i, m)] = (bf16_t)((i & 1) ? (vl >> 16) : (vl & 0xffffu)); VT[tr_idx(64 + 8 * o + i, m)] = (bf16_t)((i & 1) ? (vh >> 16) : (vh & 0xffffu));
    }
}
__device__ __forceinline__ void retA_compute(const Frame& F, int unit) {
    LAS bf16_t* KT = (LAS bf16_t*)(F.lds); LAS bf16_t* VT = KT + 128 * 72;
    const int w = F.wave, fr = F.lane & 15, fq = F.lane >> 4;
    bf16x8 vf[2];
#pragma unroll
    for (int ks = 0; ks < 2; ++ks) vf[ks] = *(const LAS bf16x8*)(VT + tr_frag(16 * w + fr, 4 * ks + fq));
    bf16_t* urow = F.U + ((size_t)unit * 128 + 16 * w + fr) * 128 + 4 * fq;
#pragma unroll
    for (int dt = 0; dt < 8; ++dt) {
        f32x4 acc = (f32x4){0.f, 0.f, 0.f, 0.f};
#pragma unroll
        for (int ks = 0; ks < 2; ++ks) { const bf16x8 kf = *(const LAS bf16x8*)(KT + tr_frag(16 * dt + fr, 4 * ks + fq)); acc = mfma16(kf, vf[ks], acc); }
        u32x2 pk; pk.x = cvt_pk_bf16(acc[0], acc[1]); pk.y = cvt_pk_bf16(acc[2], acc[3]);
        *(u32x2*)(urow + 16 * dt) = pk;
    }
}
__device__ __forceinline__ void retA_phase(Frame& F) {
    int u = F.vcu; if (u >= 1024) return;
    RawKV raw; retA_load(F, u, raw);
    for (; u < 1024; u += F.G) {
        retA_stage(F, u, raw);
        if (u + F.G < 1024) retA_load(F, u + F.G, raw);
        __syncthreads();
        retA_compute(F, u);
        __syncthreads();
    }
}

__device__ __forceinline__ void pool_load(const Frame& F, int unit, u32x4 (&raw)[3]) {
    const int g = unit & 3, tile = unit >> 2, st = (tile & 63) * 64, tok0 = tile * 64;
#pragma unroll
    for (int j = 0; j < 3; ++j) { const int idx = F.tid + 512 * j, r = idx >> 4, ch = idx & 15, s = st - 15 + r;
        raw[j] = (u32x4){0u, 0u, 0u, 0u};
        if (idx < 79 * 16 && s >= 0) raw[j] = *(const u32x4*)(F.Z + (size_t)(tok0 - 15 + r) * DIN + 2048 + g * 128 + 8 * ch); }
}
__device__ __forceinline__ void pool_phase(Frame& F) {
    int u = F.vcu; if (u >= 1024) return;
    LAS float* P = (LAS float*)(F.lds);
    LAS bf16_t* A = (LAS bf16_t*)(F.lds + 79 * 132 * 4);
    const int t = F.tid, w = F.wave, rt = w & 3, chf = w >> 2, fr = F.lane & 15, fq = F.lane >> 4;
    const bool fixed_g = (F.G & 3) == 0;
    bf16x8 wf[4][4]; f32x4 sc[4];
    { const int g = u & 3; const bf16_t* wp = F.Wpool_t + g * 16384;
#pragma unroll
      for (int dd = 0; dd < 4; ++dd) { const int dt = 4 * chf + dd; sc[dd] = *(const f32x4*)(F.pool_scale + g * 128 + 16 * dt + 4 * fq);
#pragma unroll
          for (int ks = 0; ks < 4; ++ks) wf[dd][ks] = *(const bf16x8*)(wp + (16 * dt + fr) * 128 + 32 * ks + 8 * fq); } }
    u32x4 raw[3]; pool_load(F, u, raw);
    for (; u < 1024; u += F.G) {
        const int g = u & 3, tile = u >> 2, st = (tile & 63) * 64, tok0 = tile * 64, win = 2 << g;
        if (!fixed_g) { const bf16_t* wp = F.Wpool_t + g * 16384;
#pragma unroll
            for (int dd = 0; dd < 4; ++dd) { const int dt = 4 * chf + dd; sc[dd] = *(const f32x4*)(F.pool_scale + g * 128 + 16 * dt + 4 * fq);
#pragma unroll
                for (int ks = 0; ks < 4; ++ks) wf[dd][ks] = *(const bf16x8*)(wp + (16 * dt + fr) * 128 + 32 * ks + 8 * fq); } }
#pragma unroll
        for (int j = 0; j < 3; ++j) { const int idx = t + 512 * j, r = idx >> 4, ch = idx & 15;
            if (idx < 79 * 16) { const u32x4 x = raw[j];
                *(LAS f32x4*)(P + r * 132 + 8 * ch) = (f32x4){bf_lo(x.x), bf_hi(x.x), bf_lo(x.y), bf_hi(x.y)}; *(LAS f32x4*)(P + r * 132 + 8 * ch + 4) = (f32x4){bf_lo(x.z), bf_hi(x.z), bf_lo(x.w), bf_hi(x.w)}; } }
        if (u + F.G < 1024) pool_load(F, u + F.G, raw);
        __syncthreads();
        {
            const int c4 = t & 31, n0 = 4 * (t >> 5);
            const LAS float* pc = P + (15 + n0) * 132 + 4 * c4;
            f32x4 sum = (f32x4){0.f, 0.f, 0.f, 0.f};
            for (int j = 0; j < win; ++j) sum += *(const LAS f32x4*)(pc - j * 132);
#pragma unroll
            for (int i = 0; i < 4; ++i) {
                const f32x4 self = *(const LAS f32x4*)(pc + i * 132);
                if (i > 0) sum += self - *(const LAS f32x4*)(pc + (i - win) * 132);
                const int sp = st + n0 + i;
                const float rc = 1.0f / (float)((sp + 1 < win) ? (sp + 1) : win);
                const f32x4 pv = sum * rc - self;
                u32x2 pk; pk.x = cvt_pk_bf16(pv[0], pv[1]); pk.y = cvt_pk_bf16(pv[2], pv[3]);
                *(LAS u32x2*)(A + (n0 + i) * 136 + 4 * c4) = pk;
            }
        }
        __syncthreads();
        {
            bf16x8 af[4];
#pragma unroll
            for (int ks = 0; ks < 4; ++ks) af[ks] = *(const LAS bf16x8*)(A + (16 * rt + fr) * 136 + 32 * ks + 8 * fq);
            bf16_t* orow = F.CAT + (size_t)(tok0 + 16 * rt + fr) * D + 512 + g * 128;
#pragma unroll
            for (int dd = 0; dd < 4; ++dd) { const int dt = 4 * chf + dd;
                f32x4 acc = (f32x4){0.f, 0.f, 0.f, 0.f};
#pragma unroll
                for (int ks = 0; ks < 4; ++ks) acc = mfma16(wf[dd][ks], af[ks], acc);
                u32x2 pk; pk.x = cvt_pk_bf16(acc[0] * sc[dd][0], acc[1] * sc[dd][1]); pk.y = cvt_pk_bf16(acc[2] * sc[dd][2], acc[3] * sc[dd][3]);
                *(u32x2*)(orow + 16 * dt + 4 * fq) = pk;
            }
        }
        __syncthreads();
    }
}

struct RawQKV { u32x4 qlo, qhi, klo, khi, vlo, vhi; };
__device__ __forceinline__ void retB_load(const Frame& F, int unit, RawQKV& r) {
    const int c = unit & 63, bh = unit >> 6, h = bh & 3, b = bh >> 2, m = F.tid >> 3, o = F.tid & 7;
    const bf16_t* zrow = F.Z + (size_t)(b * SEQ + c * 64 + m) * DIN + h * 128 + 8 * o;
    r.qlo = *(const u32x4*)(zrow); r.qhi = *(const u32x4*)(zrow + 64); r.klo = *(const u32x4*)(zrow + 512); r.khi = *(const u32x4*)(zrow + 512 + 64); r.vlo = *(const u32x4*)(zrow + 1024); r.vhi = *(const u32x4*)(zrow + 1024 + 64);
}
__device__ __forceinline__ void retB_phase(Frame& F) {
    int unit = F.vcu; if (unit >= 1024) return;
    LAS bf16_t* Q = (LAS bf16_t*)(F.lds);
    LAS bf16_t* Kr = Q + 64 * 136;
    LAS bf16_t* VT = Kr + 64 * 136;
    LAS bf16_t* Sm = VT + 128 * 72;
    LAS float* red = (LAS float*)(Sm + 64 * 72);
    const int t = F.tid, w = F.wave, fr = F.lane & 15, fq = F.lane >> 4;
    RawQKV raw; retB_load(F, unit, raw);
    for (; unit < 1024; unit += F.G) {
        const int c = unit & 63, bh = unit >> 6, h = bh & 3, b = bh >> 2, tok0 = b * SEQ + c * 64;
        const float lg = F.lg2(h);
        const int rt = w & 3, chf = w >> 2, n = 16 * rt + fr;
        bf16x8 rf[4][4]; u32x2 gw2[4];
#pragma unroll
        for (int dd = 0; dd < 4; ++dd) { const bf16_t* rrow = F.U + ((size_t)unit * 128 + 16 * (4 * chf + dd) + fr) * 128 + 8 * fq;
#pragma unroll
            for (int ks = 0; ks < 4; ++ks) rf[dd][ks] = *(const bf16x8*)(rrow + 32 * ks);
            gw2[dd] = *(const u32x2*)(F.Z + (size_t)(tok0 + n) * DIN + 1536 + h * 128 + 16 * (4 * chf + dd) + 4 * fq); }
        {
            const int m = t >> 3, o = t & 7, pos = c * 64 + m;
            unsigned ql[4], qh[4], kl[4], kh[4];
#pragma unroll
            for (int i = 0; i < 8; i += 2) {
                float cs0, sn0, cs1, sn1; rope_cs(pos, 8 * o + i, cs0, sn0); rope_cs(pos, 8 * o + i + 1, cs1, sn1);
                { const float l0 = bf_lo(raw.qlo[i >> 1]), l1 = bf_hi(raw.qlo[i >> 1]), h0 = bf_lo(raw.qhi[i >> 1]), h1 = bf_hi(raw.qhi[i >> 1]);
                  ql[i >> 1] = cvt_pk_bf16(l0 * cs0 - h0 * sn0, l1 * cs1 - h1 * sn1); qh[i >> 1] = cvt_pk_bf16(l0 * sn0 + h0 * cs0, l1 * sn1 + h1 * cs1); }
                { const float l0 = bf_lo(raw.klo[i >> 1]), l1 = bf_hi(raw.klo[i >> 1]), h0 = bf_lo(raw.khi[i >> 1]), h1 = bf_hi(raw.khi[i >> 1]); const float sc = 0.08838834764831845f;
                  kl[i >> 1] = cvt_pk_bf16((l0 * cs0 - h0 * sn0) * sc, (l1 * cs1 - h1 * sn1) * sc); kh[i >> 1] = cvt_pk_bf16((l0 * sn0 + h0 * cs0) * sc, (l1 * sn1 + h1 * cs1) * sc); }
            }
            *(LAS u32x4*)(Q + m * 136 + 8 * o) = (u32x4){ql[0], ql[1], ql[2], ql[3]}; *(LAS u32x4*)(Q + m * 136 + 64 + 8 * o) = (u32x4){qh[0], qh[1], qh[2], qh[3]};
            *(LAS u32x4*)(Kr + m * 136 + 8 * o) = (u32x4){kl[0], kl[1], kl[2], kl[3]}; *(LAS u32x4*)(Kr + m * 136 + 64 + 8 * o) = (u32x4){kh[0], kh[1], kh[2], kh[3]};
#pragma unroll
            for (int i = 0; i < 8; ++i) { const unsigned vl = raw.vlo[i >> 1], vh = raw.vhi[i >> 1];
                VT[tr_idx(8 * o + i, m)] = (bf16_t)((i & 1) ? (vl >> 16) : (vl & 0xffffu)); VT[tr_idx(64 + 8 * o + i, m)] = (bf16_t)((i & 1) ? (vh >> 16) : (vh & 0xffffu)); }
        }
        if (unit + F.G < 1024) retB_load(F, unit + F.G, raw);
        __syncthreads();
        {
            const int ntl = w >> 1;
            bf16x8 qf[4];
#pragma unroll
            for (int ks = 0; ks < 4; ++ks) qf[ks] = *(const LAS bf16x8*)(Q + (16 * ntl + fr) * 136 + 32 * ks + 8 * fq);
#pragma unroll
            for (int mm = 0; mm < 2; ++mm) { const int mt = 2 * (w & 1) + mm;
                f32x4 acc = (f32x4){0.f, 0.f, 0.f, 0.f};
#pragma unroll
                for (int ks = 0; ks < 4; ++ks) { const bf16x8 kf = *(const LAS bf16x8*)(Kr + (16 * mt + fr) * 136 + 32 * ks + 8 * fq); acc = mfma16(kf, qf[ks], acc); }
                const int nn = 16 * ntl + fr, m0 = 16 * mt + 4 * fq;
                float sv[4];
#pragma unroll
                for (int j = 0; j < 4; ++j) { const int dd = nn - (m0 + j); sv[j] = acc[j] * __builtin_amdgcn_exp2f(lg * (float)(dd < 0 ? -dd : dd)); }
                u32x2 pk; pk.x = cvt_pk_bf16(sv[0], sv[1]); pk.y = cvt_pk_bf16(sv[2], sv[3]);
                *(LAS u32x2*)(Sm + nn * 72 + m0) = pk;
            }
        }
        __syncthreads();
        {
            bf16x8 sf[2], qf[4];
#pragma unroll
            for (int ks = 0; ks < 2; ++ks) sf[ks] = *(const LAS bf16x8*)(Sm + n * 72 + 32 * ks + 8 * fq);
#pragma unroll
            for (int ks = 0; ks < 4; ++ks) qf[ks] = *(const LAS bf16x8*)(Q + n * 136 + 32 * ks + 8 * fq);
            const float qd = __builtin_amdgcn_exp2f(lg * (float)(n + 1));
            f32x4 ov[4]; float ss = 0.f;
#pragma unroll
            for (int dd = 0; dd < 4; ++dd) { const int vt = 4 * chf + dd;
                f32x4 ai = (f32x4){0.f, 0.f, 0.f, 0.f}, ac = ai;
#pragma unroll
                for (int ks = 0; ks < 2; ++ks) { const bf16x8 vf = *(const LAS bf16x8*)(VT + tr_frag(16 * vt + fr, 4 * ks + fq)); ai = mfma16(vf, sf[ks], ai); }
#pragma unroll
                for (int ks = 0; ks < 4; ++ks) ac = mfma16(rf[dd][ks], qf[ks], ac);
                ov[dd] = ai + ac * qd;
                ss += (ov[dd][0] * ov[dd][0] + ov[dd][1] * ov[dd][1]) + (ov[dd][2] * ov[dd][2] + ov[dd][3] * ov[dd][3]);
            }
            ss += __shfl_xor(ss, 16); ss += __shfl_xor(ss, 32);
            if (fq == 0) red[chf * 64 + n] = ss;
            __syncthreads();
            const float rstd = 1.f / sqrtf((red[n] + red[64 + n]) * (1.f / 128.f) + EPS);
            const size_t tok = (size_t)(tok0 + n);
#pragma unroll
            for (int dd = 0; dd < 4; ++dd) { const int v0 = 16 * (4 * chf + dd) + 4 * fq;
                const f32x4 rw = *(const f32x4*)(F.ret_norm_w + h * 128 + v0);
                const float gv[4] = {bf_lo(gw2[dd].x), bf_hi(gw2[dd].x), bf_lo(gw2[dd].y), bf_hi(gw2[dd].y)};
                float r[4];
#pragma unroll
                for (int j = 0; j < 4; ++j) { const float sg = gv[j] * __builtin_amdgcn_rcpf(1.0f + __builtin_amdgcn_exp2f(-1.4426950408889634f * gv[j])); r[j] = ov[dd][j] * rstd * rw[j] * sg; }
                u32x2 pk; pk.x = cvt_pk_bf16(r[0], r[1]); pk.y = cvt_pk_bf16(r[2], r[3]);
                *(u32x2*)(F.CAT + tok * D + h * 128 + v0) = pk;
            }
        }
        __syncthreads();
    }
}

struct Args { const float* in[15]; float* out; unsigned char* ws; float lg2g[4]; int ph_lo, ph_hi, li, pad; };

__global__ void __launch_bounds__(NWAVES * 64, 2) fwd_kernel(Args args) {
    extern __shared__ __attribute__((aligned(16))) unsigned char lds[];
    Frame F;
    F.lds = (LAS unsigned char*)lds;
    F.MISC = (volatile LAS unsigned*)(F.lds + MISC_OFF);
    F.tid = threadIdx.x; F.lane = F.tid & 63; F.wave = __builtin_amdgcn_readfirstlane(F.tid >> 6);
    F.G = gridDim.x; { const int bx = blockIdx.x; F.vcu = (F.G % 8 == 0) ? (bx % 8) * (F.G / 8) + bx / 8 : bx; }
#define REFRESH() do { const __attribute__((address_space(4))) Args* A_ = (const __attribute__((address_space(4))) Args*)__builtin_amdgcn_kernarg_segment_ptr(); asm volatile("" : "+s"(A_)); \
    unsigned char* ws_ = A_->ws; F.ctl = (gu32*)(ws_ + WS_CTL); \
    F.x = A_->in[0]; F.norm_mix_w = A_->in[1]; F.w_in = A_->in[2]; F.ret_norm_w = A_->in[3]; F.w_pool = A_->in[4]; F.pool_scale = A_->in[5]; F.w_out = A_->in[6]; F.norm_ffn_w = A_->in[7]; \
    F.w_router = A_->in[8]; F.b_router = A_->in[9]; F.w_gu = A_->in[10]; F.b_gu = A_->in[11]; F.w_down = A_->in[12]; F.b_down = A_->in[13]; F.norm_final_w = A_->in[14]; F.out = A_->out; \
    F.Wr_hi = (bf16_t*)(ws_ + WS_WR); F.Wr_lo = F.Wr_hi + 32 * 1024; F.Wpool_t = (bf16_t*)(ws_ + WS_WPOOL); F.Win_t = (bf16_t*)(ws_ + WS_WIN); F.Wout_t = (bf16_t*)(ws_ + WS_WOUT); \
    F.XN = (bf16_t*)(ws_ + WS_XN); F.CAT = (bf16_t*)(ws_ + WS_CAT); F.U = (bf16_t*)(ws_ + WS_U); F.Z = (bf16_t*)(ws_ + WS_Z); F.Y = (bf16_t*)(ws_ + WS_Y); \
    F.Wgu8 = ws_ + WS_WGU; F.Wd8 = ws_ + WS_WD; F.ACT8 = ws_ + WS_ACT; F.H8 = ws_ + WS_Z; F.rs1 = (float*)(ws_ + WS_RS1); F.list = (le_t*)(ws_ + WS_LIST); F.ssq = (float*)(ws_ + WS_SSQ); F.PL = (float*)(ws_ + WS_PL); \
    F.lg2g0 = A_->lg2g[0]; F.lg2g1 = A_->lg2g[1]; F.lg2g2 = A_->lg2g[2]; F.lg2g3 = A_->lg2g[3]; \
    { int t_ = threadIdx.x; asm volatile("" : "+v"(t_)); F.tid = t_; F.lane = t_ & 63; } } while (0)
    REFRESH();
    for (int u = F.tid; u < (LDS_BYTES - LDSCTL_OFF) / 4; u += NWAVES * 64) ((LAS unsigned*)(F.lds + LDSCTL_OFF))[u] = 0u;
    __syncthreads();
    XcdBarrier bar; bar.bar = (unsigned*)(F.ctl + CW_BAR); bar.x = 0; bar.st = nullptr;
    if (N_LAUNCHES != PER_PHASE) bar = xcd_barrier_post((unsigned*)(F.ctl + CW_BAR), F.MISC + 8);
    int n_stamp = 0;
#define STAMP() do { if (DBG_SPIN_A >= 0) { if (F.tid == 0) { const unsigned long long _t = __builtin_amdgcn_s_memrealtime(); F.MISC[16 + 2 * n_stamp] = (unsigned)_t; F.MISC[17 + 2 * n_stamp] = (unsigned)(_t >> 32); } ++n_stamp; } } while (0)
    STAMP();
#define GRID_BAR() do { if (N_LAUNCHES != PER_PHASE) xcd_barrier(bar); STAMP(); } while (0)
    const int lo = DBG_ONLY9 ? (args.ph_lo < 9 ? 9 : args.ph_lo) : args.ph_lo, hi = args.ph_hi;
#define IN(k) (lo <= (k) && (k) < hi)
#define BOTH(k) (IN(k) && IN((k) + 1))
    const int gw = F.vcu * NWAVES + F.wave, NGW = F.G * NWAVES;

    if (IN(0)) { REFRESH(); p0_prologue(F); conv_pull(F, CONV_GU, 0); if (BOTH(0)) GRID_BAR(); }

    if (IN(1)) {
        REFRESH();
        pg8::DenseSched S; S.init(F.XN, F.Win_t, NTOK, DIN, F.G, (int)blockIdx.x);
        pg8::EpiBf16 E{F.Z, DIN, F.rs1};
        pg8::gemm_phase<pg8::EpiBf16, pg8::DenseSched, true>(F.lds, S, E);
        { const int mine = (S.nwg - (int)blockIdx.x + F.G - 1) / F.G, most = (S.nwg + F.G - 1) / F.G; if (mine < most) conv_pull(F, 5 * (most - mine), 1); }
        if (BOTH(1)) GRID_BAR();
    }

    if (IN(2)) {
        REFRESH();
        retA_phase(F);
        pool_phase(F);
        if (BOTH(2)) GRID_BAR();
    }

    if (IN(3) && DBG_STAGE != 4) {
        REFRESH();
        const int gt = F.vcu * 512 + F.tid, NGT = F.G * 512;
        for (int p = gt; p < 16 * 8192; p += NGT) {
            const int bh = p >> 13, i = p & 8191;
            const float cd = __builtin_amdgcn_exp2f(F.lg2(bh & 3) * 64.0f);
            unsigned* up = (unsigned*)(F.U + (size_t)bh * 64 * 16384) + i;
            float s0 = 0.f, s1 = 0.f;
#pragma unroll
            for (int cb = 0; cb < 64; cb += 32) {
                unsigned uw[32];
#pragma unroll
                for (int c = 0; c < 32; ++c) uw[c] = up[(size_t)(cb + c) * 8192];
#pragma unroll
                for (int c = 0; c < 32; ++c) { up[(size_t)(cb + c) * 8192] = cvt_pk_bf16(s0, s1); s0 = cd * s0 + bf_lo(uw[c]); s1 = cd * s1 + bf_hi(uw[c]); }
            }
        }
        if (BOTH(3)) GRID_BAR();
    }

    if (IN(4) && DBG_STAGE != 4) {
        REFRESH();
        retB_phase(F);
        if (BOTH(4)) GRID_BAR();
    }

    if (IN(5) && !DBG_STAGE) {
        REFRESH();
        pg8::DenseSched S; S.init(F.CAT, F.Wout_t, NTOK, D, F.G, (int)blockIdx.x);
        pg8::EpiX1 E{F.XN, F.out, F.ssq, F.PL, F.H8, F.norm_ffn_w, F.Wr_hi, F.Wr_lo, S.nwg == F.G};
        pg8::gemm_phase<pg8::EpiX1, pg8::DenseSched, false>(F.lds, S, E);
        if (BOTH(5)) GRID_BAR();
    }

    if (IN(6) && !DBG_SKIP_Y) {
        REFRESH();
        if (gw == 0) { GAS u32x4* z = (GAS u32x4*)(F.H8 + (size_t)NTOK * D) + F.lane; z[0] = (u32x4){0u, 0u, 0u, 0u}; }
        LAS unsigned* lcnt = (LAS unsigned*)(F.lds);
        LAS unsigned* lbase = lcnt + 32;
        if (F.tid < 32) lcnt[F.tid] = 0u;
        __syncthreads();
        const int half = F.lane >> 5, e = F.lane & 31;
        const float be = F.b_router[e];
        constexpr int MAXJ = 4;
        const int nsl = ((NTOK / 256) * (D / 256) == F.G) ? 4 : 16;
        for (int base = 0; base < NTOK / 2; base += NGW * MAXJ) {
            int srank[MAXJ], slp[MAXJ], srow[MAXJ]; float sgate[MAXJ], srstd[MAXJ];
#pragma unroll
            for (int j = 0; j < MAXJ; ++j) {
                const int rp = base + gw + NGW * j; srank[j] = -1; slp[j] = 0; srow[j] = 0; sgate[j] = 0.f; srstd[j] = 0.f;
                if (rp < NTOK / 2) {
                    const int row = 2 * rp + half;
                    float lg = 0.f, ss = 0.f;
                    if (nsl == 4) {
#pragma unroll
                        for (int p = 0; p < 4; ++p) lg += F.PL[((size_t)p * NTOK + row) * 32 + e];
                        if ((F.lane & 15) < 4) ss = F.ssq[(size_t)(F.lane & 15) * NTOK + row];
                    } else {
#pragma unroll
                        for (int p = 0; p < 16; ++p) lg += F.PL[((size_t)p * NTOK + row) * 32 + e];
                        ss = F.ssq[(size_t)(F.lane & 15) * NTOK + row];
                    }
                    ss += __shfl_xor(ss, 1); ss += __shfl_xor(ss, 2); ss += __shfl_xor(ss, 4); ss += __shfl_xor(ss, 8);
                    const float rstd = 1.f / sqrtf(ss * (1.f / D) + EPS);
                    float cur = lg * rstd + be;
                    float tv[4]; int ti[4]; int myrank = -1;
#pragma unroll
                    for (int k = 0; k < 4; ++k) {
                        float bv = cur; int bi = e;
#pragma unroll
                        for (int off = 16; off >= 1; off >>= 1) { const float ov = __shfl_xor(bv, off); const int oi = __shfl_xor(bi, off); if (ov > bv || (ov == bv && oi < bi)) { bv = ov; bi = oi; } }
                        tv[k] = bv; ti[k] = bi;
                        if (e == bi) { cur = -3.0e38f; myrank = k; }
                    }
                    (void)ti;
                    const float e1 = __expf(tv[1] - tv[0]), e2 = __expf(tv[2] - tv[0]), e3 = __expf(tv[3] - tv[0]), inv = 1.0f / (1.0f + e1 + e2 + e3);
                    if (myrank >= 0) {
                        srank[j] = myrank; srow[j] = row; srstd[j] = rstd;
                        sgate[j] = (myrank == 0 ? 1.0f : myrank == 1 ? e1 : myrank == 2 ? e2 : e3) * inv;
                        slp[j] = (int)__hip_atomic_fetch_add(lcnt + e, 1u, __ATOMIC_RELAXED, __HIP_MEMORY_SCOPE_WORKGROUP);
                    }
                }
            }
            __syncthreads();
            if (F.tid < 32) { const unsigned n = lcnt[F.tid]; lbase[F.tid] = n ? atomicAdd((unsigned*)(F.ctl + CW_CNT + 64 * F.tid), n) : 0u; }
            __syncthreads();
#pragma unroll
            for (int j = 0; j < MAXJ; ++j)
                if (srank[j] >= 0) F.list[e * LISTCAP + (int)lbase[e] + slp[j]] = (le_t){srow[j] * 4 + srank[j], __float_as_int(sgate[j]), __float_as_int(srstd[j]), 0};
            __syncthreads();
            if (F.tid < 32) lcnt[F.tid] = 0u;
            __syncthreads();
        }
        if (BOTH(6)) GRID_BAR();
    }

    if ((IN(7) || IN(8)) && !DBG_SKIP_Y) {
        REFRESH();
        LAS int* tab = (LAS int*)(F.lds + TAB_OFF);
        if (F.tid < 32) tab[F.tid] = (int)__hip_atomic_load(F.ctl + CW_CNT + 64 * F.tid, RLX_AGENT);
        __syncthreads();
        if (F.tid == 0) { int s = 0; for (int e = 0; e < 32; ++e) { tab[32 + e] = s; s += (tab[e] + 255) >> 8; } tab[64] = s; }
        __syncthreads();
    }
    if (IN(7) && !DBG_SKIP_Y) {
        REFRESH();
        pg8::MoeSched<true> S; S.init((const bf16_t*)F.H8, (const bf16_t*)F.Wgu8, F.list, F.b_gu, (const LAS int*)(F.lds + TAB_OFF), F.G, (int)blockIdx.x);
        pg8::EpiGU E{F.ACT8};
        pg8::gemm_phase<pg8::EpiGU, pg8::MoeSched<true>, true, true>(F.lds, S, E);
        { const int mine = (S.nwg - (int)blockIdx.x + F.G - 1) / F.G, most = (S.nwg + F.G - 1) / F.G; if (mine < most) conv_pull(F, 3 * (most - mine), 1); }
        conv_pull(F, CONV_ITEMS, 1);
        if (BOTH(7)) GRID_BAR();
    }
    if (IN(8) && !DBG_SKIP_Y) {
        REFRESH();
        pg8::MoeSched<false> S; S.init((const bf16_t*)F.ACT8, (const bf16_t*)F.Wd8, F.list, F.b_down, (const LAS int*)(F.lds + TAB_OFF), F.G, (int)blockIdx.x);
        pg8::EpiDown E{(unsigned char*)F.Y};
        pg8::gemm_phase<pg8::EpiDown, pg8::MoeSched<false>, true, true>(F.lds, S, E);
        if (BOTH(8)) GRID_BAR();
    }
    if (IN(9) && DBG_STAGE) {
        REFRESH();
        for (int m = gw; m < NTOK; m += NGW) {
            const bf16_t* src = DBG_STAGE == 1 ? F.XN + (size_t)m * D : DBG_STAGE == 2 ? F.Z + (size_t)m * DIN + 1024 : DBG_STAGE == 3 ? F.CAT + (size_t)m * D : F.U + (size_t)m * D;
            for (int j = F.lane; j < D; j += 64) F.out[(size_t)m * D + j] = __uint_as_float(((unsigned)src[j]) << 16);
        }
    }
    if (IN(9) && !DBG_STAGE) {
        REFRESH();
        for (int m = gw; m < NTOK; m += NGW) {
            const GAS f32x4* xr = (const GAS f32x4*)((DBG_ONLY9 ? F.x : F.out) + (size_t)m * D) + F.lane; const GAS f32x4* wr = (const GAS f32x4*)F.norm_final_w + F.lane;
            f32x4 v[4]; float s = 0.f;
            if (DBG_ONLY9) {
#pragma unroll
            for (int j = 0; j < 4; ++j) v[j] = xr[64 * j];
            } else { const GAS u32x2* xb = (const GAS u32x2*)(F.out + (size_t)m * D) + F.lane;
#pragma unroll
            for (int j = 0; j < 4; ++j) { const u32x2 x = xb[64 * j]; v[j] = (f32x4){bf_lo(x.x), bf_hi(x.x), bf_lo(x.y), bf_hi(x.y)}; } }
#pragma unroll
            for (int k = 0; k < (DBG_SKIP_Y ? 0 : 4); ++k) { const GAS unsigned* yr = (const GAS unsigned*)((const unsigned char*)F.Y + ((size_t)m * 4 + k) * D) + F.lane;
#pragma unroll
                for (int j = 0; j < 4; ++j) { const unsigned y = __builtin_nontemporal_load(yr + 64 * j);
                    const f32x2 lo = __builtin_amdgcn_cvt_pk_f32_fp8((int)y, false), hi = __builtin_amdgcn_cvt_pk_f32_fp8((int)y, true); v[j] += (f32x4){lo[0], lo[1], hi[0], hi[1]} * 0.0625f; } }
#pragma unroll
            for (int j = 0; j < 4; ++j) s += (v[j].x * v[j].x + v[j].y * v[j].y) + (v[j].z * v[j].z + v[j].w * v[j].w);
            const float rstd = 1.f / sqrtf(wave_sum(s) * (1.f / D) + EPS);
            GAS f32x4* orow = (GAS f32x4*)(F.out + (size_t)m * D) + F.lane;
#pragma unroll
            for (int j = 0; j < 4; ++j) __builtin_nontemporal_store(v[j] * rstd * wr[64 * j], orow + 64 * j);
        }
    }
    if (DBG_SPIN_A >= 0) { STAMP();
        if (blockIdx.x == 0 && F.tid == 0) {
            const unsigned long long ta = ((unsigned long long)F.MISC[17 + 2 * DBG_SPIN_A] << 32) | F.MISC[16 + 2 * DBG_SPIN_A], tb = ((unsigned long long)F.MISC[17 + 2 * DBG_SPIN_B] << 32) | F.MISC[16 + 2 * DBG_SPIN_B];
            const unsigned long long t0 = __builtin_amdgcn_s_memrealtime(), want = (tb - ta) * DBG_SPIN_W;
            while (__builtin_amdgcn_s_memrealtime() - t0 < want) __builtin_amdgcn_s_sleep(8);
        } }
#undef IN
#undef BOTH
#undef GRID_BAR
#undef STAMP
#undef REFRESH
}

extern "C" void kernel_launch(void* const* d_in, const int* in_sizes, int n_in, void* d_out, int out_size, void* d_ws, size_t ws_size, hipStream_t stream) {
    static int grid = 0;
    if (grid == 0) {
        if (n_in != 15 || in_sizes[0] != NTOK * D || out_size != NTOK * D || ws_size < WS_END) { fprintf(stderr, "kernel_launch: unexpected shapes / workspace (n_in %d, ws %zu); nothing launched\n", n_in, ws_size); grid = -1; return; }
        int dev = 0, cus = 0, per_cu = 0;
        if (hipGetDevice(&dev) != hipSuccess || hipDeviceGetAttribute(&cus, hipDeviceAttributeMultiprocessorCount, dev) != hipSuccess) { grid = -1; return; }
        if (hipFuncSetAttribute((const void*)fwd_kernel, hipFuncAttributeMaxDynamicSharedMemorySize, LDS_BYTES) != hipSuccess) { fprintf(stderr, "kernel_launch: hipFuncSetAttribute failed\n"); grid = -1; return; }
        if (hipOccupancyMaxActiveBlocksPerMultiprocessor(&per_cu, (const void*)fwd_kernel, NWAVES * 64, LDS_BYTES) != hipSuccess || per_cu < 1)
            fprintf(stderr, "kernel_launch: note: occupancy query reports %d workgroups per CU\n", per_cu);
        (void)hipGetLastError();
        grid = cus;
    }
    if (grid < 0) return;
    if (hipMemsetAsync((char*)d_ws + WS_CTL, 0, CTL_ZERO_BYTES, stream) != hipSuccess) { fprintf(stderr, "kernel_launch: memset failed\n"); return; }
    Args a{};
    for (int i = 0; i < 15; ++i) a.in[i] = (const float*)d_in[i];
    a.out = (float*)d_out; a.ws = (unsigned char*)d_ws;
    for (int h = 0; h < 4; ++h) a.lg2g[h] = (float)(log1p(-exp2(-5.0 - (double)h)) / log(2.0));
    for (int li = 0; li < N_LAUNCHES; ++li) {
        a.ph_lo = (N_LAUNCHES == PER_PHASE) ? li : 0; a.ph_hi = (N_LAUNCHES == PER_PHASE) ? li + 1 : PER_PHASE; a.li = li; a.pad = 0;
        hipLaunchKernelGGL(fwd_kernel, dim3(grid), dim3(NWAVES * 64), LDS_BYTES, stream, a);
        const hipError_t le = hipPeekAtLastError();
        if (le != hipSuccess) { fprintf(stderr, "kernel_launch: launch %d failed: %s\n", li, hipGetErrorName(le)); break; }
    }
}
```
